# Optimizing an MI355X kernel written in HIP

```python
import math
import jax, jax.numpy as jnp
from jax import lax
import numpy as np

D_MODEL = 1024
BATCH = 16
SEQ = 2048
DEPTH = 2

MEM_LEN = 256
GDN_HEADS = 4
GDN_DK = 128
GDN_DV = 128
GDN_QK = GDN_HEADS * GDN_DK
GDN_V = GDN_HEADS * GDN_DV
GDN_CONV = 4
GDN_CHUNK = 64
FOX_HEADS = 8
FOX_DH = 64
FOX_W = FOX_HEADS * FOX_DH
FOX_BLOCK = 128
GLA_HEADS = 4
GLA_DK = 64
GLA_DV = 128
GLA_QK = GLA_HEADS * GLA_DK
GLA_V = GLA_HEADS * GLA_DV
GLA_RANK = 16
GLA_TAU = 16.0
GLA_CHUNK = 64
N_BRANCH = 3
XA_HEADS = 4
XA_DH = D_MODEL // XA_HEADS
MOE_GROUPS = 4
MOE_PER_GROUP = 8
MOE_EXPERTS = MOE_GROUPS * MOE_PER_GROUP
MOE_TOPK = 2
MOE_FF = D_MODEL // 4
MOE_BLOCK = 256
DEEPNORM_ALPHA = (2 * DEPTH) ** 0.25
DEEPNORM_BETA = (8 * DEPTH) ** -0.25
LN_EPS = 1e-5
RMS_EPS = 1e-6
IN_SPLITS = (2 * GDN_QK + GDN_V, GDN_HEADS, GDN_HEADS, GDN_V,
             3 * FOX_W, FOX_HEADS,
             GLA_QK, GLA_QK, GLA_V, GLA_V, GLA_RANK,
             N_BRANCH * D_MODEL)
N_IN = sum(IN_SPLITS)

kernel_name = 'hybrid_gdn_fox_gla_hmoe_block'

F32 = jnp.float32


def layer_norm(x, g, b):
    xf = x.astype(F32)
    mu = jnp.mean(xf, axis=-1, keepdims=True)
    var = jnp.mean(jnp.square(xf - mu), axis=-1, keepdims=True)
    return ((xf - mu) * lax.rsqrt(var + LN_EPS) * g.astype(F32) + b.astype(F32)).astype(x.dtype)


def rms_norm(x, w):
    xf = x.astype(F32)
    return (xf * lax.rsqrt(jnp.mean(xf * xf, axis=-1, keepdims=True) + RMS_EPS) * w.astype(F32)).astype(x.dtype)


def l2_normalize(x):
    xf = x.astype(F32)
    return (xf * lax.rsqrt(jnp.sum(xf * xf, axis=-1, keepdims=True) + RMS_EPS)).astype(x.dtype)


def causal_depthwise_conv(x, w):
    width, s = w.shape[0], x.shape[1]
    xp = jnp.pad(x, ((0, 0), (width - 1, 0), (0, 0)))
    return sum(xp[:, i:i + s, :] * w[i] for i in range(width))


def _to_chunks(t, n, c):
    b, s, h = t.shape[:3]
    t = t.astype(F32).reshape((b, n, c, h) + t.shape[3:])
    return jnp.moveaxis(t, 3, 1)


def gated_delta_rule_chunked(q, k, v, g, beta):
    out_dtype = v.dtype
    bsz, s, h, dk = q.shape
    dv = v.shape[-1]
    c = GDN_CHUNK
    n = s // c
    q = _to_chunks(q, n, c) * (dk ** -0.5)
    k = _to_chunks(k, n, c)
    v = _to_chunks(v, n, c)
    g = jnp.cumsum(_to_chunks(g, n, c), axis=-1)
    beta = _to_chunks(beta, n, c)
    causal = jnp.tril(jnp.ones((c, c), bool))
    strict = jnp.tril(jnp.ones((c, c), bool), -1)
    diff = g[..., :, None] - g[..., None, :]
    decay = jnp.where(causal, jnp.exp(jnp.where(causal, diff, 0.0)), 0.0)
    k_beta = k * beta[..., None]
    lower = jnp.where(strict, jnp.einsum('bhnid,bhnjd->bhnij', k_beta, k) * decay, 0.0)
    eye = jnp.eye(c, dtype=F32)
    t_inv = lax.linalg.triangular_solve(eye + lower, jnp.broadcast_to(eye, lower.shape),
                                        left_side=True, lower=True, unit_diagonal=True)
    u = jnp.einsum('bhnij,bhnje->bhnie', t_inv, v * beta[..., None])
    w = jnp.einsum('bhnij,bhnjd->bhnid', t_inv, k_beta * jnp.exp(g)[..., None])
    attn = jnp.where(causal, jnp.einsum('bhnid,bhnjd->bhnij', q, k) * decay, 0.0)
    q_dec = q * jnp.exp(g)[..., None]
    k_dec = k * jnp.exp(g[..., -1:] - g)[..., None]
    chunk_decay = jnp.exp(g[..., -1])

    def step(state, xs):
        attn_c, u_c, w_c, qd_c, kd_c, cd_c = xs
        v_new = u_c - jnp.einsum('bhcd,bhde->bhce', w_c, state)
        out = jnp.einsum('bhcd,bhde->bhce', qd_c, state) + jnp.einsum('bhij,bhje->bhie', attn_c, v_new)
        state = state * cd_c[..., None, None] + jnp.einsum('bhcd,bhce->bhde', kd_c, v_new)
        return state, out

    xs = tuple(jnp.moveaxis(t, 2, 0) for t in (attn, u, w, q_dec, k_dec, chunk_decay))
    _, out = lax.scan(step, jnp.zeros((bsz, h, dk, dv), F32), xs)
    return jnp.transpose(out, (1, 0, 3, 2, 4)).reshape(bsz, s, h, dv).astype(out_dtype)


def gla_chunked(q, k, v, log_a):
    out_dtype = v.dtype
    bsz, s, h, dk = q.shape
    dv = v.shape[-1]
    c = GLA_CHUNK
    n = s // c
    q = _to_chunks(q, n, c) * (dk ** -0.5)
    k = _to_chunks(k, n, c)
    v = _to_chunks(v, n, c)
    cum = jnp.cumsum(_to_chunks(log_a, n, c), axis=3)
    q_t = q * jnp.exp(cum)
    k_t = k * jnp.exp(-cum)
    causal = jnp.tril(jnp.ones((c, c), bool))
    attn = jnp.where(causal, jnp.einsum('bhnid,bhnjd->bhnij', q_t, k_t), 0.0)
    intra = jnp.einsum('bhnij,bhnje->bhnie', attn, v)
    k_dec = k * jnp.exp(cum[..., -1:, :] - cum)
    chunk_decay = jnp.exp(cum[..., -1, :])

    def step(state, xs):
        qt_c, kd_c, v_c, cd_c = xs
        out = jnp.einsum('bhcd,bhde->bhce', qt_c, state)
        state = state * cd_c[..., None] + jnp.einsum('bhcd,bhce->bhde', kd_c, v_c)
        return state, out

    xs = tuple(jnp.moveaxis(t, 2, 0) for t in (q_t, k_dec, v, chunk_decay))
    _, inter = lax.scan(step, jnp.zeros((bsz, h, dk, dv), F32), xs)
    out = intra + jnp.moveaxis(inter, 0, 2)
    return jnp.transpose(out, (0, 2, 3, 1, 4)).reshape(bsz, s, h, dv).astype(out_dtype)


def forgetting_attention(q, k, v, log_f):
    bsz, s, h, dh = q.shape
    nb = s // FOX_BLOCK
    cum_k = jnp.transpose(jnp.cumsum(log_f.astype(F32), axis=1), (0, 2, 1))
    kf = k.astype(F32)
    q_blocks = jnp.moveaxis(q.astype(F32).reshape(bsz, nb, FOX_BLOCK, h, dh), 1, 0)
    c_blocks = jnp.moveaxis(cum_k.reshape(bsz, h, nb, FOX_BLOCK), 2, 0)
    key_pos = jnp.arange(s)

    def block(args):
        q_blk, c_blk, start = args
        logits = (jnp.einsum('bqhd,bkhd->bhqk', q_blk, kf) * (dh ** -0.5)
                  + c_blk[..., :, None] - cum_k[:, :, None, :])
        query_pos = start + jnp.arange(FOX_BLOCK)
        logits = jnp.where(key_pos[None, :] <= query_pos[:, None], logits, -jnp.inf)
        p = jax.nn.softmax(logits, axis=-1)
        return jnp.einsum('bhqk,bkhd->bqhd', p.astype(v.dtype), v)

    out = lax.map(block, (q_blocks, c_blocks, jnp.arange(nb) * FOX_BLOCK))
    return jnp.moveaxis(out, 0, 1).reshape(bsz, s, h, dh)


def hybrid_token_mixer(x, w_in, gdn_conv_w, gdn_a_log, gdn_dt_bias, gdn_norm_w, fox_f_bias,
                       gla_w_gate2, gla_b_gate, gla_norm_w, p_gdn, p_fox, p_gla, b_merge, w_out):
    bsz, s, d = x.shape
    proj = x @ w_in
    offsets = np.cumsum(IN_SPLITS)[:-1].tolist()
    (gdn_qkv, gdn_b, gdn_a, gdn_z, fox_qkv, fox_f,
     gla_q, gla_k, gla_v, gla_r, gla_lr, merge_logits) = jnp.split(proj, offsets, axis=-1)

    gdn_qkv = jax.nn.silu(causal_depthwise_conv(gdn_qkv, gdn_conv_w))
    q_a, k_a, v_a = jnp.split(gdn_qkv, [GDN_QK, 2 * GDN_QK], axis=-1)
    q_a = l2_normalize(q_a.reshape(bsz, s, GDN_HEADS, GDN_DK))
    k_a = l2_normalize(k_a.reshape(bsz, s, GDN_HEADS, GDN_DK))
    v_a = v_a.reshape(bsz, s, GDN_HEADS, GDN_DV)
    beta_a = jax.nn.sigmoid(gdn_b)
    g_a = -jnp.exp(gdn_a_log) * jax.nn.softplus(gdn_a + gdn_dt_bias)
    o_a = gated_delta_rule_chunked(q_a, k_a, v_a, g_a, beta_a)
    o_a = rms_norm(o_a, gdn_norm_w) * jax.nn.silu(gdn_z.reshape(bsz, s, GDN_HEADS, GDN_DV))

    q_b, k_b, v_b = jnp.split(fox_qkv, 3, axis=-1)
    log_f = jax.nn.log_sigmoid((fox_f + fox_f_bias).astype(F32))
    o_b = forgetting_attention(q_b.reshape(bsz, s, FOX_HEADS, FOX_DH),
                               k_b.reshape(bsz, s, FOX_HEADS, FOX_DH),
                               v_b.reshape(bsz, s, FOX_HEADS, FOX_DH), log_f)

    log_a = jax.nn.log_sigmoid((gla_lr @ gla_w_gate2 + gla_b_gate).astype(F32)) / GLA_TAU
    o_c = gla_chunked(gla_q.reshape(bsz, s, GLA_HEADS, GLA_DK),
                      gla_k.reshape(bsz, s, GLA_HEADS, GLA_DK),
                      gla_v.reshape(bsz, s, GLA_HEADS, GLA_DV),
                      log_a.reshape(bsz, s, GLA_HEADS, GLA_DK))
    o_c = rms_norm(o_c, gla_norm_w) * jax.nn.silu(gla_r.reshape(bsz, s, GLA_HEADS, GLA_DV))

    gate = jax.nn.sigmoid(merge_logits + b_merge).reshape(bsz, s, N_BRANCH, d)
    merged = (gate[:, :, 0] * (o_a.reshape(bsz, s, GDN_V) @ p_gdn)
              + gate[:, :, 1] * (o_b.reshape(bsz, s, FOX_W) @ p_fox)
              + gate[:, :, 2] * (o_c.reshape(bsz, s, GLA_V) @ p_gla))
    return (merged @ w_out).astype(x.dtype)


def memory_cross_attention(x, mem, wq, wkv, wo):
    bsz, s, d = x.shape
    m = mem.shape[1]
    q = (x @ wq).reshape(bsz, s, XA_HEADS, XA_DH)
    k, v = jnp.split(mem @ wkv, 2, axis=-1)
    k = k.reshape(bsz, m, XA_HEADS, XA_DH)
    v = v.reshape(bsz, m, XA_HEADS, XA_DH)
    logits = jnp.einsum('bqhd,bkhd->bhqk', q.astype(F32), k.astype(F32)) * (XA_DH ** -0.5)
    p = jax.nn.softmax(logits, axis=-1).astype(v.dtype)
    o = jnp.einsum('bhqk,bkhd->bqhd', p, v).reshape(bsz, s, d)
    return (o @ wo).astype(x.dtype)


def routed_experts(xf, expert_idx, expert_w, w_gate, w_up, w_down):
    n, d = xf.shape
    kk = expert_idx.shape[1]
    e = w_gate.shape[0]
    nk = n * kk
    flat_e = expert_idx.reshape(nk)
    order = jnp.argsort(flat_e)
    sorted_e = flat_e[order]
    sorted_tok = order // kk
    counts = jnp.zeros((e,), jnp.int32).at[flat_e].add(1)
    padded = (counts + MOE_BLOCK - 1) // MOE_BLOCK * MOE_BLOCK
    pad_end = jnp.cumsum(padded)
    pad_start = pad_end - padded
    start = jnp.cumsum(counts) - counts
    dest = pad_start[sorted_e] + (jnp.arange(nk, dtype=jnp.int32) - start[sorted_e])
    total = (nk + MOE_BLOCK - 1) // MOE_BLOCK * MOE_BLOCK + e * MOE_BLOCK
    n_blocks = total // MOE_BLOCK
    slot_tok = jnp.full((total,), n, jnp.int32).at[dest].set(sorted_tok)
    blk_expert = jnp.minimum(
        jnp.searchsorted(pad_end, jnp.arange(n_blocks, dtype=jnp.int32) * MOE_BLOCK, side='right'), e - 1)
    x_pad = jnp.concatenate([xf, jnp.zeros((1, d), xf.dtype)], axis=0)
    xb = x_pad[slot_tok].reshape(n_blocks, MOE_BLOCK, d)

    def one_block(args):
        x_blk, ex = args
        hidden = jax.nn.silu(x_blk @ w_gate[ex]) * (x_blk @ w_up[ex])
        return hidden @ w_down[ex]

    yb = lax.map(one_block, (xb, blk_expert)).reshape(total, d)
    slot_of_assign = jnp.zeros((nk,), jnp.int32).at[order].set(dest)
    y = yb[slot_of_assign].reshape(n, kk, d)
    return jnp.einsum('nk,nkd->nd', expert_w, y)


def hierarchical_moe(x, w_group, b_group, w_expert, b_expert, w_gate, w_up, w_down):
    bsz, s, d = x.shape
    xf = x.reshape(bsz * s, d)
    p_group = jax.nn.softmax((xf @ w_group + b_group).astype(F32), axis=-1)
    p_top, g_sel = lax.top_k(p_group, 1)
    e_logits = (xf @ w_expert + b_expert).astype(F32).reshape(-1, MOE_GROUPS, MOE_PER_GROUP)
    sel_logits = jnp.take_along_axis(e_logits, g_sel[:, :, None], axis=1)[:, 0]
    p_in = jax.nn.softmax(sel_logits, axis=-1)
    w_top, e_local = lax.top_k(p_in, MOE_TOPK)
    w_top = w_top / jnp.sum(w_top, axis=-1, keepdims=True) * p_top
    e_global = g_sel * MOE_PER_GROUP + e_local
    y = routed_experts(xf, e_global, w_top.astype(x.dtype), w_gate, w_up, w_down)
    return y.reshape(bsz, s, d).astype(x.dtype)


def setup_inputs(seed: int = 0) -> dict:
    key = jax.random.key(seed)
    ks = iter(jax.random.split(key, 40))
    L, D = DEPTH, D_MODEL

    def normal(shape, scale):
        return jax.random.normal(next(ks), shape, F32) * scale

    def uniform(shape, lo, hi):
        return jax.random.uniform(next(ks), shape, F32, minval=lo, maxval=hi)

    dt = jnp.exp(uniform((L, GDN_HEADS), math.log(1e-3), math.log(0.1)))
    return {
        'x': normal((BATCH, SEQ, D), 1.0),
        'mem': normal((BATCH, MEM_LEN, D), 1.0),
        'w_in': normal((L, D, N_IN), D ** -0.5),
        'gdn_conv_w': normal((L, GDN_CONV, 2 * GDN_QK + GDN_V), GDN_CONV ** -0.5),
        'gdn_a_log': jnp.log(uniform((L, GDN_HEADS), 1.0, 16.0)),
        'gdn_dt_bias': dt + jnp.log(-jnp.expm1(-dt)),
        'gdn_norm_w': 1.0 + normal((L, GDN_DV), 0.02),
        'fox_f_bias': uniform((L, FOX_HEADS), 2.0, 5.0),
        'gla_w_gate2': normal((L, GLA_RANK, GLA_QK), GLA_RANK ** -0.5),
        'gla_b_gate': normal((L, GLA_QK), 0.1),
        'gla_norm_w': 1.0 + normal((L, GLA_DV), 0.02),
        'p_gdn': normal((L, GDN_V, D), GDN_V ** -0.5),
        'p_fox': normal((L, FOX_W, D), FOX_W ** -0.5),
        'p_gla': normal((L, GLA_V, D), GLA_V ** -0.5),
        'b_merge': normal((L, N_BRANCH * D), 0.1),
        'w_out': normal((L, D, D), DEEPNORM_BETA * D ** -0.5),
        'ln1_g': 1.0 + normal((L, D), 0.02),
        'ln1_b': normal((L, D), 0.02),
        'xa_wq': normal((L, D, D), D ** -0.5),
        'xa_wkv': normal((L, D, 2 * D), D ** -0.5),
        'xa_wo': normal((L, D, D), DEEPNORM_BETA * D ** -0.5),
        'ln2_g': 1.0 + normal((L, D), 0.02),
        'ln2_b': normal((L, D), 0.02),
        'moe_w_group': normal((L, D, MOE_GROUPS), D ** -0.5),
        'moe_b_group': normal((L, MOE_GROUPS), 0.01),
        'moe_w_expert': normal((L, D, MOE_EXPERTS), D ** -0.5),
        'moe_b_expert': normal((L, MOE_EXPERTS), 0.01),
        'moe_w_gate': normal((L, MOE_EXPERTS, D, MOE_FF), D ** -0.5),
        'moe_w_up': normal((L, MOE_EXPERTS, D, MOE_FF), D ** -0.5),
        'moe_w_down': normal((L, MOE_EXPERTS, MOE_FF, D), DEEPNORM_BETA * MOE_FF ** -0.5),
        'ln3_g': 1.0 + normal((L, D), 0.02),
        'ln3_b': normal((L, D), 0.02),
    }


def reference(x, mem, w_in, gdn_conv_w, gdn_a_log, gdn_dt_bias, gdn_norm_w, fox_f_bias,
              gla_w_gate2, gla_b_gate, gla_norm_w, p_gdn, p_fox, p_gla, b_merge, w_out,
              ln1_g, ln1_b, xa_wq, xa_wkv, xa_wo, ln2_g, ln2_b,
              moe_w_group, moe_b_group, moe_w_expert, moe_b_expert, moe_w_gate, moe_w_up, moe_w_down,
              ln3_g, ln3_b):
    for l in range(DEPTH):
        mix = hybrid_token_mixer(x, w_in[l], gdn_conv_w[l], gdn_a_log[l], gdn_dt_bias[l], gdn_norm_w[l],
                                 fox_f_bias[l], gla_w_gate2[l], gla_b_gate[l], gla_norm_w[l],
                                 p_gdn[l], p_fox[l], p_gla[l], b_merge[l], w_out[l])
        x = layer_norm(DEEPNORM_ALPHA * x + mix, ln1_g[l], ln1_b[l])
        xa = memory_cross_attention(x, mem, xa_wq[l], xa_wkv[l], xa_wo[l])
        x = layer_norm(DEEPNORM_ALPHA * x + xa, ln2_g[l], ln2_b[l])
        ff = hierarchical_moe(x, moe_w_group[l], moe_b_group[l], moe_w_expert[l], moe_b_expert[l],
                              moe_w_gate[l], moe_w_up[l], moe_w_down[l])
        x = layer_norm(DEEPNORM_ALPHA * x + ff, ln3_g[l], ln3_b[l])
    return x
```

```cpp
#include <hip/hip_runtime.h>
#include <hip/hip_cooperative_groups.h>
#include <cstdio>
#include <cstdint>
namespace cg = cooperative_groups;

#define LAS __attribute__((address_space(3)))
typedef unsigned short bf16;
typedef short bf16x8 __attribute__((ext_vector_type(8)));
typedef short s16x4 __attribute__((ext_vector_type(4)));
typedef float f32x4 __attribute__((ext_vector_type(4)));
typedef float f32x2 __attribute__((ext_vector_type(2)));
typedef unsigned u32x4 __attribute__((ext_vector_type(4)));
typedef unsigned u32x2 __attribute__((ext_vector_type(2)));

#ifndef PH_MASK
#define PH_MASK 0xFFFFFFFFu
#endif
constexpr int DM = 1024, NB = 16, SEQ = 2048, NTOK = NB * SEQ, MEMLEN = 256, NMEM = NB * MEMLEN, DEPTH = 2;
constexpr int N_IN = 8224;
constexpr int LP = 5376;
constexpr int C_OA = 0;
constexpr int C_OB = 512;
constexpr int C_OC = 1024;
constexpr int C_GQ = 1536, C_GK = 2048, C_GV = 2560;
constexpr int C_FK = 3072, C_FV = 3584;
constexpr int C_LQ = 4096, C_LK = 4352, C_LV = 4608;
constexpr int C_SM = 5120;
constexpr int C_T = 1536;
constexpr int NWIN = 8448;
constexpr float ALPHA = 1.4142135623730951f;
constexpr float LOG2E = 1.4426950408889634f;
constexpr int MAXSLOT = 73728;
constexpr int MAXBLK = MAXSLOT / 256;

constexpr size_t MiB = 1u << 20;
constexpr size_t WS_CTL = 0;
constexpr size_t WS_WT = 1 * MiB;
constexpr size_t WT_WIN = 0;
constexpr size_t WT_P = WT_WIN + (size_t)NWIN * 1024 * 2;
constexpr size_t WT_WOUT3 = WT_P + 3u * 1024 * 512 * 2;
constexpr size_t WT_WQ = WT_WOUT3 + (size_t)1024 * 3072 * 2;
constexpr size_t WT_WKV = WT_WQ + (size_t)1024 * 1024 * 2;
constexpr size_t WT_WO = WT_WKV + (size_t)2048 * 1024 * 2;
constexpr size_t WT_GU = WT_WO + (size_t)1024 * 1024 * 2;
constexpr size_t WT_DN = WT_GU + (size_t)32 * 512 * 1024 * 2;
constexpr size_t WT_END = WT_DN + (size_t)32 * 1024 * 256 * 2;
static_assert(WT_END <= 82 * MiB, "WT");
constexpr size_t WS_XB = 83 * MiB;
constexpr size_t WS_PROJ = 147 * MiB;
constexpr size_t WS_SMALL = 483 * MiB;
constexpr size_t SM_TOKE = 0;
constexpr size_t SM_TOKW = SM_TOKE + (size_t)NTOK * 8;
constexpr size_t SM_TOKR = SM_TOKW + (size_t)NTOK * 8;
constexpr size_t SM_TOKS = SM_TOKR + (size_t)NTOK * 8;
constexpr size_t WS_END = WS_SMALL + 2 * MiB;
constexpr size_t PJ_Q = 0, PJ_O = 64 * MiB;
constexpr size_t PJ_XG = 0, PJ_H = 144 * MiB, PJ_YS = 180 * MiB;
constexpr size_t DO_Y = 0, DO_KV = 64 * MiB, DO_MEMB = 80 * MiB;

constexpr int RING_BYTES = 131072;
constexpr int LDS_X = 131072;
constexpr int LDS_CTL = 147456;
constexpr int LDS_BYTES = 151552;

__device__ __forceinline__ int otid() { int t = threadIdx.x; asm volatile("" : "+v"(t)); return t; }
__device__ __forceinline__ int obid() { int t = blockIdx.x; asm volatile("" : "+s"(t)); return t; }
__device__ __forceinline__ int ogrid() { int t = gridDim.x; asm volatile("" : "+s"(t)); return t; }
__device__ __forceinline__ unsigned f2bf(float f) { unsigned u = __builtin_bit_cast(unsigned, f); return (u + 0x7fffu + ((u >> 16) & 1u)) >> 16; }
__device__ __forceinline__ unsigned pk2(float lo, float hi) { return f2bf(lo) | (f2bf(hi) << 16); }
__device__ __forceinline__ float bf2f(unsigned short b) { return __builtin_bit_cast(float, (unsigned)b << 16); }
__device__ __forceinline__ float bflo(unsigned w) { return __builtin_bit_cast(float, w << 16); }
__device__ __forceinline__ float bfhi(unsigned w) { return __builtin_bit_cast(float, w & 0xffff0000u); }
__device__ __forceinline__ float wave_sum(float v) {
#pragma unroll
    for (int o = 1; o < 64; o <<= 1) v += __shfl_xor(v, o);
    return v;
}
__device__ __forceinline__ float sigmoidf_(float x) { return 1.f / (1.f + __expf(-x)); }
__device__ __forceinline__ float siluf_(float x) { return x / (1.f + __expf(-x)); }
__device__ __forceinline__ float softplusf_(float x) { return fmaxf(x, 0.f) + log1pf(__expf(-fabsf(x))); }
__device__ __forceinline__ float logsigmoidf_(float x) { return fminf(x, 0.f) - log1pf(__expf(-fabsf(x))); }

namespace pg8 {
constexpr int BM = 256, BK = 64, HALF = 128, HTB = HALF * BK * 2, STAGE_BYTES = 8 * HTB;
__host__ __device__ __forceinline__ int lds_byte(int r, int c) { const int st = (r >> 4) * 2 + (c >> 5), rr = r & 15, cc = c & 31, ob = rr * 64 + cc * 2; return st * 1024 + (ob ^ (((ob >> 9) & 1) << 5)); }
__host__ __device__ __forceinline__ void stage_rc(int b, int& R, int& C) { const int st = b / 1024, sb = b % 1024, swz = sb ^ (((sb >> 9) & 1) << 5); R = (st >> 1) * 16 + swz / 64; C = (st & 1) * 32 + (swz % 64) / 2; }
__host__ __device__ __forceinline__ int perm32(int rho) { const int n = rho >> 4, i = rho & 15; return 8 * (i >> 2) + 4 * n + (i & 3); }

struct Unit { const char* a; const char* b; int row0, col0, aux; };
struct Gemm { int lda, ldb, K; };

template <class Epi, class Sched>
__device__ __forceinline__ void gemm_phase(LAS unsigned char* lds, const Gemm g, const Sched& S, const Epi& E) {
    const int tid = otid(), wid = __builtin_amdgcn_readfirstlane(tid >> 6), lane = tid & 63, wr = wid >> 2, wc = wid & 3, fr = lane & 15, fq = lane >> 4;
    int K = g.K; asm volatile("" : "+s"(K)); const int nt = K / BK;
    unsigned voffA[2], voffB[2];
#pragma unroll
    for (int i = 0; i < 2; ++i) { int R, C; stage_rc(tid * 16 + i * 8192, R, C); const int Rb = Epi::PERM ? ((R & ~31) + perm32(R & 31)) : R;
        voffA[i] = (unsigned)(R * g.lda + C) * 2u; voffB[i] = (unsigned)(Rb * g.ldb + C) * 2u; }
    const size_t kstep = (size_t)(BK * 2);
    const size_t hstepA = (size_t)HALF * g.lda * 2, hstepB = (size_t)HALF * g.ldb * 2;
    const unsigned ldsw = (unsigned)wid * 1024u;
    const int aoff = lds_byte(wr * 64 + fr, fq * 8), boff = lds_byte(wc * 32 + fr, fq * 8);
#define PG8_SA(b, h) (((b) * 2 + (h)) * HTB)
#define PG8_SB(b, h) ((4 + (b) * 2 + (h)) * HTB)
#define PG8_STAGE(bufoff, gbase, voff) do { _Pragma("unroll") for (int _i = 0; _i < 2; ++_i) \
        __builtin_amdgcn_global_load_lds((const unsigned*)((const char*)(gbase) + (voff)[_i]), (LAS unsigned*)(lds + (bufoff) + ldsw + _i * 8192), 16, 0, 0); } while (0)
#define PG8_LDA(dst, b, h) do { _Pragma("unroll") for (int m = 0; m < 4; ++m) _Pragma("unroll") for (int k = 0; k < 2; ++k) dst[m][k] = *(const LAS bf16x8*)(lds + PG8_SA(b, h) + aoff + m * 2048 + k * 1024); } while (0)
#define PG8_LDB(dst, b, h) do { _Pragma("unroll") for (int n = 0; n < 2; ++n) _Pragma("unroll") for (int k = 0; k < 2; ++k) dst[n][k] = *(const LAS bf16x8*)(lds + PG8_SB(b, h) + boff + n * 2048 + k * 1024); } while (0)
#define PG8_MMA(ai, bj, At, Bt) do { __builtin_amdgcn_s_setprio(1); _Pragma("unroll") for (int m = 0; m < 4; ++m) _Pragma("unroll") for (int n = 0; n < 2; ++n) _Pragma("unroll") for (int k = 0; k < 2; ++k) \
        acc[ai][bj][m][n] = __builtin_amdgcn_mfma_f32_16x16x32_bf16(Bt[n][k], At[m][k], acc[ai][bj][m][n], 0, 0, 0); __builtin_amdgcn_s_setprio(0); } while (0)
#define PG8_WAIT_V(n) asm volatile("s_waitcnt vmcnt(" #n ")" ::: "memory")
#define PG8_WAIT_L(n) asm volatile("s_waitcnt lgkmcnt(" #n ")" ::: "memory")
#define PG8_BAR __builtin_amdgcn_s_barrier()
#define PG8_SCHED __builtin_amdgcn_sched_barrier(0)
    Unit cur, nxt; int ui = 0;
    if (!S.next(0, cur)) return;
    f32x4 acc[2][2][4][2];
#pragma unroll
    for (int a = 0; a < 2; ++a)
#pragma unroll
        for (int b = 0; b < 2; ++b)
#pragma unroll
            for (int m = 0; m < 4; ++m)
#pragma unroll
                for (int n = 0; n < 2; ++n) acc[a][b][m][n] = (f32x4){0.f, 0.f, 0.f, 0.f};
    bf16x8 At[4][2], B0[2][2], B1[2][2];
    const char* cA = cur.a; const char* cB = cur.b;
    PG8_STAGE(PG8_SB(0, 0), cB, voffB); PG8_STAGE(PG8_SB(0, 1), cB + hstepB, voffB); PG8_STAGE(PG8_SA(0, 0), cA, voffA); PG8_STAGE(PG8_SA(0, 1), cA + hstepA, voffA);
    if (wr == 1) PG8_BAR;
    PG8_WAIT_V(2); PG8_BAR;
    PG8_STAGE(PG8_SB(1, 0), cB + kstep, voffB); PG8_STAGE(PG8_SA(1, 0), cA + kstep, voffA); PG8_STAGE(PG8_SB(1, 1), cB + hstepB + kstep, voffB);
    PG8_WAIT_V(6); PG8_BAR;
    for (;;) {
        const bool has_next = S.next(ui + 1, nxt);
        const char* nA = has_next ? nxt.a : cA; const char* nB = has_next ? nxt.b : cB;
        for (int t = 0; t < nt; t += 2) {
            const bool last = (t == nt - 2);
            const char* a1 = cA + (size_t)(t + 1) * kstep;
            const char* a2 = last ? nA : cA + (size_t)(t + 2) * kstep; const char* b2 = last ? nB : cB + (size_t)(t + 2) * kstep;
            const char* a3 = a2 + kstep; const char* b3 = b2 + kstep;
            PG8_LDB(B0, 0, 0); PG8_LDB(B1, 0, 1); PG8_SCHED; PG8_LDA(At, 0, 0); PG8_STAGE(PG8_SA(1, 1), a1 + hstepA, voffA);
            PG8_WAIT_V(8); PG8_WAIT_L(0); PG8_BAR; PG8_MMA(0, 0, At, B0); PG8_MMA(0, 1, At, B1); PG8_BAR; PG8_SCHED;
            PG8_LDA(At, 0, 1); PG8_STAGE(PG8_SB(0, 0), b2, voffB); PG8_STAGE(PG8_SB(0, 1), b2 + hstepB, voffB); PG8_STAGE(PG8_SA(0, 0), a2, voffA);
            PG8_WAIT_V(8); PG8_WAIT_L(0); PG8_BAR; PG8_MMA(1, 0, At, B0); PG8_MMA(1, 1, At, B1); PG8_BAR; PG8_SCHED;
            PG8_LDB(B0, 1, 0); PG8_LDB(B1, 1, 1); PG8_SCHED; PG8_LDA(At, 1, 0); PG8_STAGE(PG8_SA(0, 1), a2 + hstepA, voffA);
            PG8_WAIT_V(8); PG8_WAIT_L(0); PG8_BAR; PG8_MMA(0, 0, At, B0); PG8_MMA(0, 1, At, B1); PG8_BAR; PG8_SCHED;
            PG8_LDA(At, 1, 1); PG8_STAGE(PG8_SB(1, 0), b3, voffB); PG8_STAGE(PG8_SB(1, 1), b3 + hstepB, voffB); PG8_STAGE(PG8_SA(1, 0), a3, voffA);
            PG8_WAIT_V(8); PG8_WAIT_L(0); PG8_BAR; PG8_MMA(1, 0, At, B0); PG8_MMA(1, 1, At, B1); PG8_BAR; PG8_SCHED;
        }
        if (wr == 0) PG8_BAR;
        E(acc, cur, wr, wc, fr, fq);
        if (!has_next) break;
#pragma unroll
        for (int a = 0; a < 2; ++a)
#pragma unroll
            for (int b = 0; b < 2; ++b)
#pragma unroll
                for (int m = 0; m < 4; ++m)
#pragma unroll
                    for (int n = 0; n < 2; ++n) acc[a][b][m][n] = (f32x4){0.f, 0.f, 0.f, 0.f};
        cur = nxt; cA = nA; cB = nB; ++ui;
        if (wr == 1) PG8_BAR;
    }
    PG8_WAIT_V(0);
    PG8_BAR;
#undef PG8_SA
#undef PG8_SB
#undef PG8_STAGE
#undef PG8_LDA
#undef PG8_LDB
#undef PG8_MMA
#undef PG8_WAIT_V
#undef PG8_WAIT_L
#undef PG8_BAR
#undef PG8_SCHED
}

#define EPI_LOOP_BEGIN \
    _Pragma("unroll") for (int ai = 0; ai < 2; ++ai) _Pragma("unroll") for (int m = 0; m < 4; ++m) { const int row = u.row0 + ai * HALF + wr * 64 + m * 16 + fr; \
    _Pragma("unroll") for (int bj = 0; bj < 2; ++bj) { const int col = u.col0 + bj * HALF + wc * 32 + 8 * fq; const f32x4 v0 = acc[ai][bj][m][0], v1 = acc[ai][bj][m][1];
#define EPI_LOOP_END } }

struct EpiStore {
    static constexpr bool PERM = true;
    bf16* O; int ldc; float scale;
    __device__ __forceinline__ void operator()(const f32x4 (&acc)[2][2][4][2], const Unit& u, int wr, int wc, int fr, int fq) const {
        EPI_LOOP_BEGIN
            u32x4 w; w.x = pk2(v0[0] * scale, v0[1] * scale); w.y = pk2(v0[2] * scale, v0[3] * scale); w.z = pk2(v1[0] * scale, v1[1] * scale); w.w = pk2(v1[2] * scale, v1[3] * scale);
            *(u32x4*)(O + (size_t)row * ldc + col) = w;
        EPI_LOOP_END
    }
};
struct EpiGate {
    static constexpr bool PERM = true;
    bf16* T; int ldc; const float* bias;
    __device__ __forceinline__ void operator()(const f32x4 (&acc)[2][2][4][2], const Unit& u, int wr, int wc, int fr, int fq) const {
        EPI_LOOP_BEGIN
            const int bc = u.aux + bj * HALF + wc * 32 + 8 * fq;
            const f32x4 b0 = *(const f32x4*)(bias + bc), b1 = *(const f32x4*)(bias + bc + 4);
            bf16* p = T + (size_t)row * ldc + col; const u32x4 t = *(const u32x4*)p;
            u32x4 w;
            w.x = pk2(sigmoidf_(v0[0] + b0[0]) * bflo(t.x), sigmoidf_(v0[1] + b0[1]) * bfhi(t.x));
            w.y = pk2(sigmoidf_(v0[2] + b0[2]) * bflo(t.y), sigmoidf_(v0[3] + b0[3]) * bfhi(t.y));
            w.z = pk2(sigmoidf_(v1[0] + b1[0]) * bflo(t.z), sigmoidf_(v1[1] + b1[1]) * bfhi(t.z));
            w.w = pk2(sigmoidf_(v1[2] + b1[2]) * bflo(t.w), sigmoidf_(v1[3] + b1[3]) * bfhi(t.w));
            *(u32x4*)p = w;
        EPI_LOOP_END
    }
};
struct EpiResid {
    static constexpr bool PERM = true;
    const bf16* X; bf16* Y; int ldc;
    __device__ __forceinline__ void operator()(const f32x4 (&acc)[2][2][4][2], const Unit& u, int wr, int wc, int fr, int fq) const {
        EPI_LOOP_BEGIN
            const u32x4 t = *(const u32x4*)(X + (size_t)row * ldc + col);
            u32x4 w;
            w.x = pk2(ALPHA * bflo(t.x) + v0[0], ALPHA * bfhi(t.x) + v0[1]); w.y = pk2(ALPHA * bflo(t.y) + v0[2], ALPHA * bfhi(t.y) + v0[3]);
            w.z = pk2(ALPHA * bflo(t.z) + v1[0], ALPHA * bfhi(t.z) + v1[1]); w.w = pk2(ALPHA * bflo(t.w) + v1[2], ALPHA * bfhi(t.w) + v1[3]);
            *(u32x4*)(Y + (size_t)row * ldc + col) = w;
        EPI_LOOP_END
    }
};
struct EpiSwiglu {
    static constexpr bool PERM = true;
    bf16* H; int ldc;
    __device__ __forceinline__ void operator()(const f32x4 (&acc)[2][2][4][2], const Unit& u, int wr, int wc, int fr, int fq) const {
        EPI_LOOP_BEGIN
            u32x2 w; w.x = pk2(siluf_(v0[0]) * v1[0], siluf_(v0[1]) * v1[1]); w.y = pk2(siluf_(v0[2]) * v1[2], siluf_(v0[3]) * v1[3]);
            *(u32x2*)(H + (size_t)row * ldc + (col >> 1)) = w;
        EPI_LOOP_END
    }
};
}

struct Args {
    const float* x; const float* mem; const float* w_in; const float* gdn_conv_w; const float* gdn_a_log; const float* gdn_dt_bias; const float* gdn_norm_w; const float* fox_f_bias;
    const float* gla_w_gate2; const float* gla_b_gate; const float* gla_norm_w; const float* p_gdn; const float* p_fox; const float* p_gla; const float* b_merge; const float* w_out;
    const float* ln1_g; const float* ln1_b; const float* xa_wq; const float* xa_wkv; const float* xa_wo; const float* ln2_g; const float* ln2_b;
    const float* moe_w_group; const float* moe_b_group; const float* moe_w_expert; const float* moe_b_expert; const float* moe_w_gate; const float* moe_w_up; const float* moe_w_down;
    const float* ln3_g; const float* ln3_b;
    float* out; unsigned char* ws;
};

typedef const __attribute__((address_space(4))) Args* KArgP;

__device__ __forceinline__ int tr_srccol(int mode, int c0, int n) {
    if (mode != 3) return c0 + n;
    return n < 4 ? 1536 + n : n < 8 ? 1540 + (n - 4) : n < 16 ? 3592 + (n - 8) : 5136 + (n - 16);
}
__device__ __forceinline__ int tr_dstrow(int mode, int r0, int nn) {
    if (mode == 1) return r0 + 8 * (nn >> 2) + (nn & 3);
    if (mode == 2) return r0 + 8 * (nn >> 2) + 4 + (nn & 3);
    return r0 + nn;
}
__device__ __forceinline__ void tr_item(const float* W, int ldw, int c0, int ncols, bf16* T, int ldt, int r0, int koff, int mode, LAS float* scr, int item, int lane) {
    const int nblk = ncols / 32, kb = item / nblk, nb = item % nblk, k0 = 64 * kb, n0 = 32 * nb;
    const int sc = tr_srccol(mode, c0, n0 + (lane & 31));
#pragma unroll 8
    for (int i = 0; i < 32; ++i) { const int kk = 2 * i + (lane >> 5); scr[kk * 33 + (lane & 31)] = W[(size_t)(k0 + kk) * ldw + sc]; }
    asm volatile("s_waitcnt lgkmcnt(0)" ::: "memory");
    const int c = lane & 7;
#pragma unroll
    for (int j = 0; j < 4; ++j) { const int n = (lane >> 3) + 8 * j; const LAS float* s = scr + (8 * c) * 33 + n;
        u32x4 o; o.x = pk2(s[0 * 33], s[1 * 33]); o.y = pk2(s[2 * 33], s[3 * 33]); o.z = pk2(s[4 * 33], s[5 * 33]); o.w = pk2(s[6 * 33], s[7 * 33]);
        *(u32x4*)(T + (size_t)tr_dstrow(mode, r0, n0 + n) * ldt + koff + k0 + 8 * c) = o; }
    asm volatile("s_waitcnt lgkmcnt(0)" ::: "memory");
}
__device__ __forceinline__ void tr_job(const float* W, int ldw, int K, int c0, int ncols, size_t wstride, bf16* T, int ldt, int r0, int koff, int mode, size_t tstride, int nmat,
                                       LAS float* scr, int lane, int gw, int NGW, int& run) {
    const int per = (K / 64) * (ncols / 32), n = per * nmat;
    int first = gw - (run % NGW); if (first < 0) first += NGW;
    for (int it = first; it < n; it += NGW) { const int e = it / per, li = it % per; tr_item(W + (size_t)e * wstride, ldw, c0, ncols, T + (size_t)e * tstride, ldt, r0, koff, mode, scr, li, lane); }
    run += n;
}
__device__ __forceinline__ void phase_convert_weights(KArgP A, int l, LAS unsigned char* lds) {
    const int tid = otid(), lane = tid & 63, wid = tid >> 6;
    LAS float* scr = (LAS float*)(lds + wid * 16384);
    const int gw = obid() * 8 + wid, NGW = ogrid() * 8; int run = 0;
    unsigned char* wt = A->ws + WS_WT;
    bf16* WIN = (bf16*)(wt + WT_WIN);
    const float* w_in = A->w_in + (size_t)l * 1024 * N_IN;
    tr_job(w_in, N_IN, 1024, 1544, 512, 0, WIN, 1024, C_OA, 0, 0, 0, 1, scr, lane, gw, NGW, run);
    tr_job(w_in, N_IN, 1024, 2056, 512, 0, WIN, 1024, C_OB, 0, 0, 0, 1, scr, lane, gw, NGW, run);
    tr_job(w_in, N_IN, 1024, 4624, 512, 0, WIN, 1024, C_OC, 0, 0, 0, 1, scr, lane, gw, NGW, run);
    tr_job(w_in, N_IN, 1024, 0, 1536, 0, WIN, 1024, C_GQ, 0, 0, 0, 1, scr, lane, gw, NGW, run);
    tr_job(w_in, N_IN, 1024, 2568, 1024, 0, WIN, 1024, C_FK, 0, 0, 0, 1, scr, lane, gw, NGW, run);
    tr_job(w_in, N_IN, 1024, 3600, 1024, 0, WIN, 1024, C_LQ, 0, 0, 0, 1, scr, lane, gw, NGW, run);
    tr_job(w_in, N_IN, 1024, 0, 32, 0, WIN, 1024, C_SM, 0, 3, 0, 1, scr, lane, gw, NGW, run);
    tr_job(w_in, N_IN, 1024, 5152, 3072, 0, WIN, 1024, LP, 0, 0, 0, 1, scr, lane, gw, NGW, run);
    { u32x4 z = {0u, 0u, 0u, 0u}; u32x4* p = (u32x4*)(WIN + (size_t)5152 * 1024); const int n16 = 224 * 1024 * 2 / 16;
      for (int i = obid() * 512 + tid; i < n16; i += ogrid() * 512) p[i] = z; }
    bf16* PT = (bf16*)(wt + WT_P);
    tr_job(A->p_gdn + (size_t)l * 512 * 1024, 1024, 512, 0, 1024, 0, PT, 512, 0, 0, 0, 0, 1, scr, lane, gw, NGW, run);
    tr_job(A->p_fox + (size_t)l * 512 * 1024, 1024, 512, 0, 1024, 0, PT + 1024 * 512, 512, 0, 0, 0, 0, 1, scr, lane, gw, NGW, run);
    tr_job(A->p_gla + (size_t)l * 512 * 1024, 1024, 512, 0, 1024, 0, PT + 2 * 1024 * 512, 512, 0, 0, 0, 0, 1, scr, lane, gw, NGW, run);
    bf16* WO3 = (bf16*)(wt + WT_WOUT3);
    for (int r = 0; r < 3; ++r) tr_job(A->w_out + (size_t)l * 1024 * 1024, 1024, 1024, 0, 1024, 0, WO3, 3072, 0, 1024 * r, 0, 0, 1, scr, lane, gw, NGW, run);
    tr_job(A->xa_wq + (size_t)l * 1024 * 1024, 1024, 1024, 0, 1024, 0, (bf16*)(wt + WT_WQ), 1024, 0, 0, 0, 0, 1, scr, lane, gw, NGW, run);
    tr_job(A->xa_wkv + (size_t)l * 1024 * 2048, 2048, 1024, 0, 2048, 0, (bf16*)(wt + WT_WKV), 1024, 0, 0, 0, 0, 1, scr, lane, gw, NGW, run);
    tr_job(A->xa_wo + (size_t)l * 1024 * 1024, 1024, 1024, 0, 1024, 0, (bf16*)(wt + WT_WO), 1024, 0, 0, 0, 0, 1, scr, lane, gw, NGW, run);
    tr_job(A->moe_w_gate + (size_t)l * 32 * 1024 * 256, 256, 1024, 0, 256, (size_t)1024 * 256, (bf16*)(wt + WT_GU), 1024, 0, 0, 1, (size_t)512 * 1024, 32, scr, lane, gw, NGW, run);
    tr_job(A->moe_w_up + (size_t)l * 32 * 1024 * 256, 256, 1024, 0, 256, (size_t)1024 * 256, (bf16*)(wt + WT_GU), 1024, 0, 0, 2, (size_t)512 * 1024, 32, scr, lane, gw, NGW, run);
    tr_job(A->moe_w_down + (size_t)l * 32 * 256 * 1024, 1024, 256, 0, 1024, (size_t)256 * 1024, (bf16*)(wt + WT_DN), 256, 0, 0, 0, (size_t)1024 * 256, 32, scr, lane, gw, NGW, run);
}
__device__ __forceinline__ void convert_rows(const float* src, bf16* dst, size_t n) {
    const size_t n8 = n / 8;
    for (size_t i = (size_t)obid() * 512 + otid(); i < n8; i += (size_t)ogrid() * 512) {
        const f32x4 a = *(const f32x4*)(src + i * 8), b = *(const f32x4*)(src + i * 8 + 4);
        u32x4 w; w.x = pk2(a[0], a[1]); w.y = pk2(a[2], a[3]); w.z = pk2(b[0], b[1]); w.w = pk2(b[2], b[3]);
        *(u32x4*)(dst + i * 8) = w;
    }
}

struct RegSched {
    int nM, nN, nwg, G, c; const char* A; const char* B; size_t astride, bstride; int col_base;
    __device__ __forceinline__ bool next(int i, pg8::Unit& u) const {
        const long L = (long)i * G + c; if (L >= nwg) return false;
        int wgid = (int)L; { const int q = nwg / 8, r = nwg % 8, xcd = wgid % 8, off = wgid / 8; wgid = (xcd < r ? xcd * (q + 1) : r * (q + 1) + (xcd - r) * q) + off; }
        const int nig = 8 * nN, gid = wgid / nig, fm = gid * 8, gsz = (nM - fm) < 8 ? (nM - fm) : 8;
        const int pm = fm + ((wgid % nig) % gsz), pn = (wgid % nig) / gsz;
        u.a = A + (size_t)pm * astride; u.b = B + (size_t)pn * bstride; u.row0 = pm * 256; u.col0 = col_base + pn * 256; u.aux = pn * 256; return true;
    }
};
struct BranchSched {
    int nM, nwg, G, c; const char* A; const char* B;
    __device__ __forceinline__ bool next(int i, pg8::Unit& u) const {
        const long L = (long)i * G + c; if (L >= nwg) return false;
        int wgid = (int)L; { const int q = nwg / 8, r = nwg % 8, xcd = wgid % 8, off = wgid / 8; wgid = (xcd < r ? xcd * (q + 1) : r * (q + 1) + (xcd - r) * q) + off; }
        const int nN = 12, nig = 8 * nN, gid = wgid / nig, fm = gid * 8, gsz = (nM - fm) < 8 ? (nM - fm) : 8;
        const int pm = fm + ((wgid % nig) % gsz), pn = (wgid % nig) / gsz, br = pn >> 2;
        u.a = A + ((size_t)pm * 256 * LP + br * 512) * 2; u.b = B + ((size_t)br * 1024 * 512 + (size_t)(pn & 3) * 256 * 512) * 2; u.row0 = pm * 256; u.col0 = C_T + pn * 256; u.aux = 0; return true;
    }
};
struct MoeSched {
    int nct, G, c; const LAS int* tab;
    const char* A; size_t astride; const char* B; size_t bexp, bct;
    __device__ __forceinline__ bool next(int i, pg8::Unit& u) const {
        const long L = (long)i * G + c; const int nblk = tab[0]; if (L >= (long)nblk * nct) return false;
        const int rb = (int)(L / nct), ct = (int)(L % nct), e = tab[1 + rb];
        u.a = A + (size_t)rb * astride; u.b = B + (size_t)e * bexp + (size_t)ct * bct; u.row0 = rb * 256; u.col0 = ct * 256; u.aux = e; return true;
    }
};

template <int D, bool FOX>
__device__ __forceinline__ void flash_unit(LAS unsigned char* lds, const bf16* Q, int ldq, const bf16* K, const bf16* V, int ldkv, bf16* O, int ldo,
                                           int ntiles, int qpos0, float sc_log2, const LAS float* CK) {
    const int tid = otid(), lane = tid & 63, wid = tid >> 6, l15 = lane & 15, g = lane >> 4;
    constexpr int KST = (D + 8) * 2;
    LAS unsigned char* KS = lds; LAS unsigned char* VS = lds + 64 * KST; LAS unsigned char* PS = lds + 2 * 64 * KST + wid * 2304;
    bf16x8 qf[D / 32];
    { const bf16* qrow = Q + (size_t)(wid * 16 + l15) * ldq + 8 * g;
#pragma unroll
      for (int ks = 0; ks < D / 32; ++ks) qf[ks] = *(const bf16x8*)(qrow + ks * 32); }
    f32x4 o[D / 16];
#pragma unroll
    for (int i = 0; i < D / 16; ++i) o[i] = (f32x4){0.f, 0.f, 0.f, 0.f};
    float mrow[4], lrow[4];
#pragma unroll
    for (int r = 0; r < 4; ++r) { mrow[r] = -1e30f; lrow[r] = 0.f; }
    for (int t = 0; t < ntiles; ++t) {
        __syncthreads();
        for (int c = tid; c < 64 * (D / 8); c += 512) { const int row = c / (D / 8), ch = c % (D / 8);
            const u32x4 kv = *(const u32x4*)(K + (size_t)(t * 64 + row) * ldkv + ch * 8); const u32x4 vv = *(const u32x4*)(V + (size_t)(t * 64 + row) * ldkv + ch * 8);
            *(LAS u32x4*)(KS + row * KST + ch * 16) = kv; *(LAS u32x4*)(VS + row * KST + ch * 16) = vv; }
        __syncthreads();
        f32x4 s[4];
#pragma unroll
        for (int nb = 0; nb < 4; ++nb) { s[nb] = (f32x4){0.f, 0.f, 0.f, 0.f};
#pragma unroll
            for (int ks = 0; ks < D / 32; ++ks) { const bf16x8 kf = *(const LAS bf16x8*)(KS + (nb * 16 + l15) * KST + (ks * 32 + 8 * g) * 2);
                s[nb] = __builtin_amdgcn_mfma_f32_16x16x32_bf16(qf[ks], kf, s[nb], 0, 0, 0); } }
        float mx[4];
#pragma unroll
        for (int r = 0; r < 4; ++r) mx[r] = -1e30f;
#pragma unroll
        for (int nb = 0; nb < 4; ++nb) { const int key = t * 64 + nb * 16 + l15; float kb = 0.f; if (FOX) kb = CK[key] * LOG2E;
#pragma unroll
            for (int r = 0; r < 4; ++r) { float v = s[nb][r] * sc_log2 - kb; if (FOX) { if (key > qpos0 + wid * 16 + 4 * g + r) v = -1e30f; } s[nb][r] = v; mx[r] = fmaxf(mx[r], v); } }
#pragma unroll
        for (int r = 0; r < 4; ++r) { float m = mx[r]; m = fmaxf(m, __shfl_xor(m, 1)); m = fmaxf(m, __shfl_xor(m, 2)); m = fmaxf(m, __shfl_xor(m, 4)); m = fmaxf(m, __shfl_xor(m, 8));
            const float mn = fmaxf(mrow[r], m), al = exp2f(mrow[r] - mn); mrow[r] = mn; lrow[r] *= al;
#pragma unroll
            for (int i = 0; i < D / 16; ++i) o[i][r] *= al;
            float ps = 0.f;
#pragma unroll
            for (int nb = 0; nb < 4; ++nb) { const float p = exp2f(s[nb][r] - mn); ps += p; *(LAS bf16*)(PS + ((4 * g + r) * 72 + nb * 16 + l15) * 2) = (bf16)f2bf(p); }
            lrow[r] += ps; }
        bf16x8 pf[2];
#pragma unroll
        for (int ks = 0; ks < 2; ++ks) pf[ks] = *(const LAS bf16x8*)(PS + (l15 * 72 + ks * 32 + 8 * g) * 2);
        const int q4 = l15 >> 2, p4 = lane & 3;
#pragma unroll
        for (int nb = 0; nb < D / 16; ++nb) {
#pragma unroll
            for (int ks = 0; ks < 2; ++ks) {
                const s16x4 lo = __builtin_amdgcn_ds_read_tr16_b64_v4i16((LAS s16x4*)(VS + (32 * ks + 8 * g + q4) * KST + (16 * nb + 4 * p4) * 2));
                const s16x4 hi = __builtin_amdgcn_ds_read_tr16_b64_v4i16((LAS s16x4*)(VS + (32 * ks + 8 * g + 4 + q4) * KST + (16 * nb + 4 * p4) * 2));
                const bf16x8 vf = (bf16x8){lo[0], lo[1], lo[2], lo[3], hi[0], hi[1], hi[2], hi[3]};
                o[nb] = __builtin_amdgcn_mfma_f32_16x16x32_bf16(pf[ks], vf, o[nb], 0, 0, 0); } }
    }
#pragma unroll
    for (int r = 0; r < 4; ++r) { float l = lrow[r]; l += __shfl_xor(l, 1); l += __shfl_xor(l, 2); l += __shfl_xor(l, 4); l += __shfl_xor(l, 8);
        const float inv = 1.f / l; bf16* orow = O + (size_t)(wid * 16 + 4 * g + r) * ldo + l15;
#pragma unroll
        for (int nb = 0; nb < D / 16; ++nb) orow[nb * 16] = (bf16)f2bf(o[nb][r] * inv); }
}

__device__ __forceinline__ void fox_unit(KArgP A, int l, LAS unsigned char* lds, int b, int h, int qb) {
    bf16* PJ = (bf16*)(A->ws + WS_PROJ);
    const int tid = otid(), lane = tid & 63, wid = tid >> 6;
    LAS float* CK = (LAS float*)(lds + 2 * 64 * 144 + 8 * 2304);
    LAS float* WT = CK + 2048;
    const int nkeys = 128 * (qb + 1);
    __syncthreads();
    {
        const float fb = A->fox_f_bias[l * 8 + h];
        float v[4]; float run = 0.f;
#pragma unroll
        for (int i = 0; i < 4; ++i) { const int t = tid * 4 + i; float x = 0.f; if (t < nkeys) x = logsigmoidf_(bf2f(PJ[(size_t)(b * SEQ + t) * LP + C_SM + 8 + h]) + fb); run += x; v[i] = run; }
        float inc = run;
#pragma unroll
        for (int o = 1; o < 64; o <<= 1) { const float y = __shfl_up(inc, o); if (lane >= o) inc += y; }
        if (lane == 63) WT[wid] = inc;
        __syncthreads();
        float base = inc - run;
        for (int w = 0; w < wid; ++w) base += WT[w];
#pragma unroll
        for (int i = 0; i < 4; ++i) CK[tid * 4 + i] = base + v[i];
    }
    const size_t rowq = (size_t)(b * SEQ + qb * 128), rowk = (size_t)b * SEQ;
    flash_unit<64, true>(lds, PJ + rowq * LP + C_OB + h * 64, LP, PJ + rowk * LP + C_FK + h * 64, PJ + rowk * LP + C_FV + h * 64, LP, PJ + rowq * LP + C_OB + h * 64, LP,
                         2 * (qb + 1), qb * 128, 0.125f * LOG2E, CK);
}

__device__ __forceinline__ void gdn_chain(KArgP A, int l, LAS unsigned char* lds, int b, int h) {
    bf16* PJ = (bf16*)(A->ws + WS_PROJ);
    const int tid = otid(), lane = tid & 63, wid = tid >> 6;
    LAS float* qs = (LAS float*)lds; LAS float* ks = qs + 64 * 128; LAS float* vs = ks + 64 * 128; LAS float* os = vs + 64 * 128;
    LAS float* gs = (LAS float*)(lds + LDS_X); LAS float* bs = gs + 64;
    const float* cw = A->gdn_conv_w + (size_t)l * 4 * 1536;
    const float alog = A->gdn_a_log[l * 4 + h], dtb = A->gdn_dt_bias[l * 4 + h];
    const float* nw = A->gdn_norm_w + l * 128;
    const int j = 16 * wid + (lane & 15), s = lane >> 4;
    float S[32];
#pragma unroll
    for (int i = 0; i < 32; ++i) S[i] = 0.f;
    for (int n = 0; n < SEQ / 64; ++n) {
        const int t0 = n * 64; const size_t row0 = (size_t)b * SEQ + t0;
        __syncthreads();
        for (int it = tid; it < 64 * 48; it += 512) { const int tt = it / 48, pc = it % 48, part = pc >> 4, c8 = pc & 15;
            const int c = part * 512 + h * 128 + c8 * 8;
            float y[8];
#pragma unroll
            for (int e = 0; e < 8; ++e) y[e] = 0.f;
#pragma unroll
            for (int i = 0; i < 4; ++i) { const int t = t0 + tt - 3 + i; if (t >= 0) {
                const u32x4 xv = *(const u32x4*)(PJ + ((size_t)b * SEQ + t) * LP + C_GQ + c);
                const f32x4 w0 = *(const f32x4*)(cw + i * 1536 + c), w1 = *(const f32x4*)(cw + i * 1536 + c + 4);
                y[0] += w0[0] * bflo(xv.x); y[1] += w0[1] * bfhi(xv.x); y[2] += w0[2] * bflo(xv.y); y[3] += w0[3] * bfhi(xv.y);
                y[4] += w1[0] * bflo(xv.z); y[5] += w1[1] * bfhi(xv.z); y[6] += w1[2] * bflo(xv.w); y[7] += w1[3] * bfhi(xv.w); } }
            LAS float* dst = (part == 0 ? qs : part == 1 ? ks : vs) + tt * 128 + c8 * 8;
#pragma unroll
            for (int e = 0; e < 8; ++e) dst[e] = siluf_(y[e]); }
        if (tid < 64) { const size_t r = (row0 + tid) * LP + C_SM; const float a = bf2f(PJ[r + 4 + h]), bb = bf2f(PJ[r + h]);
            gs[tid] = __expf(-__expf(alog) * softplusf_(a + dtb)); bs[tid] = sigmoidf_(bb); }
        __syncthreads();
        for (int rr = wid; rr < 128; rr += 8) { LAS float* p = (rr < 64 ? qs + rr * 128 : ks + (rr - 64) * 128);
            const float a = p[lane * 2], c = p[lane * 2 + 1]; const float ss = wave_sum(a * a + c * c); const float sc = rsqrtf(ss + 1e-6f); p[lane * 2] = a * sc; p[lane * 2 + 1] = c * sc; }
        __syncthreads();
        for (int t = 0; t < 64; ++t) {
            const float dec = gs[t], bt = bs[t];
            float kk[32];
#pragma unroll
            for (int i4 = 0; i4 < 8; ++i4) { const f32x4 k4 = *(const LAS f32x4*)(ks + t * 128 + 32 * s + 4 * i4); kk[4 * i4] = k4[0]; kk[4 * i4 + 1] = k4[1]; kk[4 * i4 + 2] = k4[2]; kk[4 * i4 + 3] = k4[3]; }
            float kS = 0.f;
#pragma unroll
            for (int i = 0; i < 32; ++i) { S[i] *= dec; kS += kk[i] * S[i]; }
            kS += __shfl_xor(kS, 16); kS += __shfl_xor(kS, 32);
            const float vn = bt * (vs[t * 128 + j] - kS);
            float o = 0.f;
#pragma unroll
            for (int i4 = 0; i4 < 8; ++i4) { const f32x4 q4 = *(const LAS f32x4*)(qs + t * 128 + 32 * s + 4 * i4);
#pragma unroll
                for (int e = 0; e < 4; ++e) { S[4 * i4 + e] += kk[4 * i4 + e] * vn; o += q4[e] * S[4 * i4 + e]; } }
            o += __shfl_xor(o, 16); o += __shfl_xor(o, 32);
            if (s == 0) os[t * 128 + j] = o * 0.08838834764831845f;
        }
        __syncthreads();
        for (int rr = wid; rr < 64; rr += 8) { const float a = os[rr * 128 + lane * 2], c = os[rr * 128 + lane * 2 + 1];
            const float ss = wave_sum(a * a + c * c); const float sc = rsqrtf(ss * (1.f / 128.f) + 1e-6f);
            unsigned* zp = (unsigned*)(PJ + (row0 + rr) * LP + C_OA + h * 128 + lane * 2); const unsigned z = *zp;
            *zp = pk2(a * sc * nw[lane * 2] * siluf_(bflo(z)), c * sc * nw[lane * 2 + 1] * siluf_(bfhi(z))); }
    }
}

__device__ __forceinline__ void gla_chain(KArgP A, int l, LAS unsigned char* lds, int b, int h) {
    bf16* PJ = (bf16*)(A->ws + WS_PROJ);
    const int tid = otid(), lane = tid & 63, wid = tid >> 6;
    LAS float* qs = (LAS float*)lds; LAS float* ks = qs + 64 * 64; LAS float* as = ks + 64 * 64; LAS float* vs = as + 64 * 64; LAS float* os = vs + 64 * 128; LAS float* lrs = os + 64 * 128;
    const float* wg2 = A->gla_w_gate2 + (size_t)l * 16 * 256; const float* bg = A->gla_b_gate + l * 256; const float* nw = A->gla_norm_w + l * 128;
    const int j = 16 * wid + (lane & 15), s = lane >> 4;
    float S[16];
#pragma unroll
    for (int i = 0; i < 16; ++i) S[i] = 0.f;
    for (int n = 0; n < SEQ / 64; ++n) {
        const size_t row0 = (size_t)b * SEQ + n * 64;
        __syncthreads();
        for (int it = tid; it < 64 * 8; it += 512) { const int tt = it >> 3, c8 = it & 7;
            const u32x4 qv = *(const u32x4*)(PJ + (row0 + tt) * LP + C_LQ + h * 64 + c8 * 8); const u32x4 kv = *(const u32x4*)(PJ + (row0 + tt) * LP + C_LK + h * 64 + c8 * 8);
            LAS float* qd = qs + tt * 64 + c8 * 8; LAS float* kd = ks + tt * 64 + c8 * 8;
            qd[0] = bflo(qv.x); qd[1] = bfhi(qv.x); qd[2] = bflo(qv.y); qd[3] = bfhi(qv.y); qd[4] = bflo(qv.z); qd[5] = bfhi(qv.z); qd[6] = bflo(qv.w); qd[7] = bfhi(qv.w);
            kd[0] = bflo(kv.x); kd[1] = bfhi(kv.x); kd[2] = bflo(kv.y); kd[3] = bfhi(kv.y); kd[4] = bflo(kv.z); kd[5] = bfhi(kv.z); kd[6] = bflo(kv.w); kd[7] = bfhi(kv.w); }
        for (int it = tid; it < 64 * 16; it += 512) { const int tt = it >> 4, c8 = it & 15;
            const u32x4 vv = *(const u32x4*)(PJ + (row0 + tt) * LP + C_LV + h * 128 + c8 * 8); LAS float* vd = vs + tt * 128 + c8 * 8;
            vd[0] = bflo(vv.x); vd[1] = bfhi(vv.x); vd[2] = bflo(vv.y); vd[3] = bfhi(vv.y); vd[4] = bflo(vv.z); vd[5] = bfhi(vv.z); vd[6] = bflo(vv.w); vd[7] = bfhi(vv.w); }
        for (int it = tid; it < 64 * 16; it += 512) { const int tt = it >> 4, r = it & 15; lrs[it] = bf2f(PJ[(row0 + tt) * LP + C_SM + 16 + r]); }
        __syncthreads();
        for (int it = tid; it < 64 * 64; it += 512) { const int tt = it >> 6, d = it & 63; float z = bg[h * 64 + d];
#pragma unroll
            for (int r = 0; r < 16; ++r) z += lrs[tt * 16 + r] * wg2[r * 256 + h * 64 + d];
            as[it] = __expf(logsigmoidf_(z) * (1.f / 16.f)); }
        __syncthreads();
        for (int t = 0; t < 64; ++t) {
            const float vj = vs[t * 128 + j]; float o = 0.f;
#pragma unroll
            for (int i4 = 0; i4 < 4; ++i4) { const f32x4 a4 = *(const LAS f32x4*)(as + t * 64 + 16 * s + 4 * i4), k4 = *(const LAS f32x4*)(ks + t * 64 + 16 * s + 4 * i4), q4 = *(const LAS f32x4*)(qs + t * 64 + 16 * s + 4 * i4);
#pragma unroll
                for (int e = 0; e < 4; ++e) { S[4 * i4 + e] = a4[e] * S[4 * i4 + e] + k4[e] * vj; o += q4[e] * S[4 * i4 + e]; } }
            o += __shfl_xor(o, 16); o += __shfl_xor(o, 32);
            if (s == 0) os[t * 128 + j] = o * 0.125f;
        }
        __syncthreads();
        for (int rr = wid; rr < 64; rr += 8) { const float a = os[rr * 128 + lane * 2], c = os[rr * 128 + lane * 2 + 1];
            const float ss = wave_sum(a * a + c * c); const float sc = rsqrtf(ss * (1.f / 128.f) + 1e-6f);
            unsigned* zp = (unsigned*)(PJ + (row0 + rr) * LP + C_OC + h * 128 + lane * 2); const unsigned z = *zp;
            *zp = pk2(a * sc * nw[lane * 2] * siluf_(bflo(z)), c * sc * nw[lane * 2 + 1] * siluf_(bfhi(z))); }
    }
}

struct LnRow { float v[16]; };
__device__ __forceinline__ void ln_normalize(LnRow& r, const float* g, const float* bta, int lane) {
    float s = 0.f;
#pragma unroll
    for (int i = 0; i < 16; ++i) s += r.v[i];
    const float mean = wave_sum(s) * (1.f / 1024.f); float q = 0.f;
#pragma unroll
    for (int i = 0; i < 16; ++i) { r.v[i] -= mean; q += r.v[i] * r.v[i]; }
    const float rstd = rsqrtf(wave_sum(q) * (1.f / 1024.f) + 1e-5f);
#pragma unroll
    for (int jj = 0; jj < 2; ++jj) { const int k = 8 * (lane + 64 * jj);
        const f32x4 g0 = *(const f32x4*)(g + k), g1 = *(const f32x4*)(g + k + 4), b0 = *(const f32x4*)(bta + k), b1 = *(const f32x4*)(bta + k + 4);
#pragma unroll
        for (int e = 0; e < 4; ++e) { r.v[jj * 8 + e] = r.v[jj * 8 + e] * rstd * g0[e] + b0[e]; r.v[jj * 8 + 4 + e] = r.v[jj * 8 + 4 + e] * rstd * g1[e] + b1[e]; } }
}
__device__ __forceinline__ void ln_load_bf16(LnRow& r, const bf16* row, int lane, float scale) {
#pragma unroll
    for (int jj = 0; jj < 2; ++jj) { const u32x4 t = *(const u32x4*)(row + 8 * (lane + 64 * jj));
        r.v[jj * 8 + 0] = scale * bflo(t.x); r.v[jj * 8 + 1] = scale * bfhi(t.x); r.v[jj * 8 + 2] = scale * bflo(t.y); r.v[jj * 8 + 3] = scale * bfhi(t.y);
        r.v[jj * 8 + 4] = scale * bflo(t.z); r.v[jj * 8 + 5] = scale * bfhi(t.z); r.v[jj * 8 + 6] = scale * bflo(t.w); r.v[jj * 8 + 7] = scale * bfhi(t.w); }
}
__device__ __forceinline__ void ln_add_bf16(LnRow& r, const bf16* row, int lane, float scale) {
#pragma unroll
    for (int jj = 0; jj < 2; ++jj) { const u32x4 t = *(const u32x4*)(row + 8 * (lane + 64 * jj));
        r.v[jj * 8 + 0] += scale * bflo(t.x); r.v[jj * 8 + 1] += scale * bfhi(t.x); r.v[jj * 8 + 2] += scale * bflo(t.y); r.v[jj * 8 + 3] += scale * bfhi(t.y);
        r.v[jj * 8 + 4] += scale * bflo(t.z); r.v[jj * 8 + 5] += scale * bfhi(t.z); r.v[jj * 8 + 6] += scale * bflo(t.w); r.v[jj * 8 + 7] += scale * bfhi(t.w); }
}
__device__ __forceinline__ void ln_store_bf16(const LnRow& r, bf16* row, int lane) {
#pragma unroll
    for (int jj = 0; jj < 2; ++jj) { u32x4 w; w.x = pk2(r.v[jj * 8], r.v[jj * 8 + 1]); w.y = pk2(r.v[jj * 8 + 2], r.v[jj * 8 + 3]); w.z = pk2(r.v[jj * 8 + 4], r.v[jj * 8 + 5]); w.w = pk2(r.v[jj * 8 + 6], r.v[jj * 8 + 7]);
        *(u32x4*)(row + 8 * (lane + 64 * jj)) = w; }
}
__device__ __forceinline__ void ln_store_f32(const LnRow& r, float* row, int lane) {
#pragma unroll
    for (int jj = 0; jj < 2; ++jj) { float* p = row + 8 * (lane + 64 * jj);
        *(f32x4*)p = (f32x4){r.v[jj * 8], r.v[jj * 8 + 1], r.v[jj * 8 + 2], r.v[jj * 8 + 3]}; *(f32x4*)(p + 4) = (f32x4){r.v[jj * 8 + 4], r.v[jj * 8 + 5], r.v[jj * 8 + 6], r.v[jj * 8 + 7]}; }
}

__device__ __forceinline__ KArgP argp() { KArgP p = (KArgP)__builtin_amdgcn_kernarg_segment_ptr(); asm volatile("" : "+s"(p)); return p; }
#define PH_COMMON \
    KArgP ap = argp(); unsigned char* ws = ap->ws; (void)ws; \
    const int tid = otid(), lane = tid & 63, wid = tid >> 6; (void)lane; (void)wid; \
    const int G = ogrid(), bx = obid(), gw = bx * 8 + wid, NGW = G * 8; (void)gw; (void)NGW; \
    unsigned char* wt = ws + WS_WT; (void)wt; bf16* XB = (bf16*)(ws + WS_XB); (void)XB; bf16* PJ = (bf16*)(ws + WS_PROJ); (void)PJ; \
    unsigned char* dsc = (unsigned char*)ap->out; bf16* Y = (bf16*)(dsc + DO_Y); (void)Y; bf16* KV = (bf16*)(dsc + DO_KV); (void)KV; bf16* MEMB = (bf16*)(dsc + DO_MEMB); (void)MEMB;

__device__ __forceinline__ void ph_input(LAS unsigned char* lds) { PH_COMMON
    convert_rows(ap->x, XB, (size_t)NTOK * DM);
    convert_rows(ap->mem, MEMB, (size_t)NMEM * DM);
}
__device__ __forceinline__ void ph_weights(LAS unsigned char* lds, int l) { KArgP A = argp(); phase_convert_weights(A, l, lds); }
__device__ __forceinline__ void ph_proj(LAS unsigned char* lds, int l) { PH_COMMON
    pg8::Gemm g{1024, 1024, 1024};
    RegSched S{NTOK / 256, LP / 256, (NTOK / 256) * (LP / 256), G, bx, (const char*)XB, (const char*)(wt + WT_WIN), (size_t)256 * 1024 * 2, (size_t)256 * 1024 * 2, 0};
    pg8::EpiStore E{PJ, LP, 1.f};
    pg8::gemm_phase(lds, g, S, E);
}
__device__ __forceinline__ void ph_kv(LAS unsigned char* lds, int l) { PH_COMMON
    pg8::Gemm g{1024, 1024, 1024};
    RegSched S2{NMEM / 256, 2048 / 256, (NMEM / 256) * (2048 / 256), G, bx, (const char*)MEMB, (const char*)(wt + WT_WKV), (size_t)256 * 1024 * 2, (size_t)256 * 1024 * 2, 0};
    pg8::EpiStore E2{KV, 2048, 1.f};
    pg8::gemm_phase(lds, g, S2, E2);
}
__device__ __forceinline__ void ph_mix(LAS unsigned char* lds, int l) {
    KArgP A = argp();
    const int G = ogrid(), bx = obid();
    if (bx < 64) gdn_chain(A, l, lds, bx >> 2, bx & 3);
    else if (bx < 128) gla_chain(A, l, lds, (bx - 64) >> 2, (bx - 64) & 3);
    else {
        const int nfw = G - 128;
        for (int u = bx - 128; u < NB * 8 * 16; u += nfw) { const int bh = u >> 4, qi = u & 15; const int qb = (qi & 1) ? 15 - (qi >> 1) : (qi >> 1); fox_unit(A, l, lds, bh >> 3, bh & 7, qb); }
    }
}
__device__ __forceinline__ void ph_branch(LAS unsigned char* lds, int l) { PH_COMMON
    pg8::Gemm g{LP, 512, 512};
    BranchSched S{NTOK / 256, (NTOK / 256) * 12, G, bx, (const char*)PJ, (const char*)(wt + WT_P)};
    pg8::EpiStore E{PJ, LP, 1.f};
    pg8::gemm_phase(lds, g, S, E);
}
__device__ __forceinline__ void ph_gate(LAS unsigned char* lds, int l) { PH_COMMON
    pg8::Gemm g{1024, 1024, 1024};
    RegSched S{NTOK / 256, 12, (NTOK / 256) * 12, G, bx, (const char*)XB, (const char*)(wt + WT_WIN + (size_t)LP * 1024 * 2), (size_t)256 * 1024 * 2, (size_t)256 * 1024 * 2, C_T};
    pg8::EpiGate E{PJ, LP, ap->b_merge + (size_t)l * 3072};
    pg8::gemm_phase(lds, g, S, E);
}
__device__ __forceinline__ void ph_out(LAS unsigned char* lds, int l) { PH_COMMON
    pg8::Gemm g{LP, 3072, 3072};
    RegSched S{NTOK / 256, 4, (NTOK / 256) * 4, G, bx, (const char*)(PJ + C_T), (const char*)(wt + WT_WOUT3), (size_t)256 * LP * 2, (size_t)256 * 3072 * 2, 0};
    pg8::EpiResid E{XB, Y, 1024};
    pg8::gemm_phase(lds, g, S, E);
}
__device__ __forceinline__ void ph_ln1(LAS unsigned char* lds, int l) { PH_COMMON
    const float* gg = ap->ln1_g + l * 1024; const float* bb = ap->ln1_b + l * 1024;
    for (int row = gw; row < NTOK; row += NGW) { LnRow r; ln_load_bf16(r, Y + (size_t)row * 1024, lane, 1.f); ln_normalize(r, gg, bb, lane); ln_store_bf16(r, XB + (size_t)row * 1024, lane); }
}
__device__ __forceinline__ void ph_q(LAS unsigned char* lds, int l) { PH_COMMON
    bf16* Qb = (bf16*)(ws + WS_PROJ + PJ_Q);
    pg8::Gemm g{1024, 1024, 1024};
    RegSched S{NTOK / 256, 4, (NTOK / 256) * 4, G, bx, (const char*)XB, (const char*)(wt + WT_WQ), (size_t)256 * 1024 * 2, (size_t)256 * 1024 * 2, 0};
    pg8::EpiStore E{Qb, 1024, 0.0625f * LOG2E};
    pg8::gemm_phase(lds, g, S, E);
}
__device__ __forceinline__ void ph_xattn(LAS unsigned char* lds, int l) { PH_COMMON
    bf16* Qb = (bf16*)(ws + WS_PROJ + PJ_Q); bf16* Ob = (bf16*)(ws + WS_PROJ + PJ_O);
    for (int u = bx; u < NB * 4 * 16; u += G) { const int b = u >> 6, h = (u >> 4) & 3, qb = u & 15;
        const size_t rowq = (size_t)b * SEQ + qb * 128, rowk = (size_t)b * MEMLEN;
        flash_unit<256, false>(lds, Qb + rowq * 1024 + h * 256, 1024, KV + rowk * 2048 + h * 256, KV + rowk * 2048 + 1024 + h * 256, 2048, Ob + rowq * 1024 + h * 256, 1024, 4, 0, 1.f, nullptr); }
}
__device__ __forceinline__ void ph_wo(LAS unsigned char* lds, int l) { PH_COMMON
    bf16* Ob = (bf16*)(ws + WS_PROJ + PJ_O);
    pg8::Gemm g{1024, 1024, 1024};
    RegSched S{NTOK / 256, 4, (NTOK / 256) * 4, G, bx, (const char*)Ob, (const char*)(wt + WT_WO), (size_t)256 * 1024 * 2, (size_t)256 * 1024 * 2, 0};
    pg8::EpiResid E{XB, Y, 1024};
    pg8::gemm_phase(lds, g, S, E);
}
__device__ __forceinline__ void ph_ln2_router(LAS unsigned char* lds, int l) { PH_COMMON
    unsigned* ctl = (unsigned*)(ws + WS_CTL);
    int* tokE = (int*)(ws + WS_SMALL + SM_TOKE); float* tokW = (float*)(ws + WS_SMALL + SM_TOKW); int* tokR = (int*)(ws + WS_SMALL + SM_TOKR);
    __syncthreads();
    LAS float* RW = (LAS float*)lds;
    const float* wg = ap->moe_w_group + (size_t)l * 1024 * 4; const float* we = ap->moe_w_expert + (size_t)l * 1024 * 32;
    for (int i = tid; i < 1024 * 36; i += 512) { const int k = i / 36, c = i % 36; const int pos = ((k >> 9) * 8 + (k & 7)) * 64 + ((k >> 3) & 63);
        RW[pos * 36 + c] = c < 4 ? wg[k * 4 + c] : we[k * 32 + (c - 4)]; }
    __syncthreads();
    const float* gg = ap->ln2_g + l * 1024; const float* bb = ap->ln2_b + l * 1024;
    const float* bgp = ap->moe_b_group + l * 4; const float* bep = ap->moe_b_expert + l * 32;
    unsigned* cnt = ctl + 64 * l;
    for (int row = gw; row < NTOK; row += NGW) {
        LnRow r; ln_load_bf16(r, Y + (size_t)row * 1024, lane, 1.f); ln_normalize(r, gg, bb, lane); ln_store_bf16(r, XB + (size_t)row * 1024, lane);
        float acc[36];
#pragma unroll
        for (int c = 0; c < 36; ++c) acc[c] = 0.f;
#pragma unroll
        for (int i = 0; i < 16; ++i) { const LAS float* wr = RW + (i * 64 + lane) * 36; const float xv = r.v[i];
#pragma unroll
            for (int c4 = 0; c4 < 9; ++c4) { const f32x4 w4 = *(const LAS f32x4*)(wr + 4 * c4); acc[4 * c4] += xv * w4[0]; acc[4 * c4 + 1] += xv * w4[1]; acc[4 * c4 + 2] += xv * w4[2]; acc[4 * c4 + 3] += xv * w4[3]; }
            asm volatile("" ::: "memory"); }
#pragma unroll
        for (int c = 0; c < 36; ++c) acc[c] = wave_sum(acc[c]);
        float gl[4];
#pragma unroll
        for (int c = 0; c < 4; ++c) gl[c] = acc[c] + bgp[c];
        int gsel = 0; float gm = gl[0];
#pragma unroll
        for (int c = 1; c < 4; ++c) if (gl[c] > gm) { gm = gl[c]; gsel = c; }
        float gsum = 0.f;
#pragma unroll
        for (int c = 0; c < 4; ++c) gsum += __expf(gl[c] - gm);
        const float ptop = 1.f / gsum;
        float el[8];
#pragma unroll
        for (int jx = 0; jx < 8; ++jx) { const float v = gsel == 0 ? acc[4 + jx] : gsel == 1 ? acc[12 + jx] : gsel == 2 ? acc[20 + jx] : acc[28 + jx]; el[jx] = v + bep[gsel * 8 + jx]; }
        int e0 = 0; float m0 = el[0];
#pragma unroll
        for (int jx = 1; jx < 8; ++jx) if (el[jx] > m0) { m0 = el[jx]; e0 = jx; }
        int e1 = -1; float m1 = -3.0e38f;
#pragma unroll
        for (int jx = 0; jx < 8; ++jx) if (jx != e0 && el[jx] > m1) { m1 = el[jx]; e1 = jx; }
        const float ex = __expf(m1 - m0); const float w0 = ptop / (1.f + ex), w1 = ptop * ex / (1.f + ex);
        if (lane == 0) { const int ge0 = gsel * 8 + e0, ge1 = gsel * 8 + e1;
            const int r0 = (int)atomicAdd(cnt + ge0, 1u), r1 = (int)atomicAdd(cnt + ge1, 1u);
            tokE[row * 2] = ge0; tokE[row * 2 + 1] = ge1; tokW[row * 2] = w0; tokW[row * 2 + 1] = w1; tokR[row * 2] = r0; tokR[row * 2 + 1] = r1; }
    }
}
__device__ __forceinline__ void ph_dispatch(LAS unsigned char* lds, int l) { PH_COMMON
    unsigned* ctl = (unsigned*)(ws + WS_CTL);
    int* tokE = (int*)(ws + WS_SMALL + SM_TOKE); int* tokR = (int*)(ws + WS_SMALL + SM_TOKR); int* tokS = (int*)(ws + WS_SMALL + SM_TOKS);
    bf16* XG = (bf16*)(ws + WS_PROJ + PJ_XG);
    LAS int* tab = (LAS int*)(lds + LDS_CTL);
    __syncthreads();
    if (tid == 0) { const unsigned* cnt = ctl + 64 * l; int ps = 0, nb = 0;
        for (int e = 0; e < 32; ++e) { const int c = (int)__hip_atomic_load(cnt + e, __ATOMIC_RELAXED, __HIP_MEMORY_SCOPE_AGENT); const int nbe = (c + 255) >> 8; tab[320 + e] = ps; tab[360 + e] = c;
            for (int q = 0; q < nbe; ++q) tab[1 + nb + q] = e; nb += nbe; ps += nbe * 256; }
        tab[352] = ps; tab[0] = nb; }
    __syncthreads();
    for (int row = gw; row < NTOK; row += NGW) {
        const int s0 = tab[320 + tokE[row * 2]] + tokR[row * 2], s1 = tab[320 + tokE[row * 2 + 1]] + tokR[row * 2 + 1];
        if (lane == 0) { tokS[row * 2] = s0; tokS[row * 2 + 1] = s1; }
#pragma unroll
        for (int jj = 0; jj < 2; ++jj) { const u32x4 t = *(const u32x4*)(XB + (size_t)row * 1024 + 8 * (lane + 64 * jj));
            *(u32x4*)(XG + (size_t)s0 * 1024 + 8 * (lane + 64 * jj)) = t; *(u32x4*)(XG + (size_t)s1 * 1024 + 8 * (lane + 64 * jj)) = t; }
    }
    for (int e = 0; e < 32; ++e) { const int c = tab[360 + e], st = tab[320 + e] + c, en = tab[320 + e] + (((c + 255) >> 8) << 8);
        for (int rr = st + gw; rr < en; rr += NGW) { const u32x4 z = {0u, 0u, 0u, 0u}; *(u32x4*)(XG + (size_t)rr * 1024 + 8 * lane) = z; *(u32x4*)(XG + (size_t)rr * 1024 + 8 * (lane + 64)) = z; } }
}
__device__ __forceinline__ void ph_moe_gu(LAS unsigned char* lds, int l) { PH_COMMON
    bf16* XG = (bf16*)(ws + WS_PROJ + PJ_XG); bf16* Hb = (bf16*)(ws + WS_PROJ + PJ_H);
    const LAS int* tab = (const LAS int*)(lds + LDS_CTL);
    pg8::Gemm g{1024, 1024, 1024};
    MoeSched S{2, G, bx, tab, (const char*)XG, (size_t)256 * 1024 * 2, (const char*)(wt + WT_GU), (size_t)512 * 1024 * 2, (size_t)256 * 1024 * 2};
    pg8::EpiSwiglu E{Hb, 256};
    pg8::gemm_phase(lds, g, S, E);
}
__device__ __forceinline__ void ph_moe_dn(LAS unsigned char* lds, int l) { PH_COMMON
    bf16* Hb = (bf16*)(ws + WS_PROJ + PJ_H); bf16* YS = (bf16*)(ws + WS_PROJ + PJ_YS);
    const LAS int* tab = (const LAS int*)(lds + LDS_CTL);
    pg8::Gemm g{256, 256, 256};
    MoeSched S{4, G, bx, tab, (const char*)Hb, (size_t)256 * 256 * 2, (const char*)(wt + WT_DN), (size_t)1024 * 256 * 2, (size_t)256 * 256 * 2};
    pg8::EpiStore E{YS, 1024, 1.f};
    pg8::gemm_phase(lds, g, S, E);
}
__device__ __forceinline__ void ph_ln3(LAS unsigned char* lds, int l) { PH_COMMON
    float* tokW = (float*)(ws + WS_SMALL + SM_TOKW); int* tokS = (int*)(ws + WS_SMALL + SM_TOKS);
    bf16* YS = (bf16*)(ws + WS_PROJ + PJ_YS);
    const float* gg = ap->ln3_g + l * 1024; const float* bb = ap->ln3_b + l * 1024;
    float* out = ap->out;
    for (int row = gw; row < NTOK; row += NGW) {
        LnRow r; ln_load_bf16(r, XB + (size_t)row * 1024, lane, ALPHA);
        ln_add_bf16(r, YS + (size_t)tokS[row * 2] * 1024, lane, tokW[row * 2]); ln_add_bf16(r, YS + (size_t)tokS[row * 2 + 1] * 1024, lane, tokW[row * 2 + 1]);
        ln_normalize(r, gg, bb, lane);
        if (l == DEPTH - 1) ln_store_f32(r, out + (size_t)row * 1024, lane); else ln_store_bf16(r, XB + (size_t)row * 1024, lane);
    }
}

__global__ void __launch_bounds__(512, 2) mega_fwd(Args A_unused) {
    extern __shared__ __attribute__((aligned(16))) unsigned char lds_raw[];
    LAS unsigned char* lds = (LAS unsigned char*)lds_raw;
    cg::grid_group grid = cg::this_grid();
    ph_input(lds);
    for (int l = 0; l < DEPTH; ++l) {
        if (PH_MASK & 1) ph_weights(lds, l);
        grid.sync();
        if (PH_MASK & 2) ph_proj(lds, l);
        grid.sync();
        if (PH_MASK & 4) ph_mix(lds, l);
        grid.sync();
        if (PH_MASK & 8) ph_branch(lds, l);
        grid.sync();
        if (PH_MASK & 16) ph_gate(lds, l);
        grid.sync();
        if (PH_MASK & 32) ph_out(lds, l);
        grid.sync();
        if (PH_MASK & 64) { ph_kv(lds, l); ph_ln1(lds, l); }
        grid.sync();
        if (PH_MASK & 128) ph_q(lds, l);
        grid.sync();
        if (PH_MASK & 256) ph_xattn(lds, l);
        grid.sync();
        if (PH_MASK & 512) ph_wo(lds, l);
        grid.sync();
        if (PH_MASK & 1024) ph_ln2_router(lds, l);
        grid.sync();
        if (PH_MASK & 2048) ph_dispatch(lds, l);
        grid.sync();
        if (PH_MASK & 4096) ph_moe_gu(lds, l);
        grid.sync();
        if (PH_MASK & 8192) ph_moe_dn(lds, l);
        grid.sync();
        if (PH_MASK & 16384) ph_ln3(lds, l);
        if (l + 1 < DEPTH) grid.sync();
    }
}

extern "C" void kernel_launch(void* const* d_in, const int* in_sizes, int n_in, void* d_out, int out_size, void* d_ws, size_t ws_size, hipStream_t stream) {
    static int grid = 0;
    if (grid == 0) {
        if (n_in != 32 || out_size != NTOK * DM || ws_size < WS_END) { fprintf(stderr, "kernel_launch: unexpected shapes (n_in %d out %d ws %zu)\n", n_in, out_size, ws_size); grid = -1; return; }
        int dev = 0, cus = 0, per_cu = 0;
        hipGetDevice(&dev); hipDeviceGetAttribute(&cus, hipDeviceAttributeMultiprocessorCount, dev);
        hipFuncSetAttribute((const void*)mega_fwd, hipFuncAttributeMaxDynamicSharedMemorySize, LDS_BYTES);
        hipOccupancyMaxActiveBlocksPerMultiprocessor(&per_cu, (const void*)mega_fwd, 512, LDS_BYTES);
        (void)hipGetLastError();
        if (per_cu < 1) { fprintf(stderr, "kernel_launch: occupancy query says %d blocks per CU\n", per_cu); grid = -1; return; }
        grid = cus;
        if (grid < 192) { fprintf(stderr, "kernel_launch: too few CUs (%d)\n", grid); grid = -1; return; }
    }
    if (grid < 0) return;
    hipMemsetAsync((char*)d_ws + WS_CTL, 0, 1 * MiB, stream);
    Args a{};
    const float** p = (const float**)&a;
    for (int i = 0; i < 32; ++i) p[i] = (const float*)d_in[i];
    a.out = (float*)d_out; a.ws = (unsigned char*)d_ws;
    void* args[] = {&a};
    hipError_t e = hipLaunchCooperativeKernel((const void*)mega_fwd, dim3(grid), dim3(512), args, LDS_BYTES, stream);
    if (e != hipSuccess) fprintf(stderr, "cooperative launch failed: %s (grid %d)\n", hipGetErrorString(e), grid);
}
```

```cpp
#include <hip/hip_runtime.h>
#include <hip/hip_cooperative_groups.h>
#include <cstdio>
#include <cstdint>
namespace cg = cooperative_groups;

#define LAS __attribute__((address_space(3)))
typedef unsigned short bf16;
typedef short bf16x8 __attribute__((ext_vector_type(8)));
typedef short s16x4 __attribute__((ext_vector_type(4)));
typedef float f32x4 __attribute__((ext_vector_type(4)));
typedef float f32x2 __attribute__((ext_vector_type(2)));
typedef unsigned u32x4 __attribute__((ext_vector_type(4)));
typedef unsigned u32x2 __attribute__((ext_vector_type(2)));

#ifndef PH_MASK
#define PH_MASK 0xFFFFFFFFu
#endif
#ifndef REP_MASK
#define REP_MASK 0u
#endif
constexpr int DM = 1024, NB = 16, SEQ = 2048, NTOK = NB * SEQ, MEMLEN = 256, NMEM = NB * MEMLEN, DEPTH = 2;
constexpr int N_IN = 8224;
constexpr int LP = 5376;
constexpr int C_OA = 0;
constexpr int C_OB = 512;
constexpr int C_OC = 1024;
constexpr int C_GQ = 1536, C_GK = 2048, C_GV = 2560;
constexpr int C_FK = 3072, C_FV = 3584;
constexpr int C_LQ = 4096, C_LK = 4352, C_LV = 4608;
constexpr int C_SM = 5120;
constexpr int C_T = 1536;
constexpr int NWIN = 8448;
constexpr float ALPHA = 1.4142135623730951f;
constexpr float LOG2E = 1.4426950408889634f;
constexpr int MAXSLOT = 73728;
constexpr int MAXBLK = MAXSLOT / 256;

constexpr size_t MiB = 1u << 20;
constexpr size_t WS_CTL = 0;
constexpr size_t WS_WT = 1 * MiB;
constexpr size_t WT_WIN = 0;
constexpr size_t WT_P = WT_WIN + (size_t)NWIN * 1024 * 2;
constexpr size_t WT_WOUT3 = WT_P + 3u * 1024 * 512 * 2;
constexpr size_t WT_WQ = WT_WOUT3 + (size_t)1024 * 3072 * 2;
constexpr size_t WT_WKV = WT_WQ + (size_t)1024 * 1024 * 2;
constexpr size_t WT_WO = WT_WKV + (size_t)2048 * 1024 * 2;
constexpr size_t WT_GU = WT_WO + (size_t)1024 * 1024 * 2;
constexpr size_t WT_DN = WT_GU + (size_t)32 * 512 * 1024 * 2;
constexpr size_t WT_END = WT_DN + (size_t)32 * 1024 * 256 * 2;
static_assert(WT_END <= 82 * MiB, "WT");
constexpr size_t WS_XB = 83 * MiB;
constexpr size_t WS_PROJ = 147 * MiB;
constexpr size_t WS_SMALL = 483 * MiB;
constexpr size_t SM_TOKE = 0;
constexpr size_t SM_TOKW = SM_TOKE + (size_t)NTOK * 8;
constexpr size_t SM_TOKR = SM_TOKW + (size_t)NTOK * 8;
constexpr size_t SM_TOKS = SM_TOKR + (size_t)NTOK * 8;
constexpr size_t WS_END = WS_SMALL + 2 * MiB;
constexpr size_t PJ_Q = 0, PJ_O = 64 * MiB;
constexpr size_t PJ_XG = 0, PJ_H = 144 * MiB, PJ_YS = 180 * MiB;
constexpr size_t DO_Y = 0, DO_KV = 88 * MiB, DO_MEMB = 104 * MiB, DO_HALO = 112 * MiB;
constexpr size_t DO_GP = 0;
constexpr int GP_W = 0, GP_KDT = 16384, GP_ATT = 32768, GP_CD = 40960, GP_STRIDE = 41216;

constexpr int RING_BYTES = 131072;
constexpr int LDS_X = 131072;
constexpr int LDS_CTL = 147456;
constexpr int LDS_BYTES = 151552;

__device__ __forceinline__ int otid() { int t = threadIdx.x; asm volatile("" : "+v"(t)); return t; }
__device__ __forceinline__ int obid() { int t = blockIdx.x; asm volatile("" : "+s"(t)); return t; }
__device__ __forceinline__ int ogrid() { int t = gridDim.x; asm volatile("" : "+s"(t)); return t; }
__device__ __forceinline__ unsigned f2bf(float f) { unsigned u = __builtin_bit_cast(unsigned, f); return (u + 0x7fffu + ((u >> 16) & 1u)) >> 16; }
__device__ __forceinline__ unsigned pk2(float lo, float hi) { return f2bf(lo) | (f2bf(hi) << 16); }
__device__ __forceinline__ float bf2f(unsigned short b) { return __builtin_bit_cast(float, (unsigned)b << 16); }
__device__ __forceinline__ float bflo(unsigned w) { return __builtin_bit_cast(float, w << 16); }
__device__ __forceinline__ float bfhi(unsigned w) { return __builtin_bit_cast(float, w & 0xffff0000u); }
template <int M> __device__ __forceinline__ float swz_xor(float v) { return __builtin_bit_cast(float, __builtin_amdgcn_ds_swizzle(__builtin_bit_cast(int, v), 0x1f | (M << 10))); }
__device__ __forceinline__ float half_sum(float v) { const unsigned b = __builtin_bit_cast(unsigned, v); auto r = __builtin_amdgcn_permlane32_swap(b, b, false, false); return __builtin_bit_cast(float, (unsigned)r[0]) + __builtin_bit_cast(float, (unsigned)r[1]); }
__device__ __forceinline__ float wave_sum(float v) {
    v += swz_xor<1>(v); v += swz_xor<2>(v); v += swz_xor<4>(v); v += swz_xor<8>(v); v += swz_xor<16>(v);
    return half_sum(v);
}
__device__ __forceinline__ float sigmoidf_(float x) { return 1.f / (1.f + __expf(-x)); }
__device__ __forceinline__ float siluf_(float x) { return x / (1.f + __expf(-x)); }
__device__ __forceinline__ float softplusf_(float x) { return fmaxf(x, 0.f) + log1pf(__expf(-fabsf(x))); }
__device__ __forceinline__ float logsigmoidf_(float x) { return fminf(x, 0.f) - log1pf(__expf(-fabsf(x))); }

namespace pg8 {
constexpr int BM = 256, BK = 64, HALF = 128, HTB = HALF * BK * 2, STAGE_BYTES = 8 * HTB;
__host__ __device__ __forceinline__ int lds_byte(int r, int c) { const int st = (r >> 4) * 2 + (c >> 5), rr = r & 15, cc = c & 31, ob = rr * 64 + cc * 2; return st * 1024 + (ob ^ (((ob >> 9) & 1) << 5)); }
__host__ __device__ __forceinline__ void stage_rc(int b, int& R, int& C) { const int st = b / 1024, sb = b % 1024, swz = sb ^ (((sb >> 9) & 1) << 5); R = (st >> 1) * 16 + swz / 64; C = (st & 1) * 32 + (swz % 64) / 2; }
__host__ __device__ __forceinline__ int perm32(int rho) { const int n = rho >> 4, i = rho & 15; return 8 * (i >> 2) + 4 * n + (i & 3); }

struct Unit { const char* a; const char* b; int row0, col0, aux; };
struct Gemm { int lda, ldb, K; };

template <class Epi, class Sched>
__device__ __forceinline__ void gemm_phase(LAS unsigned char* lds, const Gemm g, const Sched& S, const Epi& E) {
    const int tid = otid(), wid = __builtin_amdgcn_readfirstlane(tid >> 6), lane = tid & 63, wr = wid >> 2, wc = wid & 3, fr = lane & 15, fq = lane >> 4;
    int K = g.K; asm volatile("" : "+s"(K)); const int nt = K / BK;
    unsigned voffA[2], voffB[2];
#pragma unroll
    for (int i = 0; i < 2; ++i) { int R, C; stage_rc(tid * 16 + i * 8192, R, C); const int Rb = Epi::PERM ? ((R & ~31) + perm32(R & 31)) : R;
        voffA[i] = (unsigned)(R * g.lda + C) * 2u; voffB[i] = (unsigned)(Rb * g.ldb + C) * 2u; }
    const size_t kstep = (size_t)(BK * 2);
    const size_t hstepA = (size_t)HALF * g.lda * 2, hstepB = (size_t)HALF * g.ldb * 2;
    const unsigned ldsw = (unsigned)wid * 1024u;
    const int aoff = lds_byte(wr * 64 + fr, fq * 8), boff = lds_byte(wc * 32 + fr, fq * 8);
#define PG8_SA(b, h) (((b) * 2 + (h)) * HTB)
#define PG8_SB(b, h) ((4 + (b) * 2 + (h)) * HTB)
#define PG8_STAGE(bufoff, gbase, voff) do { _Pragma("unroll") for (int _i = 0; _i < 2; ++_i) \
        __builtin_amdgcn_global_load_lds((const unsigned*)((const char*)(gbase) + (voff)[_i]), (LAS unsigned*)(lds + (bufoff) + ldsw + _i * 8192), 16, 0, 0); } while (0)
#define PG8_LDA(dst, b, h) do { _Pragma("unroll") for (int m = 0; m < 4; ++m) _Pragma("unroll") for (int k = 0; k < 2; ++k) dst[m][k] = *(const LAS bf16x8*)(lds + PG8_SA(b, h) + aoff + m * 2048 + k * 1024); } while (0)
#define PG8_LDB(dst, b, h) do { _Pragma("unroll") for (int n = 0; n < 2; ++n) _Pragma("unroll") for (int k = 0; k < 2; ++k) dst[n][k] = *(const LAS bf16x8*)(lds + PG8_SB(b, h) + boff + n * 2048 + k * 1024); } while (0)
#define PG8_MMA(ai, bj, At, Bt) do { __builtin_amdgcn_s_setprio(1); _Pragma("unroll") for (int m = 0; m < 4; ++m) _Pragma("unroll") for (int n = 0; n < 2; ++n) _Pragma("unroll") for (int k = 0; k < 2; ++k) \
        acc[ai][bj][m][n] = __builtin_amdgcn_mfma_f32_16x16x32_bf16(Bt[n][k], At[m][k], acc[ai][bj][m][n], 0, 0, 0); __builtin_amdgcn_s_setprio(0); } while (0)
#define PG8_WAIT_V(n) asm volatile("s_waitcnt vmcnt(" #n ")" ::: "memory")
#define PG8_WAIT_L(n) asm volatile("s_waitcnt lgkmcnt(" #n ")" ::: "memory")
#define PG8_BAR __builtin_amdgcn_s_barrier()
#define PG8_SCHED __builtin_amdgcn_sched_barrier(0)
    Unit cur, nxt; int ui = 0;
    if (!S.next(0, cur)) return;
    f32x4 acc[2][2][4][2];
#pragma unroll
    for (int a = 0; a < 2; ++a)
#pragma unroll
        for (int b = 0; b < 2; ++b)
#pragma unroll
            for (int m = 0; m < 4; ++m)
#pragma unroll
                for (int n = 0; n < 2; ++n) acc[a][b][m][n] = (f32x4){0.f, 0.f, 0.f, 0.f};
    bf16x8 At[4][2], B0[2][2], B1[2][2];
    const char* cA = cur.a; const char* cB = cur.b;
    PG8_STAGE(PG8_SB(0, 0), cB, voffB); PG8_STAGE(PG8_SB(0, 1), cB + hstepB, voffB); PG8_STAGE(PG8_SA(0, 0), cA, voffA); PG8_STAGE(PG8_SA(0, 1), cA + hstepA, voffA);
    if (wr == 1) PG8_BAR;
    PG8_WAIT_V(2); PG8_BAR;
    PG8_STAGE(PG8_SB(1, 0), cB + kstep, voffB); PG8_STAGE(PG8_SA(1, 0), cA + kstep, voffA); PG8_STAGE(PG8_SB(1, 1), cB + hstepB + kstep, voffB);
    PG8_WAIT_V(6); PG8_BAR;
    for (;;) {
        const bool has_next = S.next(ui + 1, nxt);
        const char* nA = has_next ? nxt.a : cA; const char* nB = has_next ? nxt.b : cB;
        for (int t = 0; t < nt; t += 2) {
            const bool last = (t == nt - 2);
            const char* a1 = cA + (size_t)(t + 1) * kstep;
            const char* a2 = last ? nA : cA + (size_t)(t + 2) * kstep; const char* b2 = last ? nB : cB + (size_t)(t + 2) * kstep;
            const char* a3 = a2 + kstep; const char* b3 = b2 + kstep;
            PG8_LDB(B0, 0, 0); PG8_LDB(B1, 0, 1); PG8_SCHED; PG8_LDA(At, 0, 0); PG8_STAGE(PG8_SA(1, 1), a1 + hstepA, voffA);
            PG8_WAIT_V(8); PG8_WAIT_L(0); PG8_BAR; PG8_MMA(0, 0, At, B0); PG8_MMA(0, 1, At, B1); PG8_BAR; PG8_SCHED;
            PG8_LDA(At, 0, 1); PG8_STAGE(PG8_SB(0, 0), b2, voffB); PG8_STAGE(PG8_SB(0, 1), b2 + hstepB, voffB); PG8_STAGE(PG8_SA(0, 0), a2, voffA);
            PG8_WAIT_V(8); PG8_WAIT_L(0); PG8_BAR; PG8_MMA(1, 0, At, B0); PG8_MMA(1, 1, At, B1); PG8_BAR; PG8_SCHED;
            PG8_LDB(B0, 1, 0); PG8_LDB(B1, 1, 1); PG8_SCHED; PG8_LDA(At, 1, 0); PG8_STAGE(PG8_SA(0, 1), a2 + hstepA, voffA);
            PG8_WAIT_V(8); PG8_WAIT_L(0); PG8_BAR; PG8_MMA(0, 0, At, B0); PG8_MMA(0, 1, At, B1); PG8_BAR; PG8_SCHED;
            PG8_LDA(At, 1, 1); PG8_STAGE(PG8_SB(1, 0), b3, voffB); PG8_STAGE(PG8_SB(1, 1), b3 + hstepB, voffB); PG8_STAGE(PG8_SA(1, 0), a3, voffA);
            PG8_WAIT_V(8); PG8_WAIT_L(0); PG8_BAR; PG8_MMA(1, 0, At, B0); PG8_MMA(1, 1, At, B1); PG8_BAR; PG8_SCHED;
        }
        if (wr == 0) PG8_BAR;
        E(acc, cur, wr, wc, fr, fq);
        if (!has_next) break;
#pragma unroll
        for (int a = 0; a < 2; ++a)
#pragma unroll
            for (int b = 0; b < 2; ++b)
#pragma unroll
                for (int m = 0; m < 4; ++m)
#pragma unroll
                    for (int n = 0; n < 2; ++n) acc[a][b][m][n] = (f32x4){0.f, 0.f, 0.f, 0.f};
        cur = nxt; cA = nA; cB = nB; ++ui;
        if (wr == 1) PG8_BAR;
    }
    PG8_WAIT_V(0);
    PG8_BAR;
#undef PG8_SA
#undef PG8_SB
#undef PG8_STAGE
#undef PG8_LDA
#undef PG8_LDB
#undef PG8_MMA
#undef PG8_WAIT_V
#undef PG8_WAIT_L
#undef PG8_BAR
#undef PG8_SCHED
}

#define EPI_LOOP_BEGIN \
    _Pragma("unroll") for (int ai = 0; ai < 2; ++ai) _Pragma("unroll") for (int m = 0; m < 4; ++m) { const int row = u.row0 + ai * HALF + wr * 64 + m * 16 + fr; \
    _Pragma("unroll") for (int bj = 0; bj < 2; ++bj) { const int col = u.col0 + bj * HALF + wc * 32 + 8 * fq; const f32x4 v0 = acc[ai][bj][m][0], v1 = acc[ai][bj][m][1];
#define EPI_LOOP_END } }

struct EpiStore {
    static constexpr bool PERM = true;
    bf16* O; int ldc; float scale;
    __device__ __forceinline__ void operator()(const f32x4 (&acc)[2][2][4][2], const Unit& u, int wr, int wc, int fr, int fq) const {
        EPI_LOOP_BEGIN
            u32x4 w; w.x = pk2(v0[0] * scale, v0[1] * scale); w.y = pk2(v0[2] * scale, v0[3] * scale); w.z = pk2(v1[0] * scale, v1[1] * scale); w.w = pk2(v1[2] * scale, v1[3] * scale);
            *(u32x4*)(O + (size_t)row * ldc + col) = w;
        EPI_LOOP_END
    }
};
struct EpiProj {
    static constexpr bool PERM = true;
    bf16* O; int ldc; bf16* halo;
    __device__ __forceinline__ void operator()(const f32x4 (&acc)[2][2][4][2], const Unit& u, int wr, int wc, int fr, int fq) const {
        const bool hz = (u.col0 >= C_GQ) && (u.col0 < C_GQ + 1536);
        EPI_LOOP_BEGIN
            u32x4 w; w.x = pk2(v0[0], v0[1]); w.y = pk2(v0[2], v0[3]); w.z = pk2(v1[0], v1[1]); w.w = pk2(v1[2], v1[3]);
            *(u32x4*)(O + (size_t)row * ldc + col) = w;
            if (hz && m == 3 && fr >= 13) *(u32x4*)(halo + ((size_t)(row >> 6) * 3 + (fr - 13)) * 1536 + (col - C_GQ)) = w;
        EPI_LOOP_END
    }
};
struct EpiGate {
    static constexpr bool PERM = true;
    bf16* T; int ldc; const float* bias;
    __device__ __forceinline__ void operator()(const f32x4 (&acc)[2][2][4][2], const Unit& u, int wr, int wc, int fr, int fq) const {
        EPI_LOOP_BEGIN
            const int bc = u.aux + bj * HALF + wc * 32 + 8 * fq;
            const f32x4 b0 = *(const f32x4*)(bias + bc), b1 = *(const f32x4*)(bias + bc + 4);
            bf16* p = T + (size_t)row * ldc + col; const u32x4 t = *(const u32x4*)p;
            u32x4 w;
            w.x = pk2(sigmoidf_(v0[0] + b0[0]) * bflo(t.x), sigmoidf_(v0[1] + b0[1]) * bfhi(t.x));
            w.y = pk2(sigmoidf_(v0[2] + b0[2]) * bflo(t.y), sigmoidf_(v0[3] + b0[3]) * bfhi(t.y));
            w.z = pk2(sigmoidf_(v1[0] + b1[0]) * bflo(t.z), sigmoidf_(v1[1] + b1[1]) * bfhi(t.z));
            w.w = pk2(sigmoidf_(v1[2] + b1[2]) * bflo(t.w), sigmoidf_(v1[3] + b1[3]) * bfhi(t.w));
            *(u32x4*)p = w;
        EPI_LOOP_END
    }
};
struct EpiResid {
    static constexpr bool PERM = true;
    const bf16* X; bf16* Y; int ldc;
    __device__ __forceinline__ void operator()(const f32x4 (&acc)[2][2][4][2], const Unit& u, int wr, int wc, int fr, int fq) const {
        EPI_LOOP_BEGIN
            const u32x4 t = *(const u32x4*)(X + (size_t)row * ldc + col);
            u32x4 w;
            w.x = pk2(ALPHA * bflo(t.x) + v0[0], ALPHA * bfhi(t.x) + v0[1]); w.y = pk2(ALPHA * bflo(t.y) + v0[2], ALPHA * bfhi(t.y) + v0[3]);
            w.z = pk2(ALPHA * bflo(t.z) + v1[0], ALPHA * bfhi(t.z) + v1[1]); w.w = pk2(ALPHA * bflo(t.w) + v1[2], ALPHA * bfhi(t.w) + v1[3]);
            *(u32x4*)(Y + (size_t)row * ldc + col) = w;
        EPI_LOOP_END
    }
};
struct EpiSwiglu {
    static constexpr bool PERM = true;
    bf16* H; int ldc;
    __device__ __forceinline__ void operator()(const f32x4 (&acc)[2][2][4][2], const Unit& u, int wr, int wc, int fr, int fq) const {
        EPI_LOOP_BEGIN
            u32x2 w; w.x = pk2(siluf_(v0[0]) * v1[0], siluf_(v0[1]) * v1[1]); w.y = pk2(siluf_(v0[2]) * v1[2], siluf_(v0[3]) * v1[3]);
            *(u32x2*)(H + (size_t)row * ldc + (col >> 1)) = w;
        EPI_LOOP_END
    }
};
}

struct Args {
    const float* x; const float* mem; const float* w_in; const float* gdn_conv_w; const float* gdn_a_log; const float* gdn_dt_bias; const float* gdn_norm_w; const float* fox_f_bias;
    const float* gla_w_gate2; const float* gla_b_gate; const float* gla_norm_w; const float* p_gdn; const float* p_fox; const float* p_gla; const float* b_merge; const float* w_out;
    const float* ln1_g; const float* ln1_b; const float* xa_wq; const float* xa_wkv; const float* xa_wo; const float* ln2_g; const float* ln2_b;
    const float* moe_w_group; const float* moe_b_group; const float* moe_w_expert; const float* moe_b_expert; const float* moe_w_gate; const float* moe_w_up; const float* moe_w_down;
    const float* ln3_g; const float* ln3_b;
    float* out; unsigned char* ws;
};

typedef const __attribute__((address_space(4))) Args* KArgP;

__device__ __forceinline__ int tr_srccol(int mode, int c0, int n) {
    if (mode != 3) return c0 + n;
    return n < 4 ? 1536 + n : n < 8 ? 1540 + (n - 4) : n < 16 ? 3592 + (n - 8) : 5136 + (n - 16);
}
__device__ __forceinline__ int tr_dstrow(int mode, int r0, int nn) {
    if (mode == 1) return r0 + 8 * (nn >> 2) + (nn & 3);
    if (mode == 2) return r0 + 8 * (nn >> 2) + 4 + (nn & 3);
    return r0 + nn;
}
__device__ __forceinline__ void tr_item(const float* W, int ldw, int c0, int ncols, bf16* T, int ldt, int r0, int koff, int mode, LAS float* scr, int item, int lane) {
    const int nblk = ncols / 32, kb = item / nblk, nb = item % nblk, k0 = 64 * kb, n0 = 32 * nb;
    const int sc = tr_srccol(mode, c0, n0 + (lane & 31));
#pragma unroll 8
    for (int i = 0; i < 32; ++i) { const int kk = 2 * i + (lane >> 5); scr[kk * 33 + (lane & 31)] = W[(size_t)(k0 + kk) * ldw + sc]; }
    asm volatile("s_waitcnt lgkmcnt(0)" ::: "memory");
    const int c = lane & 7;
#pragma unroll
    for (int j = 0; j < 4; ++j) { const int n = (lane >> 3) + 8 * j; const LAS float* s = scr + (8 * c) * 33 + n;
        u32x4 o; o.x = pk2(s[0 * 33], s[1 * 33]); o.y = pk2(s[2 * 33], s[3 * 33]); o.z = pk2(s[4 * 33], s[5 * 33]); o.w = pk2(s[6 * 33], s[7 * 33]);
        *(u32x4*)(T + (size_t)tr_dstrow(mode, r0, n0 + n) * ldt + koff + k0 + 8 * c) = o; }
    asm volatile("s_waitcnt lgkmcnt(0)" ::: "memory");
}
__device__ __forceinline__ void tr_job(const float* W, int ldw, int K, int c0, int ncols, size_t wstride, bf16* T, int ldt, int r0, int koff, int mode, size_t tstride, int nmat,
                                       LAS float* scr, int lane, int gw, int NGW, int& run) {
    const int per = (K / 64) * (ncols / 32), n = per * nmat;
    int first = gw - (run % NGW); if (first < 0) first += NGW;
    for (int it = first; it < n; it += NGW) { const int e = it / per, li = it % per; tr_item(W + (size_t)e * wstride, ldw, c0, ncols, T + (size_t)e * tstride, ldt, r0, koff, mode, scr, li, lane); }
    run += n;
}
__device__ __forceinline__ void phase_convert_weights(KArgP A, int l, LAS unsigned char* lds) {
    const int tid = otid(), lane = tid & 63, wid = tid >> 6;
    LAS float* scr = (LAS float*)(lds + wid * 16384);
    const int gw = obid() * 8 + wid, NGW = ogrid() * 8; int run = 0;
    unsigned char* wt = A->ws + WS_WT;
    bf16* WIN = (bf16*)(wt + WT_WIN);
    const float* w_in = A->w_in + (size_t)l * 1024 * N_IN;
    tr_job(w_in, N_IN, 1024, 1544, 512, 0, WIN, 1024, C_OA, 0, 0, 0, 1, scr, lane, gw, NGW, run);
    tr_job(w_in, N_IN, 1024, 2056, 512, 0, WIN, 1024, C_OB, 0, 0, 0, 1, scr, lane, gw, NGW, run);
    tr_job(w_in, N_IN, 1024, 4624, 512, 0, WIN, 1024, C_OC, 0, 0, 0, 1, scr, lane, gw, NGW, run);
    tr_job(w_in, N_IN, 1024, 0, 1536, 0, WIN, 1024, C_GQ, 0, 0, 0, 1, scr, lane, gw, NGW, run);
    tr_job(w_in, N_IN, 1024, 2568, 1024, 0, WIN, 1024, C_FK, 0, 0, 0, 1, scr, lane, gw, NGW, run);
    tr_job(w_in, N_IN, 1024, 3600, 1024, 0, WIN, 1024, C_LQ, 0, 0, 0, 1, scr, lane, gw, NGW, run);
    tr_job(w_in, N_IN, 1024, 0, 32, 0, WIN, 1024, C_SM, 0, 3, 0, 1, scr, lane, gw, NGW, run);
    tr_job(w_in, N_IN, 1024, 5152, 3072, 0, WIN, 1024, LP, 0, 0, 0, 1, scr, lane, gw, NGW, run);
    { u32x4 z = {0u, 0u, 0u, 0u}; asm volatile("" : "+v"(z)); u32x4* p = (u32x4*)(WIN + (size_t)5152 * 1024); const int n16 = 224 * 1024 * 2 / 16;
      for (int i = obid() * 512 + tid; i < n16; i += ogrid() * 512) p[i] = z; }
    bf16* PT = (bf16*)(wt + WT_P);
    tr_job(A->p_gdn + (size_t)l * 512 * 1024, 1024, 512, 0, 1024, 0, PT, 512, 0, 0, 0, 0, 1, scr, lane, gw, NGW, run);
    tr_job(A->p_fox + (size_t)l * 512 * 1024, 1024, 512, 0, 1024, 0, PT + 1024 * 512, 512, 0, 0, 0, 0, 1, scr, lane, gw, NGW, run);
    tr_job(A->p_gla + (size_t)l * 512 * 1024, 1024, 512, 0, 1024, 0, PT + 2 * 1024 * 512, 512, 0, 0, 0, 0, 1, scr, lane, gw, NGW, run);
    bf16* WO3 = (bf16*)(wt + WT_WOUT3);
    for (int r = 0; r < 3; ++r) tr_job(A->w_out + (size_t)l * 1024 * 1024, 1024, 1024, 0, 1024, 0, WO3, 3072, 0, 1024 * r, 0, 0, 1, scr, lane, gw, NGW, run);
    tr_job(A->xa_wq + (size_t)l * 1024 * 1024, 1024, 1024, 0, 1024, 0, (bf16*)(wt + WT_WQ), 1024, 0, 0, 0, 0, 1, scr, lane, gw, NGW, run);
    tr_job(A->xa_wkv + (size_t)l * 1024 * 2048, 2048, 1024, 0, 2048, 0, (bf16*)(wt + WT_WKV), 1024, 0, 0, 0, 0, 1, scr, lane, gw, NGW, run);
    tr_job(A->xa_wo + (size_t)l * 1024 * 1024, 1024, 1024, 0, 1024, 0, (bf16*)(wt + WT_WO), 1024, 0, 0, 0, 0, 1, scr, lane, gw, NGW, run);
    tr_job(A->moe_w_gate + (size_t)l * 32 * 1024 * 256, 256, 1024, 0, 256, (size_t)1024 * 256, (bf16*)(wt + WT_GU), 1024, 0, 0, 1, (size_t)512 * 1024, 32, scr, lane, gw, NGW, run);
    tr_job(A->moe_w_up + (size_t)l * 32 * 1024 * 256, 256, 1024, 0, 256, (size_t)1024 * 256, (bf16*)(wt + WT_GU), 1024, 0, 0, 2, (size_t)512 * 1024, 32, scr, lane, gw, NGW, run);
    tr_job(A->moe_w_down + (size_t)l * 32 * 256 * 1024, 1024, 256, 0, 1024, (size_t)256 * 1024, (bf16*)(wt + WT_DN), 256, 0, 0, 0, (size_t)1024 * 256, 32, scr, lane, gw, NGW, run);
}
__device__ __forceinline__ void convert_rows(const float* src, bf16* dst, size_t n) {
    const size_t n8 = n / 8;
    for (size_t i = (size_t)obid() * 512 + otid(); i < n8; i += (size_t)ogrid() * 512) {
        const f32x4 a = *(const f32x4*)(src + i * 8), b = *(const f32x4*)(src + i * 8 + 4);
        u32x4 w; w.x = pk2(a[0], a[1]); w.y = pk2(a[2], a[3]); w.z = pk2(b[0], b[1]); w.w = pk2(b[2], b[3]);
        *(u32x4*)(dst + i * 8) = w;
    }
}

struct RegSched {
    int nM, nN, nwg, G, c; const char* A; const char* B; size_t astride, bstride; int col_base;
    __device__ __forceinline__ bool next(int i, pg8::Unit& u) const {
        const long L = (long)i * G + c; if (L >= nwg) return false;
        int wgid = (int)L; { const int q = nwg / 8, r = nwg % 8, xcd = wgid % 8, off = wgid / 8; wgid = (xcd < r ? xcd * (q + 1) : r * (q + 1) + (xcd - r) * q) + off; }
        const int nig = 8 * nN, gid = wgid / nig, fm = gid * 8, gsz = (nM - fm) < 8 ? (nM - fm) : 8;
        const int pm = fm + ((wgid % nig) % gsz), pn = (wgid % nig) / gsz;
        u.a = A + (size_t)pm * astride; u.b = B + (size_t)pn * bstride; u.row0 = pm * 256; u.col0 = col_base + pn * 256; u.aux = pn * 256; return true;
    }
};
struct BranchSched {
    int nM, nwg, G, c; const char* A; const char* B;
    __device__ __forceinline__ bool next(int i, pg8::Unit& u) const {
        const long L = (long)i * G + c; if (L >= nwg) return false;
        int wgid = (int)L; { const int q = nwg / 8, r = nwg % 8, xcd = wgid % 8, off = wgid / 8; wgid = (xcd < r ? xcd * (q + 1) : r * (q + 1) + (xcd - r) * q) + off; }
        const int nN = 12, nig = 8 * nN, gid = wgid / nig, fm = gid * 8, gsz = (nM - fm) < 8 ? (nM - fm) : 8;
        const int pm = fm + ((wgid % nig) % gsz), pn = (wgid % nig) / gsz, br = pn >> 2;
        u.a = A + ((size_t)pm * 256 * LP + br * 512) * 2; u.b = B + ((size_t)br * 1024 * 512 + (size_t)(pn & 3) * 256 * 512) * 2; u.row0 = pm * 256; u.col0 = C_T + pn * 256; u.aux = 0; return true;
    }
};
struct MoeSched {
    int nct, G, c; const LAS int* tab;
    const char* A; size_t astride; const char* B; size_t bexp, bct;
    __device__ __forceinline__ bool next(int i, pg8::Unit& u) const {
        const long L = (long)i * G + c; const int nblk = tab[0]; if (L >= (long)nblk * nct) return false;
        const int rb = (int)(L / nct), ct = (int)(L % nct), e = tab[1 + rb];
        u.a = A + (size_t)rb * astride; u.b = B + (size_t)e * bexp + (size_t)ct * bct; u.row0 = rb * 256; u.col0 = ct * 256; u.aux = e; return true;
    }
};

template <int D, bool FOX>
__device__ __forceinline__ void flash_unit(LAS unsigned char* lds, const bf16* Q, int ldq, const bf16* K, const bf16* V, int ldkv, bf16* O, int ldo,
                                           int ntiles, int qpos0, float sc_log2, const LAS float* CK) {
    const int tid = otid(), lane = tid & 63, wid = tid >> 6, l15 = lane & 15, g = lane >> 4;
    constexpr int KST = (D + 8) * 2;
    LAS unsigned char* KS = lds; LAS unsigned char* VS = lds + 64 * KST; LAS unsigned char* PS = lds + 2 * 64 * KST + wid * 2304;
    bf16x8 qf[D / 32];
    { const bf16* qrow = Q + (size_t)(wid * 16 + l15) * ldq + 8 * g;
#pragma unroll
      for (int ks = 0; ks < D / 32; ++ks) qf[ks] = *(const bf16x8*)(qrow + ks * 32); }
    f32x4 o[D / 16];
#pragma unroll
    for (int i = 0; i < D / 16; ++i) o[i] = (f32x4){0.f, 0.f, 0.f, 0.f};
    float mrow[4], lrow[4];
#pragma unroll
    for (int r = 0; r < 4; ++r) { mrow[r] = -1e30f; lrow[r] = 0.f; }
    for (int t = 0; t < ntiles; ++t) {
        __syncthreads();
        for (int c = tid; c < 64 * (D / 8); c += 512) { const int row = c / (D / 8), ch = c % (D / 8);
            const u32x4 kv = *(const u32x4*)(K + (size_t)(t * 64 + row) * ldkv + ch * 8); const u32x4 vv = *(const u32x4*)(V + (size_t)(t * 64 + row) * ldkv + ch * 8);
            *(LAS u32x4*)(KS + row * KST + ch * 16) = kv; *(LAS u32x4*)(VS + row * KST + ch * 16) = vv; }
        __syncthreads();
        f32x4 s[4];
#pragma unroll
        for (int nb = 0; nb < 4; ++nb) { s[nb] = (f32x4){0.f, 0.f, 0.f, 0.f};
#pragma unroll
            for (int ks = 0; ks < D / 32; ++ks) { const bf16x8 kf = *(const LAS bf16x8*)(KS + (nb * 16 + l15) * KST + (ks * 32 + 8 * g) * 2);
                s[nb] = __builtin_amdgcn_mfma_f32_16x16x32_bf16(qf[ks], kf, s[nb], 0, 0, 0); } }
        float mx[4];
#pragma unroll
        for (int r = 0; r < 4; ++r) mx[r] = -1e30f;
#pragma unroll
        for (int nb = 0; nb < 4; ++nb) { const int key = t * 64 + nb * 16 + l15; float kb = 0.f; if (FOX) kb = CK[key] * LOG2E;
#pragma unroll
            for (int r = 0; r < 4; ++r) { float v = s[nb][r] * sc_log2 - kb; if (FOX) { if (key > qpos0 + wid * 16 + 4 * g + r) v = -1e30f; } s[nb][r] = v; mx[r] = fmaxf(mx[r], v); } }
#pragma unroll
        for (int r = 0; r < 4; ++r) { float m = mx[r]; m = fmaxf(m, swz_xor<1>(m)); m = fmaxf(m, swz_xor<2>(m)); m = fmaxf(m, swz_xor<4>(m)); m = fmaxf(m, swz_xor<8>(m));
            const float mn = fmaxf(mrow[r], m), al = exp2f(mrow[r] - mn); mrow[r] = mn; lrow[r] *= al;
#pragma unroll
            for (int i = 0; i < D / 16; ++i) o[i][r] *= al;
            float ps = 0.f;
#pragma unroll
            for (int nb = 0; nb < 4; ++nb) { const float p = exp2f(s[nb][r] - mn); ps += p; *(LAS bf16*)(PS + ((4 * g + r) * 72 + nb * 16 + l15) * 2) = (bf16)f2bf(p); }
            lrow[r] += ps; }
        bf16x8 pf[2];
#pragma unroll
        for (int ks = 0; ks < 2; ++ks) pf[ks] = *(const LAS bf16x8*)(PS + (l15 * 72 + ks * 32 + 8 * g) * 2);
        const int q4 = l15 >> 2, p4 = lane & 3;
#pragma unroll
        for (int nb = 0; nb < D / 16; ++nb) {
#pragma unroll
            for (int ks = 0; ks < 2; ++ks) {
                const s16x4 lo = __builtin_amdgcn_ds_read_tr16_b64_v4i16((LAS s16x4*)(VS + (32 * ks + 8 * g + q4) * KST + (16 * nb + 4 * p4) * 2));
                const s16x4 hi = __builtin_amdgcn_ds_read_tr16_b64_v4i16((LAS s16x4*)(VS + (32 * ks + 8 * g + 4 + q4) * KST + (16 * nb + 4 * p4) * 2));
                const bf16x8 vf = (bf16x8){lo[0], lo[1], lo[2], lo[3], hi[0], hi[1], hi[2], hi[3]};
                o[nb] = __builtin_amdgcn_mfma_f32_16x16x32_bf16(pf[ks], vf, o[nb], 0, 0, 0); } }
    }
#pragma unroll
    for (int r = 0; r < 4; ++r) { float l = lrow[r]; l += swz_xor<1>(l); l += swz_xor<2>(l); l += swz_xor<4>(l); l += swz_xor<8>(l);
        const float inv = 1.f / l; bf16* orow = O + (size_t)(wid * 16 + 4 * g + r) * ldo + l15;
#pragma unroll
        for (int nb = 0; nb < D / 16; ++nb) orow[nb * 16] = (bf16)f2bf(o[nb][r] * inv); }
}

__device__ __forceinline__ void fox_unit(KArgP A, int l, LAS unsigned char* lds, int b, int h, int qb) {
    bf16* PJ = (bf16*)(A->ws + WS_PROJ);
    const int tid = otid(), lane = tid & 63, wid = tid >> 6;
    LAS float* CK = (LAS float*)(lds + 2 * 64 * 144 + 8 * 2304);
    LAS float* WT = CK + 2048;
    const int nkeys = 128 * (qb + 1);
    __syncthreads();
    {
        const float fb = A->fox_f_bias[l * 8 + h];
        float v[4]; float run = 0.f;
#pragma unroll
        for (int i = 0; i < 4; ++i) { const int t = tid * 4 + i; float x = 0.f; if (t < nkeys) x = logsigmoidf_(bf2f(PJ[(size_t)(b * SEQ + t) * LP + C_SM + 8 + h]) + fb); run += x; v[i] = run; }
        float inc = run;
#pragma unroll
        for (int o = 1; o < 64; o <<= 1) { const float y = __builtin_bit_cast(float, __builtin_amdgcn_ds_bpermute(((lane - o) & 63) << 2, __builtin_bit_cast(int, inc))); if (lane >= o) inc += y; }
        if (lane == 63) WT[wid] = inc;
        __syncthreads();
        float base = inc - run;
        for (int w = 0; w < wid; ++w) base += WT[w];
#pragma unroll
        for (int i = 0; i < 4; ++i) CK[tid * 4 + i] = base + v[i];
    }
    const size_t rowq = (size_t)(b * SEQ + qb * 128), rowk = (size_t)b * SEQ;
    flash_unit<64, true>(lds, PJ + rowq * LP + C_OB + h * 64, LP, PJ + rowk * LP + C_FK + h * 64, PJ + rowk * LP + C_FV + h * 64, LP, PJ + rowq * LP + C_OB + h * 64, LP,
                         2 * (qb + 1), qb * 128, 0.125f * LOG2E, CK);
}

__device__ __forceinline__ bf16x8 frag_rm(const LAS unsigned char* base, int stride, int blk, int ks, int l15, int g) { return *(const LAS bf16x8*)(base + (blk * 16 + l15) * stride + (ks * 32 + 8 * g) * 2); }
__device__ __forceinline__ bf16x8 frag_tr(const LAS unsigned char* base, int stride, int ks, int nb, int g, int q4, int p4) {
    const s16x4 lo = __builtin_amdgcn_ds_read_tr16_b64_v4i16((LAS s16x4*)(base + (32 * ks + 8 * g + q4) * stride + (16 * nb + 4 * p4) * 2));
    const s16x4 hi = __builtin_amdgcn_ds_read_tr16_b64_v4i16((LAS s16x4*)(base + (32 * ks + 8 * g + 4 + q4) * stride + (16 * nb + 4 * p4) * 2));
    return (bf16x8){lo[0], lo[1], lo[2], lo[3], hi[0], hi[1], hi[2], hi[3]};
}
#define MFMA16(a, b, c) __builtin_amdgcn_mfma_f32_16x16x32_bf16((a), (b), (c), 0, 0, 0)

__device__ __forceinline__ void gdn_prep_task(KArgP A, int l, LAS unsigned char* lds, int b, int h, int n) {
    bf16* PJ = (bf16*)(A->ws + WS_PROJ);
    unsigned char* dsc = (unsigned char*)A->out; const bf16* HALO = (const bf16*)(dsc + DO_HALO);
    unsigned char* rec = dsc + DO_GP + (size_t)((b * 4 + h) * 32 + n) * GP_STRIDE;
    const int tid = otid(), lane = tid & 63, wid = tid >> 6, l15 = lane & 15, g = lane >> 4;
    constexpr int S136 = 272, S72 = 144, S40 = 80;
    LAS float* qf = (LAS float*)lds; LAS float* kf = qf + 64 * 128; LAS float* vf = kf + 64 * 128;
    LAS unsigned char* KB16 = lds + 98304; LAS unsigned char* QB16 = lds + 115712;
    LAS float* GC = (LAS float*)(lds + 146432); LAS float* BETA = GC + 64; LAS float* EG = BETA + 64;
    LAS unsigned char* AOFF = lds;
    LAS unsigned char* ATTS = lds + 9216;
    LAS float* AKK = (LAS float*)(lds + 18432);
    LAS unsigned char* TD = lds + 23552;
    LAS unsigned char* XT = lds + 98304;
    LAS unsigned char* TT = lds + 65536;
    const float* cw = A->gdn_conv_w + (size_t)l * 4 * 1536;
    const float alog = A->gdn_a_log[l * 4 + h], dtb = A->gdn_dt_bias[l * 4 + h];
    const int t0 = n * 64; const size_t row0 = (size_t)b * SEQ + t0;
    __syncthreads();
    for (int it = tid; it < 64 * 48; it += 512) { const int tt = it / 48, pc = it % 48, part = pc >> 4, c8 = pc & 15;
        const int c = part * 512 + h * 128 + c8 * 8;
        float y[8];
#pragma unroll
        for (int e = 0; e < 8; ++e) y[e] = 0.f;
#pragma unroll
        for (int i = 0; i < 4; ++i) { const int tr = tt - 3 + i; const bf16* sp = nullptr;
            if (tr >= 0) sp = PJ + (row0 + tr) * LP + C_GQ + c; else if (n > 0) sp = HALO + ((size_t)(b * 32 + n - 1) * 3 + (3 + tr)) * 1536 + c;
            if (sp) { const u32x4 xv = *(const u32x4*)sp;
                const f32x4 w0 = *(const f32x4*)(cw + i * 1536 + c), w1 = *(const f32x4*)(cw + i * 1536 + c + 4);
                y[0] += w0[0] * bflo(xv.x); y[1] += w0[1] * bfhi(xv.x); y[2] += w0[2] * bflo(xv.y); y[3] += w0[3] * bfhi(xv.y);
                y[4] += w1[0] * bflo(xv.z); y[5] += w1[1] * bfhi(xv.z); y[6] += w1[2] * bflo(xv.w); y[7] += w1[3] * bfhi(xv.w); } }
        LAS float* dst = (part == 0 ? qf : part == 1 ? kf : vf) + tt * 128 + c8 * 8;
#pragma unroll
        for (int e = 0; e < 8; ++e) dst[e] = siluf_(y[e]); }
    if (tid < 64) { const size_t r = (row0 + tid) * LP + C_SM; const float a = bf2f(PJ[r + 4 + h]), bb = bf2f(PJ[r + h]);
        float gg = -__expf(alog) * softplusf_(a + dtb);
#pragma unroll
        for (int o = 1; o < 64; o <<= 1) { const float y2 = __builtin_bit_cast(float, __builtin_amdgcn_ds_bpermute(((lane - o) & 63) << 2, __builtin_bit_cast(int, gg))); if (lane >= o) gg += y2; }
        GC[tid] = gg; EG[tid] = __expf(gg); BETA[tid] = sigmoidf_(bb); }
    __syncthreads();
    for (int rr = wid; rr < 128; rr += 8) { const bool isq = rr < 64; const int row = isq ? rr : rr - 64; LAS float* p = (isq ? qf : kf) + row * 128;
        const float a = p[lane * 2], c = p[lane * 2 + 1]; const float sc = rsqrtf(wave_sum(a * a + c * c) + 1e-6f); const float an = a * sc, cn = c * sc;
        if (isq) { *(LAS unsigned*)(QB16 + row * S136 + lane * 4) = pk2(an, cn); const float f = 0.08838834764831845f * EG[row];
            *(unsigned*)(PJ + (row0 + row) * LP + C_GQ + h * 128 + lane * 2) = pk2(an * f, cn * f); }
        else { p[lane * 2] = an; p[lane * 2 + 1] = cn; *(LAS unsigned*)(KB16 + row * S136 + lane * 4) = pk2(an, cn); } }
    __syncthreads();
    {
        const int mb = wid >> 1;
        bf16x8 ak[4], aq[4];
#pragma unroll
        for (int ks = 0; ks < 4; ++ks) { ak[ks] = frag_rm(KB16, S136, mb, ks, l15, g); aq[ks] = frag_rm(QB16, S136, mb, ks, l15, g); }
#pragma unroll
        for (int j = 0; j < 2; ++j) { const int nb = 2 * (wid & 1) + j; f32x4 kk = (f32x4){0.f, 0.f, 0.f, 0.f}, qk = (f32x4){0.f, 0.f, 0.f, 0.f};
#pragma unroll
            for (int ks = 0; ks < 4; ++ks) { const bf16x8 bfr = frag_rm(KB16, S136, nb, ks, l15, g); kk = MFMA16(ak[ks], bfr, kk); qk = MFMA16(aq[ks], bfr, qk); }
            const int jj = nb * 16 + l15; const float gj = GC[jj];
#pragma unroll
            for (int r = 0; r < 4; ++r) { const int i = mb * 16 + 4 * g + r; const float dec = jj <= i ? __expf(GC[i] - gj) : 0.f;
                const float av = jj < i ? BETA[i] * kk[r] * dec : 0.f;
                *(LAS bf16*)(AOFF + i * S72 + jj * 2) = (bf16)f2bf(nb < mb ? av : 0.f);
                if (nb == mb) AKK[(mb * 16 + 4 * g + r) * 20 + l15] = av;
                *(LAS bf16*)(ATTS + i * S72 + jj * 2) = (bf16)f2bf(qk[r] * dec * 0.08838834764831845f); } }
        for (int i = tid; i < 64 * S40 / 16; i += 512) *(LAS u32x4*)(TD + i * 16) = (u32x4){0u, 0u, 0u, 0u};
    }
    __syncthreads();
    if (tid < 64) { const int k = tid >> 4, c = tid & 15; const LAS float* ab = AKK + k * 16 * 20; float y[16];
#pragma unroll
        for (int i = 0; i < 16; ++i) { float s = (i == c) ? 1.f : 0.f;
#pragma unroll
            for (int m = 0; m < i; ++m) s -= ab[i * 20 + m] * y[m];
            y[i] = s; *(LAS bf16*)(TD + (k * 16 + i) * S40 + c * 2) = (bf16)f2bf(s); } }
    for (int it = tid; it < 64 * 256; it += 512) { const int col = it & 255, i = it >> 8;
        const float r = col < 128 ? BETA[i] * vf[i * 128 + col] : BETA[i] * EG[i] * kf[i * 128 + col - 128];
        *(LAS bf16*)(XT + col * S72 + i * 2) = (bf16)f2bf(r); }
    __syncthreads();
    {
        for (int i = lane; i < 32 * S40 / 16; i += 64) *(LAS u32x4*)(TT + wid * 32 * S40 + i * 16) = (u32x4){0u, 0u, 0u, 0u};
#pragma unroll
        for (int k = 0; k < 4; ++k) {
#pragma unroll
            for (int jn = 0; jn < 2; ++jn) { const int nb = 2 * wid + jn, col = nb * 16 + l15;
                f32x4 acc = (f32x4){0.f, 0.f, 0.f, 0.f};
                if (k > 0) { acc = MFMA16(frag_rm(AOFF, S72, k, 0, l15, g), frag_rm(XT, S72, nb, 0, l15, g), acc);
                    if (k == 3) acc = MFMA16(frag_rm(AOFF, S72, k, 1, l15, g), frag_rm(XT, S72, nb, 1, l15, g), acc); }
                const u32x2 rv = *(const LAS u32x2*)(XT + col * S72 + (16 * k + 4 * g) * 2);
                *(LAS u32x2*)(TT + col * S40 + (4 * g) * 2) = (u32x2){pk2(bflo(rv.x) - acc[0], bfhi(rv.x) - acc[1]), pk2(bflo(rv.y) - acc[2], bfhi(rv.y) - acc[3])};
                f32x4 x = MFMA16(frag_rm(TD, S40, k, 0, l15, g), frag_rm(TT, S40, nb, 0, l15, g), ((f32x4){0.f, 0.f, 0.f, 0.f}));
                *(LAS u32x2*)(XT + col * S72 + (16 * k + 4 * g) * 2) = (u32x2){pk2(x[0], x[1]), pk2(x[2], x[3])};
                if (col < 128) { bf16* up = PJ + (row0 + 16 * k + 4 * g) * LP + C_GV + h * 128 + col;
#pragma unroll
                    for (int r = 0; r < 4; ++r) up[(size_t)r * LP] = (bf16)f2bf(x[r]); }
                else { bf16* wp = (bf16*)(rec + GP_W) + (16 * k + 4 * g) * 128 + (col - 128);
#pragma unroll
                    for (int r = 0; r < 4; ++r) wp[r * 128] = (bf16)f2bf(x[r]); }
            }
        }
    }
    {
        { const int row = tid >> 3, c8 = tid & 7; *(u32x4*)(rec + GP_ATT + row * 128 + c8 * 16) = *(const LAS u32x4*)(ATTS + row * S72 + c8 * 16); }
        { const int dk = tid & 127, qt = tid >> 7; const float gl = GC[63]; unsigned w[8];
#pragma unroll
          for (int i = 0; i < 8; ++i) { const int c0 = qt * 16 + 2 * i; w[i] = pk2(kf[c0 * 128 + dk] * __expf(gl - GC[c0]), kf[(c0 + 1) * 128 + dk] * __expf(gl - GC[c0 + 1])); }
          u32x4* kp = (u32x4*)(rec + GP_KDT + dk * 128 + qt * 32);
          kp[0] = (u32x4){w[0], w[1], w[2], w[3]}; kp[1] = (u32x4){w[4], w[5], w[6], w[7]}; }
        if (tid == 0) *(float*)(rec + GP_CD) = EG[63];
    }
}

__device__ __forceinline__ void gdn_scan_chain(KArgP A, int l, LAS unsigned char* lds, int b, int h) {
    bf16* PJ = (bf16*)(A->ws + WS_PROJ);
    unsigned char* dsc = (unsigned char*)A->out;
    const int tid = otid(), lane = tid & 63, wid = tid >> 6, l15 = lane & 15, g = lane >> 4;
    constexpr int S136 = 272, S72 = 144;
    LAS unsigned char* Wl = lds; LAS unsigned char* QDl = lds + 17408; LAS unsigned char* Ul = lds + 34816; LAS unsigned char* KDTl = lds + 52224; LAS unsigned char* ATTl = lds + 70656;
    LAS unsigned char* STl = lds + 79872; LAS unsigned char* VNl = lds + 114688; LAS float* SSQ = (LAS float*)(lds + 133120);
    LAS unsigned char* OST = Wl;
    const float* nw = A->gdn_norm_w + l * 128;
    const int mb = wid >> 1, nb0 = 4 * (wid & 1);
    f32x4 S[8];
#pragma unroll
    for (int j = 0; j < 8; ++j) S[j] = (f32x4){0.f, 0.f, 0.f, 0.f};
    __syncthreads();
    for (int i = tid; i < 128 * S136 / 16; i += 512) *(LAS u32x4*)(STl + i * 16) = (u32x4){0u, 0u, 0u, 0u};
    u32x4 pw[2], pq[2], pu[2], pk[2], pa; float cd = 0.f, cdn = 0.f;
#define GDN_ISSUE(nn) do { const unsigned char* rec_ = dsc + DO_GP + (size_t)((b * 4 + h) * 32 + (nn)) * GP_STRIDE; const size_t r0_ = (size_t)b * SEQ + (nn) * 64; \
        _Pragma("unroll") for (int q_ = 0; q_ < 2; ++q_) { const int c_ = tid + 512 * q_, row_ = c_ >> 4, c16_ = c_ & 15; \
            pw[q_] = *(const u32x4*)(rec_ + GP_W + row_ * 256 + c16_ * 16); \
            pq[q_] = *(const u32x4*)(PJ + (r0_ + row_) * LP + C_GQ + h * 128 + c16_ * 8); pu[q_] = *(const u32x4*)(PJ + (r0_ + row_) * LP + C_GV + h * 128 + c16_ * 8); \
            pk[q_] = *(const u32x4*)(rec_ + GP_KDT + (c_ >> 3) * 128 + (c_ & 7) * 16); } \
        pa = *(const u32x4*)(rec_ + GP_ATT + (tid >> 3) * 128 + (tid & 7) * 16); cdn = *(const float*)(rec_ + GP_CD); } while (0)
    GDN_ISSUE(0);
    for (int n = 0; n < SEQ / 64; ++n) {
        const size_t row0 = (size_t)b * SEQ + n * 64;
        __syncthreads();
#pragma unroll
        for (int q = 0; q < 2; ++q) { const int c = tid + 512 * q, row = c >> 4, c16 = c & 15;
            *(LAS u32x4*)(Wl + row * S136 + c16 * 16) = pw[q]; *(LAS u32x4*)(QDl + row * S136 + c16 * 16) = pq[q]; *(LAS u32x4*)(Ul + row * S136 + c16 * 16) = pu[q];
            *(LAS u32x4*)(KDTl + (c >> 3) * S72 + (c & 7) * 16) = pk[q]; }
        *(LAS u32x4*)(ATTl + (tid >> 3) * S72 + (tid & 7) * 16) = pa; cd = cdn;
        __syncthreads();
        if (n + 1 < SEQ / 64) GDN_ISSUE(n + 1);
        f32x4 accO[4];
        {
            bf16x8 aw[4], aq[4];
#pragma unroll
            for (int ks = 0; ks < 4; ++ks) { aw[ks] = frag_rm(Wl, S136, mb, ks, l15, g); aq[ks] = frag_rm(QDl, S136, mb, ks, l15, g); }
#pragma unroll
            for (int j = 0; j < 4; ++j) { const int nb = nb0 + j; f32x4 ws = (f32x4){0.f, 0.f, 0.f, 0.f}; accO[j] = (f32x4){0.f, 0.f, 0.f, 0.f};
#pragma unroll
                for (int ks = 0; ks < 4; ++ks) { const bf16x8 sf = frag_rm(STl, S136, nb, ks, l15, g); ws = MFMA16(aw[ks], sf, ws); accO[j] = MFMA16(aq[ks], sf, accO[j]); }
                float vn[4];
#pragma unroll
                for (int r = 0; r < 4; ++r) vn[r] = bf2f(*(const LAS bf16*)(Ul + (mb * 16 + 4 * g + r) * S136 + (nb * 16 + l15) * 2)) - ws[r];
                *(LAS u32x2*)(VNl + (nb * 16 + l15) * S72 + (mb * 16 + 4 * g) * 2) = (u32x2){pk2(vn[0], vn[1]), pk2(vn[2], vn[3])}; }
        }
        __syncthreads();
        {
            bf16x8 aa[2], ak[2];
#pragma unroll
            for (int ks = 0; ks < 2; ++ks) { aa[ks] = frag_rm(ATTl, S72, mb, ks, l15, g); ak[ks] = frag_rm(KDTl, S72, wid, ks, l15, g); }
#pragma unroll
            for (int j = 0; j < 4; ++j)
#pragma unroll
                for (int ks = 0; ks < 2; ++ks) accO[j] = MFMA16(aa[ks], frag_rm(VNl, S72, nb0 + j, ks, l15, g), accO[j]);
#pragma unroll
            for (int jb = 0; jb < 8; ++jb) { S[jb] = S[jb] * cd;
#pragma unroll
                for (int ks = 0; ks < 2; ++ks) S[jb] = MFMA16(ak[ks], frag_rm(VNl, S72, jb, ks, l15, g), S[jb]);
                *(LAS u32x2*)(STl + (jb * 16 + l15) * S136 + (wid * 16 + 4 * g) * 2) = (u32x2){pk2(S[jb][0], S[jb][1]), pk2(S[jb][2], S[jb][3])}; }
        }
        {
            float ss[4];
#pragma unroll
            for (int r = 0; r < 4; ++r) { float s = 0.f;
#pragma unroll
                for (int j = 0; j < 4; ++j) s += accO[j][r] * accO[j][r];
                s += swz_xor<1>(s); s += swz_xor<2>(s); s += swz_xor<4>(s); s += swz_xor<8>(s); ss[r] = s; }
            if (l15 == 0) {
#pragma unroll
                for (int r = 0; r < 4; ++r) SSQ[(mb * 16 + 4 * g + r) * 2 + (wid & 1)] = ss[r]; }
            __syncthreads();
#pragma unroll
            for (int r = 0; r < 4; ++r) { const int i = mb * 16 + 4 * g + r; const float sc = rsqrtf((SSQ[i * 2] + SSQ[i * 2 + 1]) * (1.f / 128.f) + 1e-6f);
#pragma unroll
                for (int j = 0; j < 4; ++j) { const int dv = (nb0 + j) * 16 + l15; *(LAS bf16*)(OST + i * S136 + dv * 2) = (bf16)f2bf(accO[j][r] * sc * nw[dv]); } }
            __syncthreads();
            for (int it = tid; it < 64 * 16; it += 512) { const int tt = it >> 4, c8 = it & 15;
                bf16* gp = PJ + (row0 + tt) * LP + C_OA + h * 128 + c8 * 8; const u32x4 rv = *(const u32x4*)gp; const u32x4 ov = *(const LAS u32x4*)(OST + tt * S136 + c8 * 16);
                u32x4 w; w.x = pk2(bflo(ov.x) * siluf_(bflo(rv.x)), bfhi(ov.x) * siluf_(bfhi(rv.x))); w.y = pk2(bflo(ov.y) * siluf_(bflo(rv.y)), bfhi(ov.y) * siluf_(bfhi(rv.y)));
                w.z = pk2(bflo(ov.z) * siluf_(bflo(rv.z)), bfhi(ov.z) * siluf_(bfhi(rv.z))); w.w = pk2(bflo(ov.w) * siluf_(bflo(rv.w)), bfhi(ov.w) * siluf_(bfhi(rv.w)));
                *(u32x4*)gp = w; }
        }
    }
#undef GDN_ISSUE
}

__device__ __forceinline__ void gla_chain(KArgP A, int l, LAS unsigned char* lds, int b, int h) {
    bf16* PJ = (bf16*)(A->ws + WS_PROJ);
    const int tid = otid(), lane = tid & 63, wid = tid >> 6, l15 = lane & 15, g = lane >> 4, q4 = l15 >> 2, p4 = lane & 3;
    constexpr int S72 = 144, S136 = 272;
    LAS unsigned char* QT = lds;
    LAS unsigned char* KT = QT + 64 * S72;
    LAS unsigned char* KDT = KT + 64 * S72;
    LAS unsigned char* ATT = KDT + 64 * S72;
    LAS unsigned char* VV = ATT + 64 * S72;
    LAS unsigned char* ST = VV + 64 * S136;
    LAS unsigned char* OST = ST + 128 * S72;
    LAS float* LA = (LAS float*)(OST + 64 * S136);
    LAS float* LR = LA + 64 * 64;
    LAS float* SEG = LR + 64 * 16;
    LAS float* CD = SEG + 8 * 64;
    LAS float* SSQ = CD + 64;
    const float* wg2 = A->gla_w_gate2 + (size_t)l * 16 * 256; const float* bg = A->gla_b_gate + l * 256; const float* nw = A->gla_norm_w + l * 128;
    const int mb = wid >> 1, nb0 = 4 * (wid & 1);
    f32x4 S[4];
#pragma unroll
    for (int j = 0; j < 4; ++j) S[j] = (f32x4){0.f, 0.f, 0.f, 0.f};
    __syncthreads();
    for (int i = tid; i < 128 * S72 / 16; i += 512) *(LAS u32x4*)(ST + i * 16) = (u32x4){0u, 0u, 0u, 0u};
    for (int n = 0; n < SEQ / 64; ++n) {
        const size_t row0 = (size_t)b * SEQ + n * 64;
        __syncthreads();
        for (int it = tid; it < 64 * 16; it += 512) { const int tt = it >> 4, r = it & 15; LR[it] = bf2f(PJ[(row0 + tt) * LP + C_SM + 16 + r]); }
        for (int it = tid; it < 64 * 16; it += 512) { const int tt = it >> 4, c8 = it & 15;
            *(LAS u32x4*)(VV + tt * S136 + c8 * 16) = *(const u32x4*)(PJ + (row0 + tt) * LP + C_LV + h * 128 + c8 * 8); }
        __syncthreads();
        for (int it = tid; it < 64 * 64; it += 512) { const int tt = it >> 6, d = it & 63; float z = bg[h * 64 + d];
#pragma unroll
            for (int r = 0; r < 16; ++r) z += LR[tt * 16 + r] * wg2[r * 256 + h * 64 + d];
            LA[it] = logsigmoidf_(z) * (1.f / 16.f); }
        __syncthreads();
        { const int d = tid & 63, seg = tid >> 6; float run = 0.f;
#pragma unroll
          for (int i = 0; i < 8; ++i) { run += LA[(seg * 8 + i) * 64 + d]; LA[(seg * 8 + i) * 64 + d] = run; }
          SEG[seg * 64 + d] = run; }
        __syncthreads();
        { const int d = tid & 63, seg = tid >> 6; float pre = 0.f;
          for (int s2 = 0; s2 < seg; ++s2) pre += SEG[s2 * 64 + d];
#pragma unroll
          for (int i = 0; i < 8; ++i) LA[(seg * 8 + i) * 64 + d] += pre; }
        __syncthreads();
        {
            const int tt = tid >> 3, c8 = tid & 7;
            const u32x4 qv = *(const u32x4*)(PJ + (row0 + tt) * LP + C_LQ + h * 64 + c8 * 8); const u32x4 kv = *(const u32x4*)(PJ + (row0 + tt) * LP + C_LK + h * 64 + c8 * 8);
            float qf[8] = {bflo(qv.x), bfhi(qv.x), bflo(qv.y), bfhi(qv.y), bflo(qv.z), bfhi(qv.z), bflo(qv.w), bfhi(qv.w)};
            float kf[8] = {bflo(kv.x), bfhi(kv.x), bflo(kv.y), bfhi(kv.y), bflo(kv.z), bfhi(kv.z), bflo(kv.w), bfhi(kv.w)};
            float qt[8], kt[8];
#pragma unroll
            for (int e = 0; e < 8; ++e) { const int d = c8 * 8 + e; const float cu = LA[tt * 64 + d], cl = LA[63 * 64 + d];
                qt[e] = qf[e] * 0.125f * __expf(cu); kt[e] = kf[e] * __expf(-cu);
                *(LAS bf16*)(KDT + d * S72 + tt * 2) = (bf16)f2bf(kf[e] * __expf(cl - cu)); }
            *(LAS u32x4*)(QT + tt * S72 + c8 * 16) = (u32x4){pk2(qt[0], qt[1]), pk2(qt[2], qt[3]), pk2(qt[4], qt[5]), pk2(qt[6], qt[7])};
            *(LAS u32x4*)(KT + tt * S72 + c8 * 16) = (u32x4){pk2(kt[0], kt[1]), pk2(kt[2], kt[3]), pk2(kt[4], kt[5]), pk2(kt[6], kt[7])};
            if (tid < 64) CD[tid] = __expf(LA[63 * 64 + tid]);
        }
        __syncthreads();
        f32x4 acc[4];
        {
            bf16x8 af[2];
#pragma unroll
            for (int ks = 0; ks < 2; ++ks) af[ks] = frag_rm(QT, S72, mb, ks, l15, g);
#pragma unroll
            for (int j = 0; j < 2; ++j) { const int nb = 2 * (wid & 1) + j; f32x4 a = (f32x4){0.f, 0.f, 0.f, 0.f};
#pragma unroll
                for (int ks = 0; ks < 2; ++ks) a = MFMA16(af[ks], frag_rm(KT, S72, nb, ks, l15, g), a);
#pragma unroll
                for (int r = 0; r < 4; ++r) { const int i = mb * 16 + 4 * g + r, jj = nb * 16 + l15; *(LAS bf16*)(ATT + i * S72 + jj * 2) = (bf16)f2bf(jj <= i ? a[r] : 0.f); } }
#pragma unroll
            for (int j = 0; j < 4; ++j) { acc[j] = (f32x4){0.f, 0.f, 0.f, 0.f};
#pragma unroll
                for (int ks = 0; ks < 2; ++ks) acc[j] = MFMA16(af[ks], frag_rm(ST, S72, nb0 + j, ks, l15, g), acc[j]); }
        }
        __syncthreads();
        {
            bf16x8 af[2], kf2[2];
#pragma unroll
            for (int ks = 0; ks < 2; ++ks) { af[ks] = frag_rm(ATT, S72, mb, ks, l15, g); kf2[ks] = frag_rm(KDT, S72, mb, ks, l15, g); }
            float cdv[4];
#pragma unroll
            for (int r = 0; r < 4; ++r) cdv[r] = CD[mb * 16 + 4 * g + r];
#pragma unroll
            for (int j = 0; j < 4; ++j) {
#pragma unroll
                for (int r = 0; r < 4; ++r) S[j][r] *= cdv[r];
#pragma unroll
                for (int ks = 0; ks < 2; ++ks) { const bf16x8 vf = frag_tr(VV, S136, ks, nb0 + j, g, q4, p4); acc[j] = MFMA16(af[ks], vf, acc[j]); S[j] = MFMA16(kf2[ks], vf, S[j]); }
                *(LAS u32x2*)(ST + ((nb0 + j) * 16 + l15) * S72 + (mb * 16 + 4 * g) * 2) = (u32x2){pk2(S[j][0], S[j][1]), pk2(S[j][2], S[j][3])};
            }
        }
        {
            float ss[4];
#pragma unroll
            for (int r = 0; r < 4; ++r) { float s = 0.f;
#pragma unroll
                for (int j = 0; j < 4; ++j) s += acc[j][r] * acc[j][r];
                s += swz_xor<1>(s); s += swz_xor<2>(s); s += swz_xor<4>(s); s += swz_xor<8>(s); ss[r] = s; }
            if (l15 == 0) {
#pragma unroll
                for (int r = 0; r < 4; ++r) SSQ[(mb * 16 + 4 * g + r) * 2 + (wid & 1)] = ss[r]; }
            __syncthreads();
#pragma unroll
            for (int r = 0; r < 4; ++r) { const int i = mb * 16 + 4 * g + r; const float sc = rsqrtf((SSQ[i * 2] + SSQ[i * 2 + 1]) * (1.f / 128.f) + 1e-6f);
#pragma unroll
                for (int j = 0; j < 4; ++j) { const int dv = (nb0 + j) * 16 + l15; *(LAS bf16*)(OST + i * S136 + dv * 2) = (bf16)f2bf(acc[j][r] * sc * nw[dv]); } }
            __syncthreads();
            for (int it = tid; it < 64 * 16; it += 512) { const int tt = it >> 4, c8 = it & 15;
                bf16* gp = PJ + (row0 + tt) * LP + C_OC + h * 128 + c8 * 8; const u32x4 rv = *(const u32x4*)gp; const u32x4 ov = *(const LAS u32x4*)(OST + tt * S136 + c8 * 16);
                u32x4 w; w.x = pk2(bflo(ov.x) * siluf_(bflo(rv.x)), bfhi(ov.x) * siluf_(bfhi(rv.x))); w.y = pk2(bflo(ov.y) * siluf_(bflo(rv.y)), bfhi(ov.y) * siluf_(bfhi(rv.y)));
                w.z = pk2(bflo(ov.z) * siluf_(bflo(rv.z)), bfhi(ov.z) * siluf_(bfhi(rv.z))); w.w = pk2(bflo(ov.w) * siluf_(bflo(rv.w)), bfhi(ov.w) * siluf_(bfhi(rv.w)));
                *(u32x4*)gp = w; }
        }
    }
}

struct LnRow { float v[16]; };
__device__ __forceinline__ void ln_normalize(LnRow& r, const float* g, const float* bta, int lane) {
    float s = 0.f;
#pragma unroll
    for (int i = 0; i < 16; ++i) s += r.v[i];
    const float mean = wave_sum(s) * (1.f / 1024.f); float q = 0.f;
#pragma unroll
    for (int i = 0; i < 16; ++i) { r.v[i] -= mean; q += r.v[i] * r.v[i]; }
    const float rstd = rsqrtf(wave_sum(q) * (1.f / 1024.f) + 1e-5f);
#pragma unroll
    for (int jj = 0; jj < 2; ++jj) { const int k = 8 * (lane + 64 * jj);
        const f32x4 g0 = *(const f32x4*)(g + k), g1 = *(const f32x4*)(g + k + 4), b0 = *(const f32x4*)(bta + k), b1 = *(const f32x4*)(bta + k + 4);
#pragma unroll
        for (int e = 0; e < 4; ++e) { r.v[jj * 8 + e] = r.v[jj * 8 + e] * rstd * g0[e] + b0[e]; r.v[jj * 8 + 4 + e] = r.v[jj * 8 + 4 + e] * rstd * g1[e] + b1[e]; } }
}
__device__ __forceinline__ void ln_load_bf16(LnRow& r, const bf16* row, int lane, float scale) {
#pragma unroll
    for (int jj = 0; jj < 2; ++jj) { const u32x4 t = *(const u32x4*)(row + 8 * (lane + 64 * jj));
        r.v[jj * 8 + 0] = scale * bflo(t.x); r.v[jj * 8 + 1] = scale * bfhi(t.x); r.v[jj * 8 + 2] = scale * bflo(t.y); r.v[jj * 8 + 3] = scale * bfhi(t.y);
        r.v[jj * 8 + 4] = scale * bflo(t.z); r.v[jj * 8 + 5] = scale * bfhi(t.z); r.v[jj * 8 + 6] = scale * bflo(t.w); r.v[jj * 8 + 7] = scale * bfhi(t.w); }
}
__device__ __forceinline__ void ln_add_bf16(LnRow& r, const bf16* row, int lane, float scale) {
#pragma unroll
    for (int jj = 0; jj < 2; ++jj) { const u32x4 t = *(const u32x4*)(row + 8 * (lane + 64 * jj));
        r.v[jj * 8 + 0] += scale * bflo(t.x); r.v[jj * 8 + 1] += scale * bfhi(t.x); r.v[jj * 8 + 2] += scale * bflo(t.y); r.v[jj * 8 + 3] += scale * bfhi(t.y);
        r.v[jj * 8 + 4] += scale * bflo(t.z); r.v[jj * 8 + 5] += scale * bfhi(t.z); r.v[jj * 8 + 6] += scale * bflo(t.w); r.v[jj * 8 + 7] += scale * bfhi(t.w); }
}
__device__ __forceinline__ void ln_store_bf16(const LnRow& r, bf16* row, int lane) {
#pragma unroll
    for (int jj = 0; jj < 2; ++jj) { u32x4 w; w.x = pk2(r.v[jj * 8], r.v[jj * 8 + 1]); w.y = pk2(r.v[jj * 8 + 2], r.v[jj * 8 + 3]); w.z = pk2(r.v[jj * 8 + 4], r.v[jj * 8 + 5]); w.w = pk2(r.v[jj * 8 + 6], r.v[jj * 8 + 7]);
        *(u32x4*)(row + 8 * (lane + 64 * jj)) = w; }
}
__device__ __forceinline__ void ln_store_f32(const LnRow& r, float* row, int lane) {
#pragma unroll
    for (int jj = 0; jj < 2; ++jj) { float* p = row + 8 * (lane + 64 * jj);
        *(f32x4*)p = (f32x4){r.v[jj * 8], r.v[jj * 8 + 1], r.v[jj * 8 + 2], r.v[jj * 8 + 3]}; *(f32x4*)(p + 4) = (f32x4){r.v[jj * 8 + 4], r.v[jj * 8 + 5], r.v[jj * 8 + 6], r.v[jj * 8 + 7]}; }
}

__device__ __forceinline__ KArgP argp() { KArgP p = (KArgP)__builtin_amdgcn_kernarg_segment_ptr(); asm volatile("" : "+s"(p)); return p; }
#define XB_TMO      128
#define XB_XCNT(j)  (256  + 64 * (j))
#define XB_XSUB(j)  (1280 + 64 * (j))
#define XB_XGEN(j)  (2304 + 64 * (j))
#define XB_TOP      3328
#define XB_TOPGEN   3392
#define XB_SPIN_CAP (1u << 20)
constexpr int CW_BAR = 4096;
__device__ __forceinline__ unsigned xb_ld(unsigned* p)              { return __hip_atomic_load(p, __ATOMIC_RELAXED, __HIP_MEMORY_SCOPE_AGENT); }
__device__ __forceinline__ unsigned xb_add(unsigned* p, unsigned v) { return __hip_atomic_fetch_add(p, v, __ATOMIC_RELAXED, __HIP_MEMORY_SCOPE_AGENT); }
__device__ __forceinline__ unsigned xb_xcc_id() { return (unsigned)__builtin_amdgcn_s_getreg((3 << 11) | 20) & 0xFu; }
#define XB_SPIN(cond, bar) do { unsigned _sp = 0; while (cond) { __builtin_amdgcn_s_sleep(1); \
    if ((++_sp & 255u) == 0u) { if (xb_ld(&(bar)[XB_TMO])) break; if (_sp > XB_SPIN_CAP) { atomicAdd(&(bar)[XB_TMO], 1u); break; } } } } while (0)
__device__ __forceinline__ void xcd_barrier_complete(unsigned* bar, unsigned x, unsigned& nloc, unsigned& nx) {
    const unsigned G = gridDim.x;
    unsigned sum, cnt, mine, sp = 0u;
    for (;;) {
        sum = 0u; cnt = 0u; mine = 0u;
#pragma unroll
        for (unsigned j = 0; j < 16; ++j) { const unsigned c = xb_ld(&bar[XB_XCNT(j)]); sum += c; cnt += (c > 0u) ? 1u : 0u; mine = (j == x) ? c : mine; }
        if (sum == G) break;
        __builtin_amdgcn_s_sleep(1);
        if ((++sp & 255u) == 0u) { if (xb_ld(&bar[XB_TMO])) break; if (sp > XB_SPIN_CAP) { atomicAdd(&bar[XB_TMO], 1u); break; } }
    }
    nloc = mine > 0u ? mine : 1u; nx = cnt > 0u ? cnt : 1u;
}
__device__ __forceinline__ void grid_barrier(LAS unsigned char* lds) {
    volatile LAS unsigned* st = (volatile LAS unsigned*)(lds + LDS_CTL + 2048);
    asm volatile("s_waitcnt vmcnt(0)" ::: "memory");
    __syncthreads();
    if (otid() == 0) {
        unsigned* bar = (unsigned*)(argp()->ws + WS_CTL) + CW_BAR;
        const unsigned x = xb_xcc_id();
        __builtin_amdgcn_s_waitcnt(0);
        unsigned nloc = st[0], nx = st[1];
        if (nloc == 0u) { xcd_barrier_complete(bar, x, nloc, nx); st[0] = nloc; st[1] = nx; }
        const unsigned old = xb_add(&bar[XB_XSUB(x)], 1u);
        const unsigned gen = old / nloc;
        if (old + 1u == (gen + 1u) * nloc) {
            __builtin_amdgcn_fence(__ATOMIC_RELEASE, "agent");
            asm volatile("s_waitcnt vmcnt(0)" ::: "memory");
            const unsigned og = xb_add(&bar[XB_TOP], 1u);
            const unsigned tg = og / nx;
            if (og + 1u == (tg + 1u) * nx) xb_add(&bar[XB_TOPGEN], 1u);
            else XB_SPIN(xb_ld(&bar[XB_TOPGEN]) == tg, bar);
            __builtin_amdgcn_fence(__ATOMIC_ACQUIRE, "agent");
            xb_add(&bar[XB_XGEN(x)], 1u);
            asm volatile("s_waitcnt vmcnt(0)" ::: "memory");
        } else {
            XB_SPIN(xb_ld(&bar[XB_XGEN(x)]) == gen, bar);
            __builtin_amdgcn_fence(__ATOMIC_ACQUIRE, "agent");
            asm volatile("s_waitcnt vmcnt(0)" ::: "memory");
        }
    }
    __syncthreads();
}

#define PH_COMMON \
    KArgP ap = argp(); unsigned char* ws = ap->ws; (void)ws; \
    const int tid = otid(), lane = tid & 63, wid = tid >> 6; (void)lane; (void)wid; \
    const int G = ogrid(), bx = obid(), gw = bx * 8 + wid, NGW = G * 8; (void)gw; (void)NGW; \
    unsigned char* wt = ws + WS_WT; (void)wt; bf16* XB = (bf16*)(ws + WS_XB); (void)XB; bf16* PJ = (bf16*)(ws + WS_PROJ); (void)PJ; \
    unsigned char* dsc = (unsigned char*)ap->out; bf16* Y = (bf16*)(dsc + DO_Y); (void)Y; bf16* KV = (bf16*)(dsc + DO_KV); (void)KV; bf16* MEMB = (bf16*)(dsc + DO_MEMB); (void)MEMB;

__device__ __forceinline__ void ph_input(LAS unsigned char* lds) { PH_COMMON
    convert_rows(ap->x, XB, (size_t)NTOK * DM);
    convert_rows(ap->mem, MEMB, (size_t)NMEM * DM);
}
__device__ __forceinline__ void ph_weights(LAS unsigned char* lds, int l) { KArgP A = argp(); phase_convert_weights(A, l, lds); }
__device__ __forceinline__ void ph_proj(LAS unsigned char* lds, int l) { PH_COMMON
    pg8::Gemm g{1024, 1024, 1024};
    RegSched S{NTOK / 256, LP / 256, (NTOK / 256) * (LP / 256), G, bx, (const char*)XB, (const char*)(wt + WT_WIN), (size_t)256 * 1024 * 2, (size_t)256 * 1024 * 2, 0};
    pg8::EpiProj E{PJ, LP, (bf16*)(dsc + DO_HALO)};
    pg8::gemm_phase(lds, g, S, E);
}
__device__ __forceinline__ void ph_kv(LAS unsigned char* lds, int l) { PH_COMMON
    pg8::Gemm g{1024, 1024, 1024};
    RegSched S2{NMEM / 256, 2048 / 256, (NMEM / 256) * (2048 / 256), G, bx, (const char*)MEMB, (const char*)(wt + WT_WKV), (size_t)256 * 1024 * 2, (size_t)256 * 1024 * 2, 0};
    pg8::EpiStore E2{KV, 2048, 1.f};
    pg8::gemm_phase(lds, g, S2, E2);
}
__device__ __forceinline__ void ph_gdn_prep(LAS unsigned char* lds, int l) {
    KArgP A = argp();
    const int G = ogrid(), bx = obid();
    for (int t = bx; t < NB * 4 * 32; t += G) gdn_prep_task(A, l, lds, t >> 7, (t >> 5) & 3, t & 31);
}
__device__ __forceinline__ void ph_mix(LAS unsigned char* lds, int l) {
    KArgP A = argp();
    const int bx = obid();
    if (bx < 64) gdn_scan_chain(A, l, lds, bx >> 2, bx & 3);
    else if (bx < 128) gla_chain(A, l, lds, (bx - 64) >> 2, (bx - 64) & 3);
    unsigned* ctr = (unsigned*)(A->ws + WS_CTL) + 128 + l;
    volatile LAS int* qw = (volatile LAS int*)(lds + LDS_CTL + 2400);
    for (;;) {
        __syncthreads();
        if (otid() == 0) qw[0] = (int)atomicAdd(ctr, 1u);
        __syncthreads();
        const int u = qw[0];
        if (u >= NB * 8 * 16) break;
        const int qb = 15 - (u >> 7), bh = u & 127;
        fox_unit(A, l, lds, bh >> 3, bh & 7, qb);
    }
}
__device__ __forceinline__ void ph_branch(LAS unsigned char* lds, int l) { PH_COMMON
    pg8::Gemm g{LP, 512, 512};
    BranchSched S{NTOK / 256, (NTOK / 256) * 12, G, bx, (const char*)PJ, (const char*)(wt + WT_P)};
    pg8::EpiStore E{PJ, LP, 1.f};
    pg8::gemm_phase(lds, g, S, E);
}
__device__ __forceinline__ void ph_gate(LAS unsigned char* lds, int l) { PH_COMMON
    pg8::Gemm g{1024, 1024, 1024};
    RegSched S{NTOK / 256, 12, (NTOK / 256) * 12, G, bx, (const char*)XB, (const char*)(wt + WT_WIN + (size_t)LP * 1024 * 2), (size_t)256 * 1024 * 2, (size_t)256 * 1024 * 2, C_T};
    pg8::EpiGate E{PJ, LP, ap->b_merge + (size_t)l * 3072};
    pg8::gemm_phase(lds, g, S, E);
}
__device__ __forceinline__ void ph_out(LAS unsigned char* lds, int l) { PH_COMMON
    pg8::Gemm g{LP, 3072, 3072};
    RegSched S{NTOK / 256, 4, (NTOK / 256) * 4, G, bx, (const char*)(PJ + C_T), (const char*)(wt + WT_WOUT3), (size_t)256 * LP * 2, (size_t)256 * 3072 * 2, 0};
    pg8::EpiResid E{XB, Y, 1024};
    pg8::gemm_phase(lds, g, S, E);
}
__device__ __forceinline__ void ph_ln1(LAS unsigned char* lds, int l) { PH_COMMON
    const float* gg = ap->ln1_g + l * 1024; const float* bb = ap->ln1_b + l * 1024;
    for (int row = gw; row < NTOK; row += NGW) { LnRow r; ln_load_bf16(r, Y + (size_t)row * 1024, lane, 1.f); ln_normalize(r, gg, bb, lane); ln_store_bf16(r, XB + (size_t)row * 1024, lane); }
}
__device__ __forceinline__ void ph_q(LAS unsigned char* lds, int l) { PH_COMMON
    bf16* Qb = (bf16*)(ws + WS_PROJ + PJ_Q);
    pg8::Gemm g{1024, 1024, 1024};
    RegSched S{NTOK / 256, 4, (NTOK / 256) * 4, G, bx, (const char*)XB, (const char*)(wt + WT_WQ), (size_t)256 * 1024 * 2, (size_t)256 * 1024 * 2, 0};
    pg8::EpiStore E{Qb, 1024, 0.0625f * LOG2E};
    pg8::gemm_phase(lds, g, S, E);
}
__device__ __forceinline__ void ph_xattn(LAS unsigned char* lds, int l) { PH_COMMON
    bf16* Qb = (bf16*)(ws + WS_PROJ + PJ_Q); bf16* Ob = (bf16*)(ws + WS_PROJ + PJ_O);
    for (int u = bx; u < NB * 4 * 16; u += G) { const int b = u >> 6, h = (u >> 4) & 3, qb = u & 15;
        const size_t rowq = (size_t)b * SEQ + qb * 128, rowk = (size_t)b * MEMLEN;
        flash_unit<256, false>(lds, Qb + rowq * 1024 + h * 256, 1024, KV + rowk * 2048 + h * 256, KV + rowk * 2048 + 1024 + h * 256, 2048, Ob + rowq * 1024 + h * 256, 1024, 4, 0, 1.f, nullptr); }
}
__device__ __forceinline__ void ph_wo(LAS unsigned char* lds, int l) { PH_COMMON
    bf16* Ob = (bf16*)(ws + WS_PROJ + PJ_O);
    pg8::Gemm g{1024, 1024, 1024};
    RegSched S{NTOK / 256, 4, (NTOK / 256) * 4, G, bx, (const char*)Ob, (const char*)(wt + WT_WO), (size_t)256 * 1024 * 2, (size_t)256 * 1024 * 2, 0};
    pg8::EpiResid E{XB, Y, 1024};
    pg8::gemm_phase(lds, g, S, E);
}
__device__ __forceinline__ void ph_ln2_router(LAS unsigned char* lds, int l) { PH_COMMON
    unsigned* ctl = (unsigned*)(ws + WS_CTL);
    int* tokE = (int*)(ws + WS_SMALL + SM_TOKE); float* tokW = (float*)(ws + WS_SMALL + SM_TOKW); int* tokR = (int*)(ws + WS_SMALL + SM_TOKR);
    __syncthreads();
    LAS float* RW = (LAS float*)lds;
    const float* wg = ap->moe_w_group + (size_t)l * 1024 * 4; const float* we = ap->moe_w_expert + (size_t)l * 1024 * 32;
    for (int i = tid; i < 1024 * 36; i += 512) { const int k = i / 36, c = i % 36; const int pos = ((k >> 9) * 8 + (k & 7)) * 64 + ((k >> 3) & 63);
        RW[pos * 36 + c] = c < 4 ? wg[k * 4 + c] : we[k * 32 + (c - 4)]; }
    __syncthreads();
    const float* gg = ap->ln2_g + l * 1024; const float* bb = ap->ln2_b + l * 1024;
    const float* bgp = ap->moe_b_group + l * 4; const float* bep = ap->moe_b_expert + l * 32;
    unsigned* cnt = ctl + 64 * l;
    for (int row = gw; row < NTOK; row += NGW) {
        LnRow r; ln_load_bf16(r, Y + (size_t)row * 1024, lane, 1.f); ln_normalize(r, gg, bb, lane); ln_store_bf16(r, XB + (size_t)row * 1024, lane);
        float acc[36];
#pragma unroll
        for (int c = 0; c < 36; ++c) acc[c] = 0.f;
#pragma unroll
        for (int i = 0; i < 16; ++i) { const LAS float* wr = RW + (i * 64 + lane) * 36; const float xv = r.v[i];
#pragma unroll
            for (int c4 = 0; c4 < 9; ++c4) { const f32x4 w4 = *(const LAS f32x4*)(wr + 4 * c4); acc[4 * c4] += xv * w4[0]; acc[4 * c4 + 1] += xv * w4[1]; acc[4 * c4 + 2] += xv * w4[2]; acc[4 * c4 + 3] += xv * w4[3]; }
            asm volatile("" ::: "memory"); }
#pragma unroll
        for (int c = 0; c < 36; ++c) acc[c] = wave_sum(acc[c]);
        float gl[4];
#pragma unroll
        for (int c = 0; c < 4; ++c) gl[c] = acc[c] + bgp[c];
        int gsel = 0; float gm = gl[0];
#pragma unroll
        for (int c = 1; c < 4; ++c) if (gl[c] > gm) { gm = gl[c]; gsel = c; }
        float gsum = 0.f;
#pragma unroll
        for (int c = 0; c < 4; ++c) gsum += __expf(gl[c] - gm);
        const float ptop = 1.f / gsum;
        float el[8];
#pragma unroll
        for (int jx = 0; jx < 8; ++jx) { const float v = gsel == 0 ? acc[4 + jx] : gsel == 1 ? acc[12 + jx] : gsel == 2 ? acc[20 + jx] : acc[28 + jx]; el[jx] = v + bep[gsel * 8 + jx]; }
        int e0 = 0; float m0 = el[0];
#pragma unroll
        for (int jx = 1; jx < 8; ++jx) if (el[jx] > m0) { m0 = el[jx]; e0 = jx; }
        int e1 = -1; float m1 = -3.0e38f;
#pragma unroll
        for (int jx = 0; jx < 8; ++jx) if (jx != e0 && el[jx] > m1) { m1 = el[jx]; e1 = jx; }
        const float ex = __expf(m1 - m0); const float w0 = ptop / (1.f + ex), w1 = ptop * ex / (1.f + ex);
        if (lane == 0) { const int ge0 = gsel * 8 + e0, ge1 = gsel * 8 + e1;
            const int r0 = (int)atomicAdd(cnt + ge0, 1u), r1 = (int)atomicAdd(cnt + ge1, 1u);
            tokE[row * 2] = ge0; tokE[row * 2 + 1] = ge1; tokW[row * 2] = w0; tokW[row * 2 + 1] = w1; tokR[row * 2] = r0; tokR[row * 2 + 1] = r1; }
    }
}
__device__ __forceinline__ void ph_dispatch(LAS unsigned char* lds, int l) { PH_COMMON
    unsigned* ctl = (unsigned*)(ws + WS_CTL);
    int* tokE = (int*)(ws + WS_SMALL + SM_TOKE); int* tokR = (int*)(ws + WS_SMALL + SM_TOKR); int* tokS = (int*)(ws + WS_SMALL + SM_TOKS);
    bf16* XG = (bf16*)(ws + WS_PROJ + PJ_XG);
    LAS int* tab = (LAS int*)(lds + LDS_CTL);
    __syncthreads();
    if (tid == 0) { const unsigned* cnt = ctl + 64 * l; int ps = 0, nb = 0;
        for (int e = 0; e < 32; ++e) { const int c = (int)__hip_atomic_load(cnt + e, __ATOMIC_RELAXED, __HIP_MEMORY_SCOPE_AGENT); const int nbe = (c + 255) >> 8; tab[320 + e] = ps; tab[360 + e] = c;
            for (int q = 0; q < nbe; ++q) tab[1 + nb + q] = e; nb += nbe; ps += nbe * 256; }
        tab[352] = ps; tab[0] = nb; }
    __syncthreads();
    for (int row = gw; row < NTOK; row += NGW) {
        const int s0 = tab[320 + tokE[row * 2]] + tokR[row * 2], s1 = tab[320 + tokE[row * 2 + 1]] + tokR[row * 2 + 1];
        if (lane == 0) { tokS[row * 2] = s0; tokS[row * 2 + 1] = s1; }
#pragma unroll
        for (int jj = 0; jj < 2; ++jj) { const u32x4 t = *(const u32x4*)(XB + (size_t)row * 1024 + 8 * (lane + 64 * jj));
            *(u32x4*)(XG + (size_t)s0 * 1024 + 8 * (lane + 64 * jj)) = t; *(u32x4*)(XG + (size_t)s1 * 1024 + 8 * (lane + 64 * jj)) = t; }
    }
    for (int e = 0; e < 32; ++e) { const int c = tab[360 + e], st = tab[320 + e] + c, en = tab[320 + e] + (((c + 255) >> 8) << 8);
        for (int rr = st + gw; rr < en; rr += NGW) { u32x4 z = {0u, 0u, 0u, 0u}; asm volatile("" : "+v"(z)); *(u32x4*)(XG + (size_t)rr * 1024 + 8 * lane) = z; *(u32x4*)(XG + (size_t)rr * 1024 + 8 * (lane + 64)) = z; } }
}
__device__ __forceinline__ void ph_moe_gu(LAS unsigned char* lds, int l) { PH_COMMON
    bf16* XG = (bf16*)(ws + WS_PROJ + PJ_XG); bf16* Hb = (bf16*)(ws + WS_PROJ + PJ_H);
    const LAS int* tab = (const LAS int*)(lds + LDS_CTL);
    pg8::Gemm g{1024, 1024, 1024};
    MoeSched S{2, G, bx, tab, (const char*)XG, (size_t)256 * 1024 * 2, (const char*)(wt + WT_GU), (size_t)512 * 1024 * 2, (size_t)256 * 1024 * 2};
    pg8::EpiSwiglu E{Hb, 256};
    pg8::gemm_phase(lds, g, S, E);
}
__device__ __forceinline__ void ph_moe_dn(LAS unsigned char* lds, int l) { PH_COMMON
    bf16* Hb = (bf16*)(ws + WS_PROJ + PJ_H); bf16* YS = (bf16*)(ws + WS_PROJ + PJ_YS);
    const LAS int* tab = (const LAS int*)(lds + LDS_CTL);
    pg8::Gemm g{256, 256, 256};
    MoeSched S{4, G, bx, tab, (const char*)Hb, (size_t)256 * 256 * 2, (const char*)(wt + WT_DN), (size_t)1024 * 256 * 2, (size_t)256 * 256 * 2};
    pg8::EpiStore E{YS, 1024, 1.f};
    pg8::gemm_phase(lds, g, S, E);
}
__device__ __forceinline__ void ph_ln3(LAS unsigned char* lds, int l) { PH_COMMON
    float* tokW = (float*)(ws + WS_SMALL + SM_TOKW); int* tokS = (int*)(ws + WS_SMALL + SM_TOKS);
    bf16* YS = (bf16*)(ws + WS_PROJ + PJ_YS);
    const float* gg = ap->ln3_g + l * 1024; const float* bb = ap->ln3_b + l * 1024;
    float* out = ap->out;
    for (int row = gw; row < NTOK; row += NGW) {
        LnRow r; ln_load_bf16(r, XB + (size_t)row * 1024, lane, ALPHA);
        ln_add_bf16(r, YS + (size_t)tokS[row * 2] * 1024, lane, tokW[row * 2]); ln_add_bf16(r, YS + (size_t)tokS[row * 2 + 1] * 1024, lane, tokW[row * 2 + 1]);
        ln_normalize(r, gg, bb, lane);
        if (l == DEPTH - 1) ln_store_f32(r, out + (size_t)row * 1024, lane); else ln_store_bf16(r, XB + (size_t)row * 1024, lane);
    }
}

#define GSYNC() grid_barrier(lds)
template <int l> __device__ __forceinline__ void layer_body(LAS unsigned char* lds) {

        if (l > 0) { if (PH_MASK & 1) ph_weights(lds, l); GSYNC(); if (REP_MASK & 1) { ph_weights(lds, l); GSYNC(); } }
        if (PH_MASK & 2) ph_proj(lds, l);
        if (REP_MASK & 2) { GSYNC(); ph_proj(lds, l); }
        GSYNC();
        if (PH_MASK & 4) { ph_gdn_prep(lds, l); GSYNC(); ph_mix(lds, l); }
        GSYNC();
        if (PH_MASK & 8) ph_branch(lds, l);
        if (REP_MASK & 8) { GSYNC(); ph_branch(lds, l); }
        GSYNC();
        if (PH_MASK & 16) ph_gate(lds, l);
        GSYNC();
        if (PH_MASK & 32) ph_out(lds, l);
        if (REP_MASK & 32) { GSYNC(); ph_out(lds, l); }
        GSYNC();
        if (PH_MASK & 64) { ph_kv(lds, l); ph_ln1(lds, l); }
        if (REP_MASK & 64) { GSYNC(); { ph_kv(lds, l); ph_ln1(lds, l); } }
        GSYNC();
        if (PH_MASK & 128) ph_q(lds, l);
        if (REP_MASK & 128) { GSYNC(); ph_q(lds, l); }
        GSYNC();
        if (PH_MASK & 256) ph_xattn(lds, l);
        if (REP_MASK & 256) { GSYNC(); ph_xattn(lds, l); }
        GSYNC();
        if (PH_MASK & 512) ph_wo(lds, l);
        if (REP_MASK & 512) { GSYNC(); ph_wo(lds, l); }
        GSYNC();
        if (PH_MASK & 1024) ph_ln2_router(lds, l);
        GSYNC();
        if (PH_MASK & 2048) ph_dispatch(lds, l);
        if (REP_MASK & 2048) { GSYNC(); ph_dispatch(lds, l); }
        GSYNC();
        if (PH_MASK & 4096) ph_moe_gu(lds, l);
        if (REP_MASK & 4096) { GSYNC(); ph_moe_gu(lds, l); }
        GSYNC();
        if (PH_MASK & 8192) ph_moe_dn(lds, l);
        if (REP_MASK & 8192) { GSYNC(); ph_moe_dn(lds, l); }
        GSYNC();
        if (PH_MASK & 16384) ph_ln3(lds, l);
        if (l + 1 < DEPTH) GSYNC();
}

__global__ void __launch_bounds__(512, 2) mega_fwd(Args A_unused) {
    extern __shared__ __attribute__((aligned(16))) unsigned char lds_raw[];
    LAS unsigned char* lds = (LAS unsigned char*)lds_raw;
    cg::grid_group grid = cg::this_grid();
    {
        volatile LAS unsigned* st = (volatile LAS unsigned*)(lds + LDS_CTL + 2048);
        if (threadIdx.x < 2) st[threadIdx.x] = 0u;
        if (threadIdx.x == 0) { unsigned* bar = (unsigned*)(argp()->ws + WS_CTL) + CW_BAR; (void)xb_add(&bar[XB_XCNT(xb_xcc_id())], 1u); }
        __syncthreads();
    }
    ph_input(lds);
    if (PH_MASK & 1) ph_weights(lds, 0);
    grid.sync();
    layer_body<0>(lds);
    layer_body<1>(lds);
}

extern "C" void kernel_launch(void* const* d_in, const int* in_sizes, int n_in, void* d_out, int out_size, void* d_ws, size_t ws_size, hipStream_t stream) {
    static int grid = 0;
    if (grid == 0) {
        if (n_in != 32 || out_size != NTOK * DM || ws_size < WS_END) { fprintf(stderr, "kernel_launch: unexpected shapes (n_in %d out %d ws %zu)\n", n_in, out_size, ws_size); grid = -1; return; }
        int dev = 0, cus = 0, per_cu = 0;
        hipGetDevice(&dev); hipDeviceGetAttribute(&cus, hipDeviceAttributeMultiprocessorCount, dev);
        hipFuncSetAttribute((const void*)mega_fwd, hipFuncAttributeMaxDynamicSharedMemorySize, LDS_BYTES);
        hipOccupancyMaxActiveBlocksPerMultiprocessor(&per_cu, (const void*)mega_fwd, 512, LDS_BYTES);
        (void)hipGetLastError();
        if (per_cu < 1) { fprintf(stderr, "kernel_launch: occupancy query says %d blocks per CU\n", per_cu); grid = -1; return; }
        grid = cus;
        if (grid < 192) { fprintf(stderr, "kernel_launch: too few CUs (%d)\n", grid); grid = -1; return; }
    }
    if (grid < 0) return;
    hipMemsetAsync((char*)d_ws + WS_CTL, 0, 1 * MiB, stream);
    Args a{};
    const float** p = (const float**)&a;
    for (int i = 0; i < 32; ++i) p[i] = (const float*)d_in[i];
    a.out = (float*)d_out; a.ws = (unsigned char*)d_ws;
    void* args[] = {&a};
    hipError_t e = hipLaunchCooperativeKernel((const void*)mega_fwd, dim3(grid), dim3(512), args, LDS_BYTES, stream);
    if (e != hipSuccess) fprintf(stderr, "cooperative launch failed: %s (grid %d)\n", hipGetErrorString(e), grid);
}
```

```cpp
#include <hip/hip_runtime.h>
#include <hip/hip_cooperative_groups.h>
#include <cstdio>
#include <cstdint>
namespace cg = cooperative_groups;

#define LAS __attribute__((address_space(3)))
typedef unsigned short bf16;
typedef short bf16x8 __attribute__((ext_vector_type(8)));
typedef short s16x4 __attribute__((ext_vector_type(4)));
typedef float f32x4 __attribute__((ext_vector_type(4)));
typedef float f32x2 __attribute__((ext_vector_type(2)));
typedef unsigned u32x4 __attribute__((ext_vector_type(4)));
typedef unsigned u32x2 __attribute__((ext_vector_type(2)));

#ifndef PH_MASK
#define PH_MASK 0xFFFFFFFFu
#endif
#ifndef REP_MASK
#define REP_MASK 0u
#endif
#ifndef PROBE_MIX
#define PROBE_MIX 0
#endif
constexpr int DM = 1024, NB = 16, SEQ = 2048, NTOK = NB * SEQ, MEMLEN = 256, NMEM = NB * MEMLEN, DEPTH = 2;
constexpr int N_IN = 8224;
constexpr int LP = 5376;
constexpr int C_OA = 0;
constexpr int C_OB = 512;
constexpr int C_OC = 1024;
constexpr int C_GQ = 1536, C_GK = 2048, C_GV = 2560;
constexpr int C_FK = 3072, C_FV = 3584;
constexpr int C_LQ = 4096, C_LK = 4352, C_LV = 4608;
constexpr int C_SM = 5120;
constexpr int C_T = 1536;
constexpr int NWIN = 8448;
constexpr float ALPHA = 1.4142135623730951f;
constexpr float LOG2E = 1.4426950408889634f;
constexpr int MAXSLOT = 73728;
constexpr int MAXBLK = MAXSLOT / 256;

constexpr size_t MiB = 1u << 20;
constexpr size_t WS_CTL = 0;
constexpr size_t WS_WT = 1 * MiB;
constexpr size_t WT_WIN = 0;
constexpr size_t WT_P = WT_WIN + (size_t)NWIN * 1024 * 2;
constexpr size_t WT_WOUT3 = WT_P + 3u * 1024 * 512 * 2;
constexpr size_t WT_WQ = WT_WOUT3 + (size_t)1024 * 3072 * 2;
constexpr size_t WT_WKV = WT_WQ + (size_t)1024 * 1024 * 2;
constexpr size_t WT_WO = WT_WKV + (size_t)2048 * 1024 * 2;
constexpr size_t WT_GU = WT_WO + (size_t)1024 * 1024 * 2;
constexpr size_t WT_DN = WT_GU + (size_t)32 * 512 * 1024 * 2;
constexpr size_t WT_RWH = WT_DN + (size_t)32 * 1024 * 256 * 2;
constexpr size_t WT_RWL = WT_RWH + 48 * 1024 * 2;
constexpr size_t WT_END = WT_RWL + 48 * 1024 * 2;
static_assert(WT_END <= 82 * MiB, "WT");
constexpr size_t WS_XB = 83 * MiB;
constexpr size_t WS_PROJ = 147 * MiB;
constexpr size_t WS_SMALL = 483 * MiB;
constexpr size_t SM_TOKE = 0;
constexpr size_t SM_TOKW = SM_TOKE + (size_t)NTOK * 8;
constexpr size_t SM_TOKR = SM_TOKW + (size_t)NTOK * 8;
constexpr size_t SM_TOKS = SM_TOKR + (size_t)NTOK * 8;
constexpr size_t SM_SLOTTOK = SM_TOKS + (size_t)NTOK * 8;
constexpr size_t WS_KVS = 485 * MiB;
constexpr size_t WS_CDB = 511 * MiB;
constexpr size_t WS_END = 512 * MiB;
constexpr size_t PJ_Q = 0, PJ_O = 64 * MiB;
constexpr size_t PJ_XG = 0, PJ_H = 144 * MiB, PJ_YS = 180 * MiB;
constexpr size_t DO_Y = 0, DO_KV = 88 * MiB, DO_MEMB = 104 * MiB, DO_HALO = 112 * MiB;
constexpr size_t DO_CKG = 118 * MiB;
constexpr size_t DO_KVS = 82 * MiB;
constexpr size_t DO_GP = 0;
constexpr int GP_W = 0, GP_KDT = 16384, GP_ATT = 32768, GP_CD = 40960, GP_STRIDE = 41216;

constexpr int RING_BYTES = 131072;
constexpr int LDS_X = 131072;
constexpr int LDS_CTL = 147456;
constexpr int LDS_BYTES = 151552;

__device__ __forceinline__ int otid() { int t = threadIdx.x; asm volatile("" : "+v"(t)); return t; }
__device__ __forceinline__ int obid() { int t = blockIdx.x; asm volatile("" : "+s"(t)); return t; }
__device__ __forceinline__ int ogrid() { int t = gridDim.x; asm volatile("" : "+s"(t)); return t; }
__device__ __forceinline__ unsigned f2bf(float f) { unsigned u = __builtin_bit_cast(unsigned, f); return (u + 0x7fffu + ((u >> 16) & 1u)) >> 16; }
typedef __bf16 hwbf16x2 __attribute__((ext_vector_type(2)));
__device__ __forceinline__ unsigned pk2(float lo, float hi) { const f32x2 v = {lo, hi}; return __builtin_bit_cast(unsigned, __builtin_convertvector(v, hwbf16x2)); }
__device__ __forceinline__ float bf2f(unsigned short b) { return __builtin_bit_cast(float, (unsigned)b << 16); }
__device__ __forceinline__ float bflo(unsigned w) { return __builtin_bit_cast(float, w << 16); }
__device__ __forceinline__ float bfhi(unsigned w) { return __builtin_bit_cast(float, w & 0xffff0000u); }
template <int M> __device__ __forceinline__ float swz_xor(float v) { return __builtin_bit_cast(float, __builtin_amdgcn_ds_swizzle(__builtin_bit_cast(int, v), 0x1f | (M << 10))); }
__device__ __forceinline__ float half_sum(float v) { const unsigned b = __builtin_bit_cast(unsigned, v); auto r = __builtin_amdgcn_permlane32_swap(b, b, false, false); return __builtin_bit_cast(float, (unsigned)r[0]) + __builtin_bit_cast(float, (unsigned)r[1]); }
__device__ __forceinline__ float wave_sum(float v) {
    v += swz_xor<1>(v); v += swz_xor<2>(v); v += swz_xor<4>(v); v += swz_xor<8>(v); v += swz_xor<16>(v);
    return half_sum(v);
}
__device__ __forceinline__ float sigmoidf_(float x) { return __builtin_amdgcn_rcpf(1.f + __builtin_amdgcn_exp2f(-LOG2E * x)); }
__device__ __forceinline__ float siluf_(float x) { return x * __builtin_amdgcn_rcpf(1.f + __builtin_amdgcn_exp2f(-LOG2E * x)); }
__device__ __forceinline__ float softplusf_(float x) { return fmaxf(x, 0.f) + log1pf(__expf(-fabsf(x))); }
__device__ __forceinline__ float logsigmoidf_(float x) { return fminf(x, 0.f) - log1pf(__expf(-fabsf(x))); }

#ifndef TIMER_A
#define TIMER_A (-1)
#endif
#ifndef TIMER_B
#define TIMER_B (-1)
#endif
#ifndef TIMER_T
#define TIMER_T 0
#endif
#ifndef TIMER_WG
#define TIMER_WG 0
#endif
#define TMARK(id) do { if (TIMER_A >= 0 || TIMER_B >= 0) { const unsigned long long t_ = __builtin_amdgcn_s_memrealtime(); volatile LAS unsigned* tw_ = (volatile LAS unsigned*)(lds + LDS_CTL + 2800); \
    if (otid() == 0) { if ((id) == TIMER_A) tw_[0] -= (unsigned)t_; if ((id) == TIMER_A + 1) tw_[0] += (unsigned)t_; if ((id) == TIMER_B) tw_[1] -= (unsigned)t_; if ((id) == TIMER_B + 1) tw_[1] += (unsigned)t_; } } } while (0)
namespace pg8 {
constexpr int BM = 256, BK = 64, HALF = 128, HTB = HALF * BK * 2, STAGE_BYTES = 8 * HTB;
__host__ __device__ __forceinline__ int lds_byte(int r, int c) { const int st = (r >> 4) * 2 + (c >> 5), rr = r & 15, cc = c & 31, ob = rr * 64 + cc * 2; return st * 1024 + (ob ^ (((ob >> 9) & 1) << 5)); }
__host__ __device__ __forceinline__ void stage_rc(int b, int& R, int& C) { const int st = b / 1024, sb = b % 1024, swz = sb ^ (((sb >> 9) & 1) << 5); R = (st >> 1) * 16 + swz / 64; C = (st & 1) * 32 + (swz % 64) / 2; }
__host__ __device__ __forceinline__ int perm32(int rho) { const int n = rho >> 4, i = rho & 15; return 8 * (i >> 2) + 4 * n + (i & 3); }

struct Unit { const char* a; const char* b; int row0, col0, aux, aux2; };
struct Gemm { int lda, ldb, K; };

template <class Epi, class Sched>
__device__ __forceinline__ void gemm_phase(LAS unsigned char* lds, const Gemm g, const Sched& S, const Epi& E) {
    const int tid = otid(), wid = __builtin_amdgcn_readfirstlane(tid >> 6), lane = tid & 63, wr = wid >> 2, wc = wid & 3, fr = lane & 15, fq = lane >> 4;
    int K = g.K; asm volatile("" : "+s"(K)); const int nt = K / BK;
    unsigned voffA[2], voffB[2];
#pragma unroll
    for (int i = 0; i < 2; ++i) { int R, C; stage_rc(tid * 16 + i * 8192, R, C); const int Rb = Epi::PERM ? ((R & ~31) + perm32(R & 31)) : R;
        voffA[i] = (unsigned)(R * g.lda + C) * 2u; voffB[i] = (unsigned)(Rb * g.ldb + C) * 2u; }
    const size_t kstep = (size_t)(BK * 2);
    const size_t hstepA = (size_t)HALF * g.lda * 2, hstepB = (size_t)HALF * g.ldb * 2;
    const unsigned ldsw = (unsigned)wid * 1024u;
    const int aoff = lds_byte(wr * 64 + fr, fq * 8), boff = lds_byte(wc * 32 + fr, fq * 8);
#define PG8_SA(b, h) (((b) * 2 + (h)) * HTB)
#define PG8_SB(b, h) ((4 + (b) * 2 + (h)) * HTB)
#define PG8_STAGE(bufoff, gbase, voff) do { _Pragma("unroll") for (int _i = 0; _i < 2; ++_i) \
        __builtin_amdgcn_global_load_lds((const unsigned*)((const char*)(gbase) + (voff)[_i]), (LAS unsigned*)(lds + (bufoff) + ldsw + _i * 8192), 16, 0, 0); } while (0)
#define PG8_LDA(dst, b, h) do { _Pragma("unroll") for (int m = 0; m < 4; ++m) _Pragma("unroll") for (int k = 0; k < 2; ++k) dst[m][k] = *(const LAS bf16x8*)(lds + PG8_SA(b, h) + aoff + m * 2048 + k * 1024); } while (0)
#define PG8_LDB(dst, b, h) do { _Pragma("unroll") for (int n = 0; n < 2; ++n) _Pragma("unroll") for (int k = 0; k < 2; ++k) dst[n][k] = *(const LAS bf16x8*)(lds + PG8_SB(b, h) + boff + n * 2048 + k * 1024); } while (0)
#define PG8_MMA(ai, bj, At, Bt) do { __builtin_amdgcn_s_setprio(1); _Pragma("unroll") for (int m = 0; m < 4; ++m) _Pragma("unroll") for (int n = 0; n < 2; ++n) _Pragma("unroll") for (int k = 0; k < 2; ++k) \
        acc[ai][bj][m][n] = __builtin_amdgcn_mfma_f32_16x16x32_bf16(Bt[n][k], At[m][k], acc[ai][bj][m][n], 0, 0, 0); __builtin_amdgcn_s_setprio(0); } while (0)
#define PG8_WAIT_V(n) asm volatile("s_waitcnt vmcnt(" #n ")" ::: "memory")
#define PG8_WAIT_L(n) asm volatile("s_waitcnt lgkmcnt(" #n ")" ::: "memory")
#define PG8_BAR __builtin_amdgcn_s_barrier()
#define PG8_SCHED __builtin_amdgcn_sched_barrier(0)
    Unit cur, nxt; int ui = 0;
    if (!S.next(0, cur)) return;
    f32x4 acc[2][2][4][2];
#pragma unroll
    for (int a = 0; a < 2; ++a)
#pragma unroll
        for (int b = 0; b < 2; ++b)
#pragma unroll
            for (int m = 0; m < 4; ++m)
#pragma unroll
                for (int n = 0; n < 2; ++n) acc[a][b][m][n] = (f32x4){0.f, 0.f, 0.f, 0.f};
    bf16x8 At[4][2], B0[2][2], B1[2][2];
    const char* cA = cur.a; const char* cB = cur.b;
    PG8_STAGE(PG8_SB(0, 0), cB, voffB); PG8_STAGE(PG8_SB(0, 1), cB + hstepB, voffB); PG8_STAGE(PG8_SA(0, 0), cA, voffA); PG8_STAGE(PG8_SA(0, 1), cA + hstepA, voffA);
    if (wr == 1) PG8_BAR;
    PG8_WAIT_V(2); PG8_BAR;
    PG8_STAGE(PG8_SB(1, 0), cB + kstep, voffB); PG8_STAGE(PG8_SA(1, 0), cA + kstep, voffA); PG8_STAGE(PG8_SB(1, 1), cB + hstepB + kstep, voffB);
    PG8_WAIT_V(6); PG8_BAR;
    for (;;) {
        const bool has_next = S.next(ui + 1, nxt);
        const char* nA = has_next ? nxt.a : cA; const char* nB = has_next ? nxt.b : cB;
        for (int t = 0; t < nt; t += 2) {
            const bool last = (t == nt - 2);
            const char* a1 = cA + (size_t)(t + 1) * kstep;
            const char* a2 = last ? nA : cA + (size_t)(t + 2) * kstep; const char* b2 = last ? nB : cB + (size_t)(t + 2) * kstep;
            const char* a3 = a2 + kstep; const char* b3 = b2 + kstep;
            PG8_LDB(B0, 0, 0); PG8_LDB(B1, 0, 1); PG8_SCHED; PG8_LDA(At, 0, 0); PG8_STAGE(PG8_SA(1, 1), a1 + hstepA, voffA);
            PG8_WAIT_V(8); PG8_WAIT_L(0); PG8_BAR; PG8_MMA(0, 0, At, B0); PG8_MMA(0, 1, At, B1); PG8_BAR; PG8_SCHED;
            PG8_LDA(At, 0, 1); PG8_STAGE(PG8_SB(0, 0), b2, voffB); PG8_STAGE(PG8_SB(0, 1), b2 + hstepB, voffB); PG8_STAGE(PG8_SA(0, 0), a2, voffA);
            PG8_WAIT_V(8); PG8_WAIT_L(0); PG8_BAR; PG8_MMA(1, 0, At, B0); PG8_MMA(1, 1, At, B1); PG8_BAR; PG8_SCHED;
            PG8_LDB(B0, 1, 0); PG8_LDB(B1, 1, 1); PG8_SCHED; PG8_LDA(At, 1, 0); PG8_STAGE(PG8_SA(0, 1), a2 + hstepA, voffA);
            PG8_WAIT_V(8); PG8_WAIT_L(0); PG8_BAR; PG8_MMA(0, 0, At, B0); PG8_MMA(0, 1, At, B1); PG8_BAR; PG8_SCHED;
            PG8_LDA(At, 1, 1); PG8_STAGE(PG8_SB(1, 0), b3, voffB); PG8_STAGE(PG8_SB(1, 1), b3 + hstepB, voffB); PG8_STAGE(PG8_SA(1, 0), a3, voffA);
            PG8_WAIT_V(8); PG8_WAIT_L(0); PG8_BAR; PG8_MMA(1, 0, At, B0); PG8_MMA(1, 1, At, B1); PG8_BAR; PG8_SCHED;
        }
        if (wr == 0) PG8_BAR;
        TMARK(Epi::TID);
        E(acc, cur, wr, wc, fr, fq);
        TMARK(Epi::TID + 1);
        if (!has_next) break;
#pragma unroll
        for (int a = 0; a < 2; ++a)
#pragma unroll
            for (int b = 0; b < 2; ++b)
#pragma unroll
                for (int m = 0; m < 4; ++m)
#pragma unroll
                    for (int n = 0; n < 2; ++n) acc[a][b][m][n] = (f32x4){0.f, 0.f, 0.f, 0.f};
        cur = nxt; cA = nA; cB = nB; ++ui;
        if (wr == 1) PG8_BAR;
    }
    PG8_WAIT_V(0);
    PG8_BAR;
#undef PG8_SA
#undef PG8_SB
#undef PG8_STAGE
#undef PG8_LDA
#undef PG8_LDB
#undef PG8_MMA
#undef PG8_WAIT_V
#undef PG8_WAIT_L
#undef PG8_BAR
#undef PG8_SCHED
}

template <class Epi, class Sched>
__device__ __forceinline__ void gemm_phase_gather(LAS unsigned char* lds, const Gemm g, const Sched& S, const Epi& E, const char* xbase, const LAS int* gtab) {
    const int tid = otid(), wid = __builtin_amdgcn_readfirstlane(tid >> 6), lane = tid & 63, wr = wid >> 2, wc = wid & 3, fr = lane & 15, fq = lane >> 4;
    int K = g.K; asm volatile("" : "+s"(K)); const int nt = K / BK;
    unsigned voffA[2], voffB[2], cofs[2];
#pragma unroll
    for (int i = 0; i < 2; ++i) { int R, C; stage_rc(tid * 16 + i * 8192, R, C); const int Rb = Epi::PERM ? ((R & ~31) + perm32(R & 31)) : R;
        voffA[i] = (unsigned)R; voffB[i] = (unsigned)(Rb * g.ldb + C) * 2u; cofs[i] = (unsigned)C * 2u; }
    const size_t kstep = (size_t)(BK * 2);
    const size_t hstepA = (size_t)HALF * g.lda * 2, hstepB = (size_t)HALF * g.ldb * 2;
    const unsigned ldsw = (unsigned)wid * 1024u;
    const int aoff = lds_byte(wr * 64 + fr, fq * 8), boff = lds_byte(wc * 32 + fr, fq * 8);
#define PG8_SA(b, h) (((b) * 2 + (h)) * HTB)
#define PG8_SB(b, h) ((4 + (b) * 2 + (h)) * HTB)
#define PG8_STAGE(bufoff, gbase, voff) do { _Pragma("unroll") for (int _i = 0; _i < 2; ++_i) \
        __builtin_amdgcn_global_load_lds((const unsigned*)((const char*)(gbase) + (voff)[_i]), (LAS unsigned*)(lds + (bufoff) + ldsw + _i * 8192), 16, 0, 0); } while (0)
#define PG8_LDA(dst, b, h) do { _Pragma("unroll") for (int m = 0; m < 4; ++m) _Pragma("unroll") for (int k = 0; k < 2; ++k) dst[m][k] = *(const LAS bf16x8*)(lds + PG8_SA(b, h) + aoff + m * 2048 + k * 1024); } while (0)
#define PG8_LDB(dst, b, h) do { _Pragma("unroll") for (int n = 0; n < 2; ++n) _Pragma("unroll") for (int k = 0; k < 2; ++k) dst[n][k] = *(const LAS bf16x8*)(lds + PG8_SB(b, h) + boff + n * 2048 + k * 1024); } while (0)
#define PG8_MMA(ai, bj, At, Bt) do { __builtin_amdgcn_s_setprio(1); _Pragma("unroll") for (int m = 0; m < 4; ++m) _Pragma("unroll") for (int n = 0; n < 2; ++n) _Pragma("unroll") for (int k = 0; k < 2; ++k) \
        acc[ai][bj][m][n] = __builtin_amdgcn_mfma_f32_16x16x32_bf16(Bt[n][k], At[m][k], acc[ai][bj][m][n], 0, 0, 0); __builtin_amdgcn_s_setprio(0); } while (0)
#define PG8_WAIT_V(n) asm volatile("s_waitcnt vmcnt(" #n ")" ::: "memory")
#define PG8_WAIT_L(n) asm volatile("s_waitcnt lgkmcnt(" #n ")" ::: "memory")
#define PG8_BAR __builtin_amdgcn_s_barrier()
#define PG8_SCHED __builtin_amdgcn_sched_barrier(0)
    Unit cur, nxt; int ui = 0;
    if (!S.next(0, cur)) return;
    f32x4 acc[2][2][4][2];
#pragma unroll
    for (int a = 0; a < 2; ++a)
#pragma unroll
        for (int b = 0; b < 2; ++b)
#pragma unroll
            for (int m = 0; m < 4; ++m)
#pragma unroll
                for (int n = 0; n < 2; ++n) acc[a][b][m][n] = (f32x4){0.f, 0.f, 0.f, 0.f};
    bf16x8 At[4][2], B0[2][2], B1[2][2];
    const char* cB = cur.b;
    unsigned gC[2][2], gN[2][2];
#define PG8_GOFF(dst, un) do { _Pragma("unroll") for (int h_ = 0; h_ < 2; ++h_) _Pragma("unroll") for (int i_ = 0; i_ < 2; ++i_) dst[h_][i_] = (unsigned)gtab[(un).aux2 * 256 + h_ * 128 + (int)voffA[i_]] * (unsigned)(g.lda * 2) + cofs[i_]; } while (0)
    PG8_GOFF(gC, cur);
    PG8_STAGE(PG8_SB(0, 0), cB, voffB); PG8_STAGE(PG8_SB(0, 1), cB + hstepB, voffB); PG8_STAGE(PG8_SA(0, 0), xbase, gC[0]); PG8_STAGE(PG8_SA(0, 1), xbase, gC[1]);
    if (wr == 1) PG8_BAR;
    PG8_WAIT_V(2); PG8_BAR;
    PG8_STAGE(PG8_SB(1, 0), cB + kstep, voffB); PG8_STAGE(PG8_SA(1, 0), xbase + kstep, gC[0]); PG8_STAGE(PG8_SB(1, 1), cB + hstepB + kstep, voffB);
    PG8_WAIT_V(6); PG8_BAR;
    for (;;) {
        const bool has_next = S.next(ui + 1, nxt);
        const char* nB = has_next ? nxt.b : cB;
        if (has_next) { PG8_GOFF(gN, nxt); } else { gN[0][0] = gC[0][0]; gN[0][1] = gC[0][1]; gN[1][0] = gC[1][0]; gN[1][1] = gC[1][1]; }
        for (int t = 0; t < nt; t += 2) {
            const bool last = (t == nt - 2);
            const char* a1 = xbase + (size_t)(t + 1) * kstep;
            const char* a2 = last ? xbase : xbase + (size_t)(t + 2) * kstep; const char* b2 = last ? nB : cB + (size_t)(t + 2) * kstep;
            const char* a3 = a2 + kstep; const char* b3 = b2 + kstep;
            unsigned g2[2][2];
            g2[0][0] = last ? gN[0][0] : gC[0][0]; g2[0][1] = last ? gN[0][1] : gC[0][1]; g2[1][0] = last ? gN[1][0] : gC[1][0]; g2[1][1] = last ? gN[1][1] : gC[1][1];
            PG8_LDB(B0, 0, 0); PG8_LDB(B1, 0, 1); PG8_SCHED; PG8_LDA(At, 0, 0); PG8_STAGE(PG8_SA(1, 1), a1, gC[1]);
            PG8_WAIT_V(8); PG8_WAIT_L(0); PG8_BAR; PG8_MMA(0, 0, At, B0); PG8_MMA(0, 1, At, B1); PG8_BAR; PG8_SCHED;
            PG8_LDA(At, 0, 1); PG8_STAGE(PG8_SB(0, 0), b2, voffB); PG8_STAGE(PG8_SB(0, 1), b2 + hstepB, voffB); PG8_STAGE(PG8_SA(0, 0), a2, g2[0]);
            PG8_WAIT_V(8); PG8_WAIT_L(0); PG8_BAR; PG8_MMA(1, 0, At, B0); PG8_MMA(1, 1, At, B1); PG8_BAR; PG8_SCHED;
            PG8_LDB(B0, 1, 0); PG8_LDB(B1, 1, 1); PG8_SCHED; PG8_LDA(At, 1, 0); PG8_STAGE(PG8_SA(0, 1), a2, g2[1]);
            PG8_WAIT_V(8); PG8_WAIT_L(0); PG8_BAR; PG8_MMA(0, 0, At, B0); PG8_MMA(0, 1, At, B1); PG8_BAR; PG8_SCHED;
            PG8_LDA(At, 1, 1); PG8_STAGE(PG8_SB(1, 0), b3, voffB); PG8_STAGE(PG8_SB(1, 1), b3 + hstepB, voffB); PG8_STAGE(PG8_SA(1, 0), a3, g2[0]);
            PG8_WAIT_V(8); PG8_WAIT_L(0); PG8_BAR; PG8_MMA(1, 0, At, B0); PG8_MMA(1, 1, At, B1); PG8_BAR; PG8_SCHED;
        }
        if (wr == 0) PG8_BAR;
        TMARK(Epi::TID);
        E(acc, cur, wr, wc, fr, fq);
        TMARK(Epi::TID + 1);
        if (!has_next) break;
#pragma unroll
        for (int a = 0; a < 2; ++a)
#pragma unroll
            for (int b = 0; b < 2; ++b)
#pragma unroll
                for (int m = 0; m < 4; ++m)
#pragma unroll
                    for (int n = 0; n < 2; ++n) acc[a][b][m][n] = (f32x4){0.f, 0.f, 0.f, 0.f};
        cur = nxt; cB = nB; ++ui;
        gC[0][0] = gN[0][0]; gC[0][1] = gN[0][1]; gC[1][0] = gN[1][0]; gC[1][1] = gN[1][1];
        if (wr == 1) PG8_BAR;
    }
    PG8_WAIT_V(0);
    PG8_BAR;
#undef PG8_GOFF
#undef PG8_SA
#undef PG8_SB
#undef PG8_STAGE
#undef PG8_LDA
#undef PG8_LDB
#undef PG8_MMA
#undef PG8_WAIT_V
#undef PG8_WAIT_L
#undef PG8_BAR
#undef PG8_SCHED
}

#define EPI_LOOP_BEGIN \
    _Pragma("unroll") for (int ai = 0; ai < 2; ++ai) _Pragma("unroll") for (int m = 0; m < 4; ++m) { const int row = u.row0 + ai * HALF + wr * 64 + m * 16 + fr; \
    _Pragma("unroll") for (int bj = 0; bj < 2; ++bj) { const int col = u.col0 + bj * HALF + wc * 32 + 8 * fq; const f32x4 v0 = acc[ai][bj][m][0], v1 = acc[ai][bj][m][1];
#define EPI_LOOP_END } }

struct EpiStore {
    static constexpr bool PERM = true; static constexpr int TID = 66;
    bf16* O; int ldc; float scale;
    __device__ __forceinline__ void operator()(const f32x4 (&acc)[2][2][4][2], const Unit& u, int wr, int wc, int fr, int fq) const {
        EPI_LOOP_BEGIN
            u32x4 w; w.x = pk2(v0[0] * scale, v0[1] * scale); w.y = pk2(v0[2] * scale, v0[3] * scale); w.z = pk2(v1[0] * scale, v1[1] * scale); w.w = pk2(v1[2] * scale, v1[3] * scale);
            *(u32x4*)(O + (size_t)row * ldc + col) = w;
        EPI_LOOP_END
    }
};
struct EpiProj {
    static constexpr bool PERM = true; static constexpr int TID = 62;
    bf16* O; int ldc; bf16* halo;
    __device__ __forceinline__ void operator()(const f32x4 (&acc)[2][2][4][2], const Unit& u, int wr, int wc, int fr, int fq) const {
        const bool hz = (u.col0 >= C_GQ) && (u.col0 < C_GQ + 1536);
        const float sc = (u.col0 >= C_OB && u.col0 < C_OB + 512) ? 0.125f * LOG2E : 1.f;
        EPI_LOOP_BEGIN
            u32x4 w; w.x = pk2(v0[0] * sc, v0[1] * sc); w.y = pk2(v0[2] * sc, v0[3] * sc); w.z = pk2(v1[0] * sc, v1[1] * sc); w.w = pk2(v1[2] * sc, v1[3] * sc);
            *(u32x4*)(O + (size_t)row * ldc + col) = w;
            if (hz && m == 3 && fr >= 13) *(u32x4*)(halo + ((size_t)(row >> 6) * 3 + (fr - 13)) * 1536 + (col - C_GQ)) = w;
        EPI_LOOP_END
    }
};
struct EpiGate {
    static constexpr bool PERM = true; static constexpr int TID = 60;
    bf16* PJ; int ldc; const float* bias;
    __device__ __forceinline__ void operator()(const f32x4 (&acc)[2][2][4][2], const Unit& u, int wr, int wc, int fr, int fq) const {
        const bool first = u.aux < 1024;
        f32x4 bv[2][2];
#pragma unroll
        for (int bj = 0; bj < 2; ++bj) { const int gc = u.aux + bj * HALF + wc * 32 + 8 * fq; bv[bj][0] = *(const f32x4*)(bias + gc); bv[bj][1] = *(const f32x4*)(bias + gc + 4); }
#pragma unroll
        for (int ai = 0; ai < 2; ++ai) {
            u32x4 tv[4][2], mv[4][2];
#pragma unroll
            for (int m = 0; m < 4; ++m)
#pragma unroll
                for (int bj = 0; bj < 2; ++bj) { const size_t ro = (size_t)(u.row0 + ai * HALF + wr * 64 + m * 16 + fr) * ldc; const int cc = bj * HALF + wc * 32 + 8 * fq;
                    tv[m][bj] = *(const u32x4*)(PJ + ro + C_T + u.aux + cc);
                    if (!first) mv[m][bj] = *(const u32x4*)(PJ + ro + u.col0 + cc); else mv[m][bj] = (u32x4){0u, 0u, 0u, 0u}; }
#pragma unroll
            for (int m = 0; m < 4; ++m)
#pragma unroll
                for (int bj = 0; bj < 2; ++bj) { const size_t ro = (size_t)(u.row0 + ai * HALF + wr * 64 + m * 16 + fr) * ldc; const int cc = bj * HALF + wc * 32 + 8 * fq;
                    const f32x4 v0 = acc[ai][bj][m][0], v1 = acc[ai][bj][m][1]; const f32x4 b0 = bv[bj][0], b1 = bv[bj][1]; const u32x4 t = tv[m][bj], mm = mv[m][bj];
                    u32x4 w;
                    w.x = pk2(bflo(mm.x) + sigmoidf_(v0[0] + b0[0]) * bflo(t.x), bfhi(mm.x) + sigmoidf_(v0[1] + b0[1]) * bfhi(t.x));
                    w.y = pk2(bflo(mm.y) + sigmoidf_(v0[2] + b0[2]) * bflo(t.y), bfhi(mm.y) + sigmoidf_(v0[3] + b0[3]) * bfhi(t.y));
                    w.z = pk2(bflo(mm.z) + sigmoidf_(v1[0] + b1[0]) * bflo(t.z), bfhi(mm.z) + sigmoidf_(v1[1] + b1[1]) * bfhi(t.z));
                    w.w = pk2(bflo(mm.w) + sigmoidf_(v1[2] + b1[2]) * bflo(t.w), bfhi(mm.w) + sigmoidf_(v1[3] + b1[3]) * bfhi(t.w));
                    *(u32x4*)(PJ + ro + u.col0 + cc) = w; }
        }
    }
};
struct EpiResid {
    static constexpr bool PERM = true; static constexpr int TID = 64;
    const bf16* X; bf16* Y; int ldc;
    __device__ __forceinline__ void operator()(const f32x4 (&acc)[2][2][4][2], const Unit& u, int wr, int wc, int fr, int fq) const {
#pragma unroll
        for (int ai = 0; ai < 2; ++ai) {
            u32x4 xv[4][2];
#pragma unroll
            for (int m = 0; m < 4; ++m)
#pragma unroll
                for (int bj = 0; bj < 2; ++bj) xv[m][bj] = *(const u32x4*)(X + (size_t)(u.row0 + ai * HALF + wr * 64 + m * 16 + fr) * ldc + u.col0 + bj * HALF + wc * 32 + 8 * fq);
#pragma unroll
            for (int m = 0; m < 4; ++m)
#pragma unroll
                for (int bj = 0; bj < 2; ++bj) { const f32x4 v0 = acc[ai][bj][m][0], v1 = acc[ai][bj][m][1]; const u32x4 t = xv[m][bj];
                    u32x4 w;
                    w.x = pk2(ALPHA * bflo(t.x) + v0[0], ALPHA * bfhi(t.x) + v0[1]); w.y = pk2(ALPHA * bflo(t.y) + v0[2], ALPHA * bfhi(t.y) + v0[3]);
                    w.z = pk2(ALPHA * bflo(t.z) + v1[0], ALPHA * bfhi(t.z) + v1[1]); w.w = pk2(ALPHA * bflo(t.w) + v1[2], ALPHA * bfhi(t.w) + v1[3]);
                    *(u32x4*)(Y + (size_t)(u.row0 + ai * HALF + wr * 64 + m * 16 + fr) * ldc + u.col0 + bj * HALF + wc * 32 + 8 * fq) = w; }
        }
    }
};
struct EpiSwiglu {
    static constexpr bool PERM = true; static constexpr int TID = 68;
    bf16* H; int ldc;
    __device__ __forceinline__ void operator()(const f32x4 (&acc)[2][2][4][2], const Unit& u, int wr, int wc, int fr, int fq) const {
        EPI_LOOP_BEGIN
            u32x2 w; w.x = pk2(siluf_(v0[0]) * v1[0], siluf_(v0[1]) * v1[1]); w.y = pk2(siluf_(v0[2]) * v1[2], siluf_(v0[3]) * v1[3]);
            *(u32x2*)(H + (size_t)row * ldc + (col >> 1)) = w;
        EPI_LOOP_END
    }
};
}

struct Args {
    const float* x; const float* mem; const float* w_in; const float* gdn_conv_w; const float* gdn_a_log; const float* gdn_dt_bias; const float* gdn_norm_w; const float* fox_f_bias;
    const float* gla_w_gate2; const float* gla_b_gate; const float* gla_norm_w; const float* p_gdn; const float* p_fox; const float* p_gla; const float* b_merge; const float* w_out;
    const float* ln1_g; const float* ln1_b; const float* xa_wq; const float* xa_wkv; const float* xa_wo; const float* ln2_g; const float* ln2_b;
    const float* moe_w_group; const float* moe_b_group; const float* moe_w_expert; const float* moe_b_expert; const float* moe_w_gate; const float* moe_w_up; const float* moe_w_down;
    const float* ln3_g; const float* ln3_b;
    float* out; unsigned char* ws;
};

typedef const __attribute__((address_space(4))) Args* KArgP;

__device__ __forceinline__ int tr_srccol(int mode, int c0, int n) {
    if (mode != 3) return c0 + n;
    return n < 4 ? 1536 + n : n < 8 ? 1540 + (n - 4) : n < 16 ? 3592 + (n - 8) : 5136 + (n - 16);
}
__device__ __forceinline__ int tr_dstrow(int mode, int r0, int nn) {
    if (mode == 1) return r0 + 8 * (nn >> 2) + (nn & 3);
    if (mode == 2) return r0 + 8 * (nn >> 2) + 4 + (nn & 3);
    return r0 + nn;
}
__device__ __forceinline__ void tr_item(const float* W, int ldw, int c0, int ncols, bf16* T, int ldt, int r0, int koff, int mode, LAS float* scr, int item, int lane) {
    const int nblk = ncols / 32, kb = item / nblk, nb = item % nblk, k0 = 64 * kb, n0 = 32 * nb;
    if (mode != 3) {
        const int sc4 = c0 + n0 + 4 * (lane & 7);
#pragma unroll
        for (int i = 0; i < 8; ++i) { const int kk = 8 * i + (lane >> 3); const f32x4 v = *(const f32x4*)(W + (size_t)(k0 + kk) * ldw + sc4);
            LAS float* d = scr + kk * 33 + 4 * (lane & 7); d[0] = v[0]; d[1] = v[1]; d[2] = v[2]; d[3] = v[3]; }
    } else {
        const int sc = tr_srccol(mode, c0, n0 + (lane & 31));
#pragma unroll 8
        for (int i = 0; i < 32; ++i) { const int kk = 2 * i + (lane >> 5); scr[kk * 33 + (lane & 31)] = W[(size_t)(k0 + kk) * ldw + sc]; }
    }
    asm volatile("s_waitcnt lgkmcnt(0)" ::: "memory");
    const int c = lane & 7;
#pragma unroll
    for (int j = 0; j < 4; ++j) { const int n = (lane >> 3) + 8 * j; const LAS float* s = scr + (8 * c) * 33 + n;
        u32x4 o; o.x = pk2(s[0 * 33], s[1 * 33]); o.y = pk2(s[2 * 33], s[3 * 33]); o.z = pk2(s[4 * 33], s[5 * 33]); o.w = pk2(s[6 * 33], s[7 * 33]);
        *(u32x4*)(T + (size_t)tr_dstrow(mode, r0, n0 + n) * ldt + koff + k0 + 8 * c) = o; }
    asm volatile("s_waitcnt lgkmcnt(0)" ::: "memory");
}
__device__ __forceinline__ void tr_job(const float* W, int ldw, int K, int c0, int ncols, size_t wstride, bf16* T, int ldt, int r0, int koff, int mode, size_t tstride, int nmat,
                                       LAS float* scr, int lane, int gw, int NGW, int& run) {
    const int per = (K / 64) * (ncols / 32), n = per * nmat;
    int first = gw - (run % NGW); if (first < 0) first += NGW;
    for (int it = first; it < n; it += NGW) { const int e = it / per, li = it % per; tr_item(W + (size_t)e * wstride, ldw, c0, ncols, T + (size_t)e * tstride, ldt, r0, koff, mode, scr, li, lane); }
    run += n;
}
__device__ __forceinline__ void phase_convert_weights(KArgP A, int l, LAS unsigned char* lds) {
    const int tid = otid(), lane = tid & 63, wid = tid >> 6;
    LAS float* scr = (LAS float*)(lds + wid * 16384);
    const int gw = obid() * 8 + wid, NGW = ogrid() * 8; int run = 0;
    unsigned char* wt = A->ws + WS_WT;
    bf16* WIN = (bf16*)(wt + WT_WIN);
    const float* w_in = A->w_in + (size_t)l * 1024 * N_IN;
    tr_job(w_in, N_IN, 1024, 1544, 512, 0, WIN, 1024, C_OA, 0, 0, 0, 1, scr, lane, gw, NGW, run);
    tr_job(w_in, N_IN, 1024, 2056, 512, 0, WIN, 1024, C_OB, 0, 0, 0, 1, scr, lane, gw, NGW, run);
    tr_job(w_in, N_IN, 1024, 4624, 512, 0, WIN, 1024, C_OC, 0, 0, 0, 1, scr, lane, gw, NGW, run);
    tr_job(w_in, N_IN, 1024, 0, 1536, 0, WIN, 1024, C_GQ, 0, 0, 0, 1, scr, lane, gw, NGW, run);
    tr_job(w_in, N_IN, 1024, 2568, 1024, 0, WIN, 1024, C_FK, 0, 0, 0, 1, scr, lane, gw, NGW, run);
    tr_job(w_in, N_IN, 1024, 3600, 1024, 0, WIN, 1024, C_LQ, 0, 0, 0, 1, scr, lane, gw, NGW, run);
    tr_job(w_in, N_IN, 1024, 0, 32, 0, WIN, 1024, C_SM, 0, 3, 0, 1, scr, lane, gw, NGW, run);
    tr_job(w_in, N_IN, 1024, 5152, 3072, 0, WIN, 1024, LP, 0, 0, 0, 1, scr, lane, gw, NGW, run);
    { u32x4 z = {0u, 0u, 0u, 0u}; asm volatile("" : "+v"(z)); u32x4* p = (u32x4*)(WIN + (size_t)5152 * 1024); const int n16 = 224 * 1024 * 2 / 16;
      for (int i = obid() * 512 + tid; i < n16; i += ogrid() * 512) p[i] = z; }
    bf16* PT = (bf16*)(wt + WT_P);
    tr_job(A->p_gdn + (size_t)l * 512 * 1024, 1024, 512, 0, 1024, 0, PT, 512, 0, 0, 0, 0, 1, scr, lane, gw, NGW, run);
    tr_job(A->p_fox + (size_t)l * 512 * 1024, 1024, 512, 0, 1024, 0, PT + 1024 * 512, 512, 0, 0, 0, 0, 1, scr, lane, gw, NGW, run);
    tr_job(A->p_gla + (size_t)l * 512 * 1024, 1024, 512, 0, 1024, 0, PT + 2 * 1024 * 512, 512, 0, 0, 0, 0, 1, scr, lane, gw, NGW, run);
    bf16* WO3 = (bf16*)(wt + WT_WOUT3);
    tr_job(A->w_out + (size_t)l * 1024 * 1024, 1024, 1024, 0, 1024, 0, WO3, 1024, 0, 0, 0, 0, 1, scr, lane, gw, NGW, run);
    tr_job(A->xa_wq + (size_t)l * 1024 * 1024, 1024, 1024, 0, 1024, 0, (bf16*)(wt + WT_WQ), 1024, 0, 0, 0, 0, 1, scr, lane, gw, NGW, run);
    tr_job(A->xa_wkv + (size_t)l * 1024 * 2048, 2048, 1024, 0, 2048, 0, (bf16*)(wt + WT_WKV), 1024, 0, 0, 0, 0, 1, scr, lane, gw, NGW, run);
    tr_job(A->xa_wo + (size_t)l * 1024 * 1024, 1024, 1024, 0, 1024, 0, (bf16*)(wt + WT_WO), 1024, 0, 0, 0, 0, 1, scr, lane, gw, NGW, run);
    tr_job(A->moe_w_gate + (size_t)l * 32 * 1024 * 256, 256, 1024, 0, 256, (size_t)1024 * 256, (bf16*)(wt + WT_GU), 1024, 0, 0, 1, (size_t)512 * 1024, 32, scr, lane, gw, NGW, run);
    tr_job(A->moe_w_up + (size_t)l * 32 * 1024 * 256, 256, 1024, 0, 256, (size_t)1024 * 256, (bf16*)(wt + WT_GU), 1024, 0, 0, 2, (size_t)512 * 1024, 32, scr, lane, gw, NGW, run);
    tr_job(A->moe_w_down + (size_t)l * 32 * 256 * 1024, 1024, 256, 0, 1024, (size_t)256 * 1024, (bf16*)(wt + WT_DN), 256, 0, 0, 0, (size_t)1024 * 256, 32, scr, lane, gw, NGW, run);
    {
        const float* wg = A->moe_w_group + (size_t)l * 1024 * 4; const float* we = A->moe_w_expert + (size_t)l * 1024 * 32;
        bf16* RH = (bf16*)(wt + WT_RWH); bf16* RL = (bf16*)(wt + WT_RWL);
        for (int i = obid() * 512 + tid; i < 48 * 1024; i += ogrid() * 512) { const int n = i >> 10, k = i & 1023;
            const float w = n < 4 ? wg[k * 4 + n] : n < 36 ? we[k * 32 + (n - 4)] : 0.f; const unsigned h = f2bf(w); RH[i] = (bf16)h; RL[i] = (bf16)f2bf(w - bf2f((unsigned short)h)); }
    }
}
__device__ __forceinline__ void convert_rows(const float* src, bf16* dst, size_t n) {
    const size_t n8 = n / 8;
    for (size_t i = (size_t)obid() * 512 + otid(); i < n8; i += (size_t)ogrid() * 512) {
        const f32x4 a = *(const f32x4*)(src + i * 8), b = *(const f32x4*)(src + i * 8 + 4);
        u32x4 w; w.x = pk2(a[0], a[1]); w.y = pk2(a[2], a[3]); w.z = pk2(b[0], b[1]); w.w = pk2(b[2], b[3]);
        *(u32x4*)(dst + i * 8) = w;
    }
}

struct RegSched {
    int nM, nN, nwg, G, c; const char* A; const char* B; size_t astride, bstride; int col_base;
    __device__ __forceinline__ bool next(int i, pg8::Unit& u) const {
        const long L = (long)i * G + c; if (L >= nwg) return false;
        int wgid = (int)L; { const int q = nwg / 8, r = nwg % 8, xcd = wgid % 8, off = wgid / 8; wgid = (xcd < r ? xcd * (q + 1) : r * (q + 1) + (xcd - r) * q) + off; }
        const int nig = 8 * nN, gid = wgid / nig, fm = gid * 8, gsz = (nM - fm) < 8 ? (nM - fm) : 8;
        const int pm = fm + ((wgid % nig) % gsz), pn = (wgid % nig) / gsz;
        u.a = A + (size_t)pm * astride; u.b = B + (size_t)pn * bstride; u.row0 = pm * 256; u.col0 = col_base + pn * 256; u.aux = pn * 256; return true;
    }
};
struct BranchSched {
    int nM, nwg, G, c; const char* A; const char* B;
    __device__ __forceinline__ bool next(int i, pg8::Unit& u) const {
        const long L = (long)i * G + c; if (L >= nwg) return false;
        int wgid = (int)L; { const int q = nwg / 8, r = nwg % 8, xcd = wgid % 8, off = wgid / 8; wgid = (xcd < r ? xcd * (q + 1) : r * (q + 1) + (xcd - r) * q) + off; }
        const int nN = 12, nig = 8 * nN, gid = wgid / nig, fm = gid * 8, gsz = (nM - fm) < 8 ? (nM - fm) : 8;
        const int pm = fm + ((wgid % nig) % gsz), pn = (wgid % nig) / gsz, br = pn >> 2;
        u.a = A + ((size_t)pm * 256 * LP + br * 512) * 2; u.b = B + ((size_t)br * 1024 * 512 + (size_t)(pn & 3) * 256 * 512) * 2; u.row0 = pm * 256; u.col0 = C_T + pn * 256; u.aux = 0; return true;
    }
};
struct GateSched {
    int nM, nwg, G, c; const char* A; const char* B;
    __device__ __forceinline__ bool next(int i, pg8::Unit& u) const {
        const int rnd = i / 3, br = i - 3 * rnd;
        const long L = (long)rnd * G + c; if (L >= nwg) return false;
        int wgid = (int)L; { const int q = nwg / 8, r = nwg % 8, xcd = wgid % 8, off = wgid / 8; wgid = (xcd < r ? xcd * (q + 1) : r * (q + 1) + (xcd - r) * q) + off; }
        const int nN = 4, nig = 8 * nN, gid = wgid / nig, fm = gid * 8, gsz = (nM - fm) < 8 ? (nM - fm) : 8;
        const int pm = fm + ((wgid % nig) % gsz), pn = (wgid % nig) / gsz;
        u.a = A + (size_t)pm * 256 * 1024 * 2; u.b = B + ((size_t)br * 1024 + (size_t)pn * 256) * 1024 * 2; u.row0 = pm * 256; u.col0 = pn * 256; u.aux = br * 1024 + pn * 256; return true;
    }
};
struct MoeSched {
    int nct, G, c; const LAS int* tab;
    const char* A; size_t astride; const char* B; size_t bexp, bct;
    __device__ __forceinline__ bool next(int i, pg8::Unit& u) const {
        const long L = (long)i * G + c; const int nblk = tab[0]; if (L >= (long)nblk * nct) return false;
        const int rb = (int)(L / nct), ct = (int)(L % nct), e = tab[1 + rb];
        u.a = A + (size_t)rb * astride; u.b = B + (size_t)e * bexp + (size_t)ct * bct; u.row0 = rb * 256; u.col0 = ct * 256; u.aux = e; u.aux2 = i; return true;
    }
};

__device__ __forceinline__ bf16x8 frag_rm(const LAS unsigned char* base, int stride, int blk, int ks, int l15, int g) { return *(const LAS bf16x8*)(base + (blk * 16 + l15) * stride + (ks * 32 + 8 * g) * 2); }
__device__ __forceinline__ bf16x8 frag_tr(const LAS unsigned char* base, int stride, int ks, int nb, int g, int q4, int p4) {
    const s16x4 lo = __builtin_amdgcn_ds_read_tr16_b64_v4i16((LAS s16x4*)(base + (32 * ks + 8 * g + q4) * stride + (16 * nb + 4 * p4) * 2));
    const s16x4 hi = __builtin_amdgcn_ds_read_tr16_b64_v4i16((LAS s16x4*)(base + (32 * ks + 8 * g + 4 + q4) * stride + (16 * nb + 4 * p4) * 2));
    return (bf16x8){lo[0], lo[1], lo[2], lo[3], hi[0], hi[1], hi[2], hi[3]};
}
#define MFMA16(a, b, c) __builtin_amdgcn_mfma_f32_16x16x32_bf16((a), (b), (c), 0, 0, 0)

__device__ __forceinline__ void xattn_phase(LAS unsigned char* lds, const bf16* Qb, const bf16* KV, bf16* Ob, int G, int bx) {
    const int tid = otid(), lane = tid & 63, wid = tid >> 6, l15 = lane & 15, g = lane >> 4, q4 = l15 >> 2, p4 = lane & 3;
    constexpr int D = 256, KST = (D + 8) * 2, NU = NB * 4 * 16;
    LAS unsigned char* KS = lds; LAS unsigned char* VS = lds + 64 * KST; LAS unsigned char* PS = lds + 2 * 64 * KST + wid * 2304;
    LAS unsigned char* OS = lds + 2 * 64 * KST + 8 * 2304 + wid * 4352;
    const int nun = (NU - bx + G - 1) / G, NT = nun * 4;
    u32x4 kreg[4], vreg[4];
#define XA_ISSUE(tt_) do { const int u_ = bx + ((tt_) >> 2) * G, t_ = (tt_) & 3, b_ = u_ >> 6, h_ = (u_ >> 4) & 3; \
        _Pragma("unroll") for (int j_ = 0; j_ < 4; ++j_) { const int c_ = tid + 512 * j_, row_ = c_ >> 5, ch_ = c_ & 31; \
            const bf16* kp_ = KV + (size_t)(b_ * MEMLEN + t_ * 64 + row_) * 2048 + h_ * 256 + ch_ * 8; kreg[j_] = *(const u32x4*)kp_; vreg[j_] = *(const u32x4*)(kp_ + 1024); } } while (0)
    if (NT > 0) XA_ISSUE(0);
    bf16x8 qf[8]; f32x4 o[16]; float mrow[4], lrow[4];
    for (int tt = 0; tt < NT; ++tt) {
        TMARK(55);
        const int u = bx + (tt >> 2) * G, t = tt & 3, b = u >> 6, h = (u >> 4) & 3, qb = u & 15;
        const size_t rowq = (size_t)b * SEQ + qb * 128;
        if (t == 0) {
            if (tt == 0) { const bf16* qrow = Qb + (rowq + wid * 16 + l15) * 1024 + h * 256 + 8 * g;
#pragma unroll
                for (int ks = 0; ks < 8; ++ks) qf[ks] = *(const bf16x8*)(qrow + ks * 32); }
#pragma unroll
            for (int i = 0; i < 16; ++i) o[i] = (f32x4){0.f, 0.f, 0.f, 0.f};
#pragma unroll
            for (int r = 0; r < 4; ++r) { mrow[r] = -1e30f; lrow[r] = 0.f; }
        }
        TMARK(50);
        __syncthreads();
#pragma unroll
        for (int j = 0; j < 4; ++j) { const int c = tid + 512 * j, row = c >> 5, ch = c & 31; *(LAS u32x4*)(KS + row * KST + ch * 16) = kreg[j]; *(LAS u32x4*)(VS + row * KST + ch * 16) = vreg[j]; }
        __syncthreads();
        if (tt + 1 < NT) XA_ISSUE(tt + 1);
        TMARK(51);
        f32x4 s[4];
#pragma unroll
        for (int nb = 0; nb < 4; ++nb) { s[nb] = (f32x4){0.f, 0.f, 0.f, 0.f};
#pragma unroll
            for (int ks = 0; ks < 8; ++ks) s[nb] = MFMA16(qf[ks], *(const LAS bf16x8*)(KS + (nb * 16 + l15) * KST + (ks * 32 + 8 * g) * 2), s[nb]); }
        if (t == 3 && tt + 1 < NT) {
            asm volatile("" : "+v"(s[0]), "+v"(s[1]), "+v"(s[2]), "+v"(s[3]));
            const int u2 = u + G, b2 = u2 >> 6, h2 = (u2 >> 4) & 3, qb2 = u2 & 15;
            const bf16* qrow = Qb + ((size_t)b2 * SEQ + qb2 * 128 + wid * 16 + l15) * 1024 + h2 * 256 + 8 * g;
#pragma unroll
            for (int ks = 0; ks < 8; ++ks) qf[ks] = *(const bf16x8*)(qrow + ks * 32); }
        TMARK(52);
        float mx[4], al[4];
#pragma unroll
        for (int r = 0; r < 4; ++r) mx[r] = fmaxf(fmaxf(s[0][r], s[1][r]), fmaxf(s[2][r], s[3][r]));
#pragma unroll
        for (int r = 0; r < 4; ++r) mx[r] = fmaxf(mx[r], swz_xor<1>(mx[r]));
#pragma unroll
        for (int r = 0; r < 4; ++r) mx[r] = fmaxf(mx[r], swz_xor<2>(mx[r]));
#pragma unroll
        for (int r = 0; r < 4; ++r) mx[r] = fmaxf(mx[r], swz_xor<4>(mx[r]));
#pragma unroll
        for (int r = 0; r < 4; ++r) mx[r] = fmaxf(mx[r], swz_xor<8>(mx[r]));
        bool moved = false;
#pragma unroll
        for (int r = 0; r < 4; ++r) { const float mn = fmaxf(mrow[r], mx[r]); al[r] = __builtin_amdgcn_exp2f(mrow[r] - mn); moved |= (mn != mrow[r]); mrow[r] = mn; lrow[r] *= al[r]; }
        if (__any(moved)) {
#pragma unroll
            for (int i = 0; i < 16; ++i)
#pragma unroll
                for (int r = 0; r < 4; ++r) o[i][r] *= al[r]; }
#pragma unroll
        for (int r = 0; r < 4; ++r) { float ps = 0.f;
#pragma unroll
            for (int nb = 0; nb < 4; ++nb) { const float p = __builtin_amdgcn_exp2f(s[nb][r] - mrow[r]); ps += p; *(LAS bf16*)(PS + ((4 * g + r) * 72 + nb * 16 + l15) * 2) = (bf16)f2bf(p); }
            lrow[r] += ps; }
        TMARK(53);
        bf16x8 pf[2];
#pragma unroll
        for (int ks = 0; ks < 2; ++ks) pf[ks] = *(const LAS bf16x8*)(PS + (l15 * 72 + ks * 32 + 8 * g) * 2);
#pragma unroll
        for (int nb = 0; nb < 16; ++nb)
#pragma unroll
            for (int ks = 0; ks < 2; ++ks) o[nb] = MFMA16(pf[ks], frag_tr(VS, KST, ks, nb, g, q4, p4), o[nb]);
        TMARK(54);
        if (t == 3) {
            float inv[4];
#pragma unroll
            for (int r = 0; r < 4; ++r) { float l = lrow[r]; l += swz_xor<1>(l); l += swz_xor<2>(l); l += swz_xor<4>(l); l += swz_xor<8>(l); inv[r] = __builtin_amdgcn_rcpf(l); }
#pragma unroll
            for (int hf = 0; hf < 2; ++hf) {
#pragma unroll
                for (int nb = 0; nb < 8; ++nb)
#pragma unroll
                    for (int r = 0; r < 4; ++r) *(LAS bf16*)(OS + ((4 * g + r) * 136 + nb * 16 + l15) * 2) = (bf16)f2bf(o[hf * 8 + nb][r] * inv[r]);
#pragma unroll
                for (int j = 0; j < 4; ++j) { const int c = lane + 64 * j, row = c >> 4, ch = c & 15;
                    *(u32x4*)(Ob + (rowq + wid * 16 + row) * 1024 + h * 256 + hf * 128 + ch * 8) = *(const LAS u32x4*)(OS + row * 272 + ch * 16); }
            }
        }
    }
#undef XA_ISSUE
}

namespace fox_body {
using bf16=unsigned short;
using bf16x8=__attribute__((ext_vector_type(8)))short;
using s16x4=__attribute__((ext_vector_type(4)))short;
using f32x16=__attribute__((ext_vector_type(16)))float;
using u32x4=__attribute__((ext_vector_type(4)))unsigned;
constexpr int BATCH=16,NHEAD=8,SEQ=2048,D=64,DM=5376;
constexpr int NW=8,QBLK=32,QB=QBLK*NW,KVBLK=64,NQB=SEQ/QB;
constexpr int ATTN_PITCH=DM, ATTN_UNIT_ROWS=QB;
__device__ __forceinline__ int crow(int r,int hi){return (r&3)+8*(r>>2)+4*hi;}
#define SBAR() __builtin_amdgcn_sched_barrier(0)
__device__ __forceinline__ void cmask(f32x16&p0,f32x16&p1,int jb,int qrel,int hi){
  const float NEG=-INFINITY; int kb=64*jb+4*hi;
  #pragma unroll
  for(int r=0;r<16;++r){int kv=kb+(r&3)+8*(r>>2); if(kv>qrel)p0[r]=NEG; if(kv+32>qrel)p1[r]=NEG;}
}

constexpr int NSLOT=3, SLOTB=8192;
constexpr int LDS_K=0, LDS_V=NSLOT*SLOTB, LDS_WS=2*NSLOT*SLOTB, LDS_OST=LDS_WS+NW*64*4, LDS_BYTES=LDS_OST+NW*4096;
constexpr float C2=0.125f*1.4426950408889634f;
__device__ __forceinline__ void glds16(const void*gsrc,unsigned lds_dst){unsigned keep;
  asm volatile("s_mov_b32 %0, m0\n\ts_mov_b32 m0, %2\n\ts_nop 0\n\tglobal_load_lds_dwordx4 %1, off\n\ts_mov_b32 m0, %0":"=&s"(keep):"v"(gsrc),"s"(lds_dst):"memory");}
__device__ __forceinline__ float max3f(float a,float b,float c){float r;asm("v_max3_f32 %0, %1, %2, %3":"=v"(r):"v"(a),"v"(b),"v"(c));return r;}
__device__ __forceinline__ float max2f(float a,float b){float r;asm("v_max_f32_e32 %0, %1, %2":"=v"(r):"v"(a),"v"(b));return r;}
__device__ __forceinline__ float fadd_s(float a,float b){float r;asm("v_add_f32_e32 %0, %1, %2":"=v"(r):"v"(a),"v"(b));return r;}
__device__ __forceinline__ float fsub_s(float a,float b){float r;asm("v_sub_f32_e32 %0, %1, %2":"=v"(r):"v"(a),"v"(b));return r;}
typedef float f32x2_t __attribute__((ext_vector_type(2))); typedef __bf16 bf16x2_t __attribute__((ext_vector_type(2)));
__device__ __forceinline__ unsigned cvtpk_s(float lo,float hi){f32x2_t v={lo,hi};bf16x2_t b=__builtin_convertvector(v,bf16x2_t);return __builtin_bit_cast(unsigned,b);}
#define WAIT_BAR(N) asm volatile("s_waitcnt vmcnt(" #N ") lgkmcnt(0)\n\ts_barrier":::"memory")

__device__ __forceinline__ void qkt(f32x16&p0,f32x16&p1,const char*Kslot,const bf16x8*qr,const f32x16&n0,const f32x16&n1,int r32,int hi){
  const char*kb=Kslot+hi*1024+r32*16;
  #pragma unroll
  for(int d0=0;d0<4;++d0){
    const bf16x8 b0=*reinterpret_cast<const bf16x8*>(kb+d0*2048);
    const bf16x8 b1=*reinterpret_cast<const bf16x8*>(kb+d0*2048+512);
    if(d0==0){p0=__builtin_amdgcn_mfma_f32_32x32x16_bf16(b0,qr[0],n0,0,0,0);p1=__builtin_amdgcn_mfma_f32_32x32x16_bf16(b1,qr[0],n1,0,0,0);}
    else{p0=__builtin_amdgcn_mfma_f32_32x32x16_bf16(b0,qr[d0],p0,0,0,0);p1=__builtin_amdgcn_mfma_f32_32x32x16_bf16(b1,qr[d0],p1,0,0,0);}}
}
typedef __attribute__((address_space(3))) const char* lds_cptr;
typedef short v4i16_t __attribute__((ext_vector_type(4)));
__device__ __forceinline__ void kload8(bf16x8*kf,lds_cptr kp){
  kf[0]=*(const __attribute__((address_space(3))) bf16x8*)(kp);      kf[1]=*(const __attribute__((address_space(3))) bf16x8*)(kp+512);
  kf[2]=*(const __attribute__((address_space(3))) bf16x8*)(kp+2048); kf[3]=*(const __attribute__((address_space(3))) bf16x8*)(kp+2560);
  kf[4]=*(const __attribute__((address_space(3))) bf16x8*)(kp+4096); kf[5]=*(const __attribute__((address_space(3))) bf16x8*)(kp+4608);
  kf[6]=*(const __attribute__((address_space(3))) bf16x8*)(kp+6144); kf[7]=*(const __attribute__((address_space(3))) bf16x8*)(kp+6656);
}
__device__ __forceinline__ void kload2(bf16x8*kf,lds_cptr kp,int j){ kf[2*j]=*(const __attribute__((address_space(3))) bf16x8*)(kp+j*2048); kf[2*j+1]=*(const __attribute__((address_space(3))) bf16x8*)(kp+j*2048+512); }
__device__ __forceinline__ s16x4 vtr(lds_cptr p){ return __builtin_bit_cast(s16x4,__builtin_amdgcn_ds_read_tr16_b64_v4i16((__attribute__((address_space(3))) v4i16_t*)p)); }
__device__ __forceinline__ float rowmax(const f32x16&p0,const f32x16&p1){
  float a=max3f(p0[0],p0[1],p1[0]),b=max3f(p0[2],p0[3],p1[1]);a=max3f(a,p1[2],p1[3]);
  #pragma unroll
  for(int r=4;r<16;r+=4){a=max3f(a,p0[r],p0[r+1]);b=max3f(b,p0[r+2],p0[r+3]);a=max3f(a,p1[r],p1[r+1]);b=max3f(b,p1[r+2],p1[r+3]);}
  const float m=max2f(a,b);
  auto rr=__builtin_amdgcn_permlane32_swap(__float_as_uint(m),__float_as_uint(m),false,false);
  return max2f(__uint_as_float(rr[0]),__uint_as_float(rr[1]));
}
__device__ __forceinline__ void pv(f32x16*o,int vb,bf16x8 pa0,bf16x8 pa1,bf16x8 pa2,bf16x8 pa3){
  #pragma unroll
  for(int d0=0;d0<2;++d0){s16x4 lo[4],hi[4];
    #pragma unroll
    for(int ks=0;ks<4;++ks){
      asm volatile("ds_read_b64_tr_b16 %0,%1 offset:%c2":"=&v"(lo[ks]):"v"(vb),"i"(d0*4096+ks*1024):"memory");
      asm volatile("ds_read_b64_tr_b16 %0,%1 offset:%c2":"=&v"(hi[ks]):"v"(vb),"i"(d0*4096+ks*1024+512):"memory");}
    asm volatile("s_waitcnt lgkmcnt(0)":::"memory");SBAR();
    #define PK(k) (bf16x8){lo[k][0],lo[k][1],lo[k][2],lo[k][3],hi[k][0],hi[k][1],hi[k][2],hi[k][3]}
    o[d0]=__builtin_amdgcn_mfma_f32_32x32x16_bf16(pa0,PK(0),o[d0],0,0,0);
    o[d0]=__builtin_amdgcn_mfma_f32_32x32x16_bf16(pa1,PK(1),o[d0],0,0,0);
    o[d0]=__builtin_amdgcn_mfma_f32_32x32x16_bf16(pa2,PK(2),o[d0],0,0,0);
    o[d0]=__builtin_amdgcn_mfma_f32_32x32x16_bf16(pa3,PK(3),o[d0],0,0,0);
    #undef PK
  }
}

#ifndef ATTN_STORE16
#define ATTN_STORE16(p,v) (*(u32x4*)(p)=(v))
#endif
template<int THRL,bool NOBIAS=false> __device__ __forceinline__ void attn_unit(int b,int h,int qb,const bf16*Q,const bf16*__restrict__ K,const bf16*__restrict__ V,bf16*O,char*shm,const __attribute__((address_space(3))) float*CKL){
  const int tid=otid(),lane=tid&63,r32=lane&31,hi=lane>>5; const int wid=__builtin_amdgcn_readfirstlane(tid>>6);
  const long rowbase=(long)b*SEQ; const int q0=qb*QB;
  const bf16*Qw=Q+(rowbase+q0+wid*QBLK)*DM;
  const bf16*Kh=K+rowbase*DM,*Vh=V+rowbase*DM;
  const unsigned lds0=(unsigned)(uintptr_t)shm;
  float*wsf=(float*)(shm+LDS_WS)+wid*64;
  const bf16*ksrc=Kh+(long)lane*DM+wid*8;
  const bf16*vsrc=Vh+(long)(16*(wid&3)+(lane>>2))*DM+(wid>>2)*32+(lane&3)*8;
  const unsigned kdst=lds0+LDS_K+wid*1024, vdst=lds0+LDS_V+wid*1024;
  #define DMA_K(t,slot) glds16(ksrc+(long)(t)*KVBLK*DM,(unsigned)__builtin_amdgcn_readfirstlane(kdst+(slot)))
  #define DMA_V(t,slot) glds16(vsrc+(long)(t)*KVBLK*DM,(unsigned)__builtin_amdgcn_readfirstlane(vdst+(slot)))
  const int vb0=(int)(lds0+LDS_V)+((lane>>4)&1)*32+(lane&3)*8+(4*hi+((lane&15)>>2))*64;
  const char*Kbase=shm+LDS_K; bf16x8 kf[8];
  const lds_cptr shm3=(lds_cptr)shm; const lds_cptr kp0=shm3+LDS_K+hi*1024+r32*16; const lds_cptr vp0=shm3+LDS_V+((lane>>4)&1)*32+(lane&3)*8+(4*hi+((lane&15)>>2))*64;
  const int NT=(q0+QB)/KVBLK;
  DMA_K(0,0);DMA_V(0,0);DMA_K(1,SLOTB);
  bf16x8 qr[4];
  #pragma unroll
  for(int d0=0;d0<4;++d0)qr[d0]=*reinterpret_cast<const bf16x8*>(&Qw[(long)r32*DM+d0*16+hi*8]);
  float mhat=0.f,l_reg=0.f;f32x16 o[2];o[0]=f32x16{};o[1]=f32x16{};f32x16 negm=f32x16{};asm volatile("":"+v"(negm));
  const int qrel=wid*QBLK+r32;
  #define KBIAS(N0,N1,t) do{ const __attribute__((address_space(3))) float*cb_=CKL+64*(t)+4*hi; \
    _Pragma("unroll") for(int q_=0;q_<4;++q_){ const f32x4 a_=*(const __attribute__((address_space(3))) f32x4*)(cb_+8*q_), b_=*(const __attribute__((address_space(3))) f32x4*)(cb_+32+8*q_); \
      _Pragma("unroll") for(int e_=0;e_<4;++e_){ N0[4*q_+e_]=negm[4*q_+e_]-a_[e_]; N1[4*q_+e_]=negm[4*q_+e_]-b_[e_]; } } }while(0)
  #define KBLOAD(N0,N1,t) do{ const __attribute__((address_space(3))) float*cb_=CKL+64*(t)+4*hi; \
    _Pragma("unroll") for(int q_=0;q_<4;++q_){ const f32x4 a_=*(const __attribute__((address_space(3))) f32x4*)(cb_+8*q_), b_=*(const __attribute__((address_space(3))) f32x4*)(cb_+32+8*q_); \
      _Pragma("unroll") for(int e_=0;e_<4;++e_){ N0[4*q_+e_]=a_[e_]; N1[4*q_+e_]=b_[e_]; } } }while(0)
  #define KBSUB(N0,N1) do{ _Pragma("unroll") for(int r_=0;r_<16;++r_){ N0[r_]=negm[r_]-N0[r_]; N1[r_]=negm[r_]-N1[r_]; } }while(0)
  #define CMASK(P0,P1,t) do{int jb_=(t)-(NT-4); if(jb_>=0)cmask(P0,P1,jb_,qrel,hi);}while(0)
  bool resc=false;
  #define START(P0,P1) do{ const float rm=rowmax(P0,P1); resc=false; \
    { const float dl=rm; mhat=fadd_s(mhat,dl); \
      _Pragma("unroll") for(int r=0;r<16;++r){P0[r]=fsub_s(P0[r],dl);P1[r]=fsub_s(P1[r],dl);} \
      _Pragma("unroll") for(int r=0;r<16;++r)negm[r]=-mhat; asm volatile("":"+v"(negm)); } \
    _Pragma("unroll") for(int r=0;r<16;++r)P0[r]=__builtin_amdgcn_exp2f(P0[r]); }while(0)
  #define RESC() do{ if(resc){ asm volatile("s_waitcnt lgkmcnt(0)":::"memory"); \
      _Pragma("unroll") for(int d_=0;d_<2;++d_) _Pragma("unroll") for(int r=0;r<16;++r)o[d_][r]*=wsf[crow(r,hi)]; } }while(0)
  f32x16 pA0,pA1,pB0,pB1;
  int sl_prev=0,sl_cur=0,sl_next=SLOTB;
  #define ROT() do{sl_prev=sl_cur;sl_cur=sl_next;sl_next=(sl_next==(NSLOT-1)*SLOTB)?0:sl_next+SLOTB;}while(0)
  DMA_K(2,2*SLOTB);
  WAIT_BAR(3);
  { f32x16 n0_,n1_; KBIAS(n0_,n1_,0); qkt(pA0,pA1,Kbase,qr,n0_,n1_,r32,hi); } asm volatile("s_nop 15\n\ts_nop 7":"+v"(pA0),"+v"(pA1));CMASK(pA0,pA1,0);
  START(pA0,pA1);
  _Pragma("unroll") for(int r=0;r<16;++r)pA1[r]=__builtin_amdgcn_exp2f(pA1[r]);
  WAIT_BAR(0);
  DMA_K(3,0);DMA_V(1,SLOTB);
  ROT();
  kload8(kf,kp0+sl_cur);
  WAIT_BAR(2);
  s16x4 vlo[8],vhi[8]; u32x4 pw0,pw1,pw2,pw3;
  #define PKW(P,B) cvtpk_s(P[B],P[B+1])
  #define PAF(k) __builtin_bit_cast(bf16x8,pw##k)
  #define VFR(i) (bf16x8){vlo[i][0],vlo[i][1],vlo[i][2],vlo[i][3],vhi[i][0],vhi[i][1],vhi[i][2],vhi[i][3]}
  #define PIN(x) asm volatile("":"+v"(x))
  #define MX3(a,b,c) __builtin_fmaxf(__builtin_fmaxf((a),(b)),(c))
  #define GAPA(MF,A0,A1,A2,A3,W0,W1,PW) do{ MF; sacc+=A0; sacc+=A1; sacc+=A2; sacc+=A3; PIN(sacc); W0; W1; PIN(PW); SBAR(); }while(0)
  #define EX(v) __builtin_amdgcn_exp2f(v)
  #define GAPB(MF,X,B) do{ MF; X[B]=EX(X[B]); X[B+1]=EX(X[B+1]); X[B+2]=EX(X[B+2]); X[B+3]=EX(X[B+3]); PIN(X); SBAR(); }while(0)
  #define VRD(i) do{ vlo[i]=vtr(vp_+(((i)>>2)*4096+((i)&3)*1024)); vhi[i]=vtr(vp_+(((i)>>2)*4096+((i)&3)*1024+512)); }while(0)
  #define KRD(G,j) do{ if(G){ kload2(kf,kp0+sl_next,j); SBAR(); } }while(0)
  #define STEP(C0,C1,P0,P1,t,GK,GV,GL) do{ SBAR(); \
    if(NOBIAS){C0=negm;C1=negm;} SBAR(); \
    const lds_cptr vp_=vp0+sl_prev; \
    VRD(0); SBAR(); float sacc=(P0[0]+P0[1]); \
    GAPA(C0=__builtin_amdgcn_mfma_f32_32x32x16_bf16(kf[0],qr[0],C0,0,0,0), P0[2],P0[3],P0[4],P0[5],     pw0[0]=PKW(P0,0), pw0[1]=PKW(P0,2), pw0); \
    VRD(4); SBAR(); GAPA(C1=__builtin_amdgcn_mfma_f32_32x32x16_bf16(kf[1],qr[0],C1,0,0,0), P0[6],P0[7],P0[8],P0[9],     pw0[2]=PKW(P0,4), pw0[3]=PKW(P0,6), pw0); \
    VRD(1); SBAR(); GAPA(C0=__builtin_amdgcn_mfma_f32_32x32x16_bf16(kf[2],qr[1],C0,0,0,0),   P0[10],P0[11],P0[12],P0[13], pw1[0]=PKW(P0,8), pw1[1]=PKW(P0,10), pw1); \
    VRD(5); SBAR(); GAPA(C1=__builtin_amdgcn_mfma_f32_32x32x16_bf16(kf[3],qr[1],C1,0,0,0),   P0[14],P0[15],P1[0],P1[1],   pw1[2]=PKW(P0,12),pw1[3]=PKW(P0,14), pw1); \
    VRD(2); SBAR(); GAPA(C0=__builtin_amdgcn_mfma_f32_32x32x16_bf16(kf[4],qr[2],C0,0,0,0),   P1[2],P1[3],P1[4],P1[5],     pw2[0]=PKW(P1,0), pw2[1]=PKW(P1,2), pw2); \
    VRD(6); SBAR(); GAPA(C1=__builtin_amdgcn_mfma_f32_32x32x16_bf16(kf[5],qr[2],C1,0,0,0),   P1[6],P1[7],P1[8],P1[9],     pw2[2]=PKW(P1,4), pw2[3]=PKW(P1,6), pw2); \
    VRD(3); SBAR(); GAPA(C0=__builtin_amdgcn_mfma_f32_32x32x16_bf16(kf[6],qr[3],C0,0,0,0),   P1[10],P1[11],P1[12],P1[13], pw3[0]=PKW(P1,8), pw3[1]=PKW(P1,10), pw3); \
    VRD(7); SBAR(); GAPA(C1=__builtin_amdgcn_mfma_f32_32x32x16_bf16(kf[7],qr[3],C1,0,0,0),   P1[14],P1[15],0.f,0.f,       pw3[2]=PKW(P1,12),pw3[3]=PKW(P1,14), pw3); \
    l_reg+=sacc; \
    if(!NOBIAS){ if(GL){KBLOAD(P0,P1,(t)+1);} } \
    if(GK){DMA_K((t)+3,sl_cur);} if(GV){DMA_V((t)+1,sl_next);} \
    CMASK(C0,C1,t); \
    { float a=MX3(C0[0],C0[1],C1[0]),b=MX3(C0[2],C0[3],C1[1]); a=MX3(a,C1[2],C1[3]); \
      _Pragma("unroll") for(int r=4;r<16;r+=4){a=MX3(a,C0[r],C0[r+1]);b=MX3(b,C0[r+2],C0[r+3]);a=MX3(a,C1[r],C1[r+1]);b=MX3(b,C1[r+2],C1[r+3]);} \
      float rm=__builtin_fmaxf(a,b); { auto rr=__builtin_amdgcn_permlane32_swap(__float_as_uint(rm),__float_as_uint(rm),false,false); rm=__builtin_fmaxf(__uint_as_float(rr[0]),__uint_as_float(rr[1])); } \
      resc=false; \
      if(__builtin_expect(__any(rm>(float)THRL),0)){ const float dl=__builtin_fmaxf(rm,0.f); mhat+=dl; \
        _Pragma("unroll") for(int r=0;r<16;++r){C0[r]-=dl;C1[r]-=dl;} \
        _Pragma("unroll") for(int r=0;r<16;++r)negm[r]=-mhat; asm volatile("":"+v"(negm)); \
        const float f=__builtin_amdgcn_exp2f(-dl); l_reg*=f; if(hi==0)wsf[r32]=f; resc=true; } } \
    if(!NOBIAS){ if(GL){KBSUB(P0,P1);} } \
    SBAR(); \
    GAPB(o[0]=__builtin_amdgcn_mfma_f32_32x32x16_bf16(PAF(0),VFR(0),o[0],0,0,0), C0,0); \
    GAPB(o[1]=__builtin_amdgcn_mfma_f32_32x32x16_bf16(PAF(0),VFR(4),o[1],0,0,0), C0,4); \
    KRD(GL,0); GAPB(o[0]=__builtin_amdgcn_mfma_f32_32x32x16_bf16(PAF(1),VFR(1),o[0],0,0,0), C0,8); \
    KRD(GL,1); GAPB(o[1]=__builtin_amdgcn_mfma_f32_32x32x16_bf16(PAF(1),VFR(5),o[1],0,0,0), C0,12); \
    KRD(GL,2); GAPB(o[0]=__builtin_amdgcn_mfma_f32_32x32x16_bf16(PAF(2),VFR(2),o[0],0,0,0), C1,0); \
    KRD(GL,3); GAPB(o[1]=__builtin_amdgcn_mfma_f32_32x32x16_bf16(PAF(2),VFR(6),o[1],0,0,0), C1,4); \
    GAPB(o[0]=__builtin_amdgcn_mfma_f32_32x32x16_bf16(PAF(3),VFR(3),o[0],0,0,0), C1,8); \
    GAPB(o[1]=__builtin_amdgcn_mfma_f32_32x32x16_bf16(PAF(3),VFR(7),o[1],0,0,0), C1,12); \
    }while(0)
  if(!NOBIAS){ KBIAS(pB0,pB1,1); }
  int t=1;
  #undef CMASK
  #define CMASK(P0,P1,t) do{}while(0)
  for(;t+5<NT;t+=2){
    STEP(pB0,pB1,pA0,pA1,t,true,true,true);     WAIT_BAR(2); RESC(); ROT();
    STEP(pA0,pA1,pB0,pB1,t+1,true,true,true);   WAIT_BAR(2); RESC(); ROT();
  }
  #undef CMASK
  #define CMASK(P0,P1,t) do{int jb_=(t)-(NT-4); if(jb_>=0)cmask(P0,P1,jb_,qrel,hi);}while(0)
  #define ENDW(tt) do{ if((tt)+3<NT){WAIT_BAR(2);} else if((tt)+2<NT){WAIT_BAR(1);} else {WAIT_BAR(0);} }while(0)
  for(;t+1<NT;t+=2){
    STEP(pB0,pB1,pA0,pA1,t,(t+3<NT),(t+1<NT),(t+1<NT));       ENDW(t);   RESC(); ROT();
    STEP(pA0,pA1,pB0,pB1,t+1,(t+4<NT),(t+2<NT),(t+2<NT));     ENDW(t+1); RESC(); ROT();
  }
  STEP(pB0,pB1,pA0,pA1,NT-1,false,false,false); RESC();
  { float sacc=pB0[0]+pB0[1]; _Pragma("unroll") for(int r=2;r<16;++r)sacc+=pB0[r]; _Pragma("unroll") for(int r=0;r<16;++r)sacc+=pB1[r]; l_reg+=sacc;
    pw0=(u32x4){PKW(pB0,0),PKW(pB0,2),PKW(pB0,4),PKW(pB0,6)};pw1=(u32x4){PKW(pB0,8),PKW(pB0,10),PKW(pB0,12),PKW(pB0,14)};pw2=(u32x4){PKW(pB1,0),PKW(pB1,2),PKW(pB1,4),PKW(pB1,6)};pw3=(u32x4){PKW(pB1,8),PKW(pB1,10),PKW(pB1,12),PKW(pB1,14)};
    SBAR(); pv(o,vb0+sl_cur,PAF(0),PAF(1),PAF(2),PAF(3)); }
  #undef PKW
  #undef PAF
  #undef VFR
  #undef PIN
  #undef MX3
  #undef GAPA
  #undef GAPB
  #undef EX
  #undef VRD
  #undef KRD
  #undef STEP
  #undef ENDW
  {auto rr=__builtin_amdgcn_permlane32_swap(__float_as_uint(l_reg),__float_as_uint(l_reg),false,false);l_reg=__uint_as_float(rr[0])+__uint_as_float(rr[1]);}
  if(hi==0)wsf[32+r32]=l_reg;asm volatile("s_waitcnt lgkmcnt(0)":::"memory");
  float rli[16];
  #pragma unroll
  for(int r=0;r<16;++r)rli[r]=__builtin_amdgcn_rcpf(wsf[32+crow(r,hi)]);
  bf16*Ow=O+(rowbase+q0+wid*QBLK)*DM;
  { bf16*stg=(bf16*)(shm+LDS_OST)+wid*2048;
    #pragma unroll
    for(int r=0;r<16;++r){const int orow=crow(r,hi);
      #pragma unroll
      for(int d0=0;d0<2;++d0)stg[orow*64+d0*32+r32]=(bf16)f2bf(o[d0][r]*rli[r]);}
    asm volatile("s_waitcnt lgkmcnt(0)":::"memory");
    #pragma unroll
    for(int i=0;i<4;++i){const int row=i*8+(lane>>3),ch=lane&7; const u32x4 v=*(const u32x4*)(stg+row*64+ch*8); ATTN_STORE16(Ow+(long)row*DM+ch*8,v);} }
  asm volatile("s_waitcnt lgkmcnt(0)\n\ts_barrier":::"memory");
  #undef KBIAS
  #undef KBLOAD
  #undef KBSUB
  #undef DMA_K
  #undef DMA_V
  #undef CMASK
  #undef START
  #undef RESC
  #undef ROT
}
constexpr int ATTN_LDS_BYTES=LDS_BYTES;
#undef SBAR
#undef WAIT_BAR
}

__device__ __forceinline__ void fox_ck_task(KArgP A, int l, LAS unsigned char* lds, int b, int h) {
    const bf16* PJ = (const bf16*)(A->ws + WS_PROJ);
    float* CKG = (float*)((unsigned char*)A->out + DO_CKG) + (size_t)(b * 8 + h) * SEQ;
    const int tid = otid(), lane = tid & 63, wid = tid >> 6;
    LAS float* WT = (LAS float*)lds;
    const float fb = A->fox_f_bias[l * 8 + h];
    float v[4]; float run = 0.f;
#pragma unroll
    for (int i = 0; i < 4; ++i) v[i] = bf2f(PJ[(size_t)(b * SEQ + tid * 4 + i) * LP + C_SM + 8 + h]);
#pragma unroll
    for (int i = 0; i < 4; ++i) { run += LOG2E * logsigmoidf_(v[i] + fb); v[i] = run; }
    float inc = run;
#pragma unroll
    for (int o = 1; o < 64; o <<= 1) { const float y = __builtin_bit_cast(float, __builtin_amdgcn_ds_bpermute(((lane - o) & 63) << 2, __builtin_bit_cast(int, inc))); if (lane >= o) inc += y; }
    __syncthreads();
    if (lane == 63) WT[wid] = inc;
    __syncthreads();
    float base = inc - run;
    for (int w = 0; w < wid; ++w) base += WT[w];
    *(f32x4*)(CKG + tid * 4) = (f32x4){base + v[0], base + v[1], base + v[2], base + v[3]};
}
__device__ __forceinline__ void fox_unit(KArgP A, int l, LAS unsigned char* lds, int b, int h, int qb, int ocol = -1) {
    bf16* PJ = (bf16*)(A->ws + WS_PROJ);
    const float* CKG = (const float*)((unsigned char*)A->out + DO_CKG) + (size_t)(b * 8 + h) * SEQ;
    const int tid = otid();
    LAS float* CK = (LAS float*)(lds + fox_body::LDS_BYTES);
    TMARK(70);
    const f32x4 ck4 = (tid * 4 < 256 * (qb + 1)) ? *(const f32x4*)(CKG + tid * 4) : (f32x4){0.f, 0.f, 0.f, 0.f};
    __syncthreads();
    *(LAS f32x4*)(CK + tid * 4) = ck4;
    __syncthreads();
    TMARK(71);
    if (PROBE_MIX == 5 && ocol >= 0) fox_body::attn_unit<8, true>(b, h, qb, PJ + C_OB + h * 64, PJ + C_FK + h * 64, PJ + C_FV + h * 64, PJ + ocol, (char*)lds, CK);
    else fox_body::attn_unit<8>(b, h, qb, PJ + C_OB + h * 64, PJ + C_FK + h * 64, PJ + C_FV + h * 64, PJ + (ocol < 0 ? C_OB + h * 64 : ocol), (char*)lds, CK);
    TMARK(72);
}

struct GdnPre { u32x4 xr[10]; f32x4 w0[4], w1[4]; unsigned ab; };
__device__ __forceinline__ void gdn_prep_issue(GdnPre& P, KArgP A, int l, int b, int h, int n) {
    const bf16* PJ = (const bf16*)(A->ws + WS_PROJ); const bf16* HALO = (const bf16*)((unsigned char*)A->out + DO_HALO);
    const float* cw = A->gdn_conv_w + (size_t)l * 4 * 1536;
    const int tid = otid(); const size_t row0 = (size_t)b * SEQ + n * 64;
    if (tid < 480) { const int pc = tid % 48, grp = tid / 48, part = pc >> 4, c8 = pc & 15, c = part * 512 + h * 128 + c8 * 8;
#pragma unroll
        for (int i = 0; i < 10; ++i) { const int tr = 7 * grp - 3 + i; P.xr[i] = (u32x4){0u, 0u, 0u, 0u};
            if (tr >= 0) { if (tr < 64) P.xr[i] = *(const u32x4*)(PJ + (row0 + tr) * LP + C_GQ + c); }
            else if (n > 0) P.xr[i] = *(const u32x4*)(HALO + ((size_t)(b * 32 + n - 1) * 3 + (3 + tr)) * 1536 + c); }
#pragma unroll
        for (int i = 0; i < 4; ++i) { P.w0[i] = *(const f32x4*)(cw + i * 1536 + c); P.w1[i] = *(const f32x4*)(cw + i * 1536 + c + 4); } }
    if (tid < 64) { const size_t r = (row0 + tid) * LP + C_SM; P.ab = (unsigned)PJ[r + 4 + h] | ((unsigned)PJ[r + h] << 16); }
}
__device__ __forceinline__ void gdn_prep_task(KArgP A, int l, LAS unsigned char* lds, int b, int h, int n, GdnPre& P, bool has_next, int nb_, int nh_, int nn_, GdnPre& N, bool dummy = false) {
    bf16* PJ = (bf16*)(A->ws + WS_PROJ);
    unsigned char* dsc = (unsigned char*)A->out; const bf16* HALO = (const bf16*)(dsc + DO_HALO);
    unsigned char* rec = dsc + DO_GP + (size_t)(dummy ? 2048 : ((b * 4 + h) * 32 + n)) * GP_STRIDE;
    const int tid = otid(), lane = tid & 63, wid = tid >> 6, l15 = lane & 15, g = lane >> 4;
    constexpr int S136 = 272, S72 = 144, S40 = 80;
    const int oq = dummy ? 5152 : C_GQ + h * 128, ov = dummy ? 5152 : C_GV + h * 128;
    LAS float* qf = (LAS float*)lds; LAS float* kf = qf + 64 * 128; LAS float* vf = kf + 64 * 128;
    LAS unsigned char* KB16 = lds + 98304; LAS unsigned char* QB16 = lds + 115712;
    LAS float* GC = (LAS float*)(lds + 146432); LAS float* BETA = GC + 64; LAS float* EG = BETA + 64;
    LAS unsigned char* AOFF = lds;
    LAS unsigned char* ATTS = lds + 9216;
    LAS float* AKK = (LAS float*)(lds + 18432);
    LAS unsigned char* TD = lds + 23552;
    LAS unsigned char* XT = lds + 98304;
    LAS unsigned char* TT = lds + 65536;
    const float* cw = A->gdn_conv_w + (size_t)l * 4 * 1536;
    const float alog = A->gdn_a_log[l * 4 + h], dtb = A->gdn_dt_bias[l * 4 + h];
    const int t0 = n * 64; const size_t row0 = (size_t)b * SEQ + t0;
    __syncthreads();
    TMARK(30);
    if (tid < 480) {
        const int pc = tid % 48, grp = tid / 48, part = pc >> 4, c8 = pc & 15;
        LAS float* dbase = (part == 0 ? qf : part == 1 ? kf : vf) + c8 * 8;
#pragma unroll
        for (int j = 0; j < 7; ++j) { const int tt = 7 * grp + j;
            if (tt < 64) { float y[8];
#pragma unroll
                for (int e2 = 0; e2 < 8; ++e2) y[e2] = 0.f;
#pragma unroll
                for (int i = 0; i < 4; ++i) { const u32x4 xv = P.xr[j + i];
                    y[0] += P.w0[i][0] * bflo(xv.x); y[1] += P.w0[i][1] * bfhi(xv.x); y[2] += P.w0[i][2] * bflo(xv.y); y[3] += P.w0[i][3] * bfhi(xv.y);
                    y[4] += P.w1[i][0] * bflo(xv.z); y[5] += P.w1[i][1] * bfhi(xv.z); y[6] += P.w1[i][2] * bflo(xv.w); y[7] += P.w1[i][3] * bfhi(xv.w); }
                LAS float* dst = dbase + tt * 128;
                *(LAS f32x4*)dst = (f32x4){siluf_(y[0]), siluf_(y[1]), siluf_(y[2]), siluf_(y[3])}; *(LAS f32x4*)(dst + 4) = (f32x4){siluf_(y[4]), siluf_(y[5]), siluf_(y[6]), siluf_(y[7])}; } }
    }
    if (tid < 64) { const float a = bflo(P.ab), bb = bfhi(P.ab);
        float gg = -__expf(alog) * softplusf_(a + dtb);
#pragma unroll
        for (int o = 1; o < 64; o <<= 1) { const float y2 = __builtin_bit_cast(float, __builtin_amdgcn_ds_bpermute(((lane - o) & 63) << 2, __builtin_bit_cast(int, gg))); if (lane >= o) gg += y2; }
        GC[tid] = gg; EG[tid] = __expf(gg); BETA[tid] = sigmoidf_(bb); }
    if (has_next) gdn_prep_issue(N, A, l, nb_, nh_, nn_);
    __syncthreads();
    TMARK(31);
    {
        float va[16], vc[16], ss[16];
#pragma unroll
        for (int i = 0; i < 16; ++i) { const int rr = wid + 8 * i; const LAS float* p = (rr < 64 ? qf + rr * 128 : kf + (rr - 64) * 128); va[i] = p[lane * 2]; vc[i] = p[lane * 2 + 1]; ss[i] = va[i] * va[i] + vc[i] * vc[i]; }
#pragma unroll
        for (int i = 0; i < 16; ++i) ss[i] += swz_xor<1>(ss[i]);
#pragma unroll
        for (int i = 0; i < 16; ++i) ss[i] += swz_xor<2>(ss[i]);
#pragma unroll
        for (int i = 0; i < 16; ++i) ss[i] += swz_xor<4>(ss[i]);
#pragma unroll
        for (int i = 0; i < 16; ++i) ss[i] += swz_xor<8>(ss[i]);
#pragma unroll
        for (int i = 0; i < 16; ++i) ss[i] += swz_xor<16>(ss[i]);
#pragma unroll
        for (int i = 0; i < 16; ++i) ss[i] = half_sum(ss[i]);
#pragma unroll
        for (int i = 0; i < 16; ++i) { const int rr = wid + 8 * i; const bool isq = rr < 64; const int row = isq ? rr : rr - 64;
            const float sc = rsqrtf(ss[i] + 1e-6f); const float an = va[i] * sc, cn = vc[i] * sc;
            if (isq) { *(LAS unsigned*)(QB16 + row * S136 + lane * 4) = pk2(an, cn); const float f = 0.08838834764831845f * EG[row];
                *(unsigned*)(PJ + (row0 + row) * LP + oq + lane * 2) = pk2(an * f, cn * f); }
            else { LAS float* p = kf + row * 128; p[lane * 2] = an; p[lane * 2 + 1] = cn; *(LAS unsigned*)(KB16 + row * S136 + lane * 4) = pk2(an, cn); } }
    }
    __syncthreads();
    TMARK(32);
    {
        const int mb = wid >> 1;
        bf16x8 ak[4], aq[4];
#pragma unroll
        for (int ks = 0; ks < 4; ++ks) { ak[ks] = frag_rm(KB16, S136, mb, ks, l15, g); aq[ks] = frag_rm(QB16, S136, mb, ks, l15, g); }
#pragma unroll
        for (int j = 0; j < 2; ++j) { const int nb = 2 * (wid & 1) + j; f32x4 kk = (f32x4){0.f, 0.f, 0.f, 0.f}, qk = (f32x4){0.f, 0.f, 0.f, 0.f};
#pragma unroll
            for (int ks = 0; ks < 4; ++ks) { const bf16x8 bfr = frag_rm(KB16, S136, nb, ks, l15, g); kk = MFMA16(ak[ks], bfr, kk); qk = MFMA16(aq[ks], bfr, qk); }
            const int jj = nb * 16 + l15; const float gj = GC[jj];
#pragma unroll
            for (int r = 0; r < 4; ++r) { const int i = mb * 16 + 4 * g + r; const float dec = jj <= i ? __expf(GC[i] - gj) : 0.f;
                const float av = jj < i ? BETA[i] * kk[r] * dec : 0.f;
                *(LAS bf16*)(AOFF + i * S72 + jj * 2) = (bf16)f2bf(nb < mb ? av : 0.f);
                if (nb == mb) AKK[(mb * 16 + 4 * g + r) * 20 + l15] = av;
                *(LAS bf16*)(ATTS + i * S72 + jj * 2) = (bf16)f2bf(qk[r] * dec * 0.08838834764831845f); } }
        for (int i = tid; i < 64 * S40 / 16; i += 512) *(LAS u32x4*)(TD + i * 16) = (u32x4){0u, 0u, 0u, 0u};
    }
    __syncthreads();
    TMARK(33);
    if (tid < 64) { const int k = tid >> 4, c = tid & 15; const LAS float* ab = AKK + k * 16 * 20; float y[16];
#pragma unroll
        for (int i = 0; i < 16; ++i) { float s = (i == c) ? 1.f : 0.f;
#pragma unroll
            for (int m = 0; m < i; ++m) s -= ab[i * 20 + m] * y[m];
            y[i] = s; *(LAS bf16*)(TD + (k * 16 + i) * S40 + c * 2) = (bf16)f2bf(s); } }
    for (int it = tid; it < 8 * 256; it += 512) { const int col = it & 255, i0 = (it >> 8) * 8;
        const LAS float* sp = col < 128 ? vf + col : kf + (col - 128); float r[8];
#pragma unroll
        for (int e = 0; e < 8; ++e) { const int i = i0 + e; r[e] = BETA[i] * sp[i * 128]; if (col >= 128) r[e] *= EG[i]; }
        *(LAS u32x4*)(XT + col * S72 + i0 * 2) = (u32x4){pk2(r[0], r[1]), pk2(r[2], r[3]), pk2(r[4], r[5]), pk2(r[6], r[7])}; }
    __syncthreads();
    TMARK(34);
    {
        for (int i = lane; i < 32 * S40 / 16; i += 64) *(LAS u32x4*)(TT + wid * 32 * S40 + i * 16) = (u32x4){0u, 0u, 0u, 0u};
#pragma unroll
        for (int k = 0; k < 4; ++k) {
#pragma unroll
            for (int jn = 0; jn < 2; ++jn) { const int nb = 2 * wid + jn, col = nb * 16 + l15;
                f32x4 acc = (f32x4){0.f, 0.f, 0.f, 0.f};
                if (k > 0) { acc = MFMA16(frag_rm(AOFF, S72, k, 0, l15, g), frag_rm(XT, S72, nb, 0, l15, g), acc);
                    if (k == 3) acc = MFMA16(frag_rm(AOFF, S72, k, 1, l15, g), frag_rm(XT, S72, nb, 1, l15, g), acc); }
                const u32x2 rv = *(const LAS u32x2*)(XT + col * S72 + (16 * k + 4 * g) * 2);
                *(LAS u32x2*)(TT + col * S40 + (4 * g) * 2) = (u32x2){pk2(bflo(rv.x) - acc[0], bfhi(rv.x) - acc[1]), pk2(bflo(rv.y) - acc[2], bfhi(rv.y) - acc[3])};
                f32x4 x = MFMA16(frag_rm(TD, S40, k, 0, l15, g), frag_rm(TT, S40, nb, 0, l15, g), ((f32x4){0.f, 0.f, 0.f, 0.f}));
                *(LAS u32x2*)(XT + col * S72 + (16 * k + 4 * g) * 2) = (u32x2){pk2(x[0], x[1]), pk2(x[2], x[3])};
            }
        }
    }
    __syncthreads();
    {
        const int q4 = l15 >> 2, p4 = lane & 3;
#pragma unroll
        for (int j = 0; j < 4; ++j) { const int op = wid * 4 + j, which = op >> 4, ks = (op >> 2) & 3, nb = op & 3;
            const bf16x8 f = frag_tr(XT + which * 128 * S72, S72, ks, nb, g, q4, p4); const int row = 16 * nb + l15, cc = 32 * ks + 8 * g;
            if (which == 0) *(bf16x8*)(PJ + (row0 + row) * LP + ov + cc) = f; else *(bf16x8*)((bf16*)(rec + GP_W) + row * 128 + cc) = f; }
    }
    TMARK(35);
    {
        { const int row = tid >> 3, c8 = tid & 7; *(u32x4*)(rec + GP_ATT + row * 128 + c8 * 16) = *(const LAS u32x4*)(ATTS + row * S72 + c8 * 16); }
        { const int dk = tid & 127, qt = tid >> 7; const float gl = GC[63]; unsigned w[8];
#pragma unroll
          for (int i = 0; i < 8; ++i) { const int c0 = qt * 16 + 2 * i; w[i] = pk2(kf[c0 * 128 + dk] * __expf(gl - GC[c0]), kf[(c0 + 1) * 128 + dk] * __expf(gl - GC[c0 + 1])); }
          u32x4* kp = (u32x4*)(rec + GP_KDT + dk * 128 + qt * 32);
          kp[0] = (u32x4){w[0], w[1], w[2], w[3]}; kp[1] = (u32x4){w[4], w[5], w[6], w[7]}; }
        if (tid == 0) *(float*)(rec + GP_CD) = EG[63];
    }
    TMARK(36);
}

__device__ __forceinline__ void gdn_scan_chain(KArgP A, int l, LAS unsigned char* lds, int b, int h, int ocol = -1) {
    bf16* PJ = (bf16*)(A->ws + WS_PROJ);
    unsigned char* dsc = (unsigned char*)A->out;
    const int tid = otid(), lane = tid & 63, wid = tid >> 6, l15 = lane & 15, g = lane >> 4;
    constexpr int S136 = 272, S72 = 144;
    LAS unsigned char* Wl = lds; LAS unsigned char* QDl = lds + 17408; LAS unsigned char* Ul = lds + 34816; LAS unsigned char* KDTl = lds + 52224; LAS unsigned char* ATTl = lds + 70656;
    LAS unsigned char* STl = lds + 79872; LAS unsigned char* VNl = lds + 114688; LAS float* SSQ = (LAS float*)(lds + 133120);
    LAS unsigned char* OST = Wl;
    const float* nw = A->gdn_norm_w + l * 128;
    const int mb = wid >> 1, nb0 = 4 * (wid & 1);
    f32x4 S[8];
#pragma unroll
    for (int j = 0; j < 8; ++j) S[j] = (f32x4){0.f, 0.f, 0.f, 0.f};
    __syncthreads();
    for (int i = tid; i < 128 * S136 / 16; i += 512) *(LAS u32x4*)(STl + i * 16) = (u32x4){0u, 0u, 0u, 0u};
    u32x4 pw[2], pq[2], pu[2], pk[2], pa, pz[2], zc[2]; float cd = 0.f, cdn = 0.f;
#define GDN_ISSUE(nn) do { const unsigned char* rec_ = dsc + DO_GP + (size_t)((b * 4 + h) * 32 + (nn)) * GP_STRIDE; const size_t r0_ = (size_t)b * SEQ + (nn) * 64; \
        _Pragma("unroll") for (int q_ = 0; q_ < 2; ++q_) { const int c_ = tid + 512 * q_, row_ = c_ >> 4, c16_ = c_ & 15; \
            pw[q_] = *(const u32x4*)(rec_ + GP_W + row_ * 256 + c16_ * 16); \
            pq[q_] = *(const u32x4*)(PJ + (r0_ + row_) * LP + C_GQ + h * 128 + c16_ * 8); pu[q_] = *(const u32x4*)(PJ + (r0_ + row_) * LP + C_GV + h * 128 + c16_ * 8); \
            pk[q_] = *(const u32x4*)(rec_ + GP_KDT + (c_ >> 3) * 128 + (c_ & 7) * 16); pz[q_] = *(const u32x4*)(PJ + (r0_ + row_) * LP + C_OA + h * 128 + c16_ * 8); } \
        pa = *(const u32x4*)(rec_ + GP_ATT + (tid >> 3) * 128 + (tid & 7) * 16); cdn = *(const float*)(rec_ + GP_CD); } while (0)
    GDN_ISSUE(0);
    for (int n = 0; n < SEQ / 64; ++n) {
        const size_t row0 = (size_t)b * SEQ + n * 64;
        TMARK(80);
        __syncthreads();
#pragma unroll
        for (int q = 0; q < 2; ++q) { const int c = tid + 512 * q, row = c >> 4, c16 = c & 15;
            *(LAS u32x4*)(Wl + row * S136 + c16 * 16) = pw[q]; *(LAS u32x4*)(QDl + row * S136 + c16 * 16) = pq[q]; *(LAS u32x4*)(Ul + row * S136 + c16 * 16) = pu[q];
            *(LAS u32x4*)(KDTl + (c >> 3) * S72 + (c & 7) * 16) = pk[q]; }
        *(LAS u32x4*)(ATTl + (tid >> 3) * S72 + (tid & 7) * 16) = pa; cd = cdn; zc[0] = pz[0]; zc[1] = pz[1];
        __syncthreads();
        if (n + 1 < SEQ / 64) GDN_ISSUE(n + 1);
        TMARK(81);
        f32x4 accO[4];
        {
            bf16x8 aw[4], aq[4];
#pragma unroll
            for (int ks = 0; ks < 4; ++ks) { aw[ks] = frag_rm(Wl, S136, mb, ks, l15, g); aq[ks] = frag_rm(QDl, S136, mb, ks, l15, g); }
#pragma unroll
            for (int j = 0; j < 4; ++j) { const int nb = nb0 + j; f32x4 ws = (f32x4){0.f, 0.f, 0.f, 0.f}; accO[j] = (f32x4){0.f, 0.f, 0.f, 0.f};
#pragma unroll
                for (int ks = 0; ks < 4; ++ks) { const bf16x8 sf = frag_rm(STl, S136, nb, ks, l15, g); ws = MFMA16(aw[ks], sf, ws); accO[j] = MFMA16(aq[ks], sf, accO[j]); }
                float vn[4];
#pragma unroll
                for (int r = 0; r < 4; ++r) vn[r] = bf2f(*(const LAS bf16*)(Ul + (mb * 16 + 4 * g + r) * S136 + (nb * 16 + l15) * 2)) - ws[r];
                *(LAS u32x2*)(VNl + (nb * 16 + l15) * S72 + (mb * 16 + 4 * g) * 2) = (u32x2){pk2(vn[0], vn[1]), pk2(vn[2], vn[3])}; }
        }
        __syncthreads();
        TMARK(82);
        {
            bf16x8 aa[2], ak[2];
#pragma unroll
            for (int ks = 0; ks < 2; ++ks) { aa[ks] = frag_rm(ATTl, S72, mb, ks, l15, g); ak[ks] = frag_rm(KDTl, S72, wid, ks, l15, g); }
#pragma unroll
            for (int j = 0; j < 4; ++j)
#pragma unroll
                for (int ks = 0; ks < 2; ++ks) accO[j] = MFMA16(aa[ks], frag_rm(VNl, S72, nb0 + j, ks, l15, g), accO[j]);
#pragma unroll
            for (int jb = 0; jb < 8; ++jb) { S[jb] = S[jb] * cd;
#pragma unroll
                for (int ks = 0; ks < 2; ++ks) S[jb] = MFMA16(ak[ks], frag_rm(VNl, S72, jb, ks, l15, g), S[jb]);
                *(LAS u32x2*)(STl + (jb * 16 + l15) * S136 + (wid * 16 + 4 * g) * 2) = (u32x2){pk2(S[jb][0], S[jb][1]), pk2(S[jb][2], S[jb][3])}; }
        }
        TMARK(83);
        {
            float ss[4];
#pragma unroll
            for (int r = 0; r < 4; ++r) { float s = 0.f;
#pragma unroll
                for (int j = 0; j < 4; ++j) s += accO[j][r] * accO[j][r];
                s += swz_xor<1>(s); s += swz_xor<2>(s); s += swz_xor<4>(s); s += swz_xor<8>(s); ss[r] = s; }
            if (l15 == 0) {
#pragma unroll
                for (int r = 0; r < 4; ++r) SSQ[(mb * 16 + 4 * g + r) * 2 + (wid & 1)] = ss[r]; }
            __syncthreads();
#pragma unroll
            for (int r = 0; r < 4; ++r) { const int i = mb * 16 + 4 * g + r; const float sc = rsqrtf((SSQ[i * 2] + SSQ[i * 2 + 1]) * (1.f / 128.f) + 1e-6f);
#pragma unroll
                for (int j = 0; j < 4; ++j) { const int dv = (nb0 + j) * 16 + l15; *(LAS bf16*)(OST + i * S136 + dv * 2) = (bf16)f2bf(accO[j][r] * sc * nw[dv]); } }
            __syncthreads();
#pragma unroll
            for (int q = 0; q < 2; ++q) { const int it = tid + 512 * q, tt = it >> 4, c8 = it & 15;
                bf16* gp = PJ + (row0 + tt) * LP + C_OA + h * 128 + c8 * 8; const u32x4 rv = zc[q]; if (ocol >= 0) gp = PJ + (row0 + tt) * LP + ocol + c8 * 8; const u32x4 ov = *(const LAS u32x4*)(OST + tt * S136 + c8 * 16);
                u32x4 w; w.x = pk2(bflo(ov.x) * siluf_(bflo(rv.x)), bfhi(ov.x) * siluf_(bfhi(rv.x))); w.y = pk2(bflo(ov.y) * siluf_(bflo(rv.y)), bfhi(ov.y) * siluf_(bfhi(rv.y)));
                w.z = pk2(bflo(ov.z) * siluf_(bflo(rv.z)), bfhi(ov.z) * siluf_(bfhi(rv.z))); w.w = pk2(bflo(ov.w) * siluf_(bflo(rv.w)), bfhi(ov.w) * siluf_(bfhi(rv.w)));
                *(u32x4*)gp = w; }
        }
        TMARK(84);
    }
#undef GDN_ISSUE
}

__device__ __forceinline__ unsigned char* gla_slot(KArgP A, int b, int h, int n) {
    const int s = (b * 4 + h) * 32 + n;
    return b < 13 ? A->ws + WS_KVS + (size_t)s * 16384 : (unsigned char*)A->out + DO_KVS + (size_t)(s - 13 * 128) * 16384;
}
struct GlaPre { u32x4 v[2], q, k; unsigned short lr[2]; };
__device__ __forceinline__ void gla_prep_issue(GlaPre& P, KArgP A, int b, int h, int n) {
    const bf16* PJ = (const bf16*)(A->ws + WS_PROJ); const int tid = otid(); const size_t row0 = (size_t)b * SEQ + n * 64;
#pragma unroll
    for (int q = 0; q < 2; ++q) { const int it = tid + 512 * q, tt = it >> 4, c = it & 15;
        P.lr[q] = PJ[(row0 + tt) * LP + C_SM + 16 + c]; P.v[q] = *(const u32x4*)(PJ + (row0 + tt) * LP + C_LV + h * 128 + c * 8); }
    const int tt0 = tid >> 3, c80 = tid & 7;
    P.q = *(const u32x4*)(PJ + (row0 + tt0) * LP + C_LQ + h * 64 + c80 * 8); P.k = *(const u32x4*)(PJ + (row0 + tt0) * LP + C_LK + h * 64 + c80 * 8);
}
__device__ __forceinline__ void gla_prep_task(KArgP A, int l, LAS unsigned char* lds, int b, int h, int n, GlaPre& P, bool has_next, int nb_, int nh_, int nn_, GlaPre& N) {
    bf16* PJ = (bf16*)(A->ws + WS_PROJ);
    const int tid = otid(), lane = tid & 63, wid = tid >> 6, l15 = lane & 15, g = lane >> 4, q4 = l15 >> 2, p4 = lane & 3;
    constexpr int S72 = 144, S136 = 272;
    LAS unsigned char* QT = lds; LAS unsigned char* KT = QT + 64 * S72; LAS unsigned char* KDT = KT + 64 * S72; LAS unsigned char* ATT = KDT + 64 * S72; LAS unsigned char* VV = ATT + 64 * S72;
    LAS float* LA = (LAS float*)(VV + 64 * S136); LAS float* LR = LA + 64 * 64; LAS float* SEG = LR + 64 * 16;
    const float* wg2 = A->gla_w_gate2 + (size_t)l * 16 * 256; const float* bg = A->gla_b_gate + l * 256;
    const size_t row0 = (size_t)b * SEQ + n * 64;
    const int mb = wid >> 1, nb0 = 4 * (wid & 1);
    __syncthreads();
#pragma unroll
    for (int q = 0; q < 2; ++q) { const int it = tid + 512 * q; LR[it] = bf2f(P.lr[q]); *(LAS u32x4*)(VV + (it >> 4) * S136 + (it & 15) * 16) = P.v[q]; }
    const int tt0 = tid >> 3, c80 = tid & 7;
    const u32x4 qv = P.q, kv = P.k;
    if (has_next) gla_prep_issue(N, A, nb_, nh_, nn_);
    __syncthreads();
    for (int it = tid; it < 64 * 64; it += 512) { const int tt = it >> 6, d = it & 63; float z = bg[h * 64 + d];
#pragma unroll
        for (int r = 0; r < 16; ++r) z += LR[tt * 16 + r] * wg2[r * 256 + h * 64 + d];
        LA[it] = logsigmoidf_(z) * (1.f / 16.f); }
    __syncthreads();
    { const int d = tid & 63, seg = tid >> 6; float run = 0.f;
#pragma unroll
      for (int i = 0; i < 8; ++i) { run += LA[(seg * 8 + i) * 64 + d]; LA[(seg * 8 + i) * 64 + d] = run; }
      SEG[seg * 64 + d] = run; }
    __syncthreads();
    { const int d = tid & 63, seg = tid >> 6; float pre = 0.f;
      for (int s2 = 0; s2 < seg; ++s2) pre += SEG[s2 * 64 + d];
#pragma unroll
      for (int i = 0; i < 8; ++i) LA[(seg * 8 + i) * 64 + d] += pre; }
    __syncthreads();
    {
        const float qf[8] = {bflo(qv.x), bfhi(qv.x), bflo(qv.y), bfhi(qv.y), bflo(qv.z), bfhi(qv.z), bflo(qv.w), bfhi(qv.w)};
        const float kf[8] = {bflo(kv.x), bfhi(kv.x), bflo(kv.y), bfhi(kv.y), bflo(kv.z), bfhi(kv.z), bflo(kv.w), bfhi(kv.w)};
        float qt[8], kt[8];
#pragma unroll
        for (int e = 0; e < 8; ++e) { const int d = c80 * 8 + e; const float cu = LA[tt0 * 64 + d], cl = LA[63 * 64 + d];
            qt[e] = qf[e] * 0.125f * __expf(cu); kt[e] = kf[e] * __expf(-cu);
            *(LAS bf16*)(KDT + d * S72 + tt0 * 2) = (bf16)f2bf(kf[e] * __expf(cl - cu)); }
        const u32x4 qw = (u32x4){pk2(qt[0], qt[1]), pk2(qt[2], qt[3]), pk2(qt[4], qt[5]), pk2(qt[6], qt[7])};
        *(LAS u32x4*)(QT + tt0 * S72 + c80 * 16) = qw;
        *(u32x4*)(PJ + (row0 + tt0) * LP + C_LQ + h * 64 + c80 * 8) = qw;
        *(LAS u32x4*)(KT + tt0 * S72 + c80 * 16) = (u32x4){pk2(kt[0], kt[1]), pk2(kt[2], kt[3]), pk2(kt[4], kt[5]), pk2(kt[6], kt[7])};
        if (tid < 64) ((float*)(A->ws + WS_CDB))[(size_t)((b * 4 + h) * 32 + n) * 64 + tid] = __expf(LA[63 * 64 + tid]);
    }
    __syncthreads();
    {
        bf16x8 af[2], kf2[2];
#pragma unroll
        for (int ks = 0; ks < 2; ++ks) { af[ks] = frag_rm(QT, S72, mb, ks, l15, g); kf2[ks] = frag_rm(KDT, S72, mb, ks, l15, g); }
#pragma unroll
        for (int j = 0; j < 2; ++j) { const int nb = 2 * (wid & 1) + j; f32x4 a = (f32x4){0.f, 0.f, 0.f, 0.f};
#pragma unroll
            for (int ks = 0; ks < 2; ++ks) a = MFMA16(af[ks], frag_rm(KT, S72, nb, ks, l15, g), a);
#pragma unroll
            for (int r = 0; r < 4; ++r) { const int i = mb * 16 + 4 * g + r, jj = nb * 16 + l15; *(LAS bf16*)(ATT + i * S72 + jj * 2) = (bf16)f2bf(jj <= i ? a[r] : 0.f); } }
        unsigned char* slot = gla_slot(A, b, h, n);
#pragma unroll
        for (int j = 0; j < 4; ++j) { f32x4 kvb = (f32x4){0.f, 0.f, 0.f, 0.f};
#pragma unroll
            for (int ks = 0; ks < 2; ++ks) kvb = MFMA16(kf2[ks], frag_tr(VV, S136, ks, nb0 + j, g, q4, p4), kvb);
            *(u32x2*)(slot + ((nb0 + j) * 16 + l15) * 128 + (mb * 16 + 4 * g) * 2) = (u32x2){pk2(kvb[0], kvb[1]), pk2(kvb[2], kvb[3])}; }
    }
    __syncthreads();
    { const int row = tid >> 3, c8 = tid & 7; *(u32x4*)(PJ + (row0 + row) * LP + C_LK + h * 64 + c8 * 8) = *(const LAS u32x4*)(ATT + row * S72 + c8 * 16); }
}
__device__ __forceinline__ void gla_state_scan(KArgP A) {
    for (int gt = obid() * 512 + otid(); gt < 64 * 2048; gt += ogrid() * 512) {
    const int ch = gt >> 11, e4 = gt & 2047, b = ch >> 2, h = ch & 3;
    const float* cdb = (const float*)(A->ws + WS_CDB) + (size_t)ch * 32 * 64 + (e4 & 15) * 4;
    float s0 = 0.f, s1 = 0.f, s2 = 0.f, s3 = 0.f;
#pragma unroll 8
    for (int n = 0; n < 32; ++n) {
        u32x2* p = (u32x2*)(gla_slot(A, b, h, n) + e4 * 8); const u32x2 kv = *p; const f32x4 cd = *(const f32x4*)(cdb + n * 64);
        *p = (u32x2){pk2(s0, s1), pk2(s2, s3)};
        s0 = cd[0] * s0 + bflo(kv.x); s1 = cd[1] * s1 + bfhi(kv.x); s2 = cd[2] * s2 + bflo(kv.y); s3 = cd[3] * s3 + bfhi(kv.y);
    }
    }
}
__device__ __forceinline__ void gla_out_task(KArgP A, int l, LAS unsigned char* lds, int b, int h, int n) {
    bf16* PJ = (bf16*)(A->ws + WS_PROJ);
    const int tid = otid(), lane = tid & 63, wid = tid >> 6, l15 = lane & 15, g = lane >> 4, q4 = l15 >> 2, p4 = lane & 3;
    constexpr int S72 = 144, S136 = 272;
    LAS unsigned char* QT = lds; LAS unsigned char* ATT = QT + 64 * S72; LAS unsigned char* VV = ATT + 64 * S72; LAS unsigned char* ST = VV + 64 * S136; LAS unsigned char* OST = ST + 128 * S72;
    LAS float* SSQ = (LAS float*)(OST + 64 * S136);
    const float* nw = A->gla_norm_w + l * 128;
    const size_t row0 = (size_t)b * SEQ + n * 64;
    const int mb = wid >> 1, nb0 = 4 * (wid & 1);
    const unsigned char* slot = gla_slot(A, b, h, n);
    u32x4 rpre[2];
#pragma unroll
    for (int q = 0; q < 2; ++q) { const int it = tid + 512 * q; rpre[q] = *(const u32x4*)(PJ + (row0 + (it >> 4)) * LP + C_OC + h * 128 + (it & 15) * 8); }
    __syncthreads();
    { const int row = tid >> 3, c8 = tid & 7;
      *(LAS u32x4*)(QT + row * S72 + c8 * 16) = *(const u32x4*)(PJ + (row0 + row) * LP + C_LQ + h * 64 + c8 * 8);
      *(LAS u32x4*)(ATT + row * S72 + c8 * 16) = *(const u32x4*)(PJ + (row0 + row) * LP + C_LK + h * 64 + c8 * 8); }
#pragma unroll
    for (int q = 0; q < 2; ++q) { const int c = tid + 512 * q;
        *(LAS u32x4*)(VV + (c >> 4) * S136 + (c & 15) * 16) = *(const u32x4*)(PJ + (row0 + (c >> 4)) * LP + C_LV + h * 128 + (c & 15) * 8);
        *(LAS u32x4*)(ST + (c >> 3) * S72 + (c & 7) * 16) = *(const u32x4*)(slot + (c >> 3) * 128 + (c & 7) * 16); }
    __syncthreads();
    f32x4 acc[4];
    {
        bf16x8 af[2], aa[2];
#pragma unroll
        for (int ks = 0; ks < 2; ++ks) { af[ks] = frag_rm(QT, S72, mb, ks, l15, g); aa[ks] = frag_rm(ATT, S72, mb, ks, l15, g); }
#pragma unroll
        for (int j = 0; j < 4; ++j) { acc[j] = (f32x4){0.f, 0.f, 0.f, 0.f};
#pragma unroll
            for (int ks = 0; ks < 2; ++ks) { acc[j] = MFMA16(af[ks], frag_rm(ST, S72, nb0 + j, ks, l15, g), acc[j]); acc[j] = MFMA16(aa[ks], frag_tr(VV, S136, ks, nb0 + j, g, q4, p4), acc[j]); } }
    }
    float ss[4];
#pragma unroll
    for (int r = 0; r < 4; ++r) { float s = 0.f;
#pragma unroll
        for (int j = 0; j < 4; ++j) s += acc[j][r] * acc[j][r];
        s += swz_xor<1>(s); s += swz_xor<2>(s); s += swz_xor<4>(s); s += swz_xor<8>(s); ss[r] = s; }
    if (l15 == 0) {
#pragma unroll
        for (int r = 0; r < 4; ++r) SSQ[(mb * 16 + 4 * g + r) * 2 + (wid & 1)] = ss[r]; }
    __syncthreads();
#pragma unroll
    for (int r = 0; r < 4; ++r) { const int i = mb * 16 + 4 * g + r; const float sc = rsqrtf((SSQ[i * 2] + SSQ[i * 2 + 1]) * (1.f / 128.f) + 1e-6f);
#pragma unroll
        for (int j = 0; j < 4; ++j) { const int dv = (nb0 + j) * 16 + l15; *(LAS bf16*)(OST + i * S136 + dv * 2) = (bf16)f2bf(acc[j][r] * sc * nw[dv]); } }
    __syncthreads();
#pragma unroll
    for (int q = 0; q < 2; ++q) { const int it = tid + 512 * q, tt = it >> 4, c8 = it & 15;
        bf16* gp = PJ + (row0 + tt) * LP + C_OC + h * 128 + c8 * 8; const u32x4 rv = rpre[q]; const u32x4 ov = *(const LAS u32x4*)(OST + tt * S136 + c8 * 16);
        u32x4 w; w.x = pk2(bflo(ov.x) * siluf_(bflo(rv.x)), bfhi(ov.x) * siluf_(bfhi(rv.x))); w.y = pk2(bflo(ov.y) * siluf_(bflo(rv.y)), bfhi(ov.y) * siluf_(bfhi(rv.y)));
        w.z = pk2(bflo(ov.z) * siluf_(bflo(rv.z)), bfhi(ov.z) * siluf_(bfhi(rv.z))); w.w = pk2(bflo(ov.w) * siluf_(bflo(rv.w)), bfhi(ov.w) * siluf_(bfhi(rv.w)));
        *(u32x4*)gp = w; }
}

struct LnRow { float v[16]; };
__device__ __forceinline__ void ln_normalize(LnRow& r, const float* g, const float* bta, int lane) {
    float s = 0.f;
#pragma unroll
    for (int i = 0; i < 16; ++i) s += r.v[i];
    const float mean = wave_sum(s) * (1.f / 1024.f); float q = 0.f;
#pragma unroll
    for (int i = 0; i < 16; ++i) { r.v[i] -= mean; q += r.v[i] * r.v[i]; }
    const float rstd = rsqrtf(wave_sum(q) * (1.f / 1024.f) + 1e-5f);
#pragma unroll
    for (int jj = 0; jj < 2; ++jj) { const int k = 8 * (lane + 64 * jj);
        const f32x4 g0 = *(const f32x4*)(g + k), g1 = *(const f32x4*)(g + k + 4), b0 = *(const f32x4*)(bta + k), b1 = *(const f32x4*)(bta + k + 4);
#pragma unroll
        for (int e = 0; e < 4; ++e) { r.v[jj * 8 + e] = r.v[jj * 8 + e] * rstd * g0[e] + b0[e]; r.v[jj * 8 + 4 + e] = r.v[jj * 8 + 4 + e] * rstd * g1[e] + b1[e]; } }
}
__device__ __forceinline__ void ln_load_bf16(LnRow& r, const bf16* row, int lane, float scale) {
#pragma unroll
    for (int jj = 0; jj < 2; ++jj) { const u32x4 t = *(const u32x4*)(row + 8 * (lane + 64 * jj));
        r.v[jj * 8 + 0] = scale * bflo(t.x); r.v[jj * 8 + 1] = scale * bfhi(t.x); r.v[jj * 8 + 2] = scale * bflo(t.y); r.v[jj * 8 + 3] = scale * bfhi(t.y);
        r.v[jj * 8 + 4] = scale * bflo(t.z); r.v[jj * 8 + 5] = scale * bfhi(t.z); r.v[jj * 8 + 6] = scale * bflo(t.w); r.v[jj * 8 + 7] = scale * bfhi(t.w); }
}
__device__ __forceinline__ void ln_add_bf16(LnRow& r, const bf16* row, int lane, float scale) {
#pragma unroll
    for (int jj = 0; jj < 2; ++jj) { const u32x4 t = *(const u32x4*)(row + 8 * (lane + 64 * jj));
        r.v[jj * 8 + 0] += scale * bflo(t.x); r.v[jj * 8 + 1] += scale * bfhi(t.x); r.v[jj * 8 + 2] += scale * bflo(t.y); r.v[jj * 8 + 3] += scale * bfhi(t.y);
        r.v[jj * 8 + 4] += scale * bflo(t.z); r.v[jj * 8 + 5] += scale * bfhi(t.z); r.v[jj * 8 + 6] += scale * bflo(t.w); r.v[jj * 8 + 7] += scale * bfhi(t.w); }
}
__device__ __forceinline__ void ln_store_bf16(const LnRow& r, bf16* row, int lane) {
#pragma unroll
    for (int jj = 0; jj < 2; ++jj) { u32x4 w; w.x = pk2(r.v[jj * 8], r.v[jj * 8 + 1]); w.y = pk2(r.v[jj * 8 + 2], r.v[jj * 8 + 3]); w.z = pk2(r.v[jj * 8 + 4], r.v[jj * 8 + 5]); w.w = pk2(r.v[jj * 8 + 6], r.v[jj * 8 + 7]);
        *(u32x4*)(row + 8 * (lane + 64 * jj)) = w; }
}
__device__ __forceinline__ void ln_store_f32(const LnRow& r, float* row, int lane) {
#pragma unroll
    for (int jj = 0; jj < 2; ++jj) { float* p = row + 8 * (lane + 64 * jj);
        *(f32x4*)p = (f32x4){r.v[jj * 8], r.v[jj * 8 + 1], r.v[jj * 8 + 2], r.v[jj * 8 + 3]}; *(f32x4*)(p + 4) = (f32x4){r.v[jj * 8 + 4], r.v[jj * 8 + 5], r.v[jj * 8 + 6], r.v[jj * 8 + 7]}; }
}

__device__ __forceinline__ KArgP argp() { KArgP p = (KArgP)__builtin_amdgcn_kernarg_segment_ptr(); asm volatile("" : "+s"(p)); return p; }
#define XB_TMO      128
#define XB_XCNT(j)  (256  + 64 * (j))
#define XB_XSUB(j)  (1280 + 64 * (j))
#define XB_XGEN(j)  (2304 + 64 * (j))
#define XB_TOP      3328
#define XB_TOPGEN   3392
#define XB_SPIN_CAP (1u << 20)
constexpr int CW_BAR = 4096;
__device__ __forceinline__ unsigned xb_ld(unsigned* p)              { return __hip_atomic_load(p, __ATOMIC_RELAXED, __HIP_MEMORY_SCOPE_AGENT); }
__device__ __forceinline__ unsigned xb_add(unsigned* p, unsigned v) { return __hip_atomic_fetch_add(p, v, __ATOMIC_RELAXED, __HIP_MEMORY_SCOPE_AGENT); }
__device__ __forceinline__ unsigned xb_xcc_id() { return (unsigned)__builtin_amdgcn_s_getreg((3 << 11) | 20) & 0xFu; }
#define XB_SPIN(cond, bar) do { unsigned _sp = 0; while (cond) { __builtin_amdgcn_s_sleep(1); \
    if ((++_sp & 255u) == 0u) { if (xb_ld(&(bar)[XB_TMO])) break; if (_sp > XB_SPIN_CAP) { atomicAdd(&(bar)[XB_TMO], 1u); break; } } } } while (0)
__device__ __forceinline__ void xcd_barrier_complete(unsigned* bar, unsigned x, unsigned& nloc, unsigned& nx) {
    const unsigned G = gridDim.x;
    unsigned sum, cnt, mine, sp = 0u;
    for (;;) {
        sum = 0u; cnt = 0u; mine = 0u;
#pragma unroll
        for (unsigned j = 0; j < 16; ++j) { const unsigned c = xb_ld(&bar[XB_XCNT(j)]); sum += c; cnt += (c > 0u) ? 1u : 0u; mine = (j == x) ? c : mine; }
        if (sum == G) break;
        __builtin_amdgcn_s_sleep(1);
        if ((++sp & 255u) == 0u) { if (xb_ld(&bar[XB_TMO])) break; if (sp > XB_SPIN_CAP) { atomicAdd(&bar[XB_TMO], 1u); break; } }
    }
    nloc = mine > 0u ? mine : 1u; nx = cnt > 0u ? cnt : 1u;
}
__device__ __forceinline__ void grid_barrier(LAS unsigned char* lds) {
    volatile LAS unsigned* st = (volatile LAS unsigned*)(lds + LDS_CTL + 2048);
    asm volatile("s_waitcnt vmcnt(0)" ::: "memory");
    __syncthreads();
    if (otid() == 0) {
        unsigned* bar = (unsigned*)(argp()->ws + WS_CTL) + CW_BAR;
        const unsigned x = xb_xcc_id();
        __builtin_amdgcn_s_waitcnt(0);
        unsigned nloc = st[0], nx = st[1];
        if (nloc == 0u) { xcd_barrier_complete(bar, x, nloc, nx); st[0] = nloc; st[1] = nx; }
        const unsigned old = xb_add(&bar[XB_XSUB(x)], 1u);
        const unsigned gen = old / nloc;
        if (old + 1u == (gen + 1u) * nloc) {
            __builtin_amdgcn_fence(__ATOMIC_RELEASE, "agent");
            asm volatile("s_waitcnt vmcnt(0)" ::: "memory");
            const unsigned og = xb_add(&bar[XB_TOP], 1u);
            const unsigned tg = og / nx;
            if (og + 1u == (tg + 1u) * nx) xb_add(&bar[XB_TOPGEN], 1u);
            else XB_SPIN(xb_ld(&bar[XB_TOPGEN]) == tg, bar);
            __builtin_amdgcn_fence(__ATOMIC_ACQUIRE, "agent");
            xb_add(&bar[XB_XGEN(x)], 1u);
            asm volatile("s_waitcnt vmcnt(0)" ::: "memory");
        } else {
            XB_SPIN(xb_ld(&bar[XB_XGEN(x)]) == gen, bar);
            __builtin_amdgcn_fence(__ATOMIC_ACQUIRE, "agent");
            asm volatile("s_waitcnt vmcnt(0)" ::: "memory");
        }
    }
    __syncthreads();
}

#define PH_COMMON \
    KArgP ap = argp(); unsigned char* ws = ap->ws; (void)ws; \
    const int tid = otid(), lane = tid & 63, wid = tid >> 6; (void)lane; (void)wid; \
    const int G = ogrid(), bx = obid(), gw = bx * 8 + wid, NGW = G * 8; (void)gw; (void)NGW; \
    unsigned char* wt = ws + WS_WT; (void)wt; bf16* XB = (bf16*)(ws + WS_XB); (void)XB; bf16* PJ = (bf16*)(ws + WS_PROJ); (void)PJ; \
    unsigned char* dsc = (unsigned char*)ap->out; bf16* Y = (bf16*)(dsc + DO_Y); (void)Y; bf16* KV = (bf16*)(dsc + DO_KV); (void)KV; bf16* MEMB = (bf16*)(dsc + DO_MEMB); (void)MEMB;

__device__ __forceinline__ void ph_input(LAS unsigned char* lds) { PH_COMMON
    convert_rows(ap->x, XB, (size_t)NTOK * DM);
    convert_rows(ap->mem, MEMB, (size_t)NMEM * DM);
}
__device__ __forceinline__ void ph_weights(LAS unsigned char* lds, int l) { KArgP A = argp(); phase_convert_weights(A, l, lds); }
__device__ __forceinline__ void ph_proj(LAS unsigned char* lds, int l) { PH_COMMON
    pg8::Gemm g{1024, 1024, 1024};
    RegSched S{NTOK / 256, LP / 256, (NTOK / 256) * (LP / 256), G, bx, (const char*)XB, (const char*)(wt + WT_WIN), (size_t)256 * 1024 * 2, (size_t)256 * 1024 * 2, 0};
    pg8::EpiProj E{PJ, LP, (bf16*)(dsc + DO_HALO)};
    pg8::gemm_phase(lds, g, S, E);
}
__device__ __forceinline__ void ph_kv(LAS unsigned char* lds, int l) { PH_COMMON
    pg8::Gemm g{1024, 1024, 1024};
    if (bx < G - 128) return;
    RegSched S2{NMEM / 256, 2048 / 256, (NMEM / 256) * (2048 / 256), G, bx - (G - 128), (const char*)MEMB, (const char*)(wt + WT_WKV), (size_t)256 * 1024 * 2, (size_t)256 * 1024 * 2, 0};
    pg8::EpiStore E2{KV, 2048, 1.f};
    pg8::gemm_phase(lds, g, S2, E2);
}
__device__ __forceinline__ void ph_gdn_prep(LAS unsigned char* lds, int l) {
    KArgP A = argp();
    const int G = ogrid(), bx = obid();
    TMARK(20);
    if (bx < NB * 8) fox_ck_task(A, l, lds, bx >> 3, bx & 7);
    { GdnPre P, N; if (bx < NB * 4 * 32) gdn_prep_issue(P, A, l, bx >> 7, (bx >> 5) & 3, bx & 31);
      for (int t = bx; t < NB * 4 * 32; t += G) { const int t2 = t + G; const bool hn = t2 < NB * 4 * 32;
          gdn_prep_task(A, l, lds, t >> 7, (t >> 5) & 3, t & 31, P, hn, t2 >> 7, (t2 >> 5) & 3, t2 & 31, N);
          P = N; } }
    TMARK(21);
    { GlaPre P, N; if (bx < NB * 4 * 32) gla_prep_issue(P, A, bx >> 7, (bx >> 5) & 3, bx & 31);
      for (int t = bx; t < NB * 4 * 32; t += G) { const int t2 = t + G; const bool hn = t2 < NB * 4 * 32;
          gla_prep_task(A, l, lds, t >> 7, (t >> 5) & 3, t & 31, P, hn, t2 >> 7, (t2 >> 5) & 3, t2 & 31, N);
          P = N; } }
    TMARK(22);
}
__device__ __forceinline__ void ph_gla_scan(LAS unsigned char* lds, int l) { KArgP A = argp(); gla_state_scan(A); }
__device__ __forceinline__ void ph_mix(LAS unsigned char* lds, int l) {
    KArgP A = argp();
    const int bx = obid();
    TMARK(23);
    if (bx < 64) gdn_scan_chain(A, l, lds, bx >> 2, bx & 3);
    TMARK(24);
    unsigned* ctr = (unsigned*)(A->ws + WS_CTL) + 128 + l;
    volatile LAS int* qw = (volatile LAS int*)(lds + LDS_CTL + 2400);
    for (;;) {
        __syncthreads();
        if (otid() == 0) qw[0] = (int)atomicAdd(ctr, 1u);
        __syncthreads();
        const int u = qw[0];
        if (u >= NB * 8 * 8 + NB * 4 * 32) break;
        if (u < NB * 8 * 8) { TMARK(26); const int qb = 7 - (u >> 7), bh = u & 127; fox_unit(A, l, lds, bh >> 3, bh & 7, qb); TMARK(27); }
        else { TMARK(28); const int t = u - NB * 8 * 8; gla_out_task(A, l, lds, t >> 7, (t >> 5) & 3, t & 31); TMARK(29); }
    }
    TMARK(25);
}
__device__ __forceinline__ void ph_mix_probe(LAS unsigned char* lds, int l) {
    KArgP A = argp();
    const int bx = obid();
    if (PROBE_MIX == 1 || PROBE_MIX == 5) {
        unsigned* ctr = (unsigned*)(A->ws + WS_CTL) + 132 + l;
        volatile LAS int* qw = (volatile LAS int*)(lds + LDS_CTL + 2400);
        for (;;) { __syncthreads(); if (otid() == 0) qw[0] = (int)atomicAdd(ctr, 1u); __syncthreads(); const int u = qw[0]; if (u >= NB * 8 * 8) break;
            const int qb = 7 - (u >> 7), bh = u & 127; fox_unit(A, l, lds, bh >> 3, bh & 7, qb, 5152); }
    }
    else if (PROBE_MIX == 3) { if (bx < 64) gdn_scan_chain(A, l, lds, bx >> 2, bx & 3, 5152); }
    else if (PROBE_MIX == 4) { const int G = ogrid(); GdnPre P, N; for (int t = bx; t < NB * 4 * 32; t += G) { gdn_prep_issue(P, A, l, t >> 7, (t >> 5) & 3, t & 31); gdn_prep_task(A, l, lds, t >> 7, (t >> 5) & 3, t & 31, P, false, 0, 0, 0, N, true); } }
}
__device__ __forceinline__ void ph_branch(LAS unsigned char* lds, int l) { PH_COMMON
    pg8::Gemm g{LP, 512, 512};
    BranchSched S{NTOK / 256, (NTOK / 256) * 12, G, bx, (const char*)PJ, (const char*)(wt + WT_P)};
    pg8::EpiStore E{PJ, LP, 1.f};
    pg8::gemm_phase(lds, g, S, E);
}
__device__ __forceinline__ void ph_gate(LAS unsigned char* lds, int l) { PH_COMMON
    pg8::Gemm g{1024, 1024, 1024};
    GateSched S{NTOK / 256, (NTOK / 256) * 4, G, bx, (const char*)XB, (const char*)(wt + WT_WIN + (size_t)LP * 1024 * 2)};
    pg8::EpiGate E{PJ, LP, ap->b_merge + (size_t)l * 3072};
    pg8::gemm_phase(lds, g, S, E);
}
__device__ __forceinline__ void ph_out(LAS unsigned char* lds, int l) { PH_COMMON
    pg8::Gemm g{LP, 1024, 1024};
    RegSched S{NTOK / 256, 4, (NTOK / 256) * 4, G, bx, (const char*)PJ, (const char*)(wt + WT_WOUT3), (size_t)256 * LP * 2, (size_t)256 * 1024 * 2, 0};
    pg8::EpiResid E{XB, Y, 1024};
    pg8::gemm_phase(lds, g, S, E);
}
__device__ __forceinline__ void ph_ln1(LAS unsigned char* lds, int l) { PH_COMMON
    const float* gg = ap->ln1_g + l * 1024; const float* bb = ap->ln1_b + l * 1024;
    for (int row = gw; row < NTOK; row += NGW) { LnRow r; ln_load_bf16(r, Y + (size_t)row * 1024, lane, 1.f); ln_normalize(r, gg, bb, lane); ln_store_bf16(r, XB + (size_t)row * 1024, lane); }
}
__device__ __forceinline__ void ph_q(LAS unsigned char* lds, int l) { PH_COMMON
    bf16* Qb = (bf16*)(ws + WS_PROJ + PJ_Q);
    pg8::Gemm g{1024, 1024, 1024};
    RegSched S{NTOK / 256, 4, (NTOK / 256) * 4, G, bx, (const char*)XB, (const char*)(wt + WT_WQ), (size_t)256 * 1024 * 2, (size_t)256 * 1024 * 2, 0};
    pg8::EpiStore E{Qb, 1024, 0.0625f * LOG2E};
    pg8::gemm_phase(lds, g, S, E);
}
__device__ __forceinline__ void ph_xattn(LAS unsigned char* lds, int l) { PH_COMMON
    bf16* Qb = (bf16*)(ws + WS_PROJ + PJ_Q); bf16* Ob = (bf16*)(ws + WS_PROJ + PJ_O);
    xattn_phase(lds, Qb, KV, Ob, G, bx);
}
__device__ __forceinline__ void ph_wo(LAS unsigned char* lds, int l) { PH_COMMON
    bf16* Ob = (bf16*)(ws + WS_PROJ + PJ_O);
    pg8::Gemm g{1024, 1024, 1024};
    RegSched S{NTOK / 256, 4, (NTOK / 256) * 4, G, bx, (const char*)Ob, (const char*)(wt + WT_WO), (size_t)256 * 1024 * 2, (size_t)256 * 1024 * 2, 0};
    pg8::EpiResid E{XB, Y, 1024};
    pg8::gemm_phase(lds, g, S, E);
}
__device__ __forceinline__ void ph_ln2_router(LAS unsigned char* lds, int l, int cnt_off = 0) { PH_COMMON
    unsigned* ctl = (unsigned*)(ws + WS_CTL);
    int* tokE = (int*)(ws + WS_SMALL + SM_TOKE); float* tokW = (float*)(ws + WS_SMALL + SM_TOKW); int* tokR = (int*)(ws + WS_SMALL + SM_TOKR);
    const int l15 = lane & 15, g = lane >> 4;
    constexpr int SX = 2064;
    LAS unsigned char* XH = lds; LAS unsigned char* XL = lds + 16 * SX;
    LAS float* PART = (LAS float*)(lds + 2 * 16 * SX);
    LAS float* LOG = PART + 8 * 16 * 48;
    unsigned* wcnt = ctl + 16384 + l * 8192 + cnt_off * 64;
    LAS unsigned* lcnt = (LAS unsigned*)(lds + LDS_CTL + 2560);
    const float* gg = ap->ln2_g + l * 1024; const float* bb = ap->ln2_b + l * 1024;
    const float* bgp = ap->moe_b_group + l * 4; const float* bep = ap->moe_b_expert + l * 32;
    bf16x8 bh[3][4], bl[3][4];
    { const bf16* RH = (const bf16*)(wt + WT_RWH); const bf16* RL = (const bf16*)(wt + WT_RWL);
#pragma unroll
      for (int nb = 0; nb < 3; ++nb)
#pragma unroll
          for (int kk = 0; kk < 4; ++kk) { const size_t off = (size_t)(nb * 16 + l15) * 1024 + (4 * wid + kk) * 32 + 8 * g; bh[nb][kk] = *(const bf16x8*)(RH + off); bl[nb][kk] = *(const bf16x8*)(RL + off); } }
    __syncthreads();
    if (tid < 32) lcnt[tid] = 0u;
    u32x4 yp[2][2];
    if (bx < NTOK / 16) {
#pragma unroll
        for (int q = 0; q < 2; ++q)
#pragma unroll
            for (int jj = 0; jj < 2; ++jj) yp[q][jj] = *(const u32x4*)(Y + ((size_t)bx * 16 + wid * 2 + q) * 1024 + 8 * (lane + 64 * jj)); }
    for (int bt = bx; bt < NTOK / 16; bt += G) {
#pragma unroll
        for (int q = 0; q < 2; ++q) { const int rl = wid * 2 + q; const size_t row = (size_t)bt * 16 + rl;
            LnRow r;
#pragma unroll
            for (int jj = 0; jj < 2; ++jj) { const u32x4 t = yp[q][jj];
                r.v[jj * 8 + 0] = bflo(t.x); r.v[jj * 8 + 1] = bfhi(t.x); r.v[jj * 8 + 2] = bflo(t.y); r.v[jj * 8 + 3] = bfhi(t.y);
                r.v[jj * 8 + 4] = bflo(t.z); r.v[jj * 8 + 5] = bfhi(t.z); r.v[jj * 8 + 6] = bflo(t.w); r.v[jj * 8 + 7] = bfhi(t.w); }
            if (bt + G < NTOK / 16) {
#pragma unroll
                for (int jj = 0; jj < 2; ++jj) yp[q][jj] = *(const u32x4*)(Y + ((size_t)(bt + G) * 16 + rl) * 1024 + 8 * (lane + 64 * jj)); }
            ln_normalize(r, gg, bb, lane); ln_store_bf16(r, XB + row * 1024, lane);
#pragma unroll
            for (int jj = 0; jj < 2; ++jj) { unsigned hw[4], lw[4];
#pragma unroll
                for (int e2 = 0; e2 < 4; ++e2) { const float a = r.v[jj * 8 + 2 * e2], c = r.v[jj * 8 + 2 * e2 + 1]; const unsigned ha = f2bf(a), hc = f2bf(c);
                    hw[e2] = ha | (hc << 16); lw[e2] = pk2(a - bf2f((unsigned short)ha), c - bf2f((unsigned short)hc)); }
                *(LAS u32x4*)(XH + rl * SX + (lane + 64 * jj) * 16) = (u32x4){hw[0], hw[1], hw[2], hw[3]};
                *(LAS u32x4*)(XL + rl * SX + (lane + 64 * jj) * 16) = (u32x4){lw[0], lw[1], lw[2], lw[3]}; } }
        __syncthreads();
        {
            f32x4 acc[3];
#pragma unroll
            for (int nb = 0; nb < 3; ++nb) acc[nb] = (f32x4){0.f, 0.f, 0.f, 0.f};
#pragma unroll
            for (int kk = 0; kk < 4; ++kk) { const bf16x8 ah = frag_rm(XH, SX, 0, 4 * wid + kk, l15, g), al = frag_rm(XL, SX, 0, 4 * wid + kk, l15, g);
#pragma unroll
                for (int nb = 0; nb < 3; ++nb) { acc[nb] = MFMA16(ah, bh[nb][kk], acc[nb]); acc[nb] = MFMA16(ah, bl[nb][kk], acc[nb]); acc[nb] = MFMA16(al, bh[nb][kk], acc[nb]); } }
#pragma unroll
            for (int nb = 0; nb < 3; ++nb)
#pragma unroll
                for (int r = 0; r < 4; ++r) PART[(wid * 16 + 4 * g + r) * 48 + nb * 16 + l15] = acc[nb][r];
        }
        __syncthreads();
        for (int p = tid; p < 16 * 48; p += 512) { float s = 0.f;
#pragma unroll
            for (int w = 0; w < 8; ++w) s += PART[w * 16 * 48 + p];
            LOG[p] = s; }
        __syncthreads();
        if (tid < 16) { const size_t row = (size_t)bt * 16 + tid; const LAS float* lg = LOG + tid * 48;
            float gl[4];
#pragma unroll
            for (int c = 0; c < 4; ++c) gl[c] = lg[c] + bgp[c];
            int gsel = 0; float gm = gl[0];
#pragma unroll
            for (int c = 1; c < 4; ++c) if (gl[c] > gm) { gm = gl[c]; gsel = c; }
            float gsum = 0.f;
#pragma unroll
            for (int c = 0; c < 4; ++c) gsum += __expf(gl[c] - gm);
            const float ptop = 1.f / gsum;
            float el[8];
#pragma unroll
            for (int jx = 0; jx < 8; ++jx) el[jx] = lg[4 + gsel * 8 + jx] + bep[gsel * 8 + jx];
            int e0 = 0; float m0 = el[0];
#pragma unroll
            for (int jx = 1; jx < 8; ++jx) if (el[jx] > m0) { m0 = el[jx]; e0 = jx; }
            int e1 = -1; float m1 = -3.0e38f;
#pragma unroll
            for (int jx = 0; jx < 8; ++jx) if (jx != e0 && el[jx] > m1) { m1 = el[jx]; e1 = jx; }
            const float ex = __expf(m1 - m0); const float w0 = ptop / (1.f + ex), w1 = ptop * ex / (1.f + ex);
            const int ge0 = gsel * 8 + e0, ge1 = gsel * 8 + e1;
            const int r0 = (int)__hip_atomic_fetch_add(lcnt + ge0, 1u, __ATOMIC_RELAXED, __HIP_MEMORY_SCOPE_WORKGROUP), r1 = (int)__hip_atomic_fetch_add(lcnt + ge1, 1u, __ATOMIC_RELAXED, __HIP_MEMORY_SCOPE_WORKGROUP);
            tokE[row * 2] = ge0; tokE[row * 2 + 1] = ge1; tokW[row * 2] = w0; tokW[row * 2 + 1] = w1; tokR[row * 2] = r0; tokR[row * 2 + 1] = r1; }
    }
    __syncthreads();
    if (tid < 32) wcnt[bx * 32 + tid] = lcnt[tid];
}
__device__ __forceinline__ void ph_dispatch(LAS unsigned char* lds, int l) { PH_COMMON
    unsigned* ctl = (unsigned*)(ws + WS_CTL);
    int* tokE = (int*)(ws + WS_SMALL + SM_TOKE); int* tokR = (int*)(ws + WS_SMALL + SM_TOKR); int* tokS = (int*)(ws + WS_SMALL + SM_TOKS);
    int* slotTok = (int*)(ws + WS_SMALL + SM_SLOTTOK);
    LAS int* tab = (LAS int*)(lds + LDS_CTL);
    __syncthreads();
    {
        const unsigned* wcnt = ctl + 16384 + l * 8192;
        LAS int* red = (LAS int*)lds;
        const int e = tid & 31, part = tid >> 5; int tot = 0, pre = 0;
        for (int w = part; w < G; w += 16) { const int c = (int)wcnt[w * 32 + e]; tot += c; if (w < bx) pre += c; }
        red[(part * 32 + e) * 2] = tot; red[(part * 32 + e) * 2 + 1] = pre;
        __syncthreads();
        if (tid < 32) { int t2 = 0, p2 = 0; for (int p = 0; p < 16; ++p) { t2 += red[(p * 32 + tid) * 2]; p2 += red[(p * 32 + tid) * 2 + 1]; } tab[360 + tid] = t2; tab[400 + tid] = p2; }
        __syncthreads();
    }
    if (tid == 0) { int ps = 0, nb = 0;
        for (int e = 0; e < 32; ++e) { const int c = tab[360 + e]; const int nbe = (c + 255) >> 8; tab[320 + e] = ps;
            for (int q = 0; q < nbe; ++q) tab[1 + nb + q] = e; nb += nbe; ps += nbe * 256; }
        tab[352] = ps; tab[0] = nb; }
    __syncthreads();
    for (int i = tid; ; i += 512) { const int bt = bx + (i >> 4) * G; if (bt >= NTOK / 16) break; const int row = bt * 16 + (i & 15);
        const int e0 = tokE[row * 2], e1 = tokE[row * 2 + 1]; const int s0 = tab[320 + e0] + tab[400 + e0] + tokR[row * 2], s1 = tab[320 + e1] + tab[400 + e1] + tokR[row * 2 + 1];
        tokS[row * 2] = s0; tokS[row * 2 + 1] = s1; slotTok[s0] = row; slotTok[s1] = row;
    }
    for (int e = 0; e < 32; ++e) { const int c = tab[360 + e], st = tab[320 + e] + c, en = tab[320 + e] + (((c + 255) >> 8) << 8);
        for (int rr = st + bx * 512 + tid; rr < en; rr += G * 512) slotTok[rr] = 0; }
}
__device__ __forceinline__ void ph_moe_gu(LAS unsigned char* lds, int l) { PH_COMMON
    bf16* Hb = (bf16*)(ws + WS_PROJ + PJ_H);
    const int* slotTok = (const int*)(ws + WS_SMALL + SM_SLOTTOK);
    const LAS int* tab = (const LAS int*)(lds + LDS_CTL);
    LAS int* gtab = (LAS int*)(lds + LDS_X);
    __syncthreads();
    { const int nu = tab[0] * 2;
      for (int j = 0; j < 4; ++j) { const int L = j * G + bx; if (L >= nu) break; const int rb = L >> 1; if (tid < 256) gtab[j * 256 + tid] = slotTok[rb * 256 + tid]; } }
    __syncthreads();
    pg8::Gemm g{1024, 1024, 1024};
    MoeSched S{2, G, bx, tab, (const char*)XB, 0, (const char*)(wt + WT_GU), (size_t)512 * 1024 * 2, (size_t)256 * 1024 * 2};
    pg8::EpiSwiglu E{Hb, 256};
    pg8::gemm_phase_gather(lds, g, S, E, (const char*)XB, gtab);
}
__device__ __forceinline__ void ph_moe_dn(LAS unsigned char* lds, int l) { PH_COMMON
    bf16* Hb = (bf16*)(ws + WS_PROJ + PJ_H); bf16* YS = (bf16*)(ws + WS_PROJ + PJ_YS);
    const LAS int* tab = (const LAS int*)(lds + LDS_CTL);
    pg8::Gemm g{256, 256, 256};
    MoeSched S{4, G, bx, tab, (const char*)Hb, (size_t)256 * 256 * 2, (const char*)(wt + WT_DN), (size_t)1024 * 256 * 2, (size_t)256 * 256 * 2};
    pg8::EpiStore E{YS, 1024, 1.f};
    pg8::gemm_phase(lds, g, S, E);
}
__device__ __forceinline__ void ph_ln3(LAS unsigned char* lds, int l) { PH_COMMON
    float* tokW = (float*)(ws + WS_SMALL + SM_TOKW); int* tokS = (int*)(ws + WS_SMALL + SM_TOKS);
    bf16* YS = (bf16*)(ws + WS_PROJ + PJ_YS);
    const float* gg = ap->ln3_g + l * 1024; const float* bb = ap->ln3_b + l * 1024;
    float* out = ap->out;
    for (int row = gw; row < NTOK; row += NGW) {
        LnRow r; ln_load_bf16(r, XB + (size_t)row * 1024, lane, ALPHA);
        ln_add_bf16(r, YS + (size_t)tokS[row * 2] * 1024, lane, tokW[row * 2]); ln_add_bf16(r, YS + (size_t)tokS[row * 2 + 1] * 1024, lane, tokW[row * 2 + 1]);
        ln_normalize(r, gg, bb, lane);
        if (l == DEPTH - 1) ln_store_f32(r, out + (size_t)row * 1024, lane); else ln_store_bf16(r, XB + (size_t)row * 1024, lane);
    }
}

#define GSYNC() grid_barrier(lds)
template <int l> __device__ __forceinline__ void layer_body(LAS unsigned char* lds) {

        TMARK(0);
        if (PH_MASK & 2) { ph_proj(lds, l); ph_kv(lds, l); }
        if (REP_MASK & 2) { GSYNC(); ph_proj(lds, l); ph_kv(lds, l); }
        GSYNC();
        TMARK(1);
        if (PH_MASK & 4) { if (PROBE_MIX == 4) { ph_mix_probe(lds, l); GSYNC(); } ph_gdn_prep(lds, l); GSYNC(); TMARK(2); ph_gla_scan(lds, l); GSYNC(); TMARK(3); if (PROBE_MIX && PROBE_MIX != 4) { ph_mix_probe(lds, l); GSYNC(); } ph_mix(lds, l); }
        GSYNC();
        TMARK(4);
        if (PH_MASK & 8) ph_branch(lds, l);
        if (REP_MASK & 8) { GSYNC(); ph_branch(lds, l); }
        GSYNC();
        TMARK(5);
        if (PH_MASK & 16) ph_gate(lds, l);
        if (REP_MASK & 16) { GSYNC(); ph_gate(lds, l); }
        GSYNC();
        TMARK(6);
        if (PH_MASK & 32) ph_out(lds, l);
        if (REP_MASK & 32) { GSYNC(); ph_out(lds, l); }
        GSYNC();
        TMARK(7);
        if (PH_MASK & 64) ph_ln1(lds, l);
        if (REP_MASK & 64) { GSYNC(); ph_ln1(lds, l); }
        GSYNC();
        TMARK(8);
        if (PH_MASK & 128) ph_q(lds, l);
        if (REP_MASK & 128) { GSYNC(); ph_q(lds, l); }
        GSYNC();
        TMARK(9);
        if (PH_MASK & 256) ph_xattn(lds, l);
        if (REP_MASK & 256) { GSYNC(); ph_xattn(lds, l); }
        GSYNC();
        TMARK(10);
        if (PH_MASK & 512) ph_wo(lds, l);
        if (REP_MASK & 512) { GSYNC(); ph_wo(lds, l); }
        GSYNC();
        TMARK(11);
        if (REP_MASK & 1024) { ph_ln2_router(lds, l, 512); GSYNC(); }
        if (PH_MASK & 1024) ph_ln2_router(lds, l);
        GSYNC();
        TMARK(12);
        if (PH_MASK & 2048) ph_dispatch(lds, l);
        if (REP_MASK & 2048) { GSYNC(); ph_dispatch(lds, l); }
        GSYNC();
        TMARK(13);
        if (PH_MASK & 4096) ph_moe_gu(lds, l);
        if (REP_MASK & 4096) { GSYNC(); ph_moe_gu(lds, l); }
        GSYNC();
        TMARK(14);
        if (PH_MASK & 8192) ph_moe_dn(lds, l);
        if (REP_MASK & 8192) { GSYNC(); ph_moe_dn(lds, l); }
        GSYNC();
        TMARK(15);
        if (PH_MASK & 16384) ph_ln3(lds, l);
        if ((REP_MASK & 16384) && l == DEPTH - 1) { GSYNC(); ph_ln3(lds, l); }
        if (l + 1 < DEPTH) { if (PH_MASK & 1) ph_weights(lds, l + 1); GSYNC(); }
        TMARK(16);
}

__global__ void __launch_bounds__(512, 2) mega_fwd(Args A_unused) {
    extern __shared__ __attribute__((aligned(16))) unsigned char lds_raw[];
    LAS unsigned char* lds = (LAS unsigned char*)lds_raw;
    cg::grid_group grid = cg::this_grid();
    {
        volatile LAS unsigned* st = (volatile LAS unsigned*)(lds + LDS_CTL + 2048);
        if (threadIdx.x < 2) st[threadIdx.x] = 0u;
        if (threadIdx.x == 0) { unsigned* bar = (unsigned*)(argp()->ws + WS_CTL) + CW_BAR; (void)xb_add(&bar[XB_XCNT(xb_xcc_id())], 1u); }
        __syncthreads();
    }
    ph_input(lds);
    if (PH_MASK & 1) ph_weights(lds, 0);
    if (argp()->ws == nullptr) grid.sync();
    GSYNC();
    if (TIMER_A >= 0 || TIMER_B >= 0) { if (otid() < 2) ((volatile LAS unsigned*)(lds + LDS_CTL + 2800))[otid()] = 0u; }
    layer_body<0>(lds);
    layer_body<1>(lds);
    if (TIMER_A >= 0 || TIMER_B >= 0) {
        GSYNC();
        if (obid() == TIMER_WG) { volatile LAS unsigned* tw = (volatile LAS unsigned*)(lds + LDS_CTL + 2800); float* out = argp()->out;
            if (TIMER_A >= 0) { const int nz = (tw[0] / 100u > (unsigned)TIMER_T) ? 16000 : 0; for (int i = otid(); i < nz * 1024; i += 512) out[i] = 0.f; }
            if (TIMER_B >= 0 && otid() == 0) out[(size_t)NTOK * 1024 - 1] = (float)(tw[1] / 100u) * 0.25f; }
    }
}

extern "C" void kernel_launch(void* const* d_in, const int* in_sizes, int n_in, void* d_out, int out_size, void* d_ws, size_t ws_size, hipStream_t stream) {
    static int grid = 0;
    if (grid == 0) {
        if (n_in != 32 || out_size != NTOK * DM || ws_size < WS_END) { fprintf(stderr, "kernel_launch: unexpected shapes (n_in %d out %d ws %zu)\n", n_in, out_size, ws_size); grid = -1; return; }
        int dev = 0, cus = 0, per_cu = 0;
        hipGetDevice(&dev); hipDeviceGetAttribute(&cus, hipDeviceAttributeMultiprocessorCount, dev);
        hipFuncSetAttribute((const void*)mega_fwd, hipFuncAttributeMaxDynamicSharedMemorySize, LDS_BYTES);
        hipOccupancyMaxActiveBlocksPerMultiprocessor(&per_cu, (const void*)mega_fwd, 512, LDS_BYTES);
        (void)hipGetLastError();
        if (per_cu < 1) { fprintf(stderr, "kernel_launch: occupancy query says %d blocks per CU\n", per_cu); grid = -1; return; }
        grid = cus;
        if (grid < 192) { fprintf(stderr, "kernel_launch: too few CUs (%d)\n", grid); grid = -1; return; }
    }
    if (grid < 0) return;
    hipMemsetAsync((char*)d_ws + WS_CTL, 0, 1 * MiB, stream);
    Args a{};
    const float** p = (const float**)&a;
    for (int i = 0; i < 32; ++i) p[i] = (const float*)d_in[i];
    a.out = (float*)d_out; a.ws = (unsigned char*)d_ws;
    void* args[] = {&a};
    hipError_t e = hipLaunchCooperativeKernel((const void*)mega_fwd, dim3(grid), dim3(512), args, LDS_BYTES, stream);
    if (e != hipSuccess) fprintf(stderr, "cooperative launch failed: %s (grid %d)\n", hipGetErrorString(e), grid);
}
```

```cpp
#include <hip/hip_runtime.h>
#include <hip/hip_cooperative_groups.h>
#include <cstdio>
#include <cstdint>
namespace cg = cooperative_groups;

#define LAS __attribute__((address_space(3)))
typedef unsigned short bf16;
typedef short bf16x8 __attribute__((ext_vector_type(8)));
typedef short s16x4 __attribute__((ext_vector_type(4)));
typedef float f32x4 __attribute__((ext_vector_type(4)));
typedef float f32x2 __attribute__((ext_vector_type(2)));
typedef unsigned u32x4 __attribute__((ext_vector_type(4)));
typedef unsigned u32x2 __attribute__((ext_vector_type(2)));

#ifndef PH_MASK
#define PH_MASK 0xFFFFFFFFu
#endif
#ifndef REP_MASK
#define REP_MASK 0u
#endif
constexpr int DM = 1024, NB = 16, SEQ = 2048, NTOK = NB * SEQ, MEMLEN = 256, NMEM = NB * MEMLEN, DEPTH = 2;
constexpr int N_IN = 8224;
constexpr int LP = 5376;
constexpr int C_OA = 0;
constexpr int C_OB = 512;
constexpr int C_OC = 1024;
constexpr int C_GQ = 1536, C_GK = 2048, C_GV = 2560;
constexpr int C_FK = 3072, C_FV = 3584;
constexpr int C_LQ = 4096, C_LK = 4352, C_LV = 4608;
constexpr int C_SM = 5120;
constexpr int C_T = 1536;
constexpr int NWIN = 8448;
constexpr float ALPHA = 1.4142135623730951f;
constexpr float LOG2E = 1.4426950408889634f;
constexpr int MAXSLOT = 73728;
constexpr int MAXBLK = MAXSLOT / 256;

constexpr size_t MiB = 1u << 20;
constexpr size_t WS_CTL = 0;
constexpr size_t WS_WT = 1 * MiB;
constexpr size_t WT_WIN = 0;
constexpr size_t WT_P = WT_WIN + (size_t)NWIN * 1024 * 2;
constexpr size_t WT_WOUT3 = WT_P + 3u * 1024 * 512 * 2;
constexpr size_t WT_WQ = WT_WOUT3 + (size_t)1024 * 3072 * 2;
constexpr size_t WT_WKV = WT_WQ + (size_t)1024 * 1024 * 2;
constexpr size_t WT_WO = WT_WKV + (size_t)2048 * 1024 * 2;
constexpr size_t WT_GU = WT_WO + (size_t)1024 * 1024 * 2;
constexpr size_t WT_DN = WT_GU + (size_t)32 * 512 * 1024 * 2;
constexpr size_t WT_RWH = WT_DN + (size_t)32 * 1024 * 256 * 2;
constexpr size_t WT_RWL = WT_RWH + 48 * 1024 * 2;
constexpr size_t WT_END = WT_RWL + 48 * 1024 * 2;
static_assert(WT_END <= 82 * MiB, "WT");
constexpr size_t WS_XB = 83 * MiB;
constexpr size_t WS_PROJ = 147 * MiB;
constexpr size_t WS_SMALL = 483 * MiB;
constexpr size_t SM_TOKE = 0;
constexpr size_t SM_TOKW = SM_TOKE + (size_t)NTOK * 8;
constexpr size_t SM_TOKR = SM_TOKW + (size_t)NTOK * 8;
constexpr size_t SM_TOKS = SM_TOKR + (size_t)NTOK * 8;
constexpr size_t SM_SLOTTOK = SM_TOKS + (size_t)NTOK * 8;
constexpr size_t WS_KVS = 485 * MiB;
constexpr size_t WS_CDB = 511 * MiB;
constexpr size_t WS_END = 512 * MiB;
constexpr size_t PJ_Q = 0, PJ_O = 64 * MiB;
constexpr size_t PJ_XG = 0, PJ_H = 144 * MiB, PJ_YS = 180 * MiB;
constexpr size_t DO_Y = 0, DO_KV = 88 * MiB, DO_MEMB = 104 * MiB, DO_HALO = 112 * MiB;
constexpr size_t DO_CKG = 118 * MiB;
constexpr size_t DO_KVS = 82 * MiB;
constexpr size_t DO_GP = 0;
constexpr int GP_W = 0, GP_KDT = 16384, GP_ATT = 32768, GP_CD = 40960, GP_STRIDE = 41216;

constexpr int RING_BYTES = 131072;
constexpr int LDS_X = 131072;
constexpr int LDS_CTL = 147456;
constexpr int LDS_BYTES = 151552;

__device__ __forceinline__ int otid() { int t = threadIdx.x; asm volatile("" : "+v"(t)); return t; }
__device__ __forceinline__ int obid() { int t = blockIdx.x; asm volatile("" : "+s"(t)); return t; }
__device__ __forceinline__ int ogrid() { int t = gridDim.x; asm volatile("" : "+s"(t)); return t; }
__device__ __forceinline__ unsigned f2bf(float f) { unsigned u = __builtin_bit_cast(unsigned, f); return (u + 0x7fffu + ((u >> 16) & 1u)) >> 16; }
typedef __bf16 hwbf16x2 __attribute__((ext_vector_type(2)));
__device__ __forceinline__ unsigned pk2(float lo, float hi) { const f32x2 v = {lo, hi}; return __builtin_bit_cast(unsigned, __builtin_convertvector(v, hwbf16x2)); }
__device__ __forceinline__ float bf2f(unsigned short b) { return __builtin_bit_cast(float, (unsigned)b << 16); }
__device__ __forceinline__ float bflo(unsigned w) { return __builtin_bit_cast(float, w << 16); }
__device__ __forceinline__ float bfhi(unsigned w) { return __builtin_bit_cast(float, w & 0xffff0000u); }
template <int M> __device__ __forceinline__ float swz_xor(float v) { return __builtin_bit_cast(float, __builtin_amdgcn_ds_swizzle(__builtin_bit_cast(int, v), 0x1f | (M << 10))); }
__device__ __forceinline__ float half_sum(float v) { const unsigned b = __builtin_bit_cast(unsigned, v); auto r = __builtin_amdgcn_permlane32_swap(b, b, false, false); return __builtin_bit_cast(float, (unsigned)r[0]) + __builtin_bit_cast(float, (unsigned)r[1]); }
__device__ __forceinline__ float wave_sum(float v) {
    v += swz_xor<1>(v); v += swz_xor<2>(v); v += swz_xor<4>(v); v += swz_xor<8>(v); v += swz_xor<16>(v);
    return half_sum(v);
}
__device__ __forceinline__ float sigmoidf_(float x) { return __builtin_amdgcn_rcpf(1.f + __builtin_amdgcn_exp2f(-LOG2E * x)); }
__device__ __forceinline__ float siluf_(float x) { return x * __builtin_amdgcn_rcpf(1.f + __builtin_amdgcn_exp2f(-LOG2E * x)); }
__device__ __forceinline__ float softplusf_(float x) { return fmaxf(x, 0.f) + log1pf(__expf(-fabsf(x))); }
__device__ __forceinline__ float logsigmoidf_(float x) { return fminf(x, 0.f) - log1pf(__expf(-fabsf(x))); }

namespace pg8 {
constexpr int BM = 256, BK = 64, HALF = 128, HTB = HALF * BK * 2, STAGE_BYTES = 8 * HTB;
__host__ __device__ __forceinline__ int lds_byte(int r, int c) { const int st = (r >> 4) * 2 + (c >> 5), rr = r & 15, cc = c & 31, ob = rr * 64 + cc * 2; return st * 1024 + (ob ^ (((ob >> 9) & 1) << 5)); }
__host__ __device__ __forceinline__ void stage_rc(int b, int& R, int& C) { const int st = b / 1024, sb = b % 1024, swz = sb ^ (((sb >> 9) & 1) << 5); R = (st >> 1) * 16 + swz / 64; C = (st & 1) * 32 + (swz % 64) / 2; }
__host__ __device__ __forceinline__ int perm32(int rho) { const int n = rho >> 4, i = rho & 15; return 8 * (i >> 2) + 4 * n + (i & 3); }

struct Unit { const char* a; const char* b; int row0, col0, aux, aux2; };
struct Gemm { int lda, ldb, K; };

template <class Epi, class Sched>
__device__ __forceinline__ void gemm_phase(LAS unsigned char* lds, const Gemm g, const Sched& S, const Epi& E) {
    const int tid = otid(), wid = __builtin_amdgcn_readfirstlane(tid >> 6), lane = tid & 63, wr = wid >> 2, wc = wid & 3, fr = lane & 15, fq = lane >> 4;
    int K = g.K; asm volatile("" : "+s"(K)); const int nt = K / BK;
    unsigned voffA[2], voffB[2];
#pragma unroll
    for (int i = 0; i < 2; ++i) { int R, C; stage_rc(tid * 16 + i * 8192, R, C); const int Rb = Epi::PERM ? ((R & ~31) + perm32(R & 31)) : R;
        voffA[i] = (unsigned)(R * g.lda + C) * 2u; voffB[i] = (unsigned)(Rb * g.ldb + C) * 2u; }
    const size_t kstep = (size_t)(BK * 2);
    const size_t hstepA = (size_t)HALF * g.lda * 2, hstepB = (size_t)HALF * g.ldb * 2;
    const unsigned ldsw = (unsigned)wid * 1024u;
    const int aoff = lds_byte(wr * 64 + fr, fq * 8), boff = lds_byte(wc * 32 + fr, fq * 8);
#define PG8_SA(b, h) (((b) * 2 + (h)) * HTB)
#define PG8_SB(b, h) ((4 + (b) * 2 + (h)) * HTB)
#define PG8_STAGE(bufoff, gbase, voff) do { _Pragma("unroll") for (int _i = 0; _i < 2; ++_i) \
        __builtin_amdgcn_global_load_lds((const unsigned*)((const char*)(gbase) + (voff)[_i]), (LAS unsigned*)(lds + (bufoff) + ldsw + _i * 8192), 16, 0, 0); } while (0)
#define PG8_LDA(dst, b, h) do { _Pragma("unroll") for (int m = 0; m < 4; ++m) _Pragma("unroll") for (int k = 0; k < 2; ++k) dst[m][k] = *(const LAS bf16x8*)(lds + PG8_SA(b, h) + aoff + m * 2048 + k * 1024); } while (0)
#define PG8_LDB(dst, b, h) do { _Pragma("unroll") for (int n = 0; n < 2; ++n) _Pragma("unroll") for (int k = 0; k < 2; ++k) dst[n][k] = *(const LAS bf16x8*)(lds + PG8_SB(b, h) + boff + n * 2048 + k * 1024); } while (0)
#define PG8_MMA(ai, bj, At, Bt) do { __builtin_amdgcn_s_setprio(1); _Pragma("unroll") for (int m = 0; m < 4; ++m) _Pragma("unroll") for (int n = 0; n < 2; ++n) _Pragma("unroll") for (int k = 0; k < 2; ++k) \
        acc[ai][bj][m][n] = __builtin_amdgcn_mfma_f32_16x16x32_bf16(Bt[n][k], At[m][k], acc[ai][bj][m][n], 0, 0, 0); __builtin_amdgcn_s_setprio(0); } while (0)
#define PG8_WAIT_V(n) asm volatile("s_waitcnt vmcnt(" #n ")" ::: "memory")
#define PG8_WAIT_L(n) asm volatile("s_waitcnt lgkmcnt(" #n ")" ::: "memory")
#define PG8_BAR __builtin_amdgcn_s_barrier()
#define PG8_SCHED __builtin_amdgcn_sched_barrier(0)
    Unit cur, nxt; int ui = 0;
    if (!S.next(0, cur)) return;
    f32x4 acc[2][2][4][2];
#pragma unroll
    for (int a = 0; a < 2; ++a)
#pragma unroll
        for (int b = 0; b < 2; ++b)
#pragma unroll
            for (int m = 0; m < 4; ++m)
#pragma unroll
                for (int n = 0; n < 2; ++n) acc[a][b][m][n] = (f32x4){0.f, 0.f, 0.f, 0.f};
    bf16x8 At[4][2], B0[2][2], B1[2][2];
    const char* cA = cur.a; const char* cB = cur.b;
    PG8_STAGE(PG8_SB(0, 0), cB, voffB); PG8_STAGE(PG8_SB(0, 1), cB + hstepB, voffB); PG8_STAGE(PG8_SA(0, 0), cA, voffA); PG8_STAGE(PG8_SA(0, 1), cA + hstepA, voffA);
    if (wr == 1) PG8_BAR;
    PG8_WAIT_V(2); PG8_BAR;
    PG8_STAGE(PG8_SB(1, 0), cB + kstep, voffB); PG8_STAGE(PG8_SA(1, 0), cA + kstep, voffA); PG8_STAGE(PG8_SB(1, 1), cB + hstepB + kstep, voffB);
    PG8_WAIT_V(6); PG8_BAR;
    for (;;) {
        const bool has_next = S.next(ui + 1, nxt);
        const char* nA = has_next ? nxt.a : cA; const char* nB = has_next ? nxt.b : cB;
        for (int t = 0; t < nt; t += 2) {
            const bool last = (t == nt - 2);
            const char* a1 = cA + (size_t)(t + 1) * kstep;
            const char* a2 = last ? nA : cA + (size_t)(t + 2) * kstep; const char* b2 = last ? nB : cB + (size_t)(t + 2) * kstep;
            const char* a3 = a2 + kstep; const char* b3 = b2 + kstep;
            PG8_LDB(B0, 0, 0); PG8_LDB(B1, 0, 1); PG8_SCHED; PG8_LDA(At, 0, 0); PG8_STAGE(PG8_SA(1, 1), a1 + hstepA, voffA);
            PG8_WAIT_V(8); PG8_WAIT_L(0); PG8_BAR; PG8_MMA(0, 0, At, B0); PG8_MMA(0, 1, At, B1); PG8_BAR; PG8_SCHED;
            PG8_LDA(At, 0, 1); PG8_STAGE(PG8_SB(0, 0), b2, voffB); PG8_STAGE(PG8_SB(0, 1), b2 + hstepB, voffB); PG8_STAGE(PG8_SA(0, 0), a2, voffA);
            PG8_WAIT_V(8); PG8_WAIT_L(0); PG8_BAR; PG8_MMA(1, 0, At, B0); PG8_MMA(1, 1, At, B1); PG8_BAR; PG8_SCHED;
            PG8_LDB(B0, 1, 0); PG8_LDB(B1, 1, 1); PG8_SCHED; PG8_LDA(At, 1, 0); PG8_STAGE(PG8_SA(0, 1), a2 + hstepA, voffA);
            PG8_WAIT_V(8); PG8_WAIT_L(0); PG8_BAR; PG8_MMA(0, 0, At, B0); PG8_MMA(0, 1, At, B1); PG8_BAR; PG8_SCHED;
            PG8_LDA(At, 1, 1); PG8_STAGE(PG8_SB(1, 0), b3, voffB); PG8_STAGE(PG8_SB(1, 1), b3 + hstepB, voffB); PG8_STAGE(PG8_SA(1, 0), a3, voffA);
            PG8_WAIT_V(8); PG8_WAIT_L(0); PG8_BAR; PG8_MMA(1, 0, At, B0); PG8_MMA(1, 1, At, B1); PG8_BAR; PG8_SCHED;
        }
        if (wr == 0) PG8_BAR;
        E(acc, cur, wr, wc, fr, fq);
        if (!has_next) break;
#pragma unroll
        for (int a = 0; a < 2; ++a)
#pragma unroll
            for (int b = 0; b < 2; ++b)
#pragma unroll
                for (int m = 0; m < 4; ++m)
#pragma unroll
                    for (int n = 0; n < 2; ++n) acc[a][b][m][n] = (f32x4){0.f, 0.f, 0.f, 0.f};
        cur = nxt; cA = nA; cB = nB; ++ui;
        if (wr == 1) PG8_BAR;
    }
    PG8_WAIT_V(0);
    PG8_BAR;
#undef PG8_SA
#undef PG8_SB
#undef PG8_STAGE
#undef PG8_LDA
#undef PG8_LDB
#undef PG8_MMA
#undef PG8_WAIT_V
#undef PG8_WAIT_L
#undef PG8_BAR
#undef PG8_SCHED
}

template <class Epi, class Sched>
__device__ __forceinline__ void gemm_phase_gather(LAS unsigned char* lds, const Gemm g, const Sched& S, const Epi& E, const char* xbase, const LAS int* gtab) {
    const int tid = otid(), wid = __builtin_amdgcn_readfirstlane(tid >> 6), lane = tid & 63, wr = wid >> 2, wc = wid & 3, fr = lane & 15, fq = lane >> 4;
    int K = g.K; asm volatile("" : "+s"(K)); const int nt = K / BK;
    unsigned voffA[2], voffB[2], cofs[2];
#pragma unroll
    for (int i = 0; i < 2; ++i) { int R, C; stage_rc(tid * 16 + i * 8192, R, C); const int Rb = Epi::PERM ? ((R & ~31) + perm32(R & 31)) : R;
        voffA[i] = (unsigned)R; voffB[i] = (unsigned)(Rb * g.ldb + C) * 2u; cofs[i] = (unsigned)C * 2u; }
    const size_t kstep = (size_t)(BK * 2);
    const size_t hstepA = (size_t)HALF * g.lda * 2, hstepB = (size_t)HALF * g.ldb * 2;
    const unsigned ldsw = (unsigned)wid * 1024u;
    const int aoff = lds_byte(wr * 64 + fr, fq * 8), boff = lds_byte(wc * 32 + fr, fq * 8);
#define PG8_SA(b, h) (((b) * 2 + (h)) * HTB)
#define PG8_SB(b, h) ((4 + (b) * 2 + (h)) * HTB)
#define PG8_STAGE(bufoff, gbase, voff) do { _Pragma("unroll") for (int _i = 0; _i < 2; ++_i) \
        __builtin_amdgcn_global_load_lds((const unsigned*)((const char*)(gbase) + (voff)[_i]), (LAS unsigned*)(lds + (bufoff) + ldsw + _i * 8192), 16, 0, 0); } while (0)
#define PG8_LDA(dst, b, h) do { _Pragma("unroll") for (int m = 0; m < 4; ++m) _Pragma("unroll") for (int k = 0; k < 2; ++k) dst[m][k] = *(const LAS bf16x8*)(lds + PG8_SA(b, h) + aoff + m * 2048 + k * 1024); } while (0)
#define PG8_LDB(dst, b, h) do { _Pragma("unroll") for (int n = 0; n < 2; ++n) _Pragma("unroll") for (int k = 0; k < 2; ++k) dst[n][k] = *(const LAS bf16x8*)(lds + PG8_SB(b, h) + boff + n * 2048 + k * 1024); } while (0)
#define PG8_MMA(ai, bj, At, Bt) do { __builtin_amdgcn_s_setprio(1); _Pragma("unroll") for (int m = 0; m < 4; ++m) _Pragma("unroll") for (int n = 0; n < 2; ++n) _Pragma("unroll") for (int k = 0; k < 2; ++k) \
        acc[ai][bj][m][n] = __builtin_amdgcn_mfma_f32_16x16x32_bf16(Bt[n][k], At[m][k], acc[ai][bj][m][n], 0, 0, 0); __builtin_amdgcn_s_setprio(0); } while (0)
#define PG8_WAIT_V(n) asm volatile("s_waitcnt vmcnt(" #n ")" ::: "memory")
#define PG8_WAIT_L(n) asm volatile("s_waitcnt lgkmcnt(" #n ")" ::: "memory")
#define PG8_BAR __builtin_amdgcn_s_barrier()
#define PG8_SCHED __builtin_amdgcn_sched_barrier(0)
    Unit cur, nxt; int ui = 0;
    if (!S.next(0, cur)) return;
    f32x4 acc[2][2][4][2];
#pragma unroll
    for (int a = 0; a < 2; ++a)
#pragma unroll
        for (int b = 0; b < 2; ++b)
#pragma unroll
            for (int m = 0; m < 4; ++m)
#pragma unroll
                for (int n = 0; n < 2; ++n) acc[a][b][m][n] = (f32x4){0.f, 0.f, 0.f, 0.f};
    bf16x8 At[4][2], B0[2][2], B1[2][2];
    const char* cB = cur.b;
    unsigned gC[2][2], gN[2][2];
#define PG8_GOFF(dst, un) do { _Pragma("unroll") for (int h_ = 0; h_ < 2; ++h_) _Pragma("unroll") for (int i_ = 0; i_ < 2; ++i_) dst[h_][i_] = (unsigned)gtab[(un).aux2 * 256 + h_ * 128 + (int)voffA[i_]] * (unsigned)(g.lda * 2) + cofs[i_]; } while (0)
    PG8_GOFF(gC, cur);
    PG8_STAGE(PG8_SB(0, 0), cB, voffB); PG8_STAGE(PG8_SB(0, 1), cB + hstepB, voffB); PG8_STAGE(PG8_SA(0, 0), xbase, gC[0]); PG8_STAGE(PG8_SA(0, 1), xbase, gC[1]);
    if (wr == 1) PG8_BAR;
    PG8_WAIT_V(2); PG8_BAR;
    PG8_STAGE(PG8_SB(1, 0), cB + kstep, voffB); PG8_STAGE(PG8_SA(1, 0), xbase + kstep, gC[0]); PG8_STAGE(PG8_SB(1, 1), cB + hstepB + kstep, voffB);
    PG8_WAIT_V(6); PG8_BAR;
    for (;;) {
        const bool has_next = S.next(ui + 1, nxt);
        const char* nB = has_next ? nxt.b : cB;
        if (has_next) { PG8_GOFF(gN, nxt); } else { gN[0][0] = gC[0][0]; gN[0][1] = gC[0][1]; gN[1][0] = gC[1][0]; gN[1][1] = gC[1][1]; }
        for (int t = 0; t < nt; t += 2) {
            const bool last = (t == nt - 2);
            const char* a1 = xbase + (size_t)(t + 1) * kstep;
            const char* a2 = last ? xbase : xbase + (size_t)(t + 2) * kstep; const char* b2 = last ? nB : cB + (size_t)(t + 2) * kstep;
            const char* a3 = a2 + kstep; const char* b3 = b2 + kstep;
            unsigned g2[2][2];
            g2[0][0] = last ? gN[0][0] : gC[0][0]; g2[0][1] = last ? gN[0][1] : gC[0][1]; g2[1][0] = last ? gN[1][0] : gC[1][0]; g2[1][1] = last ? gN[1][1] : gC[1][1];
            PG8_LDB(B0, 0, 0); PG8_LDB(B1, 0, 1); PG8_SCHED; PG8_LDA(At, 0, 0); PG8_STAGE(PG8_SA(1, 1), a1, gC[1]);
            PG8_WAIT_V(8); PG8_WAIT_L(0); PG8_BAR; PG8_MMA(0, 0, At, B0); PG8_MMA(0, 1, At, B1); PG8_BAR; PG8_SCHED;
            PG8_LDA(At, 0, 1); PG8_STAGE(PG8_SB(0, 0), b2, voffB); PG8_STAGE(PG8_SB(0, 1), b2 + hstepB, voffB); PG8_STAGE(PG8_SA(0, 0), a2, g2[0]);
            PG8_WAIT_V(8); PG8_WAIT_L(0); PG8_BAR; PG8_MMA(1, 0, At, B0); PG8_MMA(1, 1, At, B1); PG8_BAR; PG8_SCHED;
            PG8_LDB(B0, 1, 0); PG8_LDB(B1, 1, 1); PG8_SCHED; PG8_LDA(At, 1, 0); PG8_STAGE(PG8_SA(0, 1), a2, g2[1]);
            PG8_WAIT_V(8); PG8_WAIT_L(0); PG8_BAR; PG8_MMA(0, 0, At, B0); PG8_MMA(0, 1, At, B1); PG8_BAR; PG8_SCHED;
            PG8_LDA(At, 1, 1); PG8_STAGE(PG8_SB(1, 0), b3, voffB); PG8_STAGE(PG8_SB(1, 1), b3 + hstepB, voffB); PG8_STAGE(PG8_SA(1, 0), a3, g2[0]);
            PG8_WAIT_V(8); PG8_WAIT_L(0); PG8_BAR; PG8_MMA(1, 0, At, B0); PG8_MMA(1, 1, At, B1); PG8_BAR; PG8_SCHED;
        }
        if (wr == 0) PG8_BAR;
        E(acc, cur, wr, wc, fr, fq);
        if (!has_next) break;
#pragma unroll
        for (int a = 0; a < 2; ++a)
#pragma unroll
            for (int b = 0; b < 2; ++b)
#pragma unroll
                for (int m = 0; m < 4; ++m)
#pragma unroll
                    for (int n = 0; n < 2; ++n) acc[a][b][m][n] = (f32x4){0.f, 0.f, 0.f, 0.f};
        cur = nxt; cB = nB; ++ui;
        gC[0][0] = gN[0][0]; gC[0][1] = gN[0][1]; gC[1][0] = gN[1][0]; gC[1][1] = gN[1][1];
        if (wr == 1) PG8_BAR;
    }
    PG8_WAIT_V(0);
    PG8_BAR;
#undef PG8_GOFF
#undef PG8_SA
#undef PG8_SB
#undef PG8_STAGE
#undef PG8_LDA
#undef PG8_LDB
#undef PG8_MMA
#undef PG8_WAIT_V
#undef PG8_WAIT_L
#undef PG8_BAR
#undef PG8_SCHED
}

#define EPI_LOOP_BEGIN \
    _Pragma("unroll") for (int ai = 0; ai < 2; ++ai) _Pragma("unroll") for (int m = 0; m < 4; ++m) { const int row = u.row0 + ai * HALF + wr * 64 + m * 16 + fr; \
    _Pragma("unroll") for (int bj = 0; bj < 2; ++bj) { const int col = u.col0 + bj * HALF + wc * 32 + 8 * fq; const f32x4 v0 = acc[ai][bj][m][0], v1 = acc[ai][bj][m][1];
#define EPI_LOOP_END } }

struct EpiStore {
    static constexpr bool PERM = true;
    bf16* O; int ldc; float scale;
    __device__ __forceinline__ void operator()(const f32x4 (&acc)[2][2][4][2], const Unit& u, int wr, int wc, int fr, int fq) const {
        EPI_LOOP_BEGIN
            u32x4 w; w.x = pk2(v0[0] * scale, v0[1] * scale); w.y = pk2(v0[2] * scale, v0[3] * scale); w.z = pk2(v1[0] * scale, v1[1] * scale); w.w = pk2(v1[2] * scale, v1[3] * scale);
            *(u32x4*)(O + (size_t)row * ldc + col) = w;
        EPI_LOOP_END
    }
};
struct EpiProj {
    static constexpr bool PERM = true;
    bf16* O; int ldc; bf16* halo;
    __device__ __forceinline__ void operator()(const f32x4 (&acc)[2][2][4][2], const Unit& u, int wr, int wc, int fr, int fq) const {
        const bool hz = (u.col0 >= C_GQ) && (u.col0 < C_GQ + 1536);
        const float sc = (u.col0 >= C_OB && u.col0 < C_OB + 512) ? 0.125f * LOG2E : 1.f;
        EPI_LOOP_BEGIN
            u32x4 w; w.x = pk2(v0[0] * sc, v0[1] * sc); w.y = pk2(v0[2] * sc, v0[3] * sc); w.z = pk2(v1[0] * sc, v1[1] * sc); w.w = pk2(v1[2] * sc, v1[3] * sc);
            *(u32x4*)(O + (size_t)row * ldc + col) = w;
            if (hz && m == 3 && fr >= 13) *(u32x4*)(halo + ((size_t)(row >> 6) * 3 + (fr - 13)) * 1536 + (col - C_GQ)) = w;
        EPI_LOOP_END
    }
};
struct EpiGate {
    static constexpr bool PERM = true;
    bf16* PJ; int ldc; const float* bias;
    __device__ __forceinline__ void operator()(const f32x4 (&acc)[2][2][4][2], const Unit& u, int wr, int wc, int fr, int fq) const {
        const bool first = u.aux < 1024;
        f32x4 bv[2][2];
#pragma unroll
        for (int bj = 0; bj < 2; ++bj) { const int gc = u.aux + bj * HALF + wc * 32 + 8 * fq; bv[bj][0] = *(const f32x4*)(bias + gc); bv[bj][1] = *(const f32x4*)(bias + gc + 4); }
#pragma unroll
        for (int ai = 0; ai < 2; ++ai) {
            u32x4 tv[4][2], mv[4][2];
#pragma unroll
            for (int m = 0; m < 4; ++m)
#pragma unroll
                for (int bj = 0; bj < 2; ++bj) { const size_t ro = (size_t)(u.row0 + ai * HALF + wr * 64 + m * 16 + fr) * ldc; const int cc = bj * HALF + wc * 32 + 8 * fq;
                    tv[m][bj] = *(const u32x4*)(PJ + ro + C_T + u.aux + cc);
                    if (!first) mv[m][bj] = *(const u32x4*)(PJ + ro + u.col0 + cc); else mv[m][bj] = (u32x4){0u, 0u, 0u, 0u}; }
#pragma unroll
            for (int m = 0; m < 4; ++m)
#pragma unroll
                for (int bj = 0; bj < 2; ++bj) { const size_t ro = (size_t)(u.row0 + ai * HALF + wr * 64 + m * 16 + fr) * ldc; const int cc = bj * HALF + wc * 32 + 8 * fq;
                    const f32x4 v0 = acc[ai][bj][m][0], v1 = acc[ai][bj][m][1]; const f32x4 b0 = bv[bj][0], b1 = bv[bj][1]; const u32x4 t = tv[m][bj], mm = mv[m][bj];
                    u32x4 w;
                    w.x = pk2(bflo(mm.x) + sigmoidf_(v0[0] + b0[0]) * bflo(t.x), bfhi(mm.x) + sigmoidf_(v0[1] + b0[1]) * bfhi(t.x));
                    w.y = pk2(bflo(mm.y) + sigmoidf_(v0[2] + b0[2]) * bflo(t.y), bfhi(mm.y) + sigmoidf_(v0[3] + b0[3]) * bfhi(t.y));
                    w.z = pk2(bflo(mm.z) + sigmoidf_(v1[0] + b1[0]) * bflo(t.z), bfhi(mm.z) + sigmoidf_(v1[1] + b1[1]) * bfhi(t.z));
                    w.w = pk2(bflo(mm.w) + sigmoidf_(v1[2] + b1[2]) * bflo(t.w), bfhi(mm.w) + sigmoidf_(v1[3] + b1[3]) * bfhi(t.w));
                    *(u32x4*)(PJ + ro + u.col0 + cc) = w; }
        }
    }
};
struct EpiResid {
    static constexpr bool PERM = true;
    const bf16* X; bf16* Y; int ldc;
    __device__ __forceinline__ void operator()(const f32x4 (&acc)[2][2][4][2], const Unit& u, int wr, int wc, int fr, int fq) const {
#pragma unroll
        for (int ai = 0; ai < 2; ++ai) {
            u32x4 xv[4][2];
#pragma unroll
            for (int m = 0; m < 4; ++m)
#pragma unroll
                for (int bj = 0; bj < 2; ++bj) xv[m][bj] = *(const u32x4*)(X + (size_t)(u.row0 + ai * HALF + wr * 64 + m * 16 + fr) * ldc + u.col0 + bj * HALF + wc * 32 + 8 * fq);
#pragma unroll
            for (int m = 0; m < 4; ++m)
#pragma unroll
                for (int bj = 0; bj < 2; ++bj) { const f32x4 v0 = acc[ai][bj][m][0], v1 = acc[ai][bj][m][1]; const u32x4 t = xv[m][bj];
                    u32x4 w;
                    w.x = pk2(ALPHA * bflo(t.x) + v0[0], ALPHA * bfhi(t.x) + v0[1]); w.y = pk2(ALPHA * bflo(t.y) + v0[2], ALPHA * bfhi(t.y) + v0[3]);
                    w.z = pk2(ALPHA * bflo(t.z) + v1[0], ALPHA * bfhi(t.z) + v1[1]); w.w = pk2(ALPHA * bflo(t.w) + v1[2], ALPHA * bfhi(t.w) + v1[3]);
                    *(u32x4*)(Y + (size_t)(u.row0 + ai * HALF + wr * 64 + m * 16 + fr) * ldc + u.col0 + bj * HALF + wc * 32 + 8 * fq) = w; }
        }
    }
};
struct EpiSwiglu {
    static constexpr bool PERM = true;
    bf16* H; int ldc;
    __device__ __forceinline__ void operator()(const f32x4 (&acc)[2][2][4][2], const Unit& u, int wr, int wc, int fr, int fq) const {
        EPI_LOOP_BEGIN
            u32x2 w; w.x = pk2(siluf_(v0[0]) * v1[0], siluf_(v0[1]) * v1[1]); w.y = pk2(siluf_(v0[2]) * v1[2], siluf_(v0[3]) * v1[3]);
            *(u32x2*)(H + (size_t)row * ldc + (col >> 1)) = w;
        EPI_LOOP_END
    }
};
}

struct Args {
    const float* x; const float* mem; const float* w_in; const float* gdn_conv_w; const float* gdn_a_log; const float* gdn_dt_bias; const float* gdn_norm_w; const float* fox_f_bias;
    const float* gla_w_gate2; const float* gla_b_gate; const float* gla_norm_w; const float* p_gdn; const float* p_fox; const float* p_gla; const float* b_merge; const float* w_out;
    const float* ln1_g; const float* ln1_b; const float* xa_wq; const float* xa_wkv; const float* xa_wo; const float* ln2_g; const float* ln2_b;
    const float* moe_w_group; const float* moe_b_group; const float* moe_w_expert; const float* moe_b_expert; const float* moe_w_gate; const float* moe_w_up; const float* moe_w_down;
    const float* ln3_g; const float* ln3_b;
    float* out; unsigned char* ws;
};

typedef const __attribute__((address_space(4))) Args* KArgP;

__device__ __forceinline__ int tr_srccol(int mode, int c0, int n) {
    if (mode != 3) return c0 + n;
    return n < 4 ? 1536 + n : n < 8 ? 1540 + (n - 4) : n < 16 ? 3592 + (n - 8) : 5136 + (n - 16);
}
__device__ __forceinline__ int tr_dstrow(int mode, int r0, int nn) {
    if (mode == 1) return r0 + 8 * (nn >> 2) + (nn & 3);
    if (mode == 2) return r0 + 8 * (nn >> 2) + 4 + (nn & 3);
    return r0 + nn;
}
__device__ __forceinline__ void tr_item(const float* W, int ldw, int c0, int ncols, bf16* T, int ldt, int r0, int koff, int mode, LAS float* scr, int item, int lane) {
    const int nblk = ncols / 32, kb = item / nblk, nb = item % nblk, k0 = 64 * kb, n0 = 32 * nb;
    if (mode != 3) {
        const int sc4 = c0 + n0 + 4 * (lane & 7);
#pragma unroll
        for (int i = 0; i < 8; ++i) { const int kk = 8 * i + (lane >> 3); const f32x4 v = *(const f32x4*)(W + (size_t)(k0 + kk) * ldw + sc4);
            LAS float* d = scr + kk * 33 + 4 * (lane & 7); d[0] = v[0]; d[1] = v[1]; d[2] = v[2]; d[3] = v[3]; }
    } else {
        const int sc = tr_srccol(mode, c0, n0 + (lane & 31));
#pragma unroll 8
        for (int i = 0; i < 32; ++i) { const int kk = 2 * i + (lane >> 5); scr[kk * 33 + (lane & 31)] = W[(size_t)(k0 + kk) * ldw + sc]; }
    }
    asm volatile("s_waitcnt lgkmcnt(0)" ::: "memory");
    const int c = lane & 7;
#pragma unroll
    for (int j = 0; j < 4; ++j) { const int n = (lane >> 3) + 8 * j; const LAS float* s = scr + (8 * c) * 33 + n;
        u32x4 o; o.x = pk2(s[0 * 33], s[1 * 33]); o.y = pk2(s[2 * 33], s[3 * 33]); o.z = pk2(s[4 * 33], s[5 * 33]); o.w = pk2(s[6 * 33], s[7 * 33]);
        *(u32x4*)(T + (size_t)tr_dstrow(mode, r0, n0 + n) * ldt + koff + k0 + 8 * c) = o; }
    asm volatile("s_waitcnt lgkmcnt(0)" ::: "memory");
}
__device__ __forceinline__ void tr_job(const float* W, int ldw, int K, int c0, int ncols, size_t wstride, bf16* T, int ldt, int r0, int koff, int mode, size_t tstride, int nmat,
                                       LAS float* scr, int lane, int gw, int NGW, int& run) {
    const int per = (K / 64) * (ncols / 32), n = per * nmat;
    int first = gw - (run % NGW); if (first < 0) first += NGW;
    for (int it = first; it < n; it += NGW) { const int e = it / per, li = it % per; tr_item(W + (size_t)e * wstride, ldw, c0, ncols, T + (size_t)e * tstride, ldt, r0, koff, mode, scr, li, lane); }
    run += n;
}
__device__ __forceinline__ void phase_convert_weights(KArgP A, int l, LAS unsigned char* lds) {
    const int tid = otid(), lane = tid & 63, wid = tid >> 6;
    LAS float* scr = (LAS float*)(lds + wid * 16384);
    const int gw = obid() * 8 + wid, NGW = ogrid() * 8; int run = 0;
    unsigned char* wt = A->ws + WS_WT;
    bf16* WIN = (bf16*)(wt + WT_WIN);
    const float* w_in = A->w_in + (size_t)l * 1024 * N_IN;
    tr_job(w_in, N_IN, 1024, 1544, 512, 0, WIN, 1024, C_OA, 0, 0, 0, 1, scr, lane, gw, NGW, run);
    tr_job(w_in, N_IN, 1024, 2056, 512, 0, WIN, 1024, C_OB, 0, 0, 0, 1, scr, lane, gw, NGW, run);
    tr_job(w_in, N_IN, 1024, 4624, 512, 0, WIN, 1024, C_OC, 0, 0, 0, 1, scr, lane, gw, NGW, run);
    tr_job(w_in, N_IN, 1024, 0, 1536, 0, WIN, 1024, C_GQ, 0, 0, 0, 1, scr, lane, gw, NGW, run);
    tr_job(w_in, N_IN, 1024, 2568, 1024, 0, WIN, 1024, C_FK, 0, 0, 0, 1, scr, lane, gw, NGW, run);
    tr_job(w_in, N_IN, 1024, 3600, 1024, 0, WIN, 1024, C_LQ, 0, 0, 0, 1, scr, lane, gw, NGW, run);
    tr_job(w_in, N_IN, 1024, 0, 32, 0, WIN, 1024, C_SM, 0, 3, 0, 1, scr, lane, gw, NGW, run);
    tr_job(w_in, N_IN, 1024, 5152, 3072, 0, WIN, 1024, LP, 0, 0, 0, 1, scr, lane, gw, NGW, run);
    { u32x4 z = {0u, 0u, 0u, 0u}; asm volatile("" : "+v"(z)); u32x4* p = (u32x4*)(WIN + (size_t)5152 * 1024); const int n16 = 224 * 1024 * 2 / 16;
      for (int i = obid() * 512 + tid; i < n16; i += ogrid() * 512) p[i] = z; }
    bf16* PT = (bf16*)(wt + WT_P);
    tr_job(A->p_gdn + (size_t)l * 512 * 1024, 1024, 512, 0, 1024, 0, PT, 512, 0, 0, 0, 0, 1, scr, lane, gw, NGW, run);
    tr_job(A->p_fox + (size_t)l * 512 * 1024, 1024, 512, 0, 1024, 0, PT + 1024 * 512, 512, 0, 0, 0, 0, 1, scr, lane, gw, NGW, run);
    tr_job(A->p_gla + (size_t)l * 512 * 1024, 1024, 512, 0, 1024, 0, PT + 2 * 1024 * 512, 512, 0, 0, 0, 0, 1, scr, lane, gw, NGW, run);
    bf16* WO3 = (bf16*)(wt + WT_WOUT3);
    tr_job(A->w_out + (size_t)l * 1024 * 1024, 1024, 1024, 0, 1024, 0, WO3, 1024, 0, 0, 0, 0, 1, scr, lane, gw, NGW, run);
    tr_job(A->xa_wq + (size_t)l * 1024 * 1024, 1024, 1024, 0, 1024, 0, (bf16*)(wt + WT_WQ), 1024, 0, 0, 0, 0, 1, scr, lane, gw, NGW, run);
    tr_job(A->xa_wkv + (size_t)l * 1024 * 2048, 2048, 1024, 0, 2048, 0, (bf16*)(wt + WT_WKV), 1024, 0, 0, 0, 0, 1, scr, lane, gw, NGW, run);
    tr_job(A->xa_wo + (size_t)l * 1024 * 1024, 1024, 1024, 0, 1024, 0, (bf16*)(wt + WT_WO), 1024, 0, 0, 0, 0, 1, scr, lane, gw, NGW, run);
    tr_job(A->moe_w_gate + (size_t)l * 32 * 1024 * 256, 256, 1024, 0, 256, (size_t)1024 * 256, (bf16*)(wt + WT_GU), 1024, 0, 0, 1, (size_t)512 * 1024, 32, scr, lane, gw, NGW, run);
    tr_job(A->moe_w_up + (size_t)l * 32 * 1024 * 256, 256, 1024, 0, 256, (size_t)1024 * 256, (bf16*)(wt + WT_GU), 1024, 0, 0, 2, (size_t)512 * 1024, 32, scr, lane, gw, NGW, run);
    tr_job(A->moe_w_down + (size_t)l * 32 * 256 * 1024, 1024, 256, 0, 1024, (size_t)256 * 1024, (bf16*)(wt + WT_DN), 256, 0, 0, 0, (size_t)1024 * 256, 32, scr, lane, gw, NGW, run);
    {
        const float* wg = A->moe_w_group + (size_t)l * 1024 * 4; const float* we = A->moe_w_expert + (size_t)l * 1024 * 32;
        bf16* RH = (bf16*)(wt + WT_RWH); bf16* RL = (bf16*)(wt + WT_RWL);
        for (int i = obid() * 512 + tid; i < 48 * 1024; i += ogrid() * 512) { const int n = i >> 10, k = i & 1023;
            const float w = n < 4 ? wg[k * 4 + n] : n < 36 ? we[k * 32 + (n - 4)] : 0.f; const unsigned h = f2bf(w); RH[i] = (bf16)h; RL[i] = (bf16)f2bf(w - bf2f((unsigned short)h)); }
    }
}
__device__ __forceinline__ void convert_rows(const float* src, bf16* dst, size_t n) {
    const size_t n8 = n / 8;
    for (size_t i = (size_t)obid() * 512 + otid(); i < n8; i += (size_t)ogrid() * 512) {
        const f32x4 a = *(const f32x4*)(src + i * 8), b = *(const f32x4*)(src + i * 8 + 4);
        u32x4 w; w.x = pk2(a[0], a[1]); w.y = pk2(a[2], a[3]); w.z = pk2(b[0], b[1]); w.w = pk2(b[2], b[3]);
        *(u32x4*)(dst + i * 8) = w;
    }
}

struct RegSched {
    int nM, nN, nwg, G, c; const char* A; const char* B; size_t astride, bstride; int col_base;
    __device__ __forceinline__ bool next(int i, pg8::Unit& u) const {
        const long L = (long)i * G + c; if (L >= nwg) return false;
        int wgid = (int)L; { const int q = nwg / 8, r = nwg % 8, xcd = wgid % 8, off = wgid / 8; wgid = (xcd < r ? xcd * (q + 1) : r * (q + 1) + (xcd - r) * q) + off; }
        const int nig = 8 * nN, gid = wgid / nig, fm = gid * 8, gsz = (nM - fm) < 8 ? (nM - fm) : 8;
        const int pm = fm + ((wgid % nig) % gsz), pn = (wgid % nig) / gsz;
        u.a = A + (size_t)pm * astride; u.b = B + (size_t)pn * bstride; u.row0 = pm * 256; u.col0 = col_base + pn * 256; u.aux = pn * 256; return true;
    }
};
struct BranchSched {
    int nM, nwg, G, c; const char* A; const char* B;
    __device__ __forceinline__ bool next(int i, pg8::Unit& u) const {
        const long L = (long)i * G + c; if (L >= nwg) return false;
        int wgid = (int)L; { const int q = nwg / 8, r = nwg % 8, xcd = wgid % 8, off = wgid / 8; wgid = (xcd < r ? xcd * (q + 1) : r * (q + 1) + (xcd - r) * q) + off; }
        const int nN = 12, nig = 8 * nN, gid = wgid / nig, fm = gid * 8, gsz = (nM - fm) < 8 ? (nM - fm) : 8;
        const int pm = fm + ((wgid % nig) % gsz), pn = (wgid % nig) / gsz, br = pn >> 2;
        u.a = A + ((size_t)pm * 256 * LP + br * 512) * 2; u.b = B + ((size_t)br * 1024 * 512 + (size_t)(pn & 3) * 256 * 512) * 2; u.row0 = pm * 256; u.col0 = C_T + pn * 256; u.aux = 0; return true;
    }
};
struct GateSched {
    int nM, nwg, G, c; const char* A; const char* B;
    __device__ __forceinline__ bool next(int i, pg8::Unit& u) const {
        const int rnd = i / 3, br = i - 3 * rnd;
        const long L = (long)rnd * G + c; if (L >= nwg) return false;
        int wgid = (int)L; { const int q = nwg / 8, r = nwg % 8, xcd = wgid % 8, off = wgid / 8; wgid = (xcd < r ? xcd * (q + 1) : r * (q + 1) + (xcd - r) * q) + off; }
        const int nN = 4, nig = 8 * nN, gid = wgid / nig, fm = gid * 8, gsz = (nM - fm) < 8 ? (nM - fm) : 8;
        const int pm = fm + ((wgid % nig) % gsz), pn = (wgid % nig) / gsz;
        u.a = A + (size_t)pm * 256 * 1024 * 2; u.b = B + ((size_t)br * 1024 + (size_t)pn * 256) * 1024 * 2; u.row0 = pm * 256; u.col0 = pn * 256; u.aux = br * 1024 + pn * 256; return true;
    }
};
struct MoeSched {
    int nct, G, c; const LAS int* tab;
    const char* A; size_t astride; const char* B; size_t bexp, bct;
    __device__ __forceinline__ bool next(int i, pg8::Unit& u) const {
        const long L = (long)i * G + c; const int nblk = tab[0]; if (L >= (long)nblk * nct) return false;
        const int rb = (int)(L / nct), ct = (int)(L % nct), e = tab[1 + rb];
        u.a = A + (size_t)rb * astride; u.b = B + (size_t)e * bexp + (size_t)ct * bct; u.row0 = rb * 256; u.col0 = ct * 256; u.aux = e; u.aux2 = i; return true;
    }
};

__device__ __forceinline__ bf16x8 frag_rm(const LAS unsigned char* base, int stride, int blk, int ks, int l15, int g) { return *(const LAS bf16x8*)(base + (blk * 16 + l15) * stride + (ks * 32 + 8 * g) * 2); }
__device__ __forceinline__ bf16x8 frag_tr(const LAS unsigned char* base, int stride, int ks, int nb, int g, int q4, int p4) {
    const s16x4 lo = __builtin_amdgcn_ds_read_tr16_b64_v4i16((LAS s16x4*)(base + (32 * ks + 8 * g + q4) * stride + (16 * nb + 4 * p4) * 2));
    const s16x4 hi = __builtin_amdgcn_ds_read_tr16_b64_v4i16((LAS s16x4*)(base + (32 * ks + 8 * g + 4 + q4) * stride + (16 * nb + 4 * p4) * 2));
    return (bf16x8){lo[0], lo[1], lo[2], lo[3], hi[0], hi[1], hi[2], hi[3]};
}
#define MFMA16(a, b, c) __builtin_amdgcn_mfma_f32_16x16x32_bf16((a), (b), (c), 0, 0, 0)

#ifndef TIMER_A
#define TIMER_A (-1)
#endif
#ifndef TIMER_B
#define TIMER_B (-1)
#endif
#ifndef TIMER_T
#define TIMER_T 0
#endif
#ifndef TIMER_WG
#define TIMER_WG 0
#endif
#define TMARK(id) do { if (TIMER_A >= 0 || TIMER_B >= 0) { const unsigned long long t_ = __builtin_amdgcn_s_memrealtime(); volatile LAS unsigned* tw_ = (volatile LAS unsigned*)(lds + LDS_CTL + 2800); \
    if (otid() == 0) { if ((id) == TIMER_A) tw_[0] -= (unsigned)t_; if ((id) == TIMER_A + 1) tw_[0] += (unsigned)t_; if ((id) == TIMER_B) tw_[1] -= (unsigned)t_; if ((id) == TIMER_B + 1) tw_[1] += (unsigned)t_; } } } while (0)
__device__ __forceinline__ void xattn_phase(LAS unsigned char* lds, const bf16* Qb, const bf16* KV, bf16* Ob, int G, int bx) {
    const int tid = otid(), lane = tid & 63, wid = tid >> 6, l15 = lane & 15, g = lane >> 4, q4 = l15 >> 2, p4 = lane & 3;
    constexpr int D = 256, KST = (D + 8) * 2, NU = NB * 4 * 16;
    LAS unsigned char* KS = lds; LAS unsigned char* VS = lds + 64 * KST; LAS unsigned char* PS = lds + 2 * 64 * KST + wid * 2304;
    LAS unsigned char* OS = lds + 2 * 64 * KST + 8 * 2304 + wid * 4352;
    const int nun = (NU - bx + G - 1) / G, NT = nun * 4;
    u32x4 kreg[4], vreg[4];
#define XA_ISSUE(tt_) do { const int u_ = bx + ((tt_) >> 2) * G, t_ = (tt_) & 3, b_ = u_ >> 6, h_ = (u_ >> 4) & 3; \
        _Pragma("unroll") for (int j_ = 0; j_ < 4; ++j_) { const int c_ = tid + 512 * j_, row_ = c_ >> 5, ch_ = c_ & 31; \
            const bf16* kp_ = KV + (size_t)(b_ * MEMLEN + t_ * 64 + row_) * 2048 + h_ * 256 + ch_ * 8; kreg[j_] = *(const u32x4*)kp_; vreg[j_] = *(const u32x4*)(kp_ + 1024); } } while (0)
    if (NT > 0) XA_ISSUE(0);
    bf16x8 qf[8]; f32x4 o[16]; float mrow[4], lrow[4];
    for (int tt = 0; tt < NT; ++tt) {
        TMARK(55);
        const int u = bx + (tt >> 2) * G, t = tt & 3, b = u >> 6, h = (u >> 4) & 3, qb = u & 15;
        const size_t rowq = (size_t)b * SEQ + qb * 128;
        if (t == 0) {
            if (tt == 0) { const bf16* qrow = Qb + (rowq + wid * 16 + l15) * 1024 + h * 256 + 8 * g;
#pragma unroll
                for (int ks = 0; ks < 8; ++ks) qf[ks] = *(const bf16x8*)(qrow + ks * 32); }
#pragma unroll
            for (int i = 0; i < 16; ++i) o[i] = (f32x4){0.f, 0.f, 0.f, 0.f};
#pragma unroll
            for (int r = 0; r < 4; ++r) { mrow[r] = -1e30f; lrow[r] = 0.f; }
        }
        TMARK(50);
        __syncthreads();
#pragma unroll
        for (int j = 0; j < 4; ++j) { const int c = tid + 512 * j, row = c >> 5, ch = c & 31; *(LAS u32x4*)(KS + row * KST + ch * 16) = kreg[j]; *(LAS u32x4*)(VS + row * KST + ch * 16) = vreg[j]; }
        __syncthreads();
        if (tt + 1 < NT) XA_ISSUE(tt + 1);
        TMARK(51);
        f32x4 s[4];
#pragma unroll
        for (int nb = 0; nb < 4; ++nb) { s[nb] = (f32x4){0.f, 0.f, 0.f, 0.f};
#pragma unroll
            for (int ks = 0; ks < 8; ++ks) s[nb] = MFMA16(qf[ks], *(const LAS bf16x8*)(KS + (nb * 16 + l15) * KST + (ks * 32 + 8 * g) * 2), s[nb]); }
        if (t == 3 && tt + 1 < NT) {
            asm volatile("" : "+v"(s[0]), "+v"(s[1]), "+v"(s[2]), "+v"(s[3]));
            const int u2 = u + G, b2 = u2 >> 6, h2 = (u2 >> 4) & 3, qb2 = u2 & 15;
            const bf16* qrow = Qb + ((size_t)b2 * SEQ + qb2 * 128 + wid * 16 + l15) * 1024 + h2 * 256 + 8 * g;
#pragma unroll
            for (int ks = 0; ks < 8; ++ks) qf[ks] = *(const bf16x8*)(qrow + ks * 32); }
        TMARK(52);
        float mx[4], al[4];
#pragma unroll
        for (int r = 0; r < 4; ++r) mx[r] = fmaxf(fmaxf(s[0][r], s[1][r]), fmaxf(s[2][r], s[3][r]));
#pragma unroll
        for (int r = 0; r < 4; ++r) mx[r] = fmaxf(mx[r], swz_xor<1>(mx[r]));
#pragma unroll
        for (int r = 0; r < 4; ++r) mx[r] = fmaxf(mx[r], swz_xor<2>(mx[r]));
#pragma unroll
        for (int r = 0; r < 4; ++r) mx[r] = fmaxf(mx[r], swz_xor<4>(mx[r]));
#pragma unroll
        for (int r = 0; r < 4; ++r) mx[r] = fmaxf(mx[r], swz_xor<8>(mx[r]));
        bool moved = false;
#pragma unroll
        for (int r = 0; r < 4; ++r) { const float mn = fmaxf(mrow[r], mx[r]); al[r] = __builtin_amdgcn_exp2f(mrow[r] - mn); moved |= (mn != mrow[r]); mrow[r] = mn; lrow[r] *= al[r]; }
        if (__any(moved)) {
#pragma unroll
            for (int i = 0; i < 16; ++i)
#pragma unroll
                for (int r = 0; r < 4; ++r) o[i][r] *= al[r]; }
#pragma unroll
        for (int r = 0; r < 4; ++r) { float ps = 0.f;
#pragma unroll
            for (int nb = 0; nb < 4; ++nb) { const float p = __builtin_amdgcn_exp2f(s[nb][r] - mrow[r]); ps += p; *(LAS bf16*)(PS + ((4 * g + r) * 72 + nb * 16 + l15) * 2) = (bf16)f2bf(p); }
            lrow[r] += ps; }
        TMARK(53);
        bf16x8 pf[2];
#pragma unroll
        for (int ks = 0; ks < 2; ++ks) pf[ks] = *(const LAS bf16x8*)(PS + (l15 * 72 + ks * 32 + 8 * g) * 2);
#pragma unroll
        for (int nb = 0; nb < 16; ++nb)
#pragma unroll
            for (int ks = 0; ks < 2; ++ks) o[nb] = MFMA16(pf[ks], frag_tr(VS, KST, ks, nb, g, q4, p4), o[nb]);
        TMARK(54);
        if (t == 3) {
            float inv[4];
#pragma unroll
            for (int r = 0; r < 4; ++r) { float l = lrow[r]; l += swz_xor<1>(l); l += swz_xor<2>(l); l += swz_xor<4>(l); l += swz_xor<8>(l); inv[r] = __builtin_amdgcn_rcpf(l); }
#pragma unroll
            for (int hf = 0; hf < 2; ++hf) {
#pragma unroll
                for (int nb = 0; nb < 8; ++nb)
#pragma unroll
                    for (int r = 0; r < 4; ++r) *(LAS bf16*)(OS + ((4 * g + r) * 136 + nb * 16 + l15) * 2) = (bf16)f2bf(o[hf * 8 + nb][r] * inv[r]);
#pragma unroll
                for (int j = 0; j < 4; ++j) { const int c = lane + 64 * j, row = c >> 4, ch = c & 15;
                    *(u32x4*)(Ob + (rowq + wid * 16 + row) * 1024 + h * 256 + hf * 128 + ch * 8) = *(const LAS u32x4*)(OS + row * 272 + ch * 16); }
            }
        }
    }
#undef XA_ISSUE
}

namespace fox_body {
using bf16=unsigned short;
using bf16x8=__attribute__((ext_vector_type(8)))short;
using s16x4=__attribute__((ext_vector_type(4)))short;
using f32x16=__attribute__((ext_vector_type(16)))float;
using u32x4=__attribute__((ext_vector_type(4)))unsigned;
constexpr int BATCH=16,NHEAD=8,SEQ=2048,D=64,DM=5376;
constexpr int NW=8,QBLK=32,QB=QBLK*NW,KVBLK=64,NQB=SEQ/QB;
constexpr int ATTN_PITCH=DM, ATTN_UNIT_ROWS=QB;
__device__ __forceinline__ int crow(int r,int hi){return (r&3)+8*(r>>2)+4*hi;}
#define SBAR() __builtin_amdgcn_sched_barrier(0)
__device__ __forceinline__ void cmask(f32x16&p0,f32x16&p1,int jb,int qrel,int hi){
  const float NEG=-INFINITY; int kb=64*jb+4*hi;
  #pragma unroll
  for(int r=0;r<16;++r){int kv=kb+(r&3)+8*(r>>2); if(kv>qrel)p0[r]=NEG; if(kv+32>qrel)p1[r]=NEG;}
}

constexpr int NSLOT=3, SLOTB=8192;
constexpr int LDS_K=0, LDS_V=NSLOT*SLOTB, LDS_WS=2*NSLOT*SLOTB, LDS_OST=LDS_WS+NW*64*4, LDS_BYTES=LDS_OST+NW*4096;
constexpr float C2=0.125f*1.4426950408889634f;
__device__ __forceinline__ void glds16(const void*gsrc,unsigned lds_dst){unsigned keep;
  asm volatile("s_mov_b32 %0, m0\n\ts_mov_b32 m0, %2\n\ts_nop 0\n\tglobal_load_lds_dwordx4 %1, off\n\ts_mov_b32 m0, %0":"=&s"(keep):"v"(gsrc),"s"(lds_dst):"memory");}
__device__ __forceinline__ float max3f(float a,float b,float c){float r;asm("v_max3_f32 %0, %1, %2, %3":"=v"(r):"v"(a),"v"(b),"v"(c));return r;}
__device__ __forceinline__ float max2f(float a,float b){float r;asm("v_max_f32_e32 %0, %1, %2":"=v"(r):"v"(a),"v"(b));return r;}
__device__ __forceinline__ float fadd_s(float a,float b){float r;asm("v_add_f32_e32 %0, %1, %2":"=v"(r):"v"(a),"v"(b));return r;}
__device__ __forceinline__ float fsub_s(float a,float b){float r;asm("v_sub_f32_e32 %0, %1, %2":"=v"(r):"v"(a),"v"(b));return r;}
typedef float f32x2_t __attribute__((ext_vector_type(2))); typedef __bf16 bf16x2_t __attribute__((ext_vector_type(2)));
__device__ __forceinline__ unsigned cvtpk_s(float lo,float hi){f32x2_t v={lo,hi};bf16x2_t b=__builtin_convertvector(v,bf16x2_t);return __builtin_bit_cast(unsigned,b);}
#define WAIT_BAR(N) asm volatile("s_waitcnt vmcnt(" #N ") lgkmcnt(0)\n\ts_barrier":::"memory")

__device__ __forceinline__ void qkt(f32x16&p0,f32x16&p1,const char*Kslot,const bf16x8*qr,const f32x16&n0,const f32x16&n1,int r32,int hi){
  const char*kb=Kslot+hi*1024+r32*16;
  #pragma unroll
  for(int d0=0;d0<4;++d0){
    const bf16x8 b0=*reinterpret_cast<const bf16x8*>(kb+d0*2048);
    const bf16x8 b1=*reinterpret_cast<const bf16x8*>(kb+d0*2048+512);
    if(d0==0){p0=__builtin_amdgcn_mfma_f32_32x32x16_bf16(b0,qr[0],n0,0,0,0);p1=__builtin_amdgcn_mfma_f32_32x32x16_bf16(b1,qr[0],n1,0,0,0);}
    else{p0=__builtin_amdgcn_mfma_f32_32x32x16_bf16(b0,qr[d0],p0,0,0,0);p1=__builtin_amdgcn_mfma_f32_32x32x16_bf16(b1,qr[d0],p1,0,0,0);}}
}
typedef __attribute__((address_space(3))) const char* lds_cptr;
typedef short v4i16_t __attribute__((ext_vector_type(4)));
__device__ __forceinline__ void kload8(bf16x8*kf,lds_cptr kp){
  kf[0]=*(const __attribute__((address_space(3))) bf16x8*)(kp);      kf[1]=*(const __attribute__((address_space(3))) bf16x8*)(kp+512);
  kf[2]=*(const __attribute__((address_space(3))) bf16x8*)(kp+2048); kf[3]=*(const __attribute__((address_space(3))) bf16x8*)(kp+2560);
  kf[4]=*(const __attribute__((address_space(3))) bf16x8*)(kp+4096); kf[5]=*(const __attribute__((address_space(3))) bf16x8*)(kp+4608);
  kf[6]=*(const __attribute__((address_space(3))) bf16x8*)(kp+6144); kf[7]=*(const __attribute__((address_space(3))) bf16x8*)(kp+6656);
}
__device__ __forceinline__ void kload2(bf16x8*kf,lds_cptr kp,int j){ kf[2*j]=*(const __attribute__((address_space(3))) bf16x8*)(kp+j*2048); kf[2*j+1]=*(const __attribute__((address_space(3))) bf16x8*)(kp+j*2048+512); }
__device__ __forceinline__ s16x4 vtr(lds_cptr p){ return __builtin_bit_cast(s16x4,__builtin_amdgcn_ds_read_tr16_b64_v4i16((__attribute__((address_space(3))) v4i16_t*)p)); }
__device__ __forceinline__ float rowmax(const f32x16&p0,const f32x16&p1){
  float a=max3f(p0[0],p0[1],p1[0]),b=max3f(p0[2],p0[3],p1[1]);a=max3f(a,p1[2],p1[3]);
  #pragma unroll
  for(int r=4;r<16;r+=4){a=max3f(a,p0[r],p0[r+1]);b=max3f(b,p0[r+2],p0[r+3]);a=max3f(a,p1[r],p1[r+1]);b=max3f(b,p1[r+2],p1[r+3]);}
  const float m=max2f(a,b);
  auto rr=__builtin_amdgcn_permlane32_swap(__float_as_uint(m),__float_as_uint(m),false,false);
  return max2f(__uint_as_float(rr[0]),__uint_as_float(rr[1]));
}
__device__ __forceinline__ void pv(f32x16*o,int vb,bf16x8 pa0,bf16x8 pa1,bf16x8 pa2,bf16x8 pa3){
  #pragma unroll
  for(int d0=0;d0<2;++d0){s16x4 lo[4],hi[4];
    #pragma unroll
    for(int ks=0;ks<4;++ks){
      asm volatile("ds_read_b64_tr_b16 %0,%1 offset:%c2":"=&v"(lo[ks]):"v"(vb),"i"(d0*4096+ks*1024):"memory");
      asm volatile("ds_read_b64_tr_b16 %0,%1 offset:%c2":"=&v"(hi[ks]):"v"(vb),"i"(d0*4096+ks*1024+512):"memory");}
    asm volatile("s_waitcnt lgkmcnt(0)":::"memory");SBAR();
    #define PK(k) (bf16x8){lo[k][0],lo[k][1],lo[k][2],lo[k][3],hi[k][0],hi[k][1],hi[k][2],hi[k][3]}
    o[d0]=__builtin_amdgcn_mfma_f32_32x32x16_bf16(pa0,PK(0),o[d0],0,0,0);
    o[d0]=__builtin_amdgcn_mfma_f32_32x32x16_bf16(pa1,PK(1),o[d0],0,0,0);
    o[d0]=__builtin_amdgcn_mfma_f32_32x32x16_bf16(pa2,PK(2),o[d0],0,0,0);
    o[d0]=__builtin_amdgcn_mfma_f32_32x32x16_bf16(pa3,PK(3),o[d0],0,0,0);
    #undef PK
  }
}

#ifndef ATTN_STORE16
#define ATTN_STORE16(p,v) (*(u32x4*)(p)=(v))
#endif
template<int THRL> __device__ __forceinline__ void attn_unit(int b,int h,int qb,const bf16*Q,const bf16*__restrict__ K,const bf16*__restrict__ V,bf16*O,char*shm,const __attribute__((address_space(3))) float*CKL){
  const int tid=otid(),lane=tid&63,r32=lane&31,hi=lane>>5; const int wid=__builtin_amdgcn_readfirstlane(tid>>6);
  const long rowbase=(long)b*SEQ; const int q0=qb*QB;
  const bf16*Qw=Q+(rowbase+q0+wid*QBLK)*DM;
  const bf16*Kh=K+rowbase*DM,*Vh=V+rowbase*DM;
  const unsigned lds0=(unsigned)(uintptr_t)shm;
  float*wsf=(float*)(shm+LDS_WS)+wid*64;
  const bf16*ksrc=Kh+(long)lane*DM+wid*8;
  const bf16*vsrc=Vh+(long)(16*(wid&3)+(lane>>2))*DM+(wid>>2)*32+(lane&3)*8;
  const unsigned kdst=lds0+LDS_K+wid*1024, vdst=lds0+LDS_V+wid*1024;
  #define DMA_K(t,slot) glds16(ksrc+(long)(t)*KVBLK*DM,(unsigned)__builtin_amdgcn_readfirstlane(kdst+(slot)))
  #define DMA_V(t,slot) glds16(vsrc+(long)(t)*KVBLK*DM,(unsigned)__builtin_amdgcn_readfirstlane(vdst+(slot)))
  const int vb0=(int)(lds0+LDS_V)+((lane>>4)&1)*32+(lane&3)*8+(4*hi+((lane&15)>>2))*64;
  const char*Kbase=shm+LDS_K; bf16x8 kf[8];
  const lds_cptr shm3=(lds_cptr)shm; const lds_cptr kp0=shm3+LDS_K+hi*1024+r32*16; const lds_cptr vp0=shm3+LDS_V+((lane>>4)&1)*32+(lane&3)*8+(4*hi+((lane&15)>>2))*64;
  const int NT=(q0+QB)/KVBLK;
  DMA_K(0,0);DMA_V(0,0);DMA_K(1,SLOTB);
  bf16x8 qr[4];
  #pragma unroll
  for(int d0=0;d0<4;++d0)qr[d0]=*reinterpret_cast<const bf16x8*>(&Qw[(long)r32*DM+d0*16+hi*8]);
  float mhat=0.f,l_reg=0.f;f32x16 o[2];o[0]=f32x16{};o[1]=f32x16{};f32x16 negm=f32x16{};asm volatile("":"+v"(negm));
  const int qrel=wid*QBLK+r32;
  #define KBIAS(N0,N1,t) do{ const __attribute__((address_space(3))) float*cb_=CKL+64*(t)+4*hi; \
    _Pragma("unroll") for(int q_=0;q_<4;++q_){ const f32x4 a_=*(const __attribute__((address_space(3))) f32x4*)(cb_+8*q_), b_=*(const __attribute__((address_space(3))) f32x4*)(cb_+32+8*q_); \
      _Pragma("unroll") for(int e_=0;e_<4;++e_){ N0[4*q_+e_]=negm[4*q_+e_]-a_[e_]; N1[4*q_+e_]=negm[4*q_+e_]-b_[e_]; } } }while(0)
  #define KBLOAD(N0,N1,t) do{ const __attribute__((address_space(3))) float*cb_=CKL+64*(t)+4*hi; \
    _Pragma("unroll") for(int q_=0;q_<4;++q_){ const f32x4 a_=*(const __attribute__((address_space(3))) f32x4*)(cb_+8*q_), b_=*(const __attribute__((address_space(3))) f32x4*)(cb_+32+8*q_); \
      _Pragma("unroll") for(int e_=0;e_<4;++e_){ N0[4*q_+e_]=a_[e_]; N1[4*q_+e_]=b_[e_]; } } }while(0)
  #define KBSUB(N0,N1) do{ _Pragma("unroll") for(int r_=0;r_<16;++r_){ N0[r_]=negm[r_]-N0[r_]; N1[r_]=negm[r_]-N1[r_]; } }while(0)
  #define CMASK(P0,P1,t) do{int jb_=(t)-(NT-4); if(jb_>=0)cmask(P0,P1,jb_,qrel,hi);}while(0)
  bool resc=false;
  #define START(P0,P1) do{ const float rm=rowmax(P0,P1); resc=false; \
    { const float dl=rm; mhat=fadd_s(mhat,dl); \
      _Pragma("unroll") for(int r=0;r<16;++r){P0[r]=fsub_s(P0[r],dl);P1[r]=fsub_s(P1[r],dl);} \
      _Pragma("unroll") for(int r=0;r<16;++r)negm[r]=-mhat; asm volatile("":"+v"(negm)); } \
    _Pragma("unroll") for(int r=0;r<16;++r)P0[r]=__builtin_amdgcn_exp2f(P0[r]); }while(0)
  #define RESC() do{ if(resc){ asm volatile("s_waitcnt lgkmcnt(0)":::"memory"); \
      _Pragma("unroll") for(int d_=0;d_<2;++d_) _Pragma("unroll") for(int r=0;r<16;++r)o[d_][r]*=wsf[crow(r,hi)]; } }while(0)
  f32x16 pA0,pA1,pB0,pB1;
  int sl_prev=0,sl_cur=0,sl_next=SLOTB;
  #define ROT() do{sl_prev=sl_cur;sl_cur=sl_next;sl_next=(sl_next==(NSLOT-1)*SLOTB)?0:sl_next+SLOTB;}while(0)
  DMA_K(2,2*SLOTB);
  WAIT_BAR(3);
  { f32x16 n0_,n1_; KBIAS(n0_,n1_,0); qkt(pA0,pA1,Kbase,qr,n0_,n1_,r32,hi); } asm volatile("s_nop 15\n\ts_nop 7":"+v"(pA0),"+v"(pA1));CMASK(pA0,pA1,0);
  START(pA0,pA1);
  _Pragma("unroll") for(int r=0;r<16;++r)pA1[r]=__builtin_amdgcn_exp2f(pA1[r]);
  WAIT_BAR(0);
  DMA_K(3,0);DMA_V(1,SLOTB);
  ROT();
  kload8(kf,kp0+sl_cur);
  WAIT_BAR(2);
  s16x4 vlo[8],vhi[8]; u32x4 pw0,pw1,pw2,pw3;
  #define PKW(P,B) cvtpk_s(P[B],P[B+1])
  #define PAF(k) __builtin_bit_cast(bf16x8,pw##k)
  #define VFR(i) (bf16x8){vlo[i][0],vlo[i][1],vlo[i][2],vlo[i][3],vhi[i][0],vhi[i][1],vhi[i][2],vhi[i][3]}
  #define PIN(x) asm volatile("":"+v"(x))
  #define MX3(a,b,c) __builtin_fmaxf(__builtin_fmaxf((a),(b)),(c))
  #define GAPA(MF,A0,A1,A2,A3,W0,W1,PW) do{ MF; sacc+=A0; sacc+=A1; sacc+=A2; sacc+=A3; PIN(sacc); W0; W1; PIN(PW); SBAR(); }while(0)
  #define EX(v) __builtin_amdgcn_exp2f(v)
  #define GAPB(MF,X,B) do{ MF; X[B]=EX(X[B]); X[B+1]=EX(X[B+1]); X[B+2]=EX(X[B+2]); X[B+3]=EX(X[B+3]); PIN(X); SBAR(); }while(0)
  #define VRD(i) do{ vlo[i]=vtr(vp_+(((i)>>2)*4096+((i)&3)*1024)); vhi[i]=vtr(vp_+(((i)>>2)*4096+((i)&3)*1024+512)); }while(0)
  #define KRD(G,j) do{ if(G){ kload2(kf,kp0+sl_next,j); SBAR(); } }while(0)
  #define STEP(C0,C1,P0,P1,t,GK,GV,GL) do{ SBAR(); \
    SBAR(); \
    const lds_cptr vp_=vp0+sl_prev; \
    VRD(0); SBAR(); float sacc=(P0[0]+P0[1]); \
    GAPA(C0=__builtin_amdgcn_mfma_f32_32x32x16_bf16(kf[0],qr[0],C0,0,0,0), P0[2],P0[3],P0[4],P0[5],     pw0[0]=PKW(P0,0), pw0[1]=PKW(P0,2), pw0); \
    VRD(4); SBAR(); GAPA(C1=__builtin_amdgcn_mfma_f32_32x32x16_bf16(kf[1],qr[0],C1,0,0,0), P0[6],P0[7],P0[8],P0[9],     pw0[2]=PKW(P0,4), pw0[3]=PKW(P0,6), pw0); \
    VRD(1); SBAR(); GAPA(C0=__builtin_amdgcn_mfma_f32_32x32x16_bf16(kf[2],qr[1],C0,0,0,0),   P0[10],P0[11],P0[12],P0[13], pw1[0]=PKW(P0,8), pw1[1]=PKW(P0,10), pw1); \
    VRD(5); SBAR(); GAPA(C1=__builtin_amdgcn_mfma_f32_32x32x16_bf16(kf[3],qr[1],C1,0,0,0),   P0[14],P0[15],P1[0],P1[1],   pw1[2]=PKW(P0,12),pw1[3]=PKW(P0,14), pw1); \
    VRD(2); SBAR(); GAPA(C0=__builtin_amdgcn_mfma_f32_32x32x16_bf16(kf[4],qr[2],C0,0,0,0),   P1[2],P1[3],P1[4],P1[5],     pw2[0]=PKW(P1,0), pw2[1]=PKW(P1,2), pw2); \
    VRD(6); SBAR(); GAPA(C1=__builtin_amdgcn_mfma_f32_32x32x16_bf16(kf[5],qr[2],C1,0,0,0),   P1[6],P1[7],P1[8],P1[9],     pw2[2]=PKW(P1,4), pw2[3]=PKW(P1,6), pw2); \
    VRD(3); SBAR(); GAPA(C0=__builtin_amdgcn_mfma_f32_32x32x16_bf16(kf[6],qr[3],C0,0,0,0),   P1[10],P1[11],P1[12],P1[13], pw3[0]=PKW(P1,8), pw3[1]=PKW(P1,10), pw3); \
    VRD(7); SBAR(); GAPA(C1=__builtin_amdgcn_mfma_f32_32x32x16_bf16(kf[7],qr[3],C1,0,0,0),   P1[14],P1[15],0.f,0.f,       pw3[2]=PKW(P1,12),pw3[3]=PKW(P1,14), pw3); \
    l_reg+=sacc; \
    if(GL){KBLOAD(P0,P1,(t)+1);} \
    if(GK){DMA_K((t)+3,sl_cur);} if(GV){DMA_V((t)+1,sl_next);} \
    CMASK(C0,C1,t); \
    { float a=MX3(C0[0],C0[1],C1[0]),b=MX3(C0[2],C0[3],C1[1]); a=MX3(a,C1[2],C1[3]); \
      _Pragma("unroll") for(int r=4;r<16;r+=4){a=MX3(a,C0[r],C0[r+1]);b=MX3(b,C0[r+2],C0[r+3]);a=MX3(a,C1[r],C1[r+1]);b=MX3(b,C1[r+2],C1[r+3]);} \
      float rm=__builtin_fmaxf(a,b); { auto rr=__builtin_amdgcn_permlane32_swap(__float_as_uint(rm),__float_as_uint(rm),false,false); rm=__builtin_fmaxf(__uint_as_float(rr[0]),__uint_as_float(rr[1])); } \
      resc=false; \
      if(__builtin_expect(__any(rm>(float)THRL),0)){ const float dl=__builtin_fmaxf(rm,0.f); mhat+=dl; \
        _Pragma("unroll") for(int r=0;r<16;++r){C0[r]-=dl;C1[r]-=dl;} \
        _Pragma("unroll") for(int r=0;r<16;++r)negm[r]=-mhat; asm volatile("":"+v"(negm)); \
        const float f=__builtin_amdgcn_exp2f(-dl); l_reg*=f; if(hi==0)wsf[r32]=f; resc=true; } } \
    if(GL){KBSUB(P0,P1);} \
    SBAR(); \
    GAPB(o[0]=__builtin_amdgcn_mfma_f32_32x32x16_bf16(PAF(0),VFR(0),o[0],0,0,0), C0,0); \
    GAPB(o[1]=__builtin_amdgcn_mfma_f32_32x32x16_bf16(PAF(0),VFR(4),o[1],0,0,0), C0,4); \
    KRD(GL,0); GAPB(o[0]=__builtin_amdgcn_mfma_f32_32x32x16_bf16(PAF(1),VFR(1),o[0],0,0,0), C0,8); \
    KRD(GL,1); GAPB(o[1]=__builtin_amdgcn_mfma_f32_32x32x16_bf16(PAF(1),VFR(5),o[1],0,0,0), C0,12); \
    KRD(GL,2); GAPB(o[0]=__builtin_amdgcn_mfma_f32_32x32x16_bf16(PAF(2),VFR(2),o[0],0,0,0), C1,0); \
    KRD(GL,3); GAPB(o[1]=__builtin_amdgcn_mfma_f32_32x32x16_bf16(PAF(2),VFR(6),o[1],0,0,0), C1,4); \
    GAPB(o[0]=__builtin_amdgcn_mfma_f32_32x32x16_bf16(PAF(3),VFR(3),o[0],0,0,0), C1,8); \
    GAPB(o[1]=__builtin_amdgcn_mfma_f32_32x32x16_bf16(PAF(3),VFR(7),o[1],0,0,0), C1,12); \
    }while(0)
  KBIAS(pB0,pB1,1);
  int t=1;
  #undef CMASK
  #define CMASK(P0,P1,t) do{}while(0)
  for(;t+5<NT;t+=2){
    STEP(pB0,pB1,pA0,pA1,t,true,true,true);     WAIT_BAR(2); RESC(); ROT();
    STEP(pA0,pA1,pB0,pB1,t+1,true,true,true);   WAIT_BAR(2); RESC(); ROT();
  }
  #undef CMASK
  #define CMASK(P0,P1,t) do{int jb_=(t)-(NT-4); if(jb_>=0)cmask(P0,P1,jb_,qrel,hi);}while(0)
  #define ENDW(tt) do{ if((tt)+3<NT){WAIT_BAR(2);} else if((tt)+2<NT){WAIT_BAR(1);} else {WAIT_BAR(0);} }while(0)
  for(;t+1<NT;t+=2){
    STEP(pB0,pB1,pA0,pA1,t,(t+3<NT),(t+1<NT),(t+1<NT));       ENDW(t);   RESC(); ROT();
    STEP(pA0,pA1,pB0,pB1,t+1,(t+4<NT),(t+2<NT),(t+2<NT));     ENDW(t+1); RESC(); ROT();
  }
  STEP(pB0,pB1,pA0,pA1,NT-1,false,false,false); RESC();
  { float sacc=pB0[0]+pB0[1]; _Pragma("unroll") for(int r=2;r<16;++r)sacc+=pB0[r]; _Pragma("unroll") for(int r=0;r<16;++r)sacc+=pB1[r]; l_reg+=sacc;
    pw0=(u32x4){PKW(pB0,0),PKW(pB0,2),PKW(pB0,4),PKW(pB0,6)};pw1=(u32x4){PKW(pB0,8),PKW(pB0,10),PKW(pB0,12),PKW(pB0,14)};pw2=(u32x4){PKW(pB1,0),PKW(pB1,2),PKW(pB1,4),PKW(pB1,6)};pw3=(u32x4){PKW(pB1,8),PKW(pB1,10),PKW(pB1,12),PKW(pB1,14)};
    SBAR(); pv(o,vb0+sl_cur,PAF(0),PAF(1),PAF(2),PAF(3)); }
  #undef PKW
  #undef PAF
  #undef VFR
  #undef PIN
  #undef MX3
  #undef GAPA
  #undef GAPB
  #undef EX
  #undef VRD
  #undef KRD
  #undef STEP
  #undef ENDW
  {auto rr=__builtin_amdgcn_permlane32_swap(__float_as_uint(l_reg),__float_as_uint(l_reg),false,false);l_reg=__uint_as_float(rr[0])+__uint_as_float(rr[1]);}
  if(hi==0)wsf[32+r32]=l_reg;asm volatile("s_waitcnt lgkmcnt(0)":::"memory");
  float rli[16];
  #pragma unroll
  for(int r=0;r<16;++r)rli[r]=__builtin_amdgcn_rcpf(wsf[32+crow(r,hi)]);
  bf16*Ow=O+(rowbase+q0+wid*QBLK)*DM;
  { bf16*stg=(bf16*)(shm+LDS_OST)+wid*2048;
    #pragma unroll
    for(int r=0;r<16;++r){const int orow=crow(r,hi);
      #pragma unroll
      for(int d0=0;d0<2;++d0)stg[orow*64+d0*32+r32]=(bf16)f2bf(o[d0][r]*rli[r]);}
    asm volatile("s_waitcnt lgkmcnt(0)":::"memory");
    #pragma unroll
    for(int i=0;i<4;++i){const int row=i*8+(lane>>3),ch=lane&7; const u32x4 v=*(const u32x4*)(stg+row*64+ch*8); ATTN_STORE16(Ow+(long)row*DM+ch*8,v);} }
  asm volatile("s_waitcnt lgkmcnt(0)\n\ts_barrier":::"memory");
  #undef KBIAS
  #undef KBLOAD
  #undef KBSUB
  #undef DMA_K
  #undef DMA_V
  #undef CMASK
  #undef START
  #undef RESC
  #undef ROT
}
constexpr int ATTN_LDS_BYTES=LDS_BYTES;
#undef SBAR
#undef WAIT_BAR
}

__device__ __forceinline__ void fox_ck_task(KArgP A, int l, LAS unsigned char* lds, int b, int h) {
    const bf16* PJ = (const bf16*)(A->ws + WS_PROJ);
    float* CKG = (float*)((unsigned char*)A->out + DO_CKG) + (size_t)(b * 8 + h) * SEQ;
    const int tid = otid(), lane = tid & 63, wid = tid >> 6;
    LAS float* WT = (LAS float*)lds;
    const float fb = A->fox_f_bias[l * 8 + h];
    float v[4]; float run = 0.f;
#pragma unroll
    for (int i = 0; i < 4; ++i) v[i] = bf2f(PJ[(size_t)(b * SEQ + tid * 4 + i) * LP + C_SM + 8 + h]);
#pragma unroll
    for (int i = 0; i < 4; ++i) { run += LOG2E * logsigmoidf_(v[i] + fb); v[i] = run; }
    float inc = run;
#pragma unroll
    for (int o = 1; o < 64; o <<= 1) { const float y = __builtin_bit_cast(float, __builtin_amdgcn_ds_bpermute(((lane - o) & 63) << 2, __builtin_bit_cast(int, inc))); if (lane >= o) inc += y; }
    __syncthreads();
    if (lane == 63) WT[wid] = inc;
    __syncthreads();
    float base = inc - run;
    for (int w = 0; w < wid; ++w) base += WT[w];
    *(f32x4*)(CKG + tid * 4) = (f32x4){base + v[0], base + v[1], base + v[2], base + v[3]};
}
__device__ __forceinline__ void fox_unit(KArgP A, int l, LAS unsigned char* lds, int b, int h, int qb, int ocol = -1) {
    bf16* PJ = (bf16*)(A->ws + WS_PROJ);
    const float* CKG = (const float*)((unsigned char*)A->out + DO_CKG) + (size_t)(b * 8 + h) * SEQ;
    const int tid = otid();
    LAS float* CK = (LAS float*)(lds + fox_body::LDS_BYTES);
    const f32x4 ck4 = (tid * 4 < 256 * (qb + 1)) ? *(const f32x4*)(CKG + tid * 4) : (f32x4){0.f, 0.f, 0.f, 0.f};
    __syncthreads();
    *(LAS f32x4*)(CK + tid * 4) = ck4;
    __syncthreads();
    fox_body::attn_unit<8>(b, h, qb, PJ + C_OB + h * 64, PJ + C_FK + h * 64, PJ + C_FV + h * 64, PJ + (ocol < 0 ? C_OB + h * 64 : ocol), (char*)lds, CK);
}

struct GdnPre { u32x4 xr[10]; f32x4 w0[4], w1[4]; unsigned ab; };
__device__ __forceinline__ void gdn_prep_issue(GdnPre& P, KArgP A, int l, int b, int h, int n) {
    const bf16* PJ = (const bf16*)(A->ws + WS_PROJ); const bf16* HALO = (const bf16*)((unsigned char*)A->out + DO_HALO);
    const float* cw = A->gdn_conv_w + (size_t)l * 4 * 1536;
    const int tid = otid(); const size_t row0 = (size_t)b * SEQ + n * 64;
    if (tid < 480) { const int pc = tid % 48, grp = tid / 48, part = pc >> 4, c8 = pc & 15, c = part * 512 + h * 128 + c8 * 8;
#pragma unroll
        for (int i = 0; i < 10; ++i) { const int tr = 7 * grp - 3 + i; P.xr[i] = (u32x4){0u, 0u, 0u, 0u};
            if (tr >= 0) { if (tr < 64) P.xr[i] = *(const u32x4*)(PJ + (row0 + tr) * LP + C_GQ + c); }
            else if (n > 0) P.xr[i] = *(const u32x4*)(HALO + ((size_t)(b * 32 + n - 1) * 3 + (3 + tr)) * 1536 + c); }
#pragma unroll
        for (int i = 0; i < 4; ++i) { P.w0[i] = *(const f32x4*)(cw + i * 1536 + c); P.w1[i] = *(const f32x4*)(cw + i * 1536 + c + 4); } }
    if (tid < 64) { const size_t r = (row0 + tid) * LP + C_SM; P.ab = (unsigned)PJ[r + 4 + h] | ((unsigned)PJ[r + h] << 16); }
}
__device__ __forceinline__ void gdn_prep_task(KArgP A, int l, LAS unsigned char* lds, int b, int h, int n, GdnPre& P, bool has_next, int nb_, int nh_, int nn_, GdnPre& N, bool dummy = false) {
    bf16* PJ = (bf16*)(A->ws + WS_PROJ);
    unsigned char* dsc = (unsigned char*)A->out; const bf16* HALO = (const bf16*)(dsc + DO_HALO);
    unsigned char* rec = dsc + DO_GP + (size_t)(dummy ? 2048 : ((b * 4 + h) * 32 + n)) * GP_STRIDE;
    const int tid = otid(), lane = tid & 63, wid = tid >> 6, l15 = lane & 15, g = lane >> 4;
    constexpr int S136 = 272, S72 = 144, S40 = 80;
    const int oq = dummy ? 5152 : C_GQ + h * 128, ov = dummy ? 5152 : C_GV + h * 128;
    LAS float* qf = (LAS float*)lds; LAS float* kf = qf + 64 * 128; LAS float* vf = kf + 64 * 128;
    LAS unsigned char* KB16 = lds + 98304; LAS unsigned char* QB16 = lds + 115712;
    LAS float* GC = (LAS float*)(lds + 146432); LAS float* BETA = GC + 64; LAS float* EG = BETA + 64;
    LAS unsigned char* AOFF = lds;
    LAS unsigned char* ATTS = lds + 9216;
    LAS float* AKK = (LAS float*)(lds + 18432);
    LAS unsigned char* TD = lds + 23552;
    LAS unsigned char* XT = lds + 98304;
    LAS unsigned char* TT = lds + 65536;
    const float* cw = A->gdn_conv_w + (size_t)l * 4 * 1536;
    const float alog = A->gdn_a_log[l * 4 + h], dtb = A->gdn_dt_bias[l * 4 + h];
    const int t0 = n * 64; const size_t row0 = (size_t)b * SEQ + t0;
    __syncthreads();
    TMARK(30);
    if (tid < 480) {
        const int pc = tid % 48, grp = tid / 48, part = pc >> 4, c8 = pc & 15;
        LAS float* dbase = (part == 0 ? qf : part == 1 ? kf : vf) + c8 * 8;
#pragma unroll
        for (int j = 0; j < 7; ++j) { const int tt = 7 * grp + j;
            if (tt < 64) { float y[8];
#pragma unroll
                for (int e2 = 0; e2 < 8; ++e2) y[e2] = 0.f;
#pragma unroll
                for (int i = 0; i < 4; ++i) { const u32x4 xv = P.xr[j + i];
                    y[0] += P.w0[i][0] * bflo(xv.x); y[1] += P.w0[i][1] * bfhi(xv.x); y[2] += P.w0[i][2] * bflo(xv.y); y[3] += P.w0[i][3] * bfhi(xv.y);
                    y[4] += P.w1[i][0] * bflo(xv.z); y[5] += P.w1[i][1] * bfhi(xv.z); y[6] += P.w1[i][2] * bflo(xv.w); y[7] += P.w1[i][3] * bfhi(xv.w); }
                LAS float* dst = dbase + tt * 128;
                *(LAS f32x4*)dst = (f32x4){siluf_(y[0]), siluf_(y[1]), siluf_(y[2]), siluf_(y[3])}; *(LAS f32x4*)(dst + 4) = (f32x4){siluf_(y[4]), siluf_(y[5]), siluf_(y[6]), siluf_(y[7])}; } }
    }
    if (tid < 64) { const float a = bflo(P.ab), bb = bfhi(P.ab);
        float gg = -__expf(alog) * softplusf_(a + dtb);
#pragma unroll
        for (int o = 1; o < 64; o <<= 1) { const float y2 = __builtin_bit_cast(float, __builtin_amdgcn_ds_bpermute(((lane - o) & 63) << 2, __builtin_bit_cast(int, gg))); if (lane >= o) gg += y2; }
        GC[tid] = gg; EG[tid] = __expf(gg); BETA[tid] = sigmoidf_(bb); }
    if (has_next) gdn_prep_issue(N, A, l, nb_, nh_, nn_);
    __syncthreads();
    TMARK(31);
    {
        float va[16], vc[16], ss[16];
#pragma unroll
        for (int i = 0; i < 16; ++i) { const int rr = wid + 8 * i; const LAS float* p = (rr < 64 ? qf + rr * 128 : kf + (rr - 64) * 128); va[i] = p[lane * 2]; vc[i] = p[lane * 2 + 1]; ss[i] = va[i] * va[i] + vc[i] * vc[i]; }
#pragma unroll
        for (int i = 0; i < 16; ++i) ss[i] += swz_xor<1>(ss[i]);
#pragma unroll
        for (int i = 0; i < 16; ++i) ss[i] += swz_xor<2>(ss[i]);
#pragma unroll
        for (int i = 0; i < 16; ++i) ss[i] += swz_xor<4>(ss[i]);
#pragma unroll
        for (int i = 0; i < 16; ++i) ss[i] += swz_xor<8>(ss[i]);
#pragma unroll
        for (int i = 0; i < 16; ++i) ss[i] += swz_xor<16>(ss[i]);
#pragma unroll
        for (int i = 0; i < 16; ++i) ss[i] = half_sum(ss[i]);
#pragma unroll
        for (int i = 0; i < 16; ++i) { const int rr = wid + 8 * i; const bool isq = rr < 64; const int row = isq ? rr : rr - 64;
            const float sc = rsqrtf(ss[i] + 1e-6f); const float an = va[i] * sc, cn = vc[i] * sc;
            if (isq) { *(LAS unsigned*)(QB16 + row * S136 + lane * 4) = pk2(an, cn); const float f = 0.08838834764831845f * EG[row];
                *(unsigned*)(PJ + (row0 + row) * LP + oq + lane * 2) = pk2(an * f, cn * f); }
            else { LAS float* p = kf + row * 128; p[lane * 2] = an; p[lane * 2 + 1] = cn; *(LAS unsigned*)(KB16 + row * S136 + lane * 4) = pk2(an, cn); } }
    }
    __syncthreads();
    TMARK(32);
    {
        const int mb = wid >> 1;
        bf16x8 ak[4], aq[4];
#pragma unroll
        for (int ks = 0; ks < 4; ++ks) { ak[ks] = frag_rm(KB16, S136, mb, ks, l15, g); aq[ks] = frag_rm(QB16, S136, mb, ks, l15, g); }
#pragma unroll
        for (int j = 0; j < 2; ++j) { const int nb = 2 * (wid & 1) + j; f32x4 kk = (f32x4){0.f, 0.f, 0.f, 0.f}, qk = (f32x4){0.f, 0.f, 0.f, 0.f};
#pragma unroll
            for (int ks = 0; ks < 4; ++ks) { const bf16x8 bfr = frag_rm(KB16, S136, nb, ks, l15, g); kk = MFMA16(ak[ks], bfr, kk); qk = MFMA16(aq[ks], bfr, qk); }
            const int jj = nb * 16 + l15; const float gj = GC[jj];
#pragma unroll
            for (int r = 0; r < 4; ++r) { const int i = mb * 16 + 4 * g + r; const float dec = jj <= i ? __expf(GC[i] - gj) : 0.f;
                const float av = jj < i ? BETA[i] * kk[r] * dec : 0.f;
                *(LAS bf16*)(AOFF + i * S72 + jj * 2) = (bf16)f2bf(nb < mb ? av : 0.f);
                if (nb == mb) AKK[(mb * 16 + 4 * g + r) * 20 + l15] = av;
                *(LAS bf16*)(ATTS + i * S72 + jj * 2) = (bf16)f2bf(qk[r] * dec * 0.08838834764831845f); } }
        for (int i = tid; i < 64 * S40 / 16; i += 512) *(LAS u32x4*)(TD + i * 16) = (u32x4){0u, 0u, 0u, 0u};
    }
    __syncthreads();
    TMARK(33);
    if (tid < 64) { const int k = tid >> 4, c = tid & 15; const LAS float* ab = AKK + k * 16 * 20; float y[16];
#pragma unroll
        for (int i = 0; i < 16; ++i) { float s = (i == c) ? 1.f : 0.f;
#pragma unroll
            for (int m = 0; m < i; ++m) s -= ab[i * 20 + m] * y[m];
            y[i] = s; *(LAS bf16*)(TD + (k * 16 + i) * S40 + c * 2) = (bf16)f2bf(s); } }
    for (int it = tid; it < 8 * 256; it += 512) { const int col = it & 255, i0 = (it >> 8) * 8;
        const LAS float* sp = col < 128 ? vf + col : kf + (col - 128); float r[8];
#pragma unroll
        for (int e = 0; e < 8; ++e) { const int i = i0 + e; r[e] = BETA[i] * sp[i * 128]; if (col >= 128) r[e] *= EG[i]; }
        *(LAS u32x4*)(XT + col * S72 + i0 * 2) = (u32x4){pk2(r[0], r[1]), pk2(r[2], r[3]), pk2(r[4], r[5]), pk2(r[6], r[7])}; }
    __syncthreads();
    TMARK(34);
    {
        for (int i = lane; i < 32 * S40 / 16; i += 64) *(LAS u32x4*)(TT + wid * 32 * S40 + i * 16) = (u32x4){0u, 0u, 0u, 0u};
#pragma unroll
        for (int k = 0; k < 4; ++k) {
#pragma unroll
            for (int jn = 0; jn < 2; ++jn) { const int nb = 2 * wid + jn, col = nb * 16 + l15;
                f32x4 acc = (f32x4){0.f, 0.f, 0.f, 0.f};
                if (k > 0) { acc = MFMA16(frag_rm(AOFF, S72, k, 0, l15, g), frag_rm(XT, S72, nb, 0, l15, g), acc);
                    if (k == 3) acc = MFMA16(frag_rm(AOFF, S72, k, 1, l15, g), frag_rm(XT, S72, nb, 1, l15, g), acc); }
                const u32x2 rv = *(const LAS u32x2*)(XT + col * S72 + (16 * k + 4 * g) * 2);
                *(LAS u32x2*)(TT + col * S40 + (4 * g) * 2) = (u32x2){pk2(bflo(rv.x) - acc[0], bfhi(rv.x) - acc[1]), pk2(bflo(rv.y) - acc[2], bfhi(rv.y) - acc[3])};
                f32x4 x = MFMA16(frag_rm(TD, S40, k, 0, l15, g), frag_rm(TT, S40, nb, 0, l15, g), ((f32x4){0.f, 0.f, 0.f, 0.f}));
                *(LAS u32x2*)(XT + col * S72 + (16 * k + 4 * g) * 2) = (u32x2){pk2(x[0], x[1]), pk2(x[2], x[3])};
            }
        }
    }
    __syncthreads();
    {
        const int q4 = l15 >> 2, p4 = lane & 3;
#pragma unroll
        for (int j = 0; j < 4; ++j) { const int op = wid * 4 + j, which = op >> 4, ks = (op >> 2) & 3, nb = op & 3;
            const bf16x8 f = frag_tr(XT + which * 128 * S72, S72, ks, nb, g, q4, p4); const int row = 16 * nb + l15, cc = 32 * ks + 8 * g;
            if (which == 0) *(bf16x8*)(PJ + (row0 + row) * LP + ov + cc) = f; else *(bf16x8*)((bf16*)(rec + GP_W) + row * 128 + cc) = f; }
    }
    TMARK(35);
    {
        { const int row = tid >> 3, c8 = tid & 7; *(u32x4*)(rec + GP_ATT + row * 128 + c8 * 16) = *(const LAS u32x4*)(ATTS + row * S72 + c8 * 16); }
        { const int dk = tid & 127, qt = tid >> 7; const float gl = GC[63]; unsigned w[8];
#pragma unroll
          for (int i = 0; i < 8; ++i) { const int c0 = qt * 16 + 2 * i; w[i] = pk2(kf[c0 * 128 + dk] * __expf(gl - GC[c0]), kf[(c0 + 1) * 128 + dk] * __expf(gl - GC[c0 + 1])); }
          u32x4* kp = (u32x4*)(rec + GP_KDT + dk * 128 + qt * 32);
          kp[0] = (u32x4){w[0], w[1], w[2], w[3]}; kp[1] = (u32x4){w[4], w[5], w[6], w[7]}; }
        if (tid == 0) *(float*)(rec + GP_CD) = EG[63];
    }
    TMARK(36);
}

__device__ __forceinline__ void gdn_scan_chain(KArgP A, int l, LAS unsigned char* lds, int b, int h, int ocol = -1) {
    bf16* PJ = (bf16*)(A->ws + WS_PROJ);
    unsigned char* dsc = (unsigned char*)A->out;
    const int tid = otid(), lane = tid & 63, wid = tid >> 6, l15 = lane & 15, g = lane >> 4;
    constexpr int S136 = 272, S72 = 144;
    LAS unsigned char* Wl = lds; LAS unsigned char* QDl = lds + 17408; LAS unsigned char* Ul = lds + 34816; LAS unsigned char* KDTl = lds + 52224; LAS unsigned char* ATTl = lds + 70656;
    LAS unsigned char* STl = lds + 79872; LAS unsigned char* VNl = lds + 114688; LAS float* SSQ = (LAS float*)(lds + 133120);
    LAS unsigned char* OST = Wl;
    const float* nw = A->gdn_norm_w + l * 128;
    const int mb = wid >> 1, nb0 = 4 * (wid & 1);
    f32x4 S[8];
#pragma unroll
    for (int j = 0; j < 8; ++j) S[j] = (f32x4){0.f, 0.f, 0.f, 0.f};
    __syncthreads();
    for (int i = tid; i < 128 * S136 / 16; i += 512) *(LAS u32x4*)(STl + i * 16) = (u32x4){0u, 0u, 0u, 0u};
    u32x4 pw[2], pq[2], pu[2], pk[2], pa, pz[2], zc[2]; float cd = 0.f, cdn = 0.f;
#define GDN_ISSUE(nn) do { const unsigned char* rec_ = dsc + DO_GP + (size_t)((b * 4 + h) * 32 + (nn)) * GP_STRIDE; const size_t r0_ = (size_t)b * SEQ + (nn) * 64; \
        _Pragma("unroll") for (int q_ = 0; q_ < 2; ++q_) { const int c_ = tid + 512 * q_, row_ = c_ >> 4, c16_ = c_ & 15; \
            pw[q_] = *(const u32x4*)(rec_ + GP_W + row_ * 256 + c16_ * 16); \
            pq[q_] = *(const u32x4*)(PJ + (r0_ + row_) * LP + C_GQ + h * 128 + c16_ * 8); pu[q_] = *(const u32x4*)(PJ + (r0_ + row_) * LP + C_GV + h * 128 + c16_ * 8); \
            pk[q_] = *(const u32x4*)(rec_ + GP_KDT + (c_ >> 3) * 128 + (c_ & 7) * 16); pz[q_] = *(const u32x4*)(PJ + (r0_ + row_) * LP + C_OA + h * 128 + c16_ * 8); } \
        pa = *(const u32x4*)(rec_ + GP_ATT + (tid >> 3) * 128 + (tid & 7) * 16); cdn = *(const float*)(rec_ + GP_CD); } while (0)
    GDN_ISSUE(0);
    for (int n = 0; n < SEQ / 64; ++n) {
        const size_t row0 = (size_t)b * SEQ + n * 64;
        __syncthreads();
#pragma unroll
        for (int q = 0; q < 2; ++q) { const int c = tid + 512 * q, row = c >> 4, c16 = c & 15;
            *(LAS u32x4*)(Wl + row * S136 + c16 * 16) = pw[q]; *(LAS u32x4*)(QDl + row * S136 + c16 * 16) = pq[q]; *(LAS u32x4*)(Ul + row * S136 + c16 * 16) = pu[q];
            *(LAS u32x4*)(KDTl + (c >> 3) * S72 + (c & 7) * 16) = pk[q]; }
        *(LAS u32x4*)(ATTl + (tid >> 3) * S72 + (tid & 7) * 16) = pa; cd = cdn; zc[0] = pz[0]; zc[1] = pz[1];
        __syncthreads();
        if (n + 1 < SEQ / 64) GDN_ISSUE(n + 1);
        f32x4 accO[4];
        {
            bf16x8 aw[4], aq[4];
#pragma unroll
            for (int ks = 0; ks < 4; ++ks) { aw[ks] = frag_rm(Wl, S136, mb, ks, l15, g); aq[ks] = frag_rm(QDl, S136, mb, ks, l15, g); }
#pragma unroll
            for (int j = 0; j < 4; ++j) { const int nb = nb0 + j; f32x4 ws = (f32x4){0.f, 0.f, 0.f, 0.f}; accO[j] = (f32x4){0.f, 0.f, 0.f, 0.f};
#pragma unroll
                for (int ks = 0; ks < 4; ++ks) { const bf16x8 sf = frag_rm(STl, S136, nb, ks, l15, g); ws = MFMA16(aw[ks], sf, ws); accO[j] = MFMA16(aq[ks], sf, accO[j]); }
                float vn[4];
#pragma unroll
                for (int r = 0; r < 4; ++r) vn[r] = bf2f(*(const LAS bf16*)(Ul + (mb * 16 + 4 * g + r) * S136 + (nb * 16 + l15) * 2)) - ws[r];
                *(LAS u32x2*)(VNl + (nb * 16 + l15) * S72 + (mb * 16 + 4 * g) * 2) = (u32x2){pk2(vn[0], vn[1]), pk2(vn[2], vn[3])}; }
        }
        __syncthreads();
        {
            bf16x8 aa[2], ak[2];
#pragma unroll
            for (int ks = 0; ks < 2; ++ks) { aa[ks] = frag_rm(ATTl, S72, mb, ks, l15, g); ak[ks] = frag_rm(KDTl, S72, wid, ks, l15, g); }
#pragma unroll
            for (int j = 0; j < 4; ++j)
#pragma unroll
                for (int ks = 0; ks < 2; ++ks) accO[j] = MFMA16(aa[ks], frag_rm(VNl, S72, nb0 + j, ks, l15, g), accO[j]);
#pragma unroll
            for (int jb = 0; jb < 8; ++jb) { S[jb] = S[jb] * cd;
#pragma unroll
                for (int ks = 0; ks < 2; ++ks) S[jb] = MFMA16(ak[ks], frag_rm(VNl, S72, jb, ks, l15, g), S[jb]);
                *(LAS u32x2*)(STl + (jb * 16 + l15) * S136 + (wid * 16 + 4 * g) * 2) = (u32x2){pk2(S[jb][0], S[jb][1]), pk2(S[jb][2], S[jb][3])}; }
        }
        {
            float ss[4];
#pragma unroll
            for (int r = 0; r < 4; ++r) { float s = 0.f;
#pragma unroll
                for (int j = 0; j < 4; ++j) s += accO[j][r] * accO[j][r];
                s += swz_xor<1>(s); s += swz_xor<2>(s); s += swz_xor<4>(s); s += swz_xor<8>(s); ss[r] = s; }
            if (l15 == 0) {
#pragma unroll
                for (int r = 0; r < 4; ++r) SSQ[(mb * 16 + 4 * g + r) * 2 + (wid & 1)] = ss[r]; }
            __syncthreads();
#pragma unroll
            for (int r = 0; r < 4; ++r) { const int i = mb * 16 + 4 * g + r; const float sc = rsqrtf((SSQ[i * 2] + SSQ[i * 2 + 1]) * (1.f / 128.f) + 1e-6f);
#pragma unroll
                for (int j = 0; j < 4; ++j) { const int dv = (nb0 + j) * 16 + l15; *(LAS bf16*)(OST + i * S136 + dv * 2) = (bf16)f2bf(accO[j][r] * sc * nw[dv]); } }
            __syncthreads();
#pragma unroll
            for (int q = 0; q < 2; ++q) { const int it = tid + 512 * q, tt = it >> 4, c8 = it & 15;
                bf16* gp = PJ + (row0 + tt) * LP + C_OA + h * 128 + c8 * 8; const u32x4 rv = zc[q]; if (ocol >= 0) gp = PJ + (row0 + tt) * LP + ocol + c8 * 8; const u32x4 ov = *(const LAS u32x4*)(OST + tt * S136 + c8 * 16);
                u32x4 w; w.x = pk2(bflo(ov.x) * siluf_(bflo(rv.x)), bfhi(ov.x) * siluf_(bfhi(rv.x))); w.y = pk2(bflo(ov.y) * siluf_(bflo(rv.y)), bfhi(ov.y) * siluf_(bfhi(rv.y)));
                w.z = pk2(bflo(ov.z) * siluf_(bflo(rv.z)), bfhi(ov.z) * siluf_(bfhi(rv.z))); w.w = pk2(bflo(ov.w) * siluf_(bflo(rv.w)), bfhi(ov.w) * siluf_(bfhi(rv.w)));
                *(u32x4*)gp = w; }
        }
    }
#undef GDN_ISSUE
}

__device__ __forceinline__ unsigned char* gla_slot(KArgP A, int b, int h, int n) {
    const int s = (b * 4 + h) * 32 + n;
    return b < 13 ? A->ws + WS_KVS + (size_t)s * 16384 : (unsigned char*)A->out + DO_KVS + (size_t)(s - 13 * 128) * 16384;
}
struct GlaPre { u32x4 v[2], q, k; unsigned short lr[2]; };
__device__ __forceinline__ void gla_prep_issue(GlaPre& P, KArgP A, int b, int h, int n) {
    const bf16* PJ = (const bf16*)(A->ws + WS_PROJ); const int tid = otid(); const size_t row0 = (size_t)b * SEQ + n * 64;
#pragma unroll
    for (int q = 0; q < 2; ++q) { const int it = tid + 512 * q, tt = it >> 4, c = it & 15;
        P.lr[q] = PJ[(row0 + tt) * LP + C_SM + 16 + c]; P.v[q] = *(const u32x4*)(PJ + (row0 + tt) * LP + C_LV + h * 128 + c * 8); }
    const int tt0 = tid >> 3, c80 = tid & 7;
    P.q = *(const u32x4*)(PJ + (row0 + tt0) * LP + C_LQ + h * 64 + c80 * 8); P.k = *(const u32x4*)(PJ + (row0 + tt0) * LP + C_LK + h * 64 + c80 * 8);
}
__device__ __forceinline__ void gla_prep_task(KArgP A, int l, LAS unsigned char* lds, int b, int h, int n, GlaPre& P, bool has_next, int nb_, int nh_, int nn_, GlaPre& N) {
    bf16* PJ = (bf16*)(A->ws + WS_PROJ);
    const int tid = otid(), lane = tid & 63, wid = tid >> 6, l15 = lane & 15, g = lane >> 4, q4 = l15 >> 2, p4 = lane & 3;
    constexpr int S72 = 144, S136 = 272;
    LAS unsigned char* QT = lds; LAS unsigned char* KT = QT + 64 * S72; LAS unsigned char* KDT = KT + 64 * S72; LAS unsigned char* ATT = KDT + 64 * S72; LAS unsigned char* VV = ATT + 64 * S72;
    LAS float* LA = (LAS float*)(VV + 64 * S136); LAS float* LR = LA + 64 * 64; LAS float* SEG = LR + 64 * 16;
    const float* wg2 = A->gla_w_gate2 + (size_t)l * 16 * 256; const float* bg = A->gla_b_gate + l * 256;
    const size_t row0 = (size_t)b * SEQ + n * 64;
    const int mb = wid >> 1, nb0 = 4 * (wid & 1);
    __syncthreads();
#pragma unroll
    for (int q = 0; q < 2; ++q) { const int it = tid + 512 * q; LR[it] = bf2f(P.lr[q]); *(LAS u32x4*)(VV + (it >> 4) * S136 + (it & 15) * 16) = P.v[q]; }
    const int tt0 = tid >> 3, c80 = tid & 7;
    const u32x4 qv = P.q, kv = P.k;
    if (has_next) gla_prep_issue(N, A, nb_, nh_, nn_);
    __syncthreads();
    for (int it = tid; it < 64 * 64; it += 512) { const int tt = it >> 6, d = it & 63; float z = bg[h * 64 + d];
#pragma unroll
        for (int r = 0; r < 16; ++r) z += LR[tt * 16 + r] * wg2[r * 256 + h * 64 + d];
        LA[it] = logsigmoidf_(z) * (1.f / 16.f); }
    __syncthreads();
    { const int d = tid & 63, seg = tid >> 6; float run = 0.f;
#pragma unroll
      for (int i = 0; i < 8; ++i) { run += LA[(seg * 8 + i) * 64 + d]; LA[(seg * 8 + i) * 64 + d] = run; }
      SEG[seg * 64 + d] = run; }
    __syncthreads();
    { const int d = tid & 63, seg = tid >> 6; float pre = 0.f;
      for (int s2 = 0; s2 < seg; ++s2) pre += SEG[s2 * 64 + d];
#pragma unroll
      for (int i = 0; i < 8; ++i) LA[(seg * 8 + i) * 64 + d] += pre; }
    __syncthreads();
    {
        const float qf[8] = {bflo(qv.x), bfhi(qv.x), bflo(qv.y), bfhi(qv.y), bflo(qv.z), bfhi(qv.z), bflo(qv.w), bfhi(qv.w)};
        const float kf[8] = {bflo(kv.x), bfhi(kv.x), bflo(kv.y), bfhi(kv.y), bflo(kv.z), bfhi(kv.z), bflo(kv.w), bfhi(kv.w)};
        float qt[8], kt[8];
#pragma unroll
        for (int e = 0; e < 8; ++e) { const int d = c80 * 8 + e; const float cu = LA[tt0 * 64 + d], cl = LA[63 * 64 + d];
            qt[e] = qf[e] * 0.125f * __expf(cu); kt[e] = kf[e] * __expf(-cu);
            *(LAS bf16*)(KDT + d * S72 + tt0 * 2) = (bf16)f2bf(kf[e] * __expf(cl - cu)); }
        const u32x4 qw = (u32x4){pk2(qt[0], qt[1]), pk2(qt[2], qt[3]), pk2(qt[4], qt[5]), pk2(qt[6], qt[7])};
        *(LAS u32x4*)(QT + tt0 * S72 + c80 * 16) = qw;
        *(u32x4*)(PJ + (row0 + tt0) * LP + C_LQ + h * 64 + c80 * 8) = qw;
        *(LAS u32x4*)(KT + tt0 * S72 + c80 * 16) = (u32x4){pk2(kt[0], kt[1]), pk2(kt[2], kt[3]), pk2(kt[4], kt[5]), pk2(kt[6], kt[7])};
        if (tid < 64) ((float*)(A->ws + WS_CDB))[(size_t)((b * 4 + h) * 32 + n) * 64 + tid] = __expf(LA[63 * 64 + tid]);
    }
    __syncthreads();
    {
        bf16x8 af[2], kf2[2];
#pragma unroll
        for (int ks = 0; ks < 2; ++ks) { af[ks] = frag_rm(QT, S72, mb, ks, l15, g); kf2[ks] = frag_rm(KDT, S72, mb, ks, l15, g); }
#pragma unroll
        for (int j = 0; j < 2; ++j) { const int nb = 2 * (wid & 1) + j; f32x4 a = (f32x4){0.f, 0.f, 0.f, 0.f};
#pragma unroll
            for (int ks = 0; ks < 2; ++ks) a = MFMA16(af[ks], frag_rm(KT, S72, nb, ks, l15, g), a);
#pragma unroll
            for (int r = 0; r < 4; ++r) { const int i = mb * 16 + 4 * g + r, jj = nb * 16 + l15; *(LAS bf16*)(ATT + i * S72 + jj * 2) = (bf16)f2bf(jj <= i ? a[r] : 0.f); } }
        unsigned char* slot = gla_slot(A, b, h, n);
#pragma unroll
        for (int j = 0; j < 4; ++j) { f32x4 kvb = (f32x4){0.f, 0.f, 0.f, 0.f};
#pragma unroll
            for (int ks = 0; ks < 2; ++ks) kvb = MFMA16(kf2[ks], frag_tr(VV, S136, ks, nb0 + j, g, q4, p4), kvb);
            *(u32x2*)(slot + ((nb0 + j) * 16 + l15) * 128 + (mb * 16 + 4 * g) * 2) = (u32x2){pk2(kvb[0], kvb[1]), pk2(kvb[2], kvb[3])}; }
    }
    __syncthreads();
    { const int row = tid >> 3, c8 = tid & 7; *(u32x4*)(PJ + (row0 + row) * LP + C_LK + h * 64 + c8 * 8) = *(const LAS u32x4*)(ATT + row * S72 + c8 * 16); }
}
__device__ __forceinline__ void gla_state_scan(KArgP A) {
    for (int gt = obid() * 512 + otid(); gt < 64 * 2048; gt += ogrid() * 512) {
    const int ch = gt >> 11, e4 = gt & 2047, b = ch >> 2, h = ch & 3;
    const float* cdb = (const float*)(A->ws + WS_CDB) + (size_t)ch * 32 * 64 + (e4 & 15) * 4;
    float s0 = 0.f, s1 = 0.f, s2 = 0.f, s3 = 0.f;
#pragma unroll 8
    for (int n = 0; n < 32; ++n) {
        u32x2* p = (u32x2*)(gla_slot(A, b, h, n) + e4 * 8); const u32x2 kv = *p; const f32x4 cd = *(const f32x4*)(cdb + n * 64);
        *p = (u32x2){pk2(s0, s1), pk2(s2, s3)};
        s0 = cd[0] * s0 + bflo(kv.x); s1 = cd[1] * s1 + bfhi(kv.x); s2 = cd[2] * s2 + bflo(kv.y); s3 = cd[3] * s3 + bfhi(kv.y);
    }
    }
}
__device__ __forceinline__ void gla_out_task(KArgP A, int l, LAS unsigned char* lds, int b, int h, int n) {
    bf16* PJ = (bf16*)(A->ws + WS_PROJ);
    const int tid = otid(), lane = tid & 63, wid = tid >> 6, l15 = lane & 15, g = lane >> 4, q4 = l15 >> 2, p4 = lane & 3;
    constexpr int S72 = 144, S136 = 272;
    LAS unsigned char* QT = lds; LAS unsigned char* ATT = QT + 64 * S72; LAS unsigned char* VV = ATT + 64 * S72; LAS unsigned char* ST = VV + 64 * S136; LAS unsigned char* OST = ST + 128 * S72;
    LAS float* SSQ = (LAS float*)(OST + 64 * S136);
    const float* nw = A->gla_norm_w + l * 128;
    const size_t row0 = (size_t)b * SEQ + n * 64;
    const int mb = wid >> 1, nb0 = 4 * (wid & 1);
    const unsigned char* slot = gla_slot(A, b, h, n);
    u32x4 rpre[2];
#pragma unroll
    for (int q = 0; q < 2; ++q) { const int it = tid + 512 * q; rpre[q] = *(const u32x4*)(PJ + (row0 + (it >> 4)) * LP + C_OC + h * 128 + (it & 15) * 8); }
    __syncthreads();
    { const int row = tid >> 3, c8 = tid & 7;
      *(LAS u32x4*)(QT + row * S72 + c8 * 16) = *(const u32x4*)(PJ + (row0 + row) * LP + C_LQ + h * 64 + c8 * 8);
      *(LAS u32x4*)(ATT + row * S72 + c8 * 16) = *(const u32x4*)(PJ + (row0 + row) * LP + C_LK + h * 64 + c8 * 8); }
#pragma unroll
    for (int q = 0; q < 2; ++q) { const int c = tid + 512 * q;
        *(LAS u32x4*)(VV + (c >> 4) * S136 + (c & 15) * 16) = *(const u32x4*)(PJ + (row0 + (c >> 4)) * LP + C_LV + h * 128 + (c & 15) * 8);
        *(LAS u32x4*)(ST + (c >> 3) * S72 + (c & 7) * 16) = *(const u32x4*)(slot + (c >> 3) * 128 + (c & 7) * 16); }
    __syncthreads();
    f32x4 acc[4];
    {
        bf16x8 af[2], aa[2];
#pragma unroll
        for (int ks = 0; ks < 2; ++ks) { af[ks] = frag_rm(QT, S72, mb, ks, l15, g); aa[ks] = frag_rm(ATT, S72, mb, ks, l15, g); }
#pragma unroll
        for (int j = 0; j < 4; ++j) { acc[j] = (f32x4){0.f, 0.f, 0.f, 0.f};
#pragma unroll
            for (int ks = 0; ks < 2; ++ks) { acc[j] = MFMA16(af[ks], frag_rm(ST, S72, nb0 + j, ks, l15, g), acc[j]); acc[j] = MFMA16(aa[ks], frag_tr(VV, S136, ks, nb0 + j, g, q4, p4), acc[j]); } }
    }
    float ss[4];
#pragma unroll
    for (int r = 0; r < 4; ++r) { float s = 0.f;
#pragma unroll
        for (int j = 0; j < 4; ++j) s += acc[j][r] * acc[j][r];
        s += swz_xor<1>(s); s += swz_xor<2>(s); s += swz_xor<4>(s); s += swz_xor<8>(s); ss[r] = s; }
    if (l15 == 0) {
#pragma unroll
        for (int r = 0; r < 4; ++r) SSQ[(mb * 16 + 4 * g + r) * 2 + (wid & 1)] = ss[r]; }
    __syncthreads();
#pragma unroll
    for (int r = 0; r < 4; ++r) { const int i = mb * 16 + 4 * g + r; const float sc = rsqrtf((SSQ[i * 2] + SSQ[i * 2 + 1]) * (1.f / 128.f) + 1e-6f);
#pragma unroll
        for (int j = 0; j < 4; ++j) { const int dv = (nb0 + j) * 16 + l15; *(LAS bf16*)(OST + i * S136 + dv * 2) = (bf16)f2bf(acc[j][r] * sc * nw[dv]); } }
    __syncthreads();
#pragma unroll
    for (int q = 0; q < 2; ++q) { const int it = tid + 512 * q, tt = it >> 4, c8 = it & 15;
        bf16* gp = PJ + (row0 + tt) * LP + C_OC + h * 128 + c8 * 8; const u32x4 rv = rpre[q]; const u32x4 ov = *(const LAS u32x4*)(OST + tt * S136 + c8 * 16);
        u32x4 w; w.x = pk2(bflo(ov.x) * siluf_(bflo(rv.x)), bfhi(ov.x) * siluf_(bfhi(rv.x))); w.y = pk2(bflo(ov.y) * siluf_(bflo(rv.y)), bfhi(ov.y) * siluf_(bfhi(rv.y)));
        w.z = pk2(bflo(ov.z) * siluf_(bflo(rv.z)), bfhi(ov.z) * siluf_(bfhi(rv.z))); w.w = pk2(bflo(ov.w) * siluf_(bflo(rv.w)), bfhi(ov.w) * siluf_(bfhi(rv.w)));
        *(u32x4*)gp = w; }
}

struct LnRow { float v[16]; };
__device__ __forceinline__ void ln_normalize(LnRow& r, const float* g, const float* bta, int lane) {
    float s = 0.f;
#pragma unroll
    for (int i = 0; i < 16; ++i) s += r.v[i];
    const float mean = wave_sum(s) * (1.f / 1024.f); float q = 0.f;
#pragma unroll
    for (int i = 0; i < 16; ++i) { r.v[i] -= mean; q += r.v[i] * r.v[i]; }
    const float rstd = rsqrtf(wave_sum(q) * (1.f / 1024.f) + 1e-5f);
#pragma unroll
    for (int jj = 0; jj < 2; ++jj) { const int k = 8 * (lane + 64 * jj);
        const f32x4 g0 = *(const f32x4*)(g + k), g1 = *(const f32x4*)(g + k + 4), b0 = *(const f32x4*)(bta + k), b1 = *(const f32x4*)(bta + k + 4);
#pragma unroll
        for (int e = 0; e < 4; ++e) { r.v[jj * 8 + e] = r.v[jj * 8 + e] * rstd * g0[e] + b0[e]; r.v[jj * 8 + 4 + e] = r.v[jj * 8 + 4 + e] * rstd * g1[e] + b1[e]; } }
}
__device__ __forceinline__ void ln_load_bf16(LnRow& r, const bf16* row, int lane, float scale) {
#pragma unroll
    for (int jj = 0; jj < 2; ++jj) { const u32x4 t = *(const u32x4*)(row + 8 * (lane + 64 * jj));
        r.v[jj * 8 + 0] = scale * bflo(t.x); r.v[jj * 8 + 1] = scale * bfhi(t.x); r.v[jj * 8 + 2] = scale * bflo(t.y); r.v[jj * 8 + 3] = scale * bfhi(t.y);
        r.v[jj * 8 + 4] = scale * bflo(t.z); r.v[jj * 8 + 5] = scale * bfhi(t.z); r.v[jj * 8 + 6] = scale * bflo(t.w); r.v[jj * 8 + 7] = scale * bfhi(t.w); }
}
__device__ __forceinline__ void ln_add_bf16(LnRow& r, const bf16* row, int lane, float scale) {
#pragma unroll
    for (int jj = 0; jj < 2; ++jj) { const u32x4 t = *(const u32x4*)(row + 8 * (lane + 64 * jj));
        r.v[jj * 8 + 0] += scale * bflo(t.x); r.v[jj * 8 + 1] += scale * bfhi(t.x); r.v[jj * 8 + 2] += scale * bflo(t.y); r.v[jj * 8 + 3] += scale * bfhi(t.y);
        r.v[jj * 8 + 4] += scale * bflo(t.z); r.v[jj * 8 + 5] += scale * bfhi(t.z); r.v[jj * 8 + 6] += scale * bflo(t.w); r.v[jj * 8 + 7] += scale * bfhi(t.w); }
}
__device__ __forceinline__ void ln_store_bf16(const LnRow& r, bf16* row, int lane) {
#pragma unroll
    for (int jj = 0; jj < 2; ++jj) { u32x4 w; w.x = pk2(r.v[jj * 8], r.v[jj * 8 + 1]); w.y = pk2(r.v[jj * 8 + 2], r.v[jj * 8 + 3]); w.z = pk2(r.v[jj * 8 + 4], r.v[jj * 8 + 5]); w.w = pk2(r.v[jj * 8 + 6], r.v[jj * 8 + 7]);
        *(u32x4*)(row + 8 * (lane + 64 * jj)) = w; }
}
__device__ __forceinline__ void ln_store_f32(const LnRow& r, float* row, int lane) {
#pragma unroll
    for (int jj = 0; jj < 2; ++jj) { float* p = row + 8 * (lane + 64 * jj);
        *(f32x4*)p = (f32x4){r.v[jj * 8], r.v[jj * 8 + 1], r.v[jj * 8 + 2], r.v[jj * 8 + 3]}; *(f32x4*)(p + 4) = (f32x4){r.v[jj * 8 + 4], r.v[jj * 8 + 5], r.v[jj * 8 + 6], r.v[jj * 8 + 7]}; }
}

__device__ __forceinline__ KArgP argp() { KArgP p = (KArgP)__builtin_amdgcn_kernarg_segment_ptr(); asm volatile("" : "+s"(p)); return p; }
#define XB_TMO      128
#define XB_XCNT(j)  (256  + 64 * (j))
#define XB_XSUB(j)  (1280 + 64 * (j))
#define XB_XGEN(j)  (2304 + 64 * (j))
#define XB_TOP      3328
#define XB_TOPGEN   3392
#define XB_SPIN_CAP (1u << 20)
constexpr int CW_BAR = 4096;
__device__ __forceinline__ unsigned xb_ld(unsigned* p)              { return __hip_atomic_load(p, __ATOMIC_RELAXED, __HIP_MEMORY_SCOPE_AGENT); }
__device__ __forceinline__ unsigned xb_add(unsigned* p, unsigned v) { return __hip_atomic_fetch_add(p, v, __ATOMIC_RELAXED, __HIP_MEMORY_SCOPE_AGENT); }
__device__ __forceinline__ unsigned xb_xcc_id() { return (unsigned)__builtin_amdgcn_s_getreg((3 << 11) | 20) & 0xFu; }
#define XB_SPIN(cond, bar) do { unsigned _sp = 0; while (cond) { __builtin_amdgcn_s_sleep(1); \
    if ((++_sp & 255u) == 0u) { if (xb_ld(&(bar)[XB_TMO])) break; if (_sp > XB_SPIN_CAP) { atomicAdd(&(bar)[XB_TMO], 1u); break; } } } } while (0)
__device__ __forceinline__ void xcd_barrier_complete(unsigned* bar, unsigned x, unsigned& nloc, unsigned& nx) {
    const unsigned G = gridDim.x;
    unsigned sum, cnt, mine, sp = 0u;
    for (;;) {
        sum = 0u; cnt = 0u; mine = 0u;
#pragma unroll
        for (unsigned j = 0; j < 16; ++j) { const unsigned c = xb_ld(&bar[XB_XCNT(j)]); sum += c; cnt += (c > 0u) ? 1u : 0u; mine = (j == x) ? c : mine; }
        if (sum == G) break;
        __builtin_amdgcn_s_sleep(1);
        if ((++sp & 255u) == 0u) { if (xb_ld(&bar[XB_TMO])) break; if (sp > XB_SPIN_CAP) { atomicAdd(&bar[XB_TMO], 1u); break; } }
    }
    nloc = mine > 0u ? mine : 1u; nx = cnt > 0u ? cnt : 1u;
}
__device__ __forceinline__ void grid_barrier(LAS unsigned char* lds) {
    volatile LAS unsigned* st = (volatile LAS unsigned*)(lds + LDS_CTL + 2048);
    asm volatile("s_waitcnt vmcnt(0)" ::: "memory");
    __syncthreads();
    if (otid() == 0) {
        unsigned* bar = (unsigned*)(argp()->ws + WS_CTL) + CW_BAR;
        const unsigned x = xb_xcc_id();
        __builtin_amdgcn_s_waitcnt(0);
        unsigned nloc = st[0], nx = st[1];
        if (nloc == 0u) { xcd_barrier_complete(bar, x, nloc, nx); st[0] = nloc; st[1] = nx; }
        const unsigned old = xb_add(&bar[XB_XSUB(x)], 1u);
        const unsigned gen = old / nloc;
        if (old + 1u == (gen + 1u) * nloc) {
            __builtin_amdgcn_fence(__ATOMIC_RELEASE, "agent");
            asm volatile("s_waitcnt vmcnt(0)" ::: "memory");
            const unsigned og = xb_add(&bar[XB_TOP], 1u);
            const unsigned tg = og / nx;
            if (og + 1u == (tg + 1u) * nx) xb_add(&bar[XB_TOPGEN], 1u);
            else XB_SPIN(xb_ld(&bar[XB_TOPGEN]) == tg, bar);
            __builtin_amdgcn_fence(__ATOMIC_ACQUIRE, "agent");
            xb_add(&bar[XB_XGEN(x)], 1u);
            asm volatile("s_waitcnt vmcnt(0)" ::: "memory");
        } else {
            XB_SPIN(xb_ld(&bar[XB_XGEN(x)]) == gen, bar);
            __builtin_amdgcn_fence(__ATOMIC_ACQUIRE, "agent");
            asm volatile("s_waitcnt vmcnt(0)" ::: "memory");
        }
    }
    __syncthreads();
}

#define PH_COMMON \
    KArgP ap = argp(); unsigned char* ws = ap->ws; (void)ws; \
    const int tid = otid(), lane = tid & 63, wid = tid >> 6; (void)lane; (void)wid; \
    const int G = ogrid(), bx = obid(), gw = bx * 8 + wid, NGW = G * 8; (void)gw; (void)NGW; \
    unsigned char* wt = ws + WS_WT; (void)wt; bf16* XB = (bf16*)(ws + WS_XB); (void)XB; bf16* PJ = (bf16*)(ws + WS_PROJ); (void)PJ; \
    unsigned char* dsc = (unsigned char*)ap->out; bf16* Y = (bf16*)(dsc + DO_Y); (void)Y; bf16* KV = (bf16*)(dsc + DO_KV); (void)KV; bf16* MEMB = (bf16*)(dsc + DO_MEMB); (void)MEMB;

__device__ __forceinline__ void ph_input(LAS unsigned char* lds) { PH_COMMON
    convert_rows(ap->x, XB, (size_t)NTOK * DM);
    convert_rows(ap->mem, MEMB, (size_t)NMEM * DM);
}
__device__ __forceinline__ void ph_weights(LAS unsigned char* lds, int l) { KArgP A = argp(); phase_convert_weights(A, l, lds); }
__device__ __forceinline__ void ph_proj(LAS unsigned char* lds, int l) { PH_COMMON
    pg8::Gemm g{1024, 1024, 1024};
    RegSched S{NTOK / 256, LP / 256, (NTOK / 256) * (LP / 256), G, bx, (const char*)XB, (const char*)(wt + WT_WIN), (size_t)256 * 1024 * 2, (size_t)256 * 1024 * 2, 0};
    pg8::EpiProj E{PJ, LP, (bf16*)(dsc + DO_HALO)};
    pg8::gemm_phase(lds, g, S, E);
}
__device__ __forceinline__ void ph_kv(LAS unsigned char* lds, int l) { PH_COMMON
    pg8::Gemm g{1024, 1024, 1024};
    if (bx < G - 128) return;
    RegSched S2{NMEM / 256, 2048 / 256, (NMEM / 256) * (2048 / 256), G, bx - (G - 128), (const char*)MEMB, (const char*)(wt + WT_WKV), (size_t)256 * 1024 * 2, (size_t)256 * 1024 * 2, 0};
    pg8::EpiStore E2{KV, 2048, 1.f};
    pg8::gemm_phase(lds, g, S2, E2);
}
__device__ __forceinline__ void ph_gdn_prep(LAS unsigned char* lds, int l) {
    KArgP A = argp();
    const int G = ogrid(), bx = obid();
    TMARK(20);
    if (bx < NB * 8) fox_ck_task(A, l, lds, bx >> 3, bx & 7);
    { GdnPre P, N; if (bx < NB * 4 * 32) gdn_prep_issue(P, A, l, bx >> 7, (bx >> 5) & 3, bx & 31);
      for (int t = bx; t < NB * 4 * 32; t += G) { const int t2 = t + G; const bool hn = t2 < NB * 4 * 32;
          gdn_prep_task(A, l, lds, t >> 7, (t >> 5) & 3, t & 31, P, hn, t2 >> 7, (t2 >> 5) & 3, t2 & 31, N);
          P = N; } }
    TMARK(21);
    { GlaPre P, N; if (bx < NB * 4 * 32) gla_prep_issue(P, A, bx >> 7, (bx >> 5) & 3, bx & 31);
      for (int t = bx; t < NB * 4 * 32; t += G) { const int t2 = t + G; const bool hn = t2 < NB * 4 * 32;
          gla_prep_task(A, l, lds, t >> 7, (t >> 5) & 3, t & 31, P, hn, t2 >> 7, (t2 >> 5) & 3, t2 & 31, N);
          P = N; } }
    TMARK(22);
}
__device__ __forceinline__ void ph_gla_scan(LAS unsigned char* lds, int l) { KArgP A = argp(); gla_state_scan(A); }
__device__ __forceinline__ void ph_mix(LAS unsigned char* lds, int l) {
    KArgP A = argp();
    const int bx = obid();
    TMARK(23);
    if (bx < 64) gdn_scan_chain(A, l, lds, bx >> 2, bx & 3);
    TMARK(24);
    unsigned* ctr = (unsigned*)(A->ws + WS_CTL) + 128 + l;
    volatile LAS int* qw = (volatile LAS int*)(lds + LDS_CTL + 2400);
    for (;;) {
        __syncthreads();
        if (otid() == 0) qw[0] = (int)atomicAdd(ctr, 1u);
        __syncthreads();
        const int u = qw[0];
        if (u >= NB * 8 * 8 + NB * 4 * 32) break;
        if (u < NB * 8 * 8) { TMARK(26); const int qb = 7 - (u >> 7), bh = u & 127; fox_unit(A, l, lds, bh >> 3, bh & 7, qb); TMARK(27); }
        else { TMARK(28); const int t = u - NB * 8 * 8; gla_out_task(A, l, lds, t >> 7, (t >> 5) & 3, t & 31); TMARK(29); }
    }
    TMARK(25);
}
#ifndef PROBE_MIX
#define PROBE_MIX 0
#endif
__device__ __forceinline__ void ph_mix_probe(LAS unsigned char* lds, int l) {
    KArgP A = argp();
    const int bx = obid();
    if (PROBE_MIX == 1) {
        unsigned* ctr = (unsigned*)(A->ws + WS_CTL) + 132 + l;
        volatile LAS int* qw = (volatile LAS int*)(lds + LDS_CTL + 2400);
        for (;;) { __syncthreads(); if (otid() == 0) qw[0] = (int)atomicAdd(ctr, 1u); __syncthreads(); const int u = qw[0]; if (u >= NB * 8 * 8) break;
            const int qb = 7 - (u >> 7), bh = u & 127; fox_unit(A, l, lds, bh >> 3, bh & 7, qb, 5152); }
    }
    else if (PROBE_MIX == 3) { if (bx < 64) gdn_scan_chain(A, l, lds, bx >> 2, bx & 3, 5152); }
    else if (PROBE_MIX == 4) { const int G = ogrid(); GdnPre P, N; for (int t = bx; t < NB * 4 * 32; t += G) { gdn_prep_issue(P, A, l, t >> 7, (t >> 5) & 3, t & 31); gdn_prep_task(A, l, lds, t >> 7, (t >> 5) & 3, t & 31, P, false, 0, 0, 0, N, true); } }
}
__device__ __forceinline__ void ph_branch(LAS unsigned char* lds, int l) { PH_COMMON
    pg8::Gemm g{LP, 512, 512};
    BranchSched S{NTOK / 256, (NTOK / 256) * 12, G, bx, (const char*)PJ, (const char*)(wt + WT_P)};
    pg8::EpiStore E{PJ, LP, 1.f};
    pg8::gemm_phase(lds, g, S, E);
}
__device__ __forceinline__ void ph_gate(LAS unsigned char* lds, int l) { PH_COMMON
    pg8::Gemm g{1024, 1024, 1024};
    GateSched S{NTOK / 256, (NTOK / 256) * 4, G, bx, (const char*)XB, (const char*)(wt + WT_WIN + (size_t)LP * 1024 * 2)};
    pg8::EpiGate E{PJ, LP, ap->b_merge + (size_t)l * 3072};
    pg8::gemm_phase(lds, g, S, E);
}
__device__ __forceinline__ void ph_out(LAS unsigned char* lds, int l) { PH_COMMON
    pg8::Gemm g{LP, 1024, 1024};
    RegSched S{NTOK / 256, 4, (NTOK / 256) * 4, G, bx, (const char*)PJ, (const char*)(wt + WT_WOUT3), (size_t)256 * LP * 2, (size_t)256 * 1024 * 2, 0};
    pg8::EpiResid E{XB, Y, 1024};
    pg8::gemm_phase(lds, g, S, E);
}
__device__ __forceinline__ void ph_ln1(LAS unsigned char* lds, int l) { PH_COMMON
    const float* gg = ap->ln1_g + l * 1024; const float* bb = ap->ln1_b + l * 1024;
    for (int row = gw; row < NTOK; row += NGW) { LnRow r; ln_load_bf16(r, Y + (size_t)row * 1024, lane, 1.f); ln_normalize(r, gg, bb, lane); ln_store_bf16(r, XB + (size_t)row * 1024, lane); }
}
__device__ __forceinline__ void ph_q(LAS unsigned char* lds, int l) { PH_COMMON
    bf16* Qb = (bf16*)(ws + WS_PROJ + PJ_Q);
    pg8::Gemm g{1024, 1024, 1024};
    RegSched S{NTOK / 256, 4, (NTOK / 256) * 4, G, bx, (const char*)XB, (const char*)(wt + WT_WQ), (size_t)256 * 1024 * 2, (size_t)256 * 1024 * 2, 0};
    pg8::EpiStore E{Qb, 1024, 0.0625f * LOG2E};
    pg8::gemm_phase(lds, g, S, E);
}
__device__ __forceinline__ void ph_xattn(LAS unsigned char* lds, int l) { PH_COMMON
    bf16* Qb = (bf16*)(ws + WS_PROJ + PJ_Q); bf16* Ob = (bf16*)(ws + WS_PROJ + PJ_O);
    xattn_phase(lds, Qb, KV, Ob, G, bx);
}
__device__ __forceinline__ void ph_wo(LAS unsigned char* lds, int l) { PH_COMMON
    bf16* Ob = (bf16*)(ws + WS_PROJ + PJ_O);
    pg8::Gemm g{1024, 1024, 1024};
    RegSched S{NTOK / 256, 4, (NTOK / 256) * 4, G, bx, (const char*)Ob, (const char*)(wt + WT_WO), (size_t)256 * 1024 * 2, (size_t)256 * 1024 * 2, 0};
    pg8::EpiResid E{XB, Y, 1024};
    pg8::gemm_phase(lds, g, S, E);
}
__device__ __forceinline__ void ph_ln2_router(LAS unsigned char* lds, int l, int cnt_off = 0) { PH_COMMON
    unsigned* ctl = (unsigned*)(ws + WS_CTL);
    int* tokE = (int*)(ws + WS_SMALL + SM_TOKE); float* tokW = (float*)(ws + WS_SMALL + SM_TOKW); int* tokR = (int*)(ws + WS_SMALL + SM_TOKR);
    const int l15 = lane & 15, g = lane >> 4;
    constexpr int SX = 2064;
    LAS unsigned char* XH = lds; LAS unsigned char* XL = lds + 16 * SX;
    LAS float* PART = (LAS float*)(lds + 2 * 16 * SX);
    LAS float* LOG = PART + 8 * 16 * 48;
    unsigned* wcnt = ctl + 16384 + l * 8192 + cnt_off * 64;
    LAS unsigned* lcnt = (LAS unsigned*)(lds + LDS_CTL + 2560);
    const float* gg = ap->ln2_g + l * 1024; const float* bb = ap->ln2_b + l * 1024;
    const float* bgp = ap->moe_b_group + l * 4; const float* bep = ap->moe_b_expert + l * 32;
    bf16x8 bh[3][4], bl[3][4];
    { const bf16* RH = (const bf16*)(wt + WT_RWH); const bf16* RL = (const bf16*)(wt + WT_RWL);
#pragma unroll
      for (int nb = 0; nb < 3; ++nb)
#pragma unroll
          for (int kk = 0; kk < 4; ++kk) { const size_t off = (size_t)(nb * 16 + l15) * 1024 + (4 * wid + kk) * 32 + 8 * g; bh[nb][kk] = *(const bf16x8*)(RH + off); bl[nb][kk] = *(const bf16x8*)(RL + off); } }
    __syncthreads();
    if (tid < 32) lcnt[tid] = 0u;
    u32x4 yp[2][2];
    if (bx < NTOK / 16) {
#pragma unroll
        for (int q = 0; q < 2; ++q)
#pragma unroll
            for (int jj = 0; jj < 2; ++jj) yp[q][jj] = *(const u32x4*)(Y + ((size_t)bx * 16 + wid * 2 + q) * 1024 + 8 * (lane + 64 * jj)); }
    for (int bt = bx; bt < NTOK / 16; bt += G) {
#pragma unroll
        for (int q = 0; q < 2; ++q) { const int rl = wid * 2 + q; const size_t row = (size_t)bt * 16 + rl;
            LnRow r;
#pragma unroll
            for (int jj = 0; jj < 2; ++jj) { const u32x4 t = yp[q][jj];
                r.v[jj * 8 + 0] = bflo(t.x); r.v[jj * 8 + 1] = bfhi(t.x); r.v[jj * 8 + 2] = bflo(t.y); r.v[jj * 8 + 3] = bfhi(t.y);
                r.v[jj * 8 + 4] = bflo(t.z); r.v[jj * 8 + 5] = bfhi(t.z); r.v[jj * 8 + 6] = bflo(t.w); r.v[jj * 8 + 7] = bfhi(t.w); }
            if (bt + G < NTOK / 16) {
#pragma unroll
                for (int jj = 0; jj < 2; ++jj) yp[q][jj] = *(const u32x4*)(Y + ((size_t)(bt + G) * 16 + rl) * 1024 + 8 * (lane + 64 * jj)); }
            ln_normalize(r, gg, bb, lane); ln_store_bf16(r, XB + row * 1024, lane);
#pragma unroll
            for (int jj = 0; jj < 2; ++jj) { unsigned hw[4], lw[4];
#pragma unroll
                for (int e2 = 0; e2 < 4; ++e2) { const float a = r.v[jj * 8 + 2 * e2], c = r.v[jj * 8 + 2 * e2 + 1]; const unsigned ha = f2bf(a), hc = f2bf(c);
                    hw[e2] = ha | (hc << 16); lw[e2] = pk2(a - bf2f((unsigned short)ha), c - bf2f((unsigned short)hc)); }
                *(LAS u32x4*)(XH + rl * SX + (lane + 64 * jj) * 16) = (u32x4){hw[0], hw[1], hw[2], hw[3]};
                *(LAS u32x4*)(XL + rl * SX + (lane + 64 * jj) * 16) = (u32x4){lw[0], lw[1], lw[2], lw[3]}; } }
        __syncthreads();
        {
            f32x4 acc[3];
#pragma unroll
            for (int nb = 0; nb < 3; ++nb) acc[nb] = (f32x4){0.f, 0.f, 0.f, 0.f};
#pragma unroll
            for (int kk = 0; kk < 4; ++kk) { const bf16x8 ah = frag_rm(XH, SX, 0, 4 * wid + kk, l15, g), al = frag_rm(XL, SX, 0, 4 * wid + kk, l15, g);
#pragma unroll
                for (int nb = 0; nb < 3; ++nb) { acc[nb] = MFMA16(ah, bh[nb][kk], acc[nb]); acc[nb] = MFMA16(ah, bl[nb][kk], acc[nb]); acc[nb] = MFMA16(al, bh[nb][kk], acc[nb]); } }
#pragma unroll
            for (int nb = 0; nb < 3; ++nb)
#pragma unroll
                for (int r = 0; r < 4; ++r) PART[(wid * 16 + 4 * g + r) * 48 + nb * 16 + l15] = acc[nb][r];
        }
        __syncthreads();
        for (int p = tid; p < 16 * 48; p += 512) { float s = 0.f;
#pragma unroll
            for (int w = 0; w < 8; ++w) s += PART[w * 16 * 48 + p];
            LOG[p] = s; }
        __syncthreads();
        if (tid < 16) { const size_t row = (size_t)bt * 16 + tid; const LAS float* lg = LOG + tid * 48;
            float gl[4];
#pragma unroll
            for (int c = 0; c < 4; ++c) gl[c] = lg[c] + bgp[c];
            int gsel = 0; float gm = gl[0];
#pragma unroll
            for (int c = 1; c < 4; ++c) if (gl[c] > gm) { gm = gl[c]; gsel = c; }
            float gsum = 0.f;
#pragma unroll
            for (int c = 0; c < 4; ++c) gsum += __expf(gl[c] - gm);
            const float ptop = 1.f / gsum;
            float el[8];
#pragma unroll
            for (int jx = 0; jx < 8; ++jx) el[jx] = lg[4 + gsel * 8 + jx] + bep[gsel * 8 + jx];
            int e0 = 0; float m0 = el[0];
#pragma unroll
            for (int jx = 1; jx < 8; ++jx) if (el[jx] > m0) { m0 = el[jx]; e0 = jx; }
            int e1 = -1; float m1 = -3.0e38f;
#pragma unroll
            for (int jx = 0; jx < 8; ++jx) if (jx != e0 && el[jx] > m1) { m1 = el[jx]; e1 = jx; }
            const float ex = __expf(m1 - m0); const float w0 = ptop / (1.f + ex), w1 = ptop * ex / (1.f + ex);
            const int ge0 = gsel * 8 + e0, ge1 = gsel * 8 + e1;
            const int r0 = (int)__hip_atomic_fetch_add(lcnt + ge0, 1u, __ATOMIC_RELAXED, __HIP_MEMORY_SCOPE_WORKGROUP), r1 = (int)__hip_atomic_fetch_add(lcnt + ge1, 1u, __ATOMIC_RELAXED, __HIP_MEMORY_SCOPE_WORKGROUP);
            tokE[row * 2] = ge0; tokE[row * 2 + 1] = ge1; tokW[row * 2] = w0; tokW[row * 2 + 1] = w1; tokR[row * 2] = r0; tokR[row * 2 + 1] = r1; }
    }
    __syncthreads();
    if (tid < 32) wcnt[bx * 32 + tid] = lcnt[tid];
}
__device__ __forceinline__ void ph_dispatch(LAS unsigned char* lds, int l) { PH_COMMON
    unsigned* ctl = (unsigned*)(ws + WS_CTL);
    int* tokE = (int*)(ws + WS_SMALL + SM_TOKE); int* tokR = (int*)(ws + WS_SMALL + SM_TOKR); int* tokS = (int*)(ws + WS_SMALL + SM_TOKS);
    int* slotTok = (int*)(ws + WS_SMALL + SM_SLOTTOK);
    LAS int* tab = (LAS int*)(lds + LDS_CTL);
    __syncthreads();
    {
        const unsigned* wcnt = ctl + 16384 + l * 8192;
        LAS int* red = (LAS int*)lds;
        const int e = tid & 31, part = tid >> 5; int tot = 0, pre = 0;
        for (int w = part; w < G; w += 16) { const int c = (int)wcnt[w * 32 + e]; tot += c; if (w < bx) pre += c; }
        red[(part * 32 + e) * 2] = tot; red[(part * 32 + e) * 2 + 1] = pre;
        __syncthreads();
        if (tid < 32) { int t2 = 0, p2 = 0; for (int p = 0; p < 16; ++p) { t2 += red[(p * 32 + tid) * 2]; p2 += red[(p * 32 + tid) * 2 + 1]; } tab[360 + tid] = t2; tab[400 + tid] = p2; }
        __syncthreads();
    }
    if (tid == 0) { int ps = 0, nb = 0;
        for (int e = 0; e < 32; ++e) { const int c = tab[360 + e]; const int nbe = (c + 255) >> 8; tab[320 + e] = ps;
            for (int q = 0; q < nbe; ++q) tab[1 + nb + q] = e; nb += nbe; ps += nbe * 256; }
        tab[352] = ps; tab[0] = nb; }
    __syncthreads();
    for (int i = tid; ; i += 512) { const int bt = bx + (i >> 4) * G; if (bt >= NTOK / 16) break; const int row = bt * 16 + (i & 15);
        const int e0 = tokE[row * 2], e1 = tokE[row * 2 + 1]; const int s0 = tab[320 + e0] + tab[400 + e0] + tokR[row * 2], s1 = tab[320 + e1] + tab[400 + e1] + tokR[row * 2 + 1];
        tokS[row * 2] = s0; tokS[row * 2 + 1] = s1; slotTok[s0] = row; slotTok[s1] = row;
    }
    for (int e = 0; e < 32; ++e) { const int c = tab[360 + e], st = tab[320 + e] + c, en = tab[320 + e] + (((c + 255) >> 8) << 8);
        for (int rr = st + bx * 512 + tid; rr < en; rr += G * 512) slotTok[rr] = 0; }
}
__device__ __forceinline__ void ph_moe_gu(LAS unsigned char* lds, int l) { PH_COMMON
    bf16* Hb = (bf16*)(ws + WS_PROJ + PJ_H);
    const int* slotTok = (const int*)(ws + WS_SMALL + SM_SLOTTOK);
    const LAS int* tab = (const LAS int*)(lds + LDS_CTL);
    LAS int* gtab = (LAS int*)(lds + LDS_X);
    __syncthreads();
    { const int nu = tab[0] * 2;
      for (int j = 0; j < 4; ++j) { const int L = j * G + bx; if (L >= nu) break; const int rb = L >> 1; if (tid < 256) gtab[j * 256 + tid] = slotTok[rb * 256 + tid]; } }
    __syncthreads();
    pg8::Gemm g{1024, 1024, 1024};
    MoeSched S{2, G, bx, tab, (const char*)XB, 0, (const char*)(wt + WT_GU), (size_t)512 * 1024 * 2, (size_t)256 * 1024 * 2};
    pg8::EpiSwiglu E{Hb, 256};
    pg8::gemm_phase_gather(lds, g, S, E, (const char*)XB, gtab);
}
__device__ __forceinline__ void ph_moe_dn(LAS unsigned char* lds, int l) { PH_COMMON
    bf16* Hb = (bf16*)(ws + WS_PROJ + PJ_H); bf16* YS = (bf16*)(ws + WS_PROJ + PJ_YS);
    const LAS int* tab = (const LAS int*)(lds + LDS_CTL);
    pg8::Gemm g{256, 256, 256};
    MoeSched S{4, G, bx, tab, (const char*)Hb, (size_t)256 * 256 * 2, (const char*)(wt + WT_DN), (size_t)1024 * 256 * 2, (size_t)256 * 256 * 2};
    pg8::EpiStore E{YS, 1024, 1.f};
    pg8::gemm_phase(lds, g, S, E);
}
__device__ __forceinline__ void ph_ln3(LAS unsigned char* lds, int l) { PH_COMMON
    float* tokW = (float*)(ws + WS_SMALL + SM_TOKW); int* tokS = (int*)(ws + WS_SMALL + SM_TOKS);
    bf16* YS = (bf16*)(ws + WS_PROJ + PJ_YS);
    const float* gg = ap->ln3_g + l * 1024; const float* bb = ap->ln3_b + l * 1024;
    float* out = ap->out;
    for (int row = gw; row < NTOK; row += NGW) {
        LnRow r; ln_load_bf16(r, XB + (size_t)row * 1024, lane, ALPHA);
        ln_add_bf16(r, YS + (size_t)tokS[row * 2] * 1024, lane, tokW[row * 2]); ln_add_bf16(r, YS + (size_t)tokS[row * 2 + 1] * 1024, lane, tokW[row * 2 + 1]);
        ln_normalize(r, gg, bb, lane);
        if (l == DEPTH - 1) ln_store_f32(r, out + (size_t)row * 1024, lane); else ln_store_bf16(r, XB + (size_t)row * 1024, lane);
    }
}

#define GSYNC() grid_barrier(lds)
template <int l> __device__ __forceinline__ void layer_body(LAS unsigned char* lds) {

        TMARK(0);
        if (PH_MASK & 2) { ph_proj(lds, l); ph_kv(lds, l); }
        if (REP_MASK & 2) { GSYNC(); ph_proj(lds, l); ph_kv(lds, l); }
        GSYNC();
        TMARK(1);
        if (PH_MASK & 4) { if (PROBE_MIX == 4) { ph_mix_probe(lds, l); GSYNC(); } ph_gdn_prep(lds, l); GSYNC(); TMARK(2); ph_gla_scan(lds, l); GSYNC(); TMARK(3); if (PROBE_MIX && PROBE_MIX != 4) { ph_mix_probe(lds, l); GSYNC(); } ph_mix(lds, l); }
        GSYNC();
        TMARK(4);
        if (PH_MASK & 8) ph_branch(lds, l);
        if (REP_MASK & 8) { GSYNC(); ph_branch(lds, l); }
        GSYNC();
        TMARK(5);
        if (PH_MASK & 16) ph_gate(lds, l);
        if (REP_MASK & 16) { GSYNC(); ph_gate(lds, l); }
        GSYNC();
        TMARK(6);
        if (PH_MASK & 32) ph_out(lds, l);
        if (REP_MASK & 32) { GSYNC(); ph_out(lds, l); }
        GSYNC();
        TMARK(7);
        if (PH_MASK & 64) ph_ln1(lds, l);
        if (REP_MASK & 64) { GSYNC(); ph_ln1(lds, l); }
        GSYNC();
        TMARK(8);
        if (PH_MASK & 128) ph_q(lds, l);
        if (REP_MASK & 128) { GSYNC(); ph_q(lds, l); }
        GSYNC();
        TMARK(9);
        if (PH_MASK & 256) ph_xattn(lds, l);
        if (REP_MASK & 256) { GSYNC(); ph_xattn(lds, l); }
        GSYNC();
        TMARK(10);
        if (PH_MASK & 512) ph_wo(lds, l);
        if (REP_MASK & 512) { GSYNC(); ph_wo(lds, l); }
        GSYNC();
        TMARK(11);
        if (REP_MASK & 1024) { ph_ln2_router(lds, l, 512); GSYNC(); }
        if (PH_MASK & 1024) ph_ln2_router(lds, l);
        GSYNC();
        TMARK(12);
        if (PH_MASK & 2048) ph_dispatch(lds, l);
        if (REP_MASK & 2048) { GSYNC(); ph_dispatch(lds, l); }
        GSYNC();
        TMARK(13);
        if (PH_MASK & 4096) ph_moe_gu(lds, l);
        if (REP_MASK & 4096) { GSYNC(); ph_moe_gu(lds, l); }
        GSYNC();
        TMARK(14);
        if (PH_MASK & 8192) ph_moe_dn(lds, l);
        if (REP_MASK & 8192) { GSYNC(); ph_moe_dn(lds, l); }
        GSYNC();
        TMARK(15);
        if (PH_MASK & 16384) ph_ln3(lds, l);
        if ((REP_MASK & 16384) && l == DEPTH - 1) { GSYNC(); ph_ln3(lds, l); }
        if (l + 1 < DEPTH) { if (PH_MASK & 1) ph_weights(lds, l + 1); GSYNC(); }
        TMARK(16);
}

__global__ void __launch_bounds__(512, 2) mega_fwd(Args A_unused) {
    extern __shared__ __attribute__((aligned(16))) unsigned char lds_raw[];
    LAS unsigned char* lds = (LAS unsigned char*)lds_raw;
    cg::grid_group grid = cg::this_grid();
    {
        volatile LAS unsigned* st = (volatile LAS unsigned*)(lds + LDS_CTL + 2048);
        if (threadIdx.x < 2) st[threadIdx.x] = 0u;
        if (threadIdx.x == 0) { unsigned* bar = (unsigned*)(argp()->ws + WS_CTL) + CW_BAR; (void)xb_add(&bar[XB_XCNT(xb_xcc_id())], 1u); }
        __syncthreads();
    }
    ph_input(lds);
    if (PH_MASK & 1) ph_weights(lds, 0);
    if (argp()->ws == nullptr) grid.sync();
    GSYNC();
    if (TIMER_A >= 0 || TIMER_B >= 0) { if (otid() < 2) ((volatile LAS unsigned*)(lds + LDS_CTL + 2800))[otid()] = 0u; }
    layer_body<0>(lds);
    layer_body<1>(lds);
    if (TIMER_A >= 0 || TIMER_B >= 0) {
        GSYNC();
        if (obid() == TIMER_WG) { volatile LAS unsigned* tw = (volatile LAS unsigned*)(lds + LDS_CTL + 2800); float* out = argp()->out;
            if (TIMER_A >= 0) { const int nz = (tw[0] / 100u > (unsigned)TIMER_T) ? 16000 : 0; for (int i = otid(); i < nz * 1024; i += 512) out[i] = 0.f; }
            if (TIMER_B >= 0 && otid() == 0) out[(size_t)NTOK * 1024 - 1] = (float)(tw[1] / 100u) * 0.25f; }
    }
}

extern "C" void kernel_launch(void* const* d_in, const int* in_sizes, int n_in, void* d_out, int out_size, void* d_ws, size_t ws_size, hipStream_t stream) {
    static int grid = 0;
    if (grid == 0) {
        if (n_in != 32 || out_size != NTOK * DM || ws_size < WS_END) { fprintf(stderr, "kernel_launch: unexpected shapes (n_in %d out %d ws %zu)\n", n_in, out_size, ws_size); grid = -1; return; }
        int dev = 0, cus = 0, per_cu = 0;
        hipGetDevice(&dev); hipDeviceGetAttribute(&cus, hipDeviceAttributeMultiprocessorCount, dev);
        hipFuncSetAttribute((const void*)mega_fwd, hipFuncAttributeMaxDynamicSharedMemorySize, LDS_BYTES);
        hipOccupancyMaxActiveBlocksPerMultiprocessor(&per_cu, (const void*)mega_fwd, 512, LDS_BYTES);
        (void)hipGetLastError();
        if (per_cu < 1) { fprintf(stderr, "kernel_launch: occupancy query says %d blocks per CU\n", per_cu); grid = -1; return; }
        grid = cus;
        if (grid < 192) { fprintf(stderr, "kernel_launch: too few CUs (%d)\n", grid); grid = -1; return; }
    }
    if (grid < 0) return;
    hipMemsetAsync((char*)d_ws + WS_CTL, 0, 1 * MiB, stream);
    Args a{};
    const float** p = (const float**)&a;
    for (int i = 0; i < 32; ++i) p[i] = (const float*)d_in[i];
    a.out = (float*)d_out; a.ws = (unsigned char*)d_ws;
    void* args[] = {&a};
    hipError_t e = hipLaunchCooperativeKernel((const void*)mega_fwd, dim3(grid), dim3(512), args, LDS_BYTES, stream);
    if (e != hipSuccess) fprintf(stderr, "cooperative launch failed: %s (grid %d)\n", hipGetErrorString(e), grid);
}
```

```cpp
#include <hip/hip_runtime.h>
#include <hip/hip_cooperative_groups.h>
#include <cstdio>
#include <cstdint>
namespace cg = cooperative_groups;

#define LAS __attribute__((address_space(3)))
typedef unsigned short bf16;
typedef short bf16x8 __attribute__((ext_vector_type(8)));
typedef short s16x4 __attribute__((ext_vector_type(4)));
typedef float f32x4 __attribute__((ext_vector_type(4)));
typedef float f32x2 __attribute__((ext_vector_type(2)));
typedef unsigned u32x4 __attribute__((ext_vector_type(4)));
typedef unsigned u32x2 __attribute__((ext_vector_type(2)));

#ifndef PH_MASK
#define PH_MASK 0xFFFFFFFFu
#endif
#ifndef REP_MASK
#define REP_MASK 0u
#endif
constexpr int DM = 1024, NB = 16, SEQ = 2048, NTOK = NB * SEQ, MEMLEN = 256, NMEM = NB * MEMLEN, DEPTH = 2;
constexpr int N_IN = 8224;
constexpr int LP = 5376;
constexpr int C_OA = 0;
constexpr int C_OB = 512;
constexpr int C_OC = 1024;
constexpr int C_GQ = 1536, C_GK = 2048, C_GV = 2560;
constexpr int C_FK = 3072, C_FV = 3584;
constexpr int C_LQ = 4096, C_LK = 4352, C_LV = 4608;
constexpr int C_SM = 5120;
constexpr int C_T = 1536;
constexpr int NWIN = 8448;
constexpr float ALPHA = 1.4142135623730951f;
constexpr float LOG2E = 1.4426950408889634f;
constexpr int MAXSLOT = 73728;
constexpr int MAXBLK = MAXSLOT / 256;

constexpr size_t MiB = 1u << 20;
constexpr size_t WS_CTL = 0;
constexpr size_t WS_WT = 1 * MiB;
constexpr size_t WT_WIN = 0;
constexpr size_t WT_P = WT_WIN + (size_t)NWIN * 1024 * 2;
constexpr size_t WT_WOUT3 = WT_P + 3u * 1024 * 512 * 2;
constexpr size_t WT_WQ = WT_WOUT3 + (size_t)1024 * 3072 * 2;
constexpr size_t WT_WKV = WT_WQ + (size_t)1024 * 1024 * 2;
constexpr size_t WT_WO = WT_WKV + (size_t)2048 * 1024 * 2;
constexpr size_t WT_GU = WT_WO + (size_t)1024 * 1024 * 2;
constexpr size_t WT_DN = WT_GU + (size_t)32 * 512 * 1024 * 2;
constexpr size_t WT_RWH = WT_DN + (size_t)32 * 1024 * 256 * 2;
constexpr size_t WT_RWL = WT_RWH + 48 * 1024 * 2;
constexpr size_t WT_END = WT_RWL + 48 * 1024 * 2;
static_assert(WT_END <= 82 * MiB, "WT");
constexpr size_t WS_XB = 83 * MiB;
constexpr size_t WS_PROJ = 147 * MiB;
constexpr size_t WS_SMALL = 483 * MiB;
constexpr size_t SM_TOKE = 0;
constexpr size_t SM_TOKW = SM_TOKE + (size_t)NTOK * 8;
constexpr size_t SM_TOKR = SM_TOKW + (size_t)NTOK * 8;
constexpr size_t SM_TOKS = SM_TOKR + (size_t)NTOK * 8;
constexpr size_t SM_SLOTTOK = SM_TOKS + (size_t)NTOK * 8;
constexpr size_t WS_KVS = 485 * MiB;
constexpr size_t WS_CDB = 511 * MiB;
constexpr size_t WS_END = 512 * MiB;
constexpr size_t PJ_Q = 0, PJ_O = 64 * MiB;
constexpr size_t PJ_XG = 0, PJ_H = 144 * MiB, PJ_YS = 180 * MiB;
constexpr size_t DO_Y = 0, DO_KV = 88 * MiB, DO_MEMB = 104 * MiB, DO_HALO = 112 * MiB;
constexpr size_t DO_CKG = 118 * MiB;
constexpr size_t DO_KVS = 82 * MiB;
constexpr size_t DO_GP = 0;
constexpr int GP_W = 0, GP_KDT = 16384, GP_ATT = 32768, GP_CD = 40960, GP_STRIDE = 41216;

constexpr int RING_BYTES = 131072;
constexpr int LDS_X = 131072;
constexpr int LDS_CTL = 147456;
constexpr int LDS_BYTES = 151552;

__device__ __forceinline__ int otid() { int t = threadIdx.x; asm volatile("" : "+v"(t)); return t; }
__device__ __forceinline__ int obid() { int t = blockIdx.x; asm volatile("" : "+s"(t)); return t; }
__device__ __forceinline__ int ogrid() { int t = gridDim.x; asm volatile("" : "+s"(t)); return t; }
__device__ __forceinline__ unsigned f2bf(float f) { unsigned u = __builtin_bit_cast(unsigned, f); return (u + 0x7fffu + ((u >> 16) & 1u)) >> 16; }
typedef __bf16 hwbf16x2 __attribute__((ext_vector_type(2)));
__device__ __forceinline__ unsigned pk2(float lo, float hi) { const f32x2 v = {lo, hi}; return __builtin_bit_cast(unsigned, __builtin_convertvector(v, hwbf16x2)); }
__device__ __forceinline__ float bf2f(unsigned short b) { return __builtin_bit_cast(float, (unsigned)b << 16); }
__device__ __forceinline__ float bflo(unsigned w) { return __builtin_bit_cast(float, w << 16); }
__device__ __forceinline__ float bfhi(unsigned w) { return __builtin_bit_cast(float, w & 0xffff0000u); }
template <int M> __device__ __forceinline__ float swz_xor(float v) { return __builtin_bit_cast(float, __builtin_amdgcn_ds_swizzle(__builtin_bit_cast(int, v), 0x1f | (M << 10))); }
__device__ __forceinline__ float half_sum(float v) { const unsigned b = __builtin_bit_cast(unsigned, v); auto r = __builtin_amdgcn_permlane32_swap(b, b, false, false); return __builtin_bit_cast(float, (unsigned)r[0]) + __builtin_bit_cast(float, (unsigned)r[1]); }
__device__ __forceinline__ float wave_sum(float v) {
    v += swz_xor<1>(v); v += swz_xor<2>(v); v += swz_xor<4>(v); v += swz_xor<8>(v); v += swz_xor<16>(v);
    return half_sum(v);
}
__device__ __forceinline__ float sigmoidf_(float x) { return __builtin_amdgcn_rcpf(1.f + __builtin_amdgcn_exp2f(-LOG2E * x)); }
__device__ __forceinline__ float siluf_(float x) { return x * __builtin_amdgcn_rcpf(1.f + __builtin_amdgcn_exp2f(-LOG2E * x)); }
__device__ __forceinline__ float softplusf_(float x) { return fmaxf(x, 0.f) + log1pf(__expf(-fabsf(x))); }
__device__ __forceinline__ float logsigmoidf_(float x) { return fminf(x, 0.f) - log1pf(__expf(-fabsf(x))); }

namespace pg8 {
constexpr int BM = 256, BK = 64, HALF = 128, HTB = HALF * BK * 2, STAGE_BYTES = 8 * HTB;
__host__ __device__ __forceinline__ int lds_byte(int r, int c) { const int st = (r >> 4) * 2 + (c >> 5), rr = r & 15, cc = c & 31, ob = rr * 64 + cc * 2; return st * 1024 + (ob ^ (((ob >> 9) & 1) << 5)); }
__host__ __device__ __forceinline__ void stage_rc(int b, int& R, int& C) { const int st = b / 1024, sb = b % 1024, swz = sb ^ (((sb >> 9) & 1) << 5); R = (st >> 1) * 16 + swz / 64; C = (st & 1) * 32 + (swz % 64) / 2; }
__host__ __device__ __forceinline__ int perm32(int rho) { const int n = rho >> 4, i = rho & 15; return 8 * (i >> 2) + 4 * n + (i & 3); }

struct Unit { const char* a; const char* b; int row0, col0, aux, aux2; };
struct Gemm { int lda, ldb, K; };

template <class Epi, class Sched>
__device__ __forceinline__ void gemm_phase(LAS unsigned char* lds, const Gemm g, const Sched& S, const Epi& E) {
    const int tid = otid(), wid = __builtin_amdgcn_readfirstlane(tid >> 6), lane = tid & 63, wr = wid >> 2, wc = wid & 3, fr = lane & 15, fq = lane >> 4;
    int K = g.K; asm volatile("" : "+s"(K)); const int nt = K / BK;
    unsigned voffA[2], voffB[2];
#pragma unroll
    for (int i = 0; i < 2; ++i) { int R, C; stage_rc(tid * 16 + i * 8192, R, C); const int Rb = Epi::PERM ? ((R & ~31) + perm32(R & 31)) : R;
        voffA[i] = (unsigned)(R * g.lda + C) * 2u; voffB[i] = (unsigned)(Rb * g.ldb + C) * 2u; }
    const size_t kstep = (size_t)(BK * 2);
    const size_t hstepA = (size_t)HALF * g.lda * 2, hstepB = (size_t)HALF * g.ldb * 2;
    const unsigned ldsw = (unsigned)wid * 1024u;
    const int aoff = lds_byte(wr * 64 + fr, fq * 8), boff = lds_byte(wc * 32 + fr, fq * 8);
#define PG8_SA(b, h) (((b) * 2 + (h)) * HTB)
#define PG8_SB(b, h) ((4 + (b) * 2 + (h)) * HTB)
#define PG8_STAGE(bufoff, gbase, voff) do { _Pragma("unroll") for (int _i = 0; _i < 2; ++_i) \
        __builtin_amdgcn_global_load_lds((const unsigned*)((const char*)(gbase) + (voff)[_i]), (LAS unsigned*)(lds + (bufoff) + ldsw + _i * 8192), 16, 0, 0); } while (0)
#define PG8_LDA(dst, b, h) do { _Pragma("unroll") for (int m = 0; m < 4; ++m) _Pragma("unroll") for (int k = 0; k < 2; ++k) dst[m][k] = *(const LAS bf16x8*)(lds + PG8_SA(b, h) + aoff + m * 2048 + k * 1024); } while (0)
#define PG8_LDB(dst, b, h) do { _Pragma("unroll") for (int n = 0; n < 2; ++n) _Pragma("unroll") for (int k = 0; k < 2; ++k) dst[n][k] = *(const LAS bf16x8*)(lds + PG8_SB(b, h) + boff + n * 2048 + k * 1024); } while (0)
#define PG8_MMA(ai, bj, At, Bt) do { __builtin_amdgcn_s_setprio(1); _Pragma("unroll") for (int m = 0; m < 4; ++m) _Pragma("unroll") for (int n = 0; n < 2; ++n) _Pragma("unroll") for (int k = 0; k < 2; ++k) \
        acc[ai][bj][m][n] = __builtin_amdgcn_mfma_f32_16x16x32_bf16(Bt[n][k], At[m][k], acc[ai][bj][m][n], 0, 0, 0); __builtin_amdgcn_s_setprio(0); } while (0)
#define PG8_WAIT_V(n) asm volatile("s_waitcnt vmcnt(" #n ")" ::: "memory")
#define PG8_WAIT_L(n) asm volatile("s_waitcnt lgkmcnt(" #n ")" ::: "memory")
#define PG8_BAR __builtin_amdgcn_s_barrier()
#define PG8_SCHED __builtin_amdgcn_sched_barrier(0)
    Unit cur, nxt; int ui = 0;
    if (!S.next(0, cur)) return;
    f32x4 acc[2][2][4][2];
#pragma unroll
    for (int a = 0; a < 2; ++a)
#pragma unroll
        for (int b = 0; b < 2; ++b)
#pragma unroll
            for (int m = 0; m < 4; ++m)
#pragma unroll
                for (int n = 0; n < 2; ++n) acc[a][b][m][n] = (f32x4){0.f, 0.f, 0.f, 0.f};
    bf16x8 At[4][2], B0[2][2], B1[2][2];
    const char* cA = cur.a; const char* cB = cur.b;
    PG8_STAGE(PG8_SB(0, 0), cB, voffB); PG8_STAGE(PG8_SB(0, 1), cB + hstepB, voffB); PG8_STAGE(PG8_SA(0, 0), cA, voffA); PG8_STAGE(PG8_SA(0, 1), cA + hstepA, voffA);
    if (wr == 1) PG8_BAR;
    PG8_WAIT_V(2); PG8_BAR;
    PG8_STAGE(PG8_SB(1, 0), cB + kstep, voffB); PG8_STAGE(PG8_SA(1, 0), cA + kstep, voffA); PG8_STAGE(PG8_SB(1, 1), cB + hstepB + kstep, voffB);
    PG8_WAIT_V(6); PG8_BAR;
    for (;;) {
        const bool has_next = S.next(ui + 1, nxt);
        const char* nA = has_next ? nxt.a : cA; const char* nB = has_next ? nxt.b : cB;
        for (int t = 0; t < nt; t += 2) {
            const bool last = (t == nt - 2);
            const char* a1 = cA + (size_t)(t + 1) * kstep;
            const char* a2 = last ? nA : cA + (size_t)(t + 2) * kstep; const char* b2 = last ? nB : cB + (size_t)(t + 2) * kstep;
            const char* a3 = a2 + kstep; const char* b3 = b2 + kstep;
            PG8_LDB(B0, 0, 0); PG8_LDB(B1, 0, 1); PG8_SCHED; PG8_LDA(At, 0, 0); PG8_STAGE(PG8_SA(1, 1), a1 + hstepA, voffA);
            PG8_WAIT_V(8); PG8_WAIT_L(0); PG8_BAR; PG8_MMA(0, 0, At, B0); PG8_MMA(0, 1, At, B1); PG8_BAR; PG8_SCHED;
            PG8_LDA(At, 0, 1); PG8_STAGE(PG8_SB(0, 0), b2, voffB); PG8_STAGE(PG8_SB(0, 1), b2 + hstepB, voffB); PG8_STAGE(PG8_SA(0, 0), a2, voffA);
            PG8_WAIT_V(8); PG8_WAIT_L(0); PG8_BAR; PG8_MMA(1, 0, At, B0); PG8_MMA(1, 1, At, B1); PG8_BAR; PG8_SCHED;
            PG8_LDB(B0, 1, 0); PG8_LDB(B1, 1, 1); PG8_SCHED; PG8_LDA(At, 1, 0); PG8_STAGE(PG8_SA(0, 1), a2 + hstepA, voffA);
            PG8_WAIT_V(8); PG8_WAIT_L(0); PG8_BAR; PG8_MMA(0, 0, At, B0); PG8_MMA(0, 1, At, B1); PG8_BAR; PG8_SCHED;
            PG8_LDA(At, 1, 1); PG8_STAGE(PG8_SB(1, 0), b3, voffB); PG8_STAGE(PG8_SB(1, 1), b3 + hstepB, voffB); PG8_STAGE(PG8_SA(1, 0), a3, voffA);
            PG8_WAIT_V(8); PG8_WAIT_L(0); PG8_BAR; PG8_MMA(1, 0, At, B0); PG8_MMA(1, 1, At, B1); PG8_BAR; PG8_SCHED;
        }
        if (wr == 0) PG8_BAR;
        E(acc, cur, wr, wc, fr, fq);
        if (!has_next) break;
#pragma unroll
        for (int a = 0; a < 2; ++a)
#pragma unroll
            for (int b = 0; b < 2; ++b)
#pragma unroll
                for (int m = 0; m < 4; ++m)
#pragma unroll
                    for (int n = 0; n < 2; ++n) acc[a][b][m][n] = (f32x4){0.f, 0.f, 0.f, 0.f};
        cur = nxt; cA = nA; cB = nB; ++ui;
        if (wr == 1) PG8_BAR;
    }
    PG8_WAIT_V(0);
    PG8_BAR;
#undef PG8_SA
#undef PG8_SB
#undef PG8_STAGE
#undef PG8_LDA
#undef PG8_LDB
#undef PG8_MMA
#undef PG8_WAIT_V
#undef PG8_WAIT_L
#undef PG8_BAR
#undef PG8_SCHED
}

template <class Epi, class Sched>
__device__ __forceinline__ void gemm_phase_gather(LAS unsigned char* lds, const Gemm g, const Sched& S, const Epi& E, const char* xbase, const LAS int* gtab) {
    const int tid = otid(), wid = __builtin_amdgcn_readfirstlane(tid >> 6), lane = tid & 63, wr = wid >> 2, wc = wid & 3, fr = lane & 15, fq = lane >> 4;
    int K = g.K; asm volatile("" : "+s"(K)); const int nt = K / BK;
    unsigned voffA[2], voffB[2], cofs[2];
#pragma unroll
    for (int i = 0; i < 2; ++i) { int R, C; stage_rc(tid * 16 + i * 8192, R, C); const int Rb = Epi::PERM ? ((R & ~31) + perm32(R & 31)) : R;
        voffA[i] = (unsigned)R; voffB[i] = (unsigned)(Rb * g.ldb + C) * 2u; cofs[i] = (unsigned)C * 2u; }
    const size_t kstep = (size_t)(BK * 2);
    const size_t hstepA = (size_t)HALF * g.lda * 2, hstepB = (size_t)HALF * g.ldb * 2;
    const unsigned ldsw = (unsigned)wid * 1024u;
    const int aoff = lds_byte(wr * 64 + fr, fq * 8), boff = lds_byte(wc * 32 + fr, fq * 8);
#define PG8_SA(b, h) (((b) * 2 + (h)) * HTB)
#define PG8_SB(b, h) ((4 + (b) * 2 + (h)) * HTB)
#define PG8_STAGE(bufoff, gbase, voff) do { _Pragma("unroll") for (int _i = 0; _i < 2; ++_i) \
        __builtin_amdgcn_global_load_lds((const unsigned*)((const char*)(gbase) + (voff)[_i]), (LAS unsigned*)(lds + (bufoff) + ldsw + _i * 8192), 16, 0, 0); } while (0)
#define PG8_LDA(dst, b, h) do { _Pragma("unroll") for (int m = 0; m < 4; ++m) _Pragma("unroll") for (int k = 0; k < 2; ++k) dst[m][k] = *(const LAS bf16x8*)(lds + PG8_SA(b, h) + aoff + m * 2048 + k * 1024); } while (0)
#define PG8_LDB(dst, b, h) do { _Pragma("unroll") for (int n = 0; n < 2; ++n) _Pragma("unroll") for (int k = 0; k < 2; ++k) dst[n][k] = *(const LAS bf16x8*)(lds + PG8_SB(b, h) + boff + n * 2048 + k * 1024); } while (0)
#define PG8_MMA(ai, bj, At, Bt) do { __builtin_amdgcn_s_setprio(1); _Pragma("unroll") for (int m = 0; m < 4; ++m) _Pragma("unroll") for (int n = 0; n < 2; ++n) _Pragma("unroll") for (int k = 0; k < 2; ++k) \
        acc[ai][bj][m][n] = __builtin_amdgcn_mfma_f32_16x16x32_bf16(Bt[n][k], At[m][k], acc[ai][bj][m][n], 0, 0, 0); __builtin_amdgcn_s_setprio(0); } while (0)
#define PG8_WAIT_V(n) asm volatile("s_waitcnt vmcnt(" #n ")" ::: "memory")
#define PG8_WAIT_L(n) asm volatile("s_waitcnt lgkmcnt(" #n ")" ::: "memory")
#define PG8_BAR __builtin_amdgcn_s_barrier()
#define PG8_SCHED __builtin_amdgcn_sched_barrier(0)
    Unit cur, nxt; int ui = 0;
    if (!S.next(0, cur)) return;
    f32x4 acc[2][2][4][2];
#pragma unroll
    for (int a = 0; a < 2; ++a)
#pragma unroll
        for (int b = 0; b < 2; ++b)
#pragma unroll
            for (int m = 0; m < 4; ++m)
#pragma unroll
                for (int n = 0; n < 2; ++n) acc[a][b][m][n] = (f32x4){0.f, 0.f, 0.f, 0.f};
    bf16x8 At[4][2], B0[2][2], B1[2][2];
    const char* cB = cur.b;
    unsigned gC[2][2], gN[2][2];
#define PG8_GOFF(dst, un) do { _Pragma("unroll") for (int h_ = 0; h_ < 2; ++h_) _Pragma("unroll") for (int i_ = 0; i_ < 2; ++i_) dst[h_][i_] = (unsigned)gtab[(un).aux2 * 256 + h_ * 128 + (int)voffA[i_]] * (unsigned)(g.lda * 2) + cofs[i_]; } while (0)
    PG8_GOFF(gC, cur);
    PG8_STAGE(PG8_SB(0, 0), cB, voffB); PG8_STAGE(PG8_SB(0, 1), cB + hstepB, voffB); PG8_STAGE(PG8_SA(0, 0), xbase, gC[0]); PG8_STAGE(PG8_SA(0, 1), xbase, gC[1]);
    if (wr == 1) PG8_BAR;
    PG8_WAIT_V(2); PG8_BAR;
    PG8_STAGE(PG8_SB(1, 0), cB + kstep, voffB); PG8_STAGE(PG8_SA(1, 0), xbase + kstep, gC[0]); PG8_STAGE(PG8_SB(1, 1), cB + hstepB + kstep, voffB);
    PG8_WAIT_V(6); PG8_BAR;
    for (;;) {
        const bool has_next = S.next(ui + 1, nxt);
        const char* nB = has_next ? nxt.b : cB;
        if (has_next) { PG8_GOFF(gN, nxt); } else { gN[0][0] = gC[0][0]; gN[0][1] = gC[0][1]; gN[1][0] = gC[1][0]; gN[1][1] = gC[1][1]; }
        for (int t = 0; t < nt; t += 2) {
            const bool last = (t == nt - 2);
            const char* a1 = xbase + (size_t)(t + 1) * kstep;
            const char* a2 = last ? xbase : xbase + (size_t)(t + 2) * kstep; const char* b2 = last ? nB : cB + (size_t)(t + 2) * kstep;
            const char* a3 = a2 + kstep; const char* b3 = b2 + kstep;
            unsigned g2[2][2];
            g2[0][0] = last ? gN[0][0] : gC[0][0]; g2[0][1] = last ? gN[0][1] : gC[0][1]; g2[1][0] = last ? gN[1][0] : gC[1][0]; g2[1][1] = last ? gN[1][1] : gC[1][1];
            PG8_LDB(B0, 0, 0); PG8_LDB(B1, 0, 1); PG8_SCHED; PG8_LDA(At, 0, 0); PG8_STAGE(PG8_SA(1, 1), a1, gC[1]);
            PG8_WAIT_V(8); PG8_WAIT_L(0); PG8_BAR; PG8_MMA(0, 0, At, B0); PG8_MMA(0, 1, At, B1); PG8_BAR; PG8_SCHED;
            PG8_LDA(At, 0, 1); PG8_STAGE(PG8_SB(0, 0), b2, voffB); PG8_STAGE(PG8_SB(0, 1), b2 + hstepB, voffB); PG8_STAGE(PG8_SA(0, 0), a2, g2[0]);
            PG8_WAIT_V(8); PG8_WAIT_L(0); PG8_BAR; PG8_MMA(1, 0, At, B0); PG8_MMA(1, 1, At, B1); PG8_BAR; PG8_SCHED;
            PG8_LDB(B0, 1, 0); PG8_LDB(B1, 1, 1); PG8_SCHED; PG8_LDA(At, 1, 0); PG8_STAGE(PG8_SA(0, 1), a2, g2[1]);
            PG8_WAIT_V(8); PG8_WAIT_L(0); PG8_BAR; PG8_MMA(0, 0, At, B0); PG8_MMA(0, 1, At, B1); PG8_BAR; PG8_SCHED;
            PG8_LDA(At, 1, 1); PG8_STAGE(PG8_SB(1, 0), b3, voffB); PG8_STAGE(PG8_SB(1, 1), b3 + hstepB, voffB); PG8_STAGE(PG8_SA(1, 0), a3, g2[0]);
            PG8_WAIT_V(8); PG8_WAIT_L(0); PG8_BAR; PG8_MMA(1, 0, At, B0); PG8_MMA(1, 1, At, B1); PG8_BAR; PG8_SCHED;
        }
        if (wr == 0) PG8_BAR;
        E(acc, cur, wr, wc, fr, fq);
        if (!has_next) break;
#pragma unroll
        for (int a = 0; a < 2; ++a)
#pragma unroll
            for (int b = 0; b < 2; ++b)
#pragma unroll
                for (int m = 0; m < 4; ++m)
#pragma unroll
                    for (int n = 0; n < 2; ++n) acc[a][b][m][n] = (f32x4){0.f, 0.f, 0.f, 0.f};
        cur = nxt; cB = nB; ++ui;
        gC[0][0] = gN[0][0]; gC[0][1] = gN[0][1]; gC[1][0] = gN[1][0]; gC[1][1] = gN[1][1];
        if (wr == 1) PG8_BAR;
    }
    PG8_WAIT_V(0);
    PG8_BAR;
#undef PG8_GOFF
#undef PG8_SA
#undef PG8_SB
#undef PG8_STAGE
#undef PG8_LDA
#undef PG8_LDB
#undef PG8_MMA
#undef PG8_WAIT_V
#undef PG8_WAIT_L
#undef PG8_BAR
#undef PG8_SCHED
}

#define EPI_LOOP_BEGIN \
    _Pragma("unroll") for (int ai = 0; ai < 2; ++ai) _Pragma("unroll") for (int m = 0; m < 4; ++m) { const int row = u.row0 + ai * HALF + wr * 64 + m * 16 + fr; \
    _Pragma("unroll") for (int bj = 0; bj < 2; ++bj) { const int col = u.col0 + bj * HALF + wc * 32 + 8 * fq; const f32x4 v0 = acc[ai][bj][m][0], v1 = acc[ai][bj][m][1];
#define EPI_LOOP_END } }

struct EpiStore {
    static constexpr bool PERM = true;
    bf16* O; int ldc; float scale;
    __device__ __forceinline__ void operator()(const f32x4 (&acc)[2][2][4][2], const Unit& u, int wr, int wc, int fr, int fq) const {
        EPI_LOOP_BEGIN
            u32x4 w; w.x = pk2(v0[0] * scale, v0[1] * scale); w.y = pk2(v0[2] * scale, v0[3] * scale); w.z = pk2(v1[0] * scale, v1[1] * scale); w.w = pk2(v1[2] * scale, v1[3] * scale);
            *(u32x4*)(O + (size_t)row * ldc + col) = w;
        EPI_LOOP_END
    }
};
struct EpiProj {
    static constexpr bool PERM = true;
    bf16* O; int ldc; bf16* halo;
    __device__ __forceinline__ void operator()(const f32x4 (&acc)[2][2][4][2], const Unit& u, int wr, int wc, int fr, int fq) const {
        const bool hz = (u.col0 >= C_GQ) && (u.col0 < C_GQ + 1536);
        const float sc = (u.col0 >= C_OB && u.col0 < C_OB + 512) ? 0.125f * LOG2E : 1.f;
        EPI_LOOP_BEGIN
            u32x4 w; w.x = pk2(v0[0] * sc, v0[1] * sc); w.y = pk2(v0[2] * sc, v0[3] * sc); w.z = pk2(v1[0] * sc, v1[1] * sc); w.w = pk2(v1[2] * sc, v1[3] * sc);
            *(u32x4*)(O + (size_t)row * ldc + col) = w;
            if (hz && m == 3 && fr >= 13) *(u32x4*)(halo + ((size_t)(row >> 6) * 3 + (fr - 13)) * 1536 + (col - C_GQ)) = w;
        EPI_LOOP_END
    }
};
struct EpiGate {
    static constexpr bool PERM = true;
    bf16* PJ; int ldc; const float* bias;
    __device__ __forceinline__ void operator()(const f32x4 (&acc)[2][2][4][2], const Unit& u, int wr, int wc, int fr, int fq) const {
        const bool first = u.aux < 1024;
        f32x4 bv[2][2];
#pragma unroll
        for (int bj = 0; bj < 2; ++bj) { const int gc = u.aux + bj * HALF + wc * 32 + 8 * fq; bv[bj][0] = *(const f32x4*)(bias + gc); bv[bj][1] = *(const f32x4*)(bias + gc + 4); }
#pragma unroll
        for (int ai = 0; ai < 2; ++ai) {
            u32x4 tv[4][2], mv[4][2];
#pragma unroll
            for (int m = 0; m < 4; ++m)
#pragma unroll
                for (int bj = 0; bj < 2; ++bj) { const size_t ro = (size_t)(u.row0 + ai * HALF + wr * 64 + m * 16 + fr) * ldc; const int cc = bj * HALF + wc * 32 + 8 * fq;
                    tv[m][bj] = *(const u32x4*)(PJ + ro + C_T + u.aux + cc);
                    if (!first) mv[m][bj] = *(const u32x4*)(PJ + ro + u.col0 + cc); else mv[m][bj] = (u32x4){0u, 0u, 0u, 0u}; }
#pragma unroll
            for (int m = 0; m < 4; ++m)
#pragma unroll
                for (int bj = 0; bj < 2; ++bj) { const size_t ro = (size_t)(u.row0 + ai * HALF + wr * 64 + m * 16 + fr) * ldc; const int cc = bj * HALF + wc * 32 + 8 * fq;
                    const f32x4 v0 = acc[ai][bj][m][0], v1 = acc[ai][bj][m][1]; const f32x4 b0 = bv[bj][0], b1 = bv[bj][1]; const u32x4 t = tv[m][bj], mm = mv[m][bj];
                    u32x4 w;
                    w.x = pk2(bflo(mm.x) + sigmoidf_(v0[0] + b0[0]) * bflo(t.x), bfhi(mm.x) + sigmoidf_(v0[1] + b0[1]) * bfhi(t.x));
                    w.y = pk2(bflo(mm.y) + sigmoidf_(v0[2] + b0[2]) * bflo(t.y), bfhi(mm.y) + sigmoidf_(v0[3] + b0[3]) * bfhi(t.y));
                    w.z = pk2(bflo(mm.z) + sigmoidf_(v1[0] + b1[0]) * bflo(t.z), bfhi(mm.z) + sigmoidf_(v1[1] + b1[1]) * bfhi(t.z));
                    w.w = pk2(bflo(mm.w) + sigmoidf_(v1[2] + b1[2]) * bflo(t.w), bfhi(mm.w) + sigmoidf_(v1[3] + b1[3]) * bfhi(t.w));
                    *(u32x4*)(PJ + ro + u.col0 + cc) = w; }
        }
    }
};
struct EpiResid {
    static constexpr bool PERM = true;
    const bf16* X; bf16* Y; int ldc;
    __device__ __forceinline__ void operator()(const f32x4 (&acc)[2][2][4][2], const Unit& u, int wr, int wc, int fr, int fq) const {
#pragma unroll
        for (int ai = 0; ai < 2; ++ai) {
            u32x4 xv[4][2];
#pragma unroll
            for (int m = 0; m < 4; ++m)
#pragma unroll
                for (int bj = 0; bj < 2; ++bj) xv[m][bj] = *(const u32x4*)(X + (size_t)(u.row0 + ai * HALF + wr * 64 + m * 16 + fr) * ldc + u.col0 + bj * HALF + wc * 32 + 8 * fq);
#pragma unroll
            for (int m = 0; m < 4; ++m)
#pragma unroll
                for (int bj = 0; bj < 2; ++bj) { const f32x4 v0 = acc[ai][bj][m][0], v1 = acc[ai][bj][m][1]; const u32x4 t = xv[m][bj];
                    u32x4 w;
                    w.x = pk2(ALPHA * bflo(t.x) + v0[0], ALPHA * bfhi(t.x) + v0[1]); w.y = pk2(ALPHA * bflo(t.y) + v0[2], ALPHA * bfhi(t.y) + v0[3]);
                    w.z = pk2(ALPHA * bflo(t.z) + v1[0], ALPHA * bfhi(t.z) + v1[1]); w.w = pk2(ALPHA * bflo(t.w) + v1[2], ALPHA * bfhi(t.w) + v1[3]);
                    *(u32x4*)(Y + (size_t)(u.row0 + ai * HALF + wr * 64 + m * 16 + fr) * ldc + u.col0 + bj * HALF + wc * 32 + 8 * fq) = w; }
        }
    }
};
struct EpiSwiglu {
    static constexpr bool PERM = true;
    bf16* H; int ldc;
    __device__ __forceinline__ void operator()(const f32x4 (&acc)[2][2][4][2], const Unit& u, int wr, int wc, int fr, int fq) const {
        EPI_LOOP_BEGIN
            u32x2 w; w.x = pk2(siluf_(v0[0]) * v1[0], siluf_(v0[1]) * v1[1]); w.y = pk2(siluf_(v0[2]) * v1[2], siluf_(v0[3]) * v1[3]);
            *(u32x2*)(H + (size_t)row * ldc + (col >> 1)) = w;
        EPI_LOOP_END
    }
};
}

struct Args {
    const float* x; const float* mem; const float* w_in; const float* gdn_conv_w; const float* gdn_a_log; const float* gdn_dt_bias; const float* gdn_norm_w; const float* fox_f_bias;
    const float* gla_w_gate2; const float* gla_b_gate; const float* gla_norm_w; const float* p_gdn; const float* p_fox; const float* p_gla; const float* b_merge; const float* w_out;
    const float* ln1_g; const float* ln1_b; const float* xa_wq; const float* xa_wkv; const float* xa_wo; const float* ln2_g; const float* ln2_b;
    const float* moe_w_group; const float* moe_b_group; const float* moe_w_expert; const float* moe_b_expert; const float* moe_w_gate; const float* moe_w_up; const float* moe_w_down;
    const float* ln3_g; const float* ln3_b;
    float* out; unsigned char* ws;
};

typedef const __attribute__((address_space(4))) Args* KArgP;

__device__ __forceinline__ int tr_srccol(int mode, int c0, int n) {
    if (mode != 3) return c0 + n;
    return n < 4 ? 1536 + n : n < 8 ? 1540 + (n - 4) : n < 16 ? 3592 + (n - 8) : 5136 + (n - 16);
}
__device__ __forceinline__ int tr_dstrow(int mode, int r0, int nn) {
    if (mode == 1) return r0 + 8 * (nn >> 2) + (nn & 3);
    if (mode == 2) return r0 + 8 * (nn >> 2) + 4 + (nn & 3);
    return r0 + nn;
}
__device__ __forceinline__ void tr_item(const float* W, int ldw, int c0, int ncols, bf16* T, int ldt, int r0, int koff, int mode, LAS float* scr, int item, int lane) {
    const int nblk = ncols / 32, kb = item / nblk, nb = item % nblk, k0 = 64 * kb, n0 = 32 * nb;
    if (mode != 3) {
        const int sc4 = c0 + n0 + 4 * (lane & 7);
#pragma unroll
        for (int i = 0; i < 8; ++i) { const int kk = 8 * i + (lane >> 3); const f32x4 v = *(const f32x4*)(W + (size_t)(k0 + kk) * ldw + sc4);
            LAS float* d = scr + kk * 33 + 4 * (lane & 7); d[0] = v[0]; d[1] = v[1]; d[2] = v[2]; d[3] = v[3]; }
    } else {
        const int sc = tr_srccol(mode, c0, n0 + (lane & 31));
#pragma unroll 8
        for (int i = 0; i < 32; ++i) { const int kk = 2 * i + (lane >> 5); scr[kk * 33 + (lane & 31)] = W[(size_t)(k0 + kk) * ldw + sc]; }
    }
    asm volatile("s_waitcnt lgkmcnt(0)" ::: "memory");
    const int c = lane & 7;
#pragma unroll
    for (int j = 0; j < 4; ++j) { const int n = (lane >> 3) + 8 * j; const LAS float* s = scr + (8 * c) * 33 + n;
        u32x4 o; o.x = pk2(s[0 * 33], s[1 * 33]); o.y = pk2(s[2 * 33], s[3 * 33]); o.z = pk2(s[4 * 33], s[5 * 33]); o.w = pk2(s[6 * 33], s[7 * 33]);
        *(u32x4*)(T + (size_t)tr_dstrow(mode, r0, n0 + n) * ldt + koff + k0 + 8 * c) = o; }
    asm volatile("s_waitcnt lgkmcnt(0)" ::: "memory");
}
__device__ __forceinline__ void tr_job(const float* W, int ldw, int K, int c0, int ncols, size_t wstride, bf16* T, int ldt, int r0, int koff, int mode, size_t tstride, int nmat,
                                       LAS float* scr, int lane, int gw, int NGW, int& run) {
    const int per = (K / 64) * (ncols / 32), n = per * nmat;
    int first = gw - (run % NGW); if (first < 0) first += NGW;
    for (int it = first; it < n; it += NGW) { const int e = it / per, li = it % per; tr_item(W + (size_t)e * wstride, ldw, c0, ncols, T + (size_t)e * tstride, ldt, r0, koff, mode, scr, li, lane); }
    run += n;
}
__device__ __forceinline__ void phase_convert_weights(KArgP A, int l, LAS unsigned char* lds) {
    const int tid = otid(), lane = tid & 63, wid = tid >> 6;
    LAS float* scr = (LAS float*)(lds + wid * 16384);
    const int gw = obid() * 8 + wid, NGW = ogrid() * 8; int run = 0;
    unsigned char* wt = A->ws + WS_WT;
    bf16* WIN = (bf16*)(wt + WT_WIN);
    const float* w_in = A->w_in + (size_t)l * 1024 * N_IN;
    tr_job(w_in, N_IN, 1024, 1544, 512, 0, WIN, 1024, C_OA, 0, 0, 0, 1, scr, lane, gw, NGW, run);
    tr_job(w_in, N_IN, 1024, 2056, 512, 0, WIN, 1024, C_OB, 0, 0, 0, 1, scr, lane, gw, NGW, run);
    tr_job(w_in, N_IN, 1024, 4624, 512, 0, WIN, 1024, C_OC, 0, 0, 0, 1, scr, lane, gw, NGW, run);
    tr_job(w_in, N_IN, 1024, 0, 1536, 0, WIN, 1024, C_GQ, 0, 0, 0, 1, scr, lane, gw, NGW, run);
    tr_job(w_in, N_IN, 1024, 2568, 1024, 0, WIN, 1024, C_FK, 0, 0, 0, 1, scr, lane, gw, NGW, run);
    tr_job(w_in, N_IN, 1024, 3600, 1024, 0, WIN, 1024, C_LQ, 0, 0, 0, 1, scr, lane, gw, NGW, run);
    tr_job(w_in, N_IN, 1024, 0, 32, 0, WIN, 1024, C_SM, 0, 3, 0, 1, scr, lane, gw, NGW, run);
    tr_job(w_in, N_IN, 1024, 5152, 3072, 0, WIN, 1024, LP, 0, 0, 0, 1, scr, lane, gw, NGW, run);
    { u32x4 z = {0u, 0u, 0u, 0u}; asm volatile("" : "+v"(z)); u32x4* p = (u32x4*)(WIN + (size_t)5152 * 1024); const int n16 = 224 * 1024 * 2 / 16;
      for (int i = obid() * 512 + tid; i < n16; i += ogrid() * 512) p[i] = z; }
    bf16* PT = (bf16*)(wt + WT_P);
    tr_job(A->p_gdn + (size_t)l * 512 * 1024, 1024, 512, 0, 1024, 0, PT, 512, 0, 0, 0, 0, 1, scr, lane, gw, NGW, run);
    tr_job(A->p_fox + (size_t)l * 512 * 1024, 1024, 512, 0, 1024, 0, PT + 1024 * 512, 512, 0, 0, 0, 0, 1, scr, lane, gw, NGW, run);
    tr_job(A->p_gla + (size_t)l * 512 * 1024, 1024, 512, 0, 1024, 0, PT + 2 * 1024 * 512, 512, 0, 0, 0, 0, 1, scr, lane, gw, NGW, run);
    bf16* WO3 = (bf16*)(wt + WT_WOUT3);
    tr_job(A->w_out + (size_t)l * 1024 * 1024, 1024, 1024, 0, 1024, 0, WO3, 1024, 0, 0, 0, 0, 1, scr, lane, gw, NGW, run);
    tr_job(A->xa_wq + (size_t)l * 1024 * 1024, 1024, 1024, 0, 1024, 0, (bf16*)(wt + WT_WQ), 1024, 0, 0, 0, 0, 1, scr, lane, gw, NGW, run);
    tr_job(A->xa_wkv + (size_t)l * 1024 * 2048, 2048, 1024, 0, 2048, 0, (bf16*)(wt + WT_WKV), 1024, 0, 0, 0, 0, 1, scr, lane, gw, NGW, run);
    tr_job(A->xa_wo + (size_t)l * 1024 * 1024, 1024, 1024, 0, 1024, 0, (bf16*)(wt + WT_WO), 1024, 0, 0, 0, 0, 1, scr, lane, gw, NGW, run);
    tr_job(A->moe_w_gate + (size_t)l * 32 * 1024 * 256, 256, 1024, 0, 256, (size_t)1024 * 256, (bf16*)(wt + WT_GU), 1024, 0, 0, 1, (size_t)512 * 1024, 32, scr, lane, gw, NGW, run);
    tr_job(A->moe_w_up + (size_t)l * 32 * 1024 * 256, 256, 1024, 0, 256, (size_t)1024 * 256, (bf16*)(wt + WT_GU), 1024, 0, 0, 2, (size_t)512 * 1024, 32, scr, lane, gw, NGW, run);
    tr_job(A->moe_w_down + (size_t)l * 32 * 256 * 1024, 1024, 256, 0, 1024, (size_t)256 * 1024, (bf16*)(wt + WT_DN), 256, 0, 0, 0, (size_t)1024 * 256, 32, scr, lane, gw, NGW, run);
    {
        const float* wg = A->moe_w_group + (size_t)l * 1024 * 4; const float* we = A->moe_w_expert + (size_t)l * 1024 * 32;
        bf16* RH = (bf16*)(wt + WT_RWH); bf16* RL = (bf16*)(wt + WT_RWL);
        for (int i = obid() * 512 + tid; i < 48 * 1024; i += ogrid() * 512) { const int n = i >> 10, k = i & 1023;
            const float w = n < 4 ? wg[k * 4 + n] : n < 36 ? we[k * 32 + (n - 4)] : 0.f; const unsigned h = f2bf(w); RH[i] = (bf16)h; RL[i] = (bf16)f2bf(w - bf2f((unsigned short)h)); }
    }
}
__device__ __forceinline__ void convert_rows(const float* src, bf16* dst, size_t n) {
    const size_t n8 = n / 8;
    for (size_t i = (size_t)obid() * 512 + otid(); i < n8; i += (size_t)ogrid() * 512) {
        const f32x4 a = *(const f32x4*)(src + i * 8), b = *(const f32x4*)(src + i * 8 + 4);
        u32x4 w; w.x = pk2(a[0], a[1]); w.y = pk2(a[2], a[3]); w.z = pk2(b[0], b[1]); w.w = pk2(b[2], b[3]);
        *(u32x4*)(dst + i * 8) = w;
    }
}

struct RegSched {
    int nM, nN, nwg, G, c; const char* A; const char* B; size_t astride, bstride; int col_base;
    __device__ __forceinline__ bool next(int i, pg8::Unit& u) const {
        const long L = (long)i * G + c; if (L >= nwg) return false;
        int wgid = (int)L; { const int q = nwg / 8, r = nwg % 8, xcd = wgid % 8, off = wgid / 8; wgid = (xcd < r ? xcd * (q + 1) : r * (q + 1) + (xcd - r) * q) + off; }
        const int nig = 8 * nN, gid = wgid / nig, fm = gid * 8, gsz = (nM - fm) < 8 ? (nM - fm) : 8;
        const int pm = fm + ((wgid % nig) % gsz), pn = (wgid % nig) / gsz;
        u.a = A + (size_t)pm * astride; u.b = B + (size_t)pn * bstride; u.row0 = pm * 256; u.col0 = col_base + pn * 256; u.aux = pn * 256; return true;
    }
};
struct BranchSched {
    int nM, nwg, G, c; const char* A; const char* B;
    __device__ __forceinline__ bool next(int i, pg8::Unit& u) const {
        const long L = (long)i * G + c; if (L >= nwg) return false;
        int wgid = (int)L; { const int q = nwg / 8, r = nwg % 8, xcd = wgid % 8, off = wgid / 8; wgid = (xcd < r ? xcd * (q + 1) : r * (q + 1) + (xcd - r) * q) + off; }
        const int nN = 12, nig = 8 * nN, gid = wgid / nig, fm = gid * 8, gsz = (nM - fm) < 8 ? (nM - fm) : 8;
        const int pm = fm + ((wgid % nig) % gsz), pn = (wgid % nig) / gsz, br = pn >> 2;
        u.a = A + ((size_t)pm * 256 * LP + br * 512) * 2; u.b = B + ((size_t)br * 1024 * 512 + (size_t)(pn & 3) * 256 * 512) * 2; u.row0 = pm * 256; u.col0 = C_T + pn * 256; u.aux = 0; return true;
    }
};
struct GateSched {
    int nM, nwg, G, c; const char* A; const char* B;
    __device__ __forceinline__ bool next(int i, pg8::Unit& u) const {
        const int rnd = i / 3, br = i - 3 * rnd;
        const long L = (long)rnd * G + c; if (L >= nwg) return false;
        int wgid = (int)L; { const int q = nwg / 8, r = nwg % 8, xcd = wgid % 8, off = wgid / 8; wgid = (xcd < r ? xcd * (q + 1) : r * (q + 1) + (xcd - r) * q) + off; }
        const int nN = 4, nig = 8 * nN, gid = wgid / nig, fm = gid * 8, gsz = (nM - fm) < 8 ? (nM - fm) : 8;
        const int pm = fm + ((wgid % nig) % gsz), pn = (wgid % nig) / gsz;
        u.a = A + (size_t)pm * 256 * 1024 * 2; u.b = B + ((size_t)br * 1024 + (size_t)pn * 256) * 1024 * 2; u.row0 = pm * 256; u.col0 = pn * 256; u.aux = br * 1024 + pn * 256; return true;
    }
};
struct MoeSched {
    int nct, G, c; const LAS int* tab;
    const char* A; size_t astride; const char* B; size_t bexp, bct;
    __device__ __forceinline__ bool next(int i, pg8::Unit& u) const {
        const long L = (long)i * G + c; const int nblk = tab[0]; if (L >= (long)nblk * nct) return false;
        const int rb = (int)(L / nct), ct = (int)(L % nct), e = tab[1 + rb];
        u.a = A + (size_t)rb * astride; u.b = B + (size_t)e * bexp + (size_t)ct * bct; u.row0 = rb * 256; u.col0 = ct * 256; u.aux = e; u.aux2 = i; return true;
    }
};

__device__ __forceinline__ bf16x8 frag_rm(const LAS unsigned char* base, int stride, int blk, int ks, int l15, int g) { return *(const LAS bf16x8*)(base + (blk * 16 + l15) * stride + (ks * 32 + 8 * g) * 2); }
__device__ __forceinline__ bf16x8 frag_tr(const LAS unsigned char* base, int stride, int ks, int nb, int g, int q4, int p4) {
    const s16x4 lo = __builtin_amdgcn_ds_read_tr16_b64_v4i16((LAS s16x4*)(base + (32 * ks + 8 * g + q4) * stride + (16 * nb + 4 * p4) * 2));
    const s16x4 hi = __builtin_amdgcn_ds_read_tr16_b64_v4i16((LAS s16x4*)(base + (32 * ks + 8 * g + 4 + q4) * stride + (16 * nb + 4 * p4) * 2));
    return (bf16x8){lo[0], lo[1], lo[2], lo[3], hi[0], hi[1], hi[2], hi[3]};
}
#define MFMA16(a, b, c) __builtin_amdgcn_mfma_f32_16x16x32_bf16((a), (b), (c), 0, 0, 0)

#ifndef TIMER_A
#define TIMER_A (-1)
#endif
#ifndef TIMER_B
#define TIMER_B (-1)
#endif
#ifndef TIMER_T
#define TIMER_T 0
#endif
#ifndef TIMER_WG
#define TIMER_WG 0
#endif
#define TMARK(id) do { if (TIMER_A >= 0 || TIMER_B >= 0) { const unsigned long long t_ = __builtin_amdgcn_s_memrealtime(); volatile LAS unsigned* tw_ = (volatile LAS unsigned*)(lds + LDS_CTL + 2800); \
    if (otid() == 0) { if ((id) == TIMER_A) tw_[0] -= (unsigned)t_; if ((id) == TIMER_A + 1) tw_[0] += (unsigned)t_; if ((id) == TIMER_B) tw_[1] -= (unsigned)t_; if ((id) == TIMER_B + 1) tw_[1] += (unsigned)t_; } } } while (0)
__device__ __forceinline__ void xattn_phase(LAS unsigned char* lds, const bf16* Qb, const bf16* KV, bf16* Ob, int G, int bx) {
    const int tid = otid(), lane = tid & 63, wid = tid >> 6, l15 = lane & 15, g = lane >> 4, q4 = l15 >> 2, p4 = lane & 3;
    constexpr int D = 256, KST = (D + 8) * 2, NU = NB * 4 * 16;
    LAS unsigned char* KS = lds; LAS unsigned char* VS = lds + 64 * KST; LAS unsigned char* PS = lds + 2 * 64 * KST + wid * 2304;
    LAS unsigned char* OS = lds + 2 * 64 * KST + 8 * 2304 + wid * 4352;
    const int nun = (NU - bx + G - 1) / G, NT = nun * 4;
    u32x4 kreg[4], vreg[4];
#define XA_ISSUE(tt_) do { const int u_ = bx + ((tt_) >> 2) * G, t_ = (tt_) & 3, b_ = u_ >> 6, h_ = (u_ >> 4) & 3; \
        _Pragma("unroll") for (int j_ = 0; j_ < 4; ++j_) { const int c_ = tid + 512 * j_, row_ = c_ >> 5, ch_ = c_ & 31; \
            const bf16* kp_ = KV + (size_t)(b_ * MEMLEN + t_ * 64 + row_) * 2048 + h_ * 256 + ch_ * 8; kreg[j_] = *(const u32x4*)kp_; vreg[j_] = *(const u32x4*)(kp_ + 1024); } } while (0)
    if (NT > 0) XA_ISSUE(0);
    bf16x8 qf[8]; f32x4 o[16]; float mrow[4], lrow[4];
    for (int tt = 0; tt < NT; ++tt) {
        TMARK(55);
        const int u = bx + (tt >> 2) * G, t = tt & 3, b = u >> 6, h = (u >> 4) & 3, qb = u & 15;
        const size_t rowq = (size_t)b * SEQ + qb * 128;
        if (t == 0) {
            if (tt == 0) { const bf16* qrow = Qb + (rowq + wid * 16 + l15) * 1024 + h * 256 + 8 * g;
#pragma unroll
                for (int ks = 0; ks < 8; ++ks) qf[ks] = *(const bf16x8*)(qrow + ks * 32); }
#pragma unroll
            for (int i = 0; i < 16; ++i) o[i] = (f32x4){0.f, 0.f, 0.f, 0.f};
#pragma unroll
            for (int r = 0; r < 4; ++r) { mrow[r] = -1e30f; lrow[r] = 0.f; }
        }
        TMARK(50);
        __syncthreads();
#pragma unroll
        for (int j = 0; j < 4; ++j) { const int c = tid + 512 * j, row = c >> 5, ch = c & 31; *(LAS u32x4*)(KS + row * KST + ch * 16) = kreg[j]; *(LAS u32x4*)(VS + row * KST + ch * 16) = vreg[j]; }
        __syncthreads();
        if (tt + 1 < NT) XA_ISSUE(tt + 1);
        TMARK(51);
        f32x4 s[4];
#pragma unroll
        for (int nb = 0; nb < 4; ++nb) { s[nb] = (f32x4){0.f, 0.f, 0.f, 0.f};
#pragma unroll
            for (int ks = 0; ks < 8; ++ks) s[nb] = MFMA16(qf[ks], *(const LAS bf16x8*)(KS + (nb * 16 + l15) * KST + (ks * 32 + 8 * g) * 2), s[nb]); }
        if (t == 3 && tt + 1 < NT) {
            asm volatile("" : "+v"(s[0]), "+v"(s[1]), "+v"(s[2]), "+v"(s[3]));
            const int u2 = u + G, b2 = u2 >> 6, h2 = (u2 >> 4) & 3, qb2 = u2 & 15;
            const bf16* qrow = Qb + ((size_t)b2 * SEQ + qb2 * 128 + wid * 16 + l15) * 1024 + h2 * 256 + 8 * g;
#pragma unroll
            for (int ks = 0; ks < 8; ++ks) qf[ks] = *(const bf16x8*)(qrow + ks * 32); }
        TMARK(52);
        float mx[4], al[4];
#pragma unroll
        for (int r = 0; r < 4; ++r) mx[r] = fmaxf(fmaxf(s[0][r], s[1][r]), fmaxf(s[2][r], s[3][r]));
#pragma unroll
        for (int r = 0; r < 4; ++r) mx[r] = fmaxf(mx[r], swz_xor<1>(mx[r]));
#pragma unroll
        for (int r = 0; r < 4; ++r) mx[r] = fmaxf(mx[r], swz_xor<2>(mx[r]));
#pragma unroll
        for (int r = 0; r < 4; ++r) mx[r] = fmaxf(mx[r], swz_xor<4>(mx[r]));
#pragma unroll
        for (int r = 0; r < 4; ++r) mx[r] = fmaxf(mx[r], swz_xor<8>(mx[r]));
        bool moved = false;
#pragma unroll
        for (int r = 0; r < 4; ++r) { const float mn = fmaxf(mrow[r], mx[r]); al[r] = __builtin_amdgcn_exp2f(mrow[r] - mn); moved |= (mn != mrow[r]); mrow[r] = mn; lrow[r] *= al[r]; }
        if (__any(moved)) {
#pragma unroll
            for (int i = 0; i < 16; ++i)
#pragma unroll
                for (int r = 0; r < 4; ++r) o[i][r] *= al[r]; }
#pragma unroll
        for (int r = 0; r < 4; ++r) { float ps = 0.f;
#pragma unroll
            for (int nb = 0; nb < 4; ++nb) { const float p = __builtin_amdgcn_exp2f(s[nb][r] - mrow[r]); ps += p; *(LAS bf16*)(PS + ((4 * g + r) * 72 + nb * 16 + l15) * 2) = (bf16)f2bf(p); }
            lrow[r] += ps; }
        TMARK(53);
        bf16x8 pf[2];
#pragma unroll
        for (int ks = 0; ks < 2; ++ks) pf[ks] = *(const LAS bf16x8*)(PS + (l15 * 72 + ks * 32 + 8 * g) * 2);
#pragma unroll
        for (int nb = 0; nb < 16; ++nb)
#pragma unroll
            for (int ks = 0; ks < 2; ++ks) o[nb] = MFMA16(pf[ks], frag_tr(VS, KST, ks, nb, g, q4, p4), o[nb]);
        TMARK(54);
        if (t == 3) {
            float inv[4];
#pragma unroll
            for (int r = 0; r < 4; ++r) { float l = lrow[r]; l += swz_xor<1>(l); l += swz_xor<2>(l); l += swz_xor<4>(l); l += swz_xor<8>(l); inv[r] = __builtin_amdgcn_rcpf(l); }
#pragma unroll
            for (int hf = 0; hf < 2; ++hf) {
#pragma unroll
                for (int nb = 0; nb < 8; ++nb)
#pragma unroll
                    for (int r = 0; r < 4; ++r) *(LAS bf16*)(OS + ((4 * g + r) * 136 + nb * 16 + l15) * 2) = (bf16)f2bf(o[hf * 8 + nb][r] * inv[r]);
#pragma unroll
                for (int j = 0; j < 4; ++j) { const int c = lane + 64 * j, row = c >> 4, ch = c & 15;
                    *(u32x4*)(Ob + (rowq + wid * 16 + row) * 1024 + h * 256 + hf * 128 + ch * 8) = *(const LAS u32x4*)(OS + row * 272 + ch * 16); }
            }
        }
    }
#undef XA_ISSUE
}

namespace fox_body {
using bf16=unsigned short;
using bf16x8=__attribute__((ext_vector_type(8)))short;
using s16x4=__attribute__((ext_vector_type(4)))short;
using f32x16=__attribute__((ext_vector_type(16)))float;
using u32x4=__attribute__((ext_vector_type(4)))unsigned;
constexpr int BATCH=16,NHEAD=8,SEQ=2048,D=64,DM=5376;
constexpr int NW=8,QBLK=32,QB=QBLK*NW,KVBLK=64,NQB=SEQ/QB;
constexpr int ATTN_PITCH=DM, ATTN_UNIT_ROWS=QB;
__device__ __forceinline__ int crow(int r,int hi){return (r&3)+8*(r>>2)+4*hi;}
#define SBAR() __builtin_amdgcn_sched_barrier(0)
__device__ __forceinline__ void cmask(f32x16&p0,f32x16&p1,int jb,int qrel,int hi){
  const float NEG=-INFINITY; int kb=64*jb+4*hi;
  #pragma unroll
  for(int r=0;r<16;++r){int kv=kb+(r&3)+8*(r>>2); if(kv>qrel)p0[r]=NEG; if(kv+32>qrel)p1[r]=NEG;}
}

constexpr int NSLOT=3, SLOTB=8192;
constexpr int LDS_K=0, LDS_V=NSLOT*SLOTB, LDS_WS=2*NSLOT*SLOTB, LDS_OST=LDS_WS+NW*64*4, LDS_BYTES=LDS_OST+NW*4096;
constexpr float C2=0.125f*1.4426950408889634f;
__device__ __forceinline__ void glds16(const void*gsrc,unsigned lds_dst){unsigned keep;
  asm volatile("s_mov_b32 %0, m0\n\ts_mov_b32 m0, %2\n\ts_nop 0\n\tglobal_load_lds_dwordx4 %1, off\n\ts_mov_b32 m0, %0":"=&s"(keep):"v"(gsrc),"s"(lds_dst):"memory");}
__device__ __forceinline__ float max3f(float a,float b,float c){float r;asm("v_max3_f32 %0, %1, %2, %3":"=v"(r):"v"(a),"v"(b),"v"(c));return r;}
__device__ __forceinline__ float max2f(float a,float b){float r;asm("v_max_f32_e32 %0, %1, %2":"=v"(r):"v"(a),"v"(b));return r;}
__device__ __forceinline__ float fadd_s(float a,float b){float r;asm("v_add_f32_e32 %0, %1, %2":"=v"(r):"v"(a),"v"(b));return r;}
__device__ __forceinline__ float fsub_s(float a,float b){float r;asm("v_sub_f32_e32 %0, %1, %2":"=v"(r):"v"(a),"v"(b));return r;}
typedef float f32x2_t __attribute__((ext_vector_type(2))); typedef __bf16 bf16x2_t __attribute__((ext_vector_type(2)));
__device__ __forceinline__ unsigned cvtpk_s(float lo,float hi){f32x2_t v={lo,hi};bf16x2_t b=__builtin_convertvector(v,bf16x2_t);return __builtin_bit_cast(unsigned,b);}
#define WAIT_BAR(N) asm volatile("s_waitcnt vmcnt(" #N ") lgkmcnt(0)\n\ts_barrier":::"memory")

__device__ __forceinline__ void qkt(f32x16&p0,f32x16&p1,const char*Kslot,const bf16x8*qr,const f32x16&n0,const f32x16&n1,int r32,int hi){
  const char*kb=Kslot+hi*1024+r32*16;
  #pragma unroll
  for(int d0=0;d0<4;++d0){
    const bf16x8 b0=*reinterpret_cast<const bf16x8*>(kb+d0*2048);
    const bf16x8 b1=*reinterpret_cast<const bf16x8*>(kb+d0*2048+512);
    if(d0==0){p0=__builtin_amdgcn_mfma_f32_32x32x16_bf16(b0,qr[0],n0,0,0,0);p1=__builtin_amdgcn_mfma_f32_32x32x16_bf16(b1,qr[0],n1,0,0,0);}
    else{p0=__builtin_amdgcn_mfma_f32_32x32x16_bf16(b0,qr[d0],p0,0,0,0);p1=__builtin_amdgcn_mfma_f32_32x32x16_bf16(b1,qr[d0],p1,0,0,0);}}
}
typedef __attribute__((address_space(3))) const char* lds_cptr;
typedef short v4i16_t __attribute__((ext_vector_type(4)));
__device__ __forceinline__ void kload8(bf16x8*kf,lds_cptr kp){
  kf[0]=*(const __attribute__((address_space(3))) bf16x8*)(kp);      kf[1]=*(const __attribute__((address_space(3))) bf16x8*)(kp+512);
  kf[2]=*(const __attribute__((address_space(3))) bf16x8*)(kp+2048); kf[3]=*(const __attribute__((address_space(3))) bf16x8*)(kp+2560);
  kf[4]=*(const __attribute__((address_space(3))) bf16x8*)(kp+4096); kf[5]=*(const __attribute__((address_space(3))) bf16x8*)(kp+4608);
  kf[6]=*(const __attribute__((address_space(3))) bf16x8*)(kp+6144); kf[7]=*(const __attribute__((address_space(3))) bf16x8*)(kp+6656);
}
__device__ __forceinline__ void kload2(bf16x8*kf,lds_cptr kp,int j){ kf[2*j]=*(const __attribute__((address_space(3))) bf16x8*)(kp+j*2048); kf[2*j+1]=*(const __attribute__((address_space(3))) bf16x8*)(kp+j*2048+512); }
__device__ __forceinline__ s16x4 vtr(lds_cptr p){ return __builtin_bit_cast(s16x4,__builtin_amdgcn_ds_read_tr16_b64_v4i16((__attribute__((address_space(3))) v4i16_t*)p)); }
__device__ __forceinline__ float rowmax(const f32x16&p0,const f32x16&p1){
  float a=max3f(p0[0],p0[1],p1[0]),b=max3f(p0[2],p0[3],p1[1]);a=max3f(a,p1[2],p1[3]);
  #pragma unroll
  for(int r=4;r<16;r+=4){a=max3f(a,p0[r],p0[r+1]);b=max3f(b,p0[r+2],p0[r+3]);a=max3f(a,p1[r],p1[r+1]);b=max3f(b,p1[r+2],p1[r+3]);}
  const float m=max2f(a,b);
  auto rr=__builtin_amdgcn_permlane32_swap(__float_as_uint(m),__float_as_uint(m),false,false);
  return max2f(__uint_as_float(rr[0]),__uint_as_float(rr[1]));
}
__device__ __forceinline__ void pv(f32x16*o,int vb,bf16x8 pa0,bf16x8 pa1,bf16x8 pa2,bf16x8 pa3){
  #pragma unroll
  for(int d0=0;d0<2;++d0){s16x4 lo[4],hi[4];
    #pragma unroll
    for(int ks=0;ks<4;++ks){
      asm volatile("ds_read_b64_tr_b16 %0,%1 offset:%c2":"=&v"(lo[ks]):"v"(vb),"i"(d0*4096+ks*1024):"memory");
      asm volatile("ds_read_b64_tr_b16 %0,%1 offset:%c2":"=&v"(hi[ks]):"v"(vb),"i"(d0*4096+ks*1024+512):"memory");}
    asm volatile("s_waitcnt lgkmcnt(0)":::"memory");SBAR();
    #define PK(k) (bf16x8){lo[k][0],lo[k][1],lo[k][2],lo[k][3],hi[k][0],hi[k][1],hi[k][2],hi[k][3]}
    o[d0]=__builtin_amdgcn_mfma_f32_32x32x16_bf16(pa0,PK(0),o[d0],0,0,0);
    o[d0]=__builtin_amdgcn_mfma_f32_32x32x16_bf16(pa1,PK(1),o[d0],0,0,0);
    o[d0]=__builtin_amdgcn_mfma_f32_32x32x16_bf16(pa2,PK(2),o[d0],0,0,0);
    o[d0]=__builtin_amdgcn_mfma_f32_32x32x16_bf16(pa3,PK(3),o[d0],0,0,0);
    #undef PK
  }
}

#ifndef ATTN_STORE16
#define ATTN_STORE16(p,v) (*(u32x4*)(p)=(v))
#endif
template<int THRL> __device__ __forceinline__ void attn_unit(int b,int h,int qb,const bf16*Q,const bf16*__restrict__ K,const bf16*__restrict__ V,bf16*O,char*shm,const __attribute__((address_space(3))) float*CKL){
  const int tid=otid(),lane=tid&63,r32=lane&31,hi=lane>>5; const int wid=__builtin_amdgcn_readfirstlane(tid>>6);
  const long rowbase=(long)b*SEQ; const int q0=qb*QB;
  const bf16*Qw=Q+(rowbase+q0+wid*QBLK)*DM;
  const bf16*Kh=K+rowbase*DM,*Vh=V+rowbase*DM;
  const unsigned lds0=(unsigned)(uintptr_t)shm;
  float*wsf=(float*)(shm+LDS_WS)+wid*64;
  const bf16*ksrc=Kh+(long)lane*DM+wid*8;
  const bf16*vsrc=Vh+(long)(16*(wid&3)+(lane>>2))*DM+(wid>>2)*32+(lane&3)*8;
  const unsigned kdst=lds0+LDS_K+wid*1024, vdst=lds0+LDS_V+wid*1024;
  #define DMA_K(t,slot) glds16(ksrc+(long)(t)*KVBLK*DM,(unsigned)__builtin_amdgcn_readfirstlane(kdst+(slot)))
  #define DMA_V(t,slot) glds16(vsrc+(long)(t)*KVBLK*DM,(unsigned)__builtin_amdgcn_readfirstlane(vdst+(slot)))
  const int vb0=(int)(lds0+LDS_V)+((lane>>4)&1)*32+(lane&3)*8+(4*hi+((lane&15)>>2))*64;
  const char*Kbase=shm+LDS_K; bf16x8 kf[8];
  const lds_cptr shm3=(lds_cptr)shm; const lds_cptr kp0=shm3+LDS_K+hi*1024+r32*16; const lds_cptr vp0=shm3+LDS_V+((lane>>4)&1)*32+(lane&3)*8+(4*hi+((lane&15)>>2))*64;
  const int NT=(q0+QB)/KVBLK;
  DMA_K(0,0);DMA_V(0,0);DMA_K(1,SLOTB);
  bf16x8 qr[4];
  #pragma unroll
  for(int d0=0;d0<4;++d0)qr[d0]=*reinterpret_cast<const bf16x8*>(&Qw[(long)r32*DM+d0*16+hi*8]);
  float mhat=0.f,l_reg=0.f;f32x16 o[2];o[0]=f32x16{};o[1]=f32x16{};f32x16 negm=f32x16{};asm volatile("":"+v"(negm));
  const int qrel=wid*QBLK+r32;
  #define KBIAS(N0,N1,t) do{ const __attribute__((address_space(3))) float*cb_=CKL+64*(t)+4*hi; \
    _Pragma("unroll") for(int q_=0;q_<4;++q_){ const f32x4 a_=*(const __attribute__((address_space(3))) f32x4*)(cb_+8*q_), b_=*(const __attribute__((address_space(3))) f32x4*)(cb_+32+8*q_); \
      _Pragma("unroll") for(int e_=0;e_<4;++e_){ N0[4*q_+e_]=negm[4*q_+e_]-a_[e_]; N1[4*q_+e_]=negm[4*q_+e_]-b_[e_]; } } }while(0)
  #define CMASK(P0,P1,t) do{int jb_=(t)-(NT-4); if(jb_>=0)cmask(P0,P1,jb_,qrel,hi);}while(0)
  bool resc=false;
  #define START(P0,P1) do{ const float rm=rowmax(P0,P1); resc=false; \
    { const float dl=rm; mhat=fadd_s(mhat,dl); \
      _Pragma("unroll") for(int r=0;r<16;++r){P0[r]=fsub_s(P0[r],dl);P1[r]=fsub_s(P1[r],dl);} \
      _Pragma("unroll") for(int r=0;r<16;++r)negm[r]=-mhat; asm volatile("":"+v"(negm)); } \
    _Pragma("unroll") for(int r=0;r<16;++r)P0[r]=__builtin_amdgcn_exp2f(P0[r]); }while(0)
  #define RESC() do{ if(resc){ asm volatile("s_waitcnt lgkmcnt(0)":::"memory"); \
      _Pragma("unroll") for(int d_=0;d_<2;++d_) _Pragma("unroll") for(int r=0;r<16;++r)o[d_][r]*=wsf[crow(r,hi)]; } }while(0)
  f32x16 pA0,pA1,pB0,pB1;
  int sl_prev=0,sl_cur=0,sl_next=SLOTB;
  #define ROT() do{sl_prev=sl_cur;sl_cur=sl_next;sl_next=(sl_next==(NSLOT-1)*SLOTB)?0:sl_next+SLOTB;}while(0)
  DMA_K(2,2*SLOTB);
  WAIT_BAR(3);
  { f32x16 n0_,n1_; KBIAS(n0_,n1_,0); qkt(pA0,pA1,Kbase,qr,n0_,n1_,r32,hi); } asm volatile("s_nop 15\n\ts_nop 7":"+v"(pA0),"+v"(pA1));CMASK(pA0,pA1,0);
  START(pA0,pA1);
  _Pragma("unroll") for(int r=0;r<16;++r)pA1[r]=__builtin_amdgcn_exp2f(pA1[r]);
  WAIT_BAR(0);
  DMA_K(3,0);DMA_V(1,SLOTB);
  ROT();
  kload8(kf,kp0+sl_cur);
  WAIT_BAR(2);
  s16x4 vlo[8],vhi[8]; u32x4 pw0,pw1,pw2,pw3;
  #define PKW(P,B) cvtpk_s(P[B],P[B+1])
  #define PAF(k) __builtin_bit_cast(bf16x8,pw##k)
  #define VFR(i) (bf16x8){vlo[i][0],vlo[i][1],vlo[i][2],vlo[i][3],vhi[i][0],vhi[i][1],vhi[i][2],vhi[i][3]}
  #define PIN(x) asm volatile("":"+v"(x))
  #define MX3(a,b,c) __builtin_fmaxf(__builtin_fmaxf((a),(b)),(c))
  #define GAPA(MF,A0,A1,A2,A3,W0,W1,PW) do{ MF; sacc+=A0; sacc+=A1; sacc+=A2; sacc+=A3; PIN(sacc); W0; W1; PIN(PW); SBAR(); }while(0)
  #define EX(v) __builtin_amdgcn_exp2f(v)
  #define GAPB(MF,X,B) do{ MF; X[B]=EX(X[B]); X[B+1]=EX(X[B+1]); X[B+2]=EX(X[B+2]); X[B+3]=EX(X[B+3]); PIN(X); SBAR(); }while(0)
  #define VRD(i) do{ vlo[i]=vtr(vp_+(((i)>>2)*4096+((i)&3)*1024)); vhi[i]=vtr(vp_+(((i)>>2)*4096+((i)&3)*1024+512)); }while(0)
  #define KRD(G,j) do{ if(G){ kload2(kf,kp0+sl_next,j); SBAR(); } }while(0)
  #define STEP(C0,C1,P0,P1,t,GK,GV,GL) do{ SBAR(); \
    KBIAS(C0,C1,t); SBAR(); \
    const lds_cptr vp_=vp0+sl_prev; \
    VRD(0); SBAR(); float sacc=(P0[0]+P0[1]); \
    GAPA(C0=__builtin_amdgcn_mfma_f32_32x32x16_bf16(kf[0],qr[0],C0,0,0,0), P0[2],P0[3],P0[4],P0[5],     pw0[0]=PKW(P0,0), pw0[1]=PKW(P0,2), pw0); \
    VRD(4); SBAR(); GAPA(C1=__builtin_amdgcn_mfma_f32_32x32x16_bf16(kf[1],qr[0],C1,0,0,0), P0[6],P0[7],P0[8],P0[9],     pw0[2]=PKW(P0,4), pw0[3]=PKW(P0,6), pw0); \
    VRD(1); SBAR(); GAPA(C0=__builtin_amdgcn_mfma_f32_32x32x16_bf16(kf[2],qr[1],C0,0,0,0),   P0[10],P0[11],P0[12],P0[13], pw1[0]=PKW(P0,8), pw1[1]=PKW(P0,10), pw1); \
    VRD(5); SBAR(); GAPA(C1=__builtin_amdgcn_mfma_f32_32x32x16_bf16(kf[3],qr[1],C1,0,0,0),   P0[14],P0[15],P1[0],P1[1],   pw1[2]=PKW(P0,12),pw1[3]=PKW(P0,14), pw1); \
    VRD(2); SBAR(); GAPA(C0=__builtin_amdgcn_mfma_f32_32x32x16_bf16(kf[4],qr[2],C0,0,0,0),   P1[2],P1[3],P1[4],P1[5],     pw2[0]=PKW(P1,0), pw2[1]=PKW(P1,2), pw2); \
    VRD(6); SBAR(); GAPA(C1=__builtin_amdgcn_mfma_f32_32x32x16_bf16(kf[5],qr[2],C1,0,0,0),   P1[6],P1[7],P1[8],P1[9],     pw2[2]=PKW(P1,4), pw2[3]=PKW(P1,6), pw2); \
    VRD(3); SBAR(); GAPA(C0=__builtin_amdgcn_mfma_f32_32x32x16_bf16(kf[6],qr[3],C0,0,0,0),   P1[10],P1[11],P1[12],P1[13], pw3[0]=PKW(P1,8), pw3[1]=PKW(P1,10), pw3); \
    VRD(7); SBAR(); GAPA(C1=__builtin_amdgcn_mfma_f32_32x32x16_bf16(kf[7],qr[3],C1,0,0,0),   P1[14],P1[15],0.f,0.f,       pw3[2]=PKW(P1,12),pw3[3]=PKW(P1,14), pw3); \
    l_reg+=sacc; \
    if(GK){DMA_K((t)+3,sl_cur);} if(GV){DMA_V((t)+1,sl_next);} \
    CMASK(C0,C1,t); \
    { float a=MX3(C0[0],C0[1],C1[0]),b=MX3(C0[2],C0[3],C1[1]); a=MX3(a,C1[2],C1[3]); \
      _Pragma("unroll") for(int r=4;r<16;r+=4){a=MX3(a,C0[r],C0[r+1]);b=MX3(b,C0[r+2],C0[r+3]);a=MX3(a,C1[r],C1[r+1]);b=MX3(b,C1[r+2],C1[r+3]);} \
      float rm=__builtin_fmaxf(a,b); { auto rr=__builtin_amdgcn_permlane32_swap(__float_as_uint(rm),__float_as_uint(rm),false,false); rm=__builtin_fmaxf(__uint_as_float(rr[0]),__uint_as_float(rr[1])); } \
      resc=false; \
      if(__builtin_expect(__any(rm>(float)THRL),0)){ const float dl=__builtin_fmaxf(rm,0.f); mhat+=dl; \
        _Pragma("unroll") for(int r=0;r<16;++r){C0[r]-=dl;C1[r]-=dl;} \
        _Pragma("unroll") for(int r=0;r<16;++r)negm[r]=-mhat; asm volatile("":"+v"(negm)); \
        const float f=__builtin_amdgcn_exp2f(-dl); l_reg*=f; if(hi==0)wsf[r32]=f; resc=true; } } \
    SBAR(); \
    GAPB(o[0]=__builtin_amdgcn_mfma_f32_32x32x16_bf16(PAF(0),VFR(0),o[0],0,0,0), C0,0); \
    GAPB(o[1]=__builtin_amdgcn_mfma_f32_32x32x16_bf16(PAF(0),VFR(4),o[1],0,0,0), C0,4); \
    KRD(GL,0); GAPB(o[0]=__builtin_amdgcn_mfma_f32_32x32x16_bf16(PAF(1),VFR(1),o[0],0,0,0), C0,8); \
    KRD(GL,1); GAPB(o[1]=__builtin_amdgcn_mfma_f32_32x32x16_bf16(PAF(1),VFR(5),o[1],0,0,0), C0,12); \
    KRD(GL,2); GAPB(o[0]=__builtin_amdgcn_mfma_f32_32x32x16_bf16(PAF(2),VFR(2),o[0],0,0,0), C1,0); \
    KRD(GL,3); GAPB(o[1]=__builtin_amdgcn_mfma_f32_32x32x16_bf16(PAF(2),VFR(6),o[1],0,0,0), C1,4); \
    GAPB(o[0]=__builtin_amdgcn_mfma_f32_32x32x16_bf16(PAF(3),VFR(3),o[0],0,0,0), C1,8); \
    GAPB(o[1]=__builtin_amdgcn_mfma_f32_32x32x16_bf16(PAF(3),VFR(7),o[1],0,0,0), C1,12); \
    }while(0)
  int t=1;
  #undef CMASK
  #define CMASK(P0,P1,t) do{}while(0)
  for(;t+5<NT;t+=2){
    STEP(pB0,pB1,pA0,pA1,t,true,true,true);     WAIT_BAR(2); RESC(); ROT();
    STEP(pA0,pA1,pB0,pB1,t+1,true,true,true);   WAIT_BAR(2); RESC(); ROT();
  }
  #undef CMASK
  #define CMASK(P0,P1,t) do{int jb_=(t)-(NT-4); if(jb_>=0)cmask(P0,P1,jb_,qrel,hi);}while(0)
  #define ENDW(tt) do{ if((tt)+3<NT){WAIT_BAR(2);} else if((tt)+2<NT){WAIT_BAR(1);} else {WAIT_BAR(0);} }while(0)
  for(;t+1<NT;t+=2){
    STEP(pB0,pB1,pA0,pA1,t,(t+3<NT),(t+1<NT),(t+1<NT));       ENDW(t);   RESC(); ROT();
    STEP(pA0,pA1,pB0,pB1,t+1,(t+4<NT),(t+2<NT),(t+2<NT));     ENDW(t+1); RESC(); ROT();
  }
  STEP(pB0,pB1,pA0,pA1,NT-1,false,false,false); RESC();
  { float sacc=pB0[0]+pB0[1]; _Pragma("unroll") for(int r=2;r<16;++r)sacc+=pB0[r]; _Pragma("unroll") for(int r=0;r<16;++r)sacc+=pB1[r]; l_reg+=sacc;
    pw0=(u32x4){PKW(pB0,0),PKW(pB0,2),PKW(pB0,4),PKW(pB0,6)};pw1=(u32x4){PKW(pB0,8),PKW(pB0,10),PKW(pB0,12),PKW(pB0,14)};pw2=(u32x4){PKW(pB1,0),PKW(pB1,2),PKW(pB1,4),PKW(pB1,6)};pw3=(u32x4){PKW(pB1,8),PKW(pB1,10),PKW(pB1,12),PKW(pB1,14)};
    SBAR(); pv(o,vb0+sl_cur,PAF(0),PAF(1),PAF(2),PAF(3)); }
  #undef PKW
  #undef PAF
  #undef VFR
  #undef PIN
  #undef MX3
  #undef GAPA
  #undef GAPB
  #undef EX
  #undef VRD
  #undef KRD
  #undef STEP
  #undef ENDW
  {auto rr=__builtin_amdgcn_permlane32_swap(__float_as_uint(l_reg),__float_as_uint(l_reg),false,false);l_reg=__uint_as_float(rr[0])+__uint_as_float(rr[1]);}
  if(hi==0)wsf[32+r32]=l_reg;asm volatile("s_waitcnt lgkmcnt(0)":::"memory");
  float rli[16];
  #pragma unroll
  for(int r=0;r<16;++r)rli[r]=__builtin_amdgcn_rcpf(wsf[32+crow(r,hi)]);
  bf16*Ow=O+(rowbase+q0+wid*QBLK)*DM;
  { bf16*stg=(bf16*)(shm+LDS_OST)+wid*2048;
    #pragma unroll
    for(int r=0;r<16;++r){const int orow=crow(r,hi);
      #pragma unroll
      for(int d0=0;d0<2;++d0)stg[orow*64+d0*32+r32]=(bf16)f2bf(o[d0][r]*rli[r]);}
    asm volatile("s_waitcnt lgkmcnt(0)":::"memory");
    #pragma unroll
    for(int i=0;i<4;++i){const int row=i*8+(lane>>3),ch=lane&7; const u32x4 v=*(const u32x4*)(stg+row*64+ch*8); ATTN_STORE16(Ow+(long)row*DM+ch*8,v);} }
  asm volatile("s_waitcnt lgkmcnt(0)\n\ts_barrier":::"memory");
  #undef KBIAS
  #undef DMA_K
  #undef DMA_V
  #undef CMASK
  #undef START
  #undef RESC
  #undef ROT
}
constexpr int ATTN_LDS_BYTES=LDS_BYTES;
#undef SBAR
#undef WAIT_BAR
}

__device__ __forceinline__ void fox_ck_task(KArgP A, int l, LAS unsigned char* lds, int b, int h) {
    const bf16* PJ = (const bf16*)(A->ws + WS_PROJ);
    float* CKG = (float*)((unsigned char*)A->out + DO_CKG) + (size_t)(b * 8 + h) * SEQ;
    const int tid = otid(), lane = tid & 63, wid = tid >> 6;
    LAS float* WT = (LAS float*)lds;
    const float fb = A->fox_f_bias[l * 8 + h];
    float v[4]; float run = 0.f;
#pragma unroll
    for (int i = 0; i < 4; ++i) v[i] = bf2f(PJ[(size_t)(b * SEQ + tid * 4 + i) * LP + C_SM + 8 + h]);
#pragma unroll
    for (int i = 0; i < 4; ++i) { run += LOG2E * logsigmoidf_(v[i] + fb); v[i] = run; }
    float inc = run;
#pragma unroll
    for (int o = 1; o < 64; o <<= 1) { const float y = __builtin_bit_cast(float, __builtin_amdgcn_ds_bpermute(((lane - o) & 63) << 2, __builtin_bit_cast(int, inc))); if (lane >= o) inc += y; }
    __syncthreads();
    if (lane == 63) WT[wid] = inc;
    __syncthreads();
    float base = inc - run;
    for (int w = 0; w < wid; ++w) base += WT[w];
    *(f32x4*)(CKG + tid * 4) = (f32x4){base + v[0], base + v[1], base + v[2], base + v[3]};
}
__device__ __forceinline__ void fox_unit(KArgP A, int l, LAS unsigned char* lds, int b, int h, int qb, int ocol = -1) {
    bf16* PJ = (bf16*)(A->ws + WS_PROJ);
    const float* CKG = (const float*)((unsigned char*)A->out + DO_CKG) + (size_t)(b * 8 + h) * SEQ;
    const int tid = otid();
    LAS float* CK = (LAS float*)(lds + fox_body::LDS_BYTES);
    const f32x4 ck4 = (tid * 4 < 256 * (qb + 1)) ? *(const f32x4*)(CKG + tid * 4) : (f32x4){0.f, 0.f, 0.f, 0.f};
    __syncthreads();
    *(LAS f32x4*)(CK + tid * 4) = ck4;
    __syncthreads();
    fox_body::attn_unit<8>(b, h, qb, PJ + C_OB + h * 64, PJ + C_FK + h * 64, PJ + C_FV + h * 64, PJ + (ocol < 0 ? C_OB + h * 64 : ocol), (char*)lds, CK);
}

struct GdnPre { u32x4 xr[10]; f32x4 w0[4], w1[4]; unsigned ab; };
__device__ __forceinline__ void gdn_prep_issue(GdnPre& P, KArgP A, int l, int b, int h, int n) {
    const bf16* PJ = (const bf16*)(A->ws + WS_PROJ); const bf16* HALO = (const bf16*)((unsigned char*)A->out + DO_HALO);
    const float* cw = A->gdn_conv_w + (size_t)l * 4 * 1536;
    const int tid = otid(); const size_t row0 = (size_t)b * SEQ + n * 64;
    if (tid < 480) { const int pc = tid % 48, grp = tid / 48, part = pc >> 4, c8 = pc & 15, c = part * 512 + h * 128 + c8 * 8;
#pragma unroll
        for (int i = 0; i < 10; ++i) { const int tr = 7 * grp - 3 + i; P.xr[i] = (u32x4){0u, 0u, 0u, 0u};
            if (tr >= 0) { if (tr < 64) P.xr[i] = *(const u32x4*)(PJ + (row0 + tr) * LP + C_GQ + c); }
            else if (n > 0) P.xr[i] = *(const u32x4*)(HALO + ((size_t)(b * 32 + n - 1) * 3 + (3 + tr)) * 1536 + c); }
#pragma unroll
        for (int i = 0; i < 4; ++i) { P.w0[i] = *(const f32x4*)(cw + i * 1536 + c); P.w1[i] = *(const f32x4*)(cw + i * 1536 + c + 4); } }
    if (tid < 64) { const size_t r = (row0 + tid) * LP + C_SM; P.ab = (unsigned)PJ[r + 4 + h] | ((unsigned)PJ[r + h] << 16); }
}
__device__ __forceinline__ void gdn_prep_task(KArgP A, int l, LAS unsigned char* lds, int b, int h, int n, GdnPre& P, bool has_next, int nb_, int nh_, int nn_, GdnPre& N, bool dummy = false) {
    bf16* PJ = (bf16*)(A->ws + WS_PROJ);
    unsigned char* dsc = (unsigned char*)A->out; const bf16* HALO = (const bf16*)(dsc + DO_HALO);
    unsigned char* rec = dsc + DO_GP + (size_t)(dummy ? 2048 : ((b * 4 + h) * 32 + n)) * GP_STRIDE;
    const int tid = otid(), lane = tid & 63, wid = tid >> 6, l15 = lane & 15, g = lane >> 4;
    constexpr int S136 = 272, S72 = 144, S40 = 80;
    const int oq = dummy ? 5152 : C_GQ + h * 128, ov = dummy ? 5152 : C_GV + h * 128;
    LAS float* qf = (LAS float*)lds; LAS float* kf = qf + 64 * 128; LAS float* vf = kf + 64 * 128;
    LAS unsigned char* KB16 = lds + 98304; LAS unsigned char* QB16 = lds + 115712;
    LAS float* GC = (LAS float*)(lds + 146432); LAS float* BETA = GC + 64; LAS float* EG = BETA + 64;
    LAS unsigned char* AOFF = lds;
    LAS unsigned char* ATTS = lds + 9216;
    LAS float* AKK = (LAS float*)(lds + 18432);
    LAS unsigned char* TD = lds + 23552;
    LAS unsigned char* XT = lds + 98304;
    LAS unsigned char* TT = lds + 65536;
    const float* cw = A->gdn_conv_w + (size_t)l * 4 * 1536;
    const float alog = A->gdn_a_log[l * 4 + h], dtb = A->gdn_dt_bias[l * 4 + h];
    const int t0 = n * 64; const size_t row0 = (size_t)b * SEQ + t0;
    __syncthreads();
    TMARK(30);
    if (tid < 480) {
        const int pc = tid % 48, grp = tid / 48, part = pc >> 4, c8 = pc & 15;
        LAS float* dbase = (part == 0 ? qf : part == 1 ? kf : vf) + c8 * 8;
#pragma unroll
        for (int j = 0; j < 7; ++j) { const int tt = 7 * grp + j;
            if (tt < 64) { float y[8];
#pragma unroll
                for (int e2 = 0; e2 < 8; ++e2) y[e2] = 0.f;
#pragma unroll
                for (int i = 0; i < 4; ++i) { const u32x4 xv = P.xr[j + i];
                    y[0] += P.w0[i][0] * bflo(xv.x); y[1] += P.w0[i][1] * bfhi(xv.x); y[2] += P.w0[i][2] * bflo(xv.y); y[3] += P.w0[i][3] * bfhi(xv.y);
                    y[4] += P.w1[i][0] * bflo(xv.z); y[5] += P.w1[i][1] * bfhi(xv.z); y[6] += P.w1[i][2] * bflo(xv.w); y[7] += P.w1[i][3] * bfhi(xv.w); }
                LAS float* dst = dbase + tt * 128;
                *(LAS f32x4*)dst = (f32x4){siluf_(y[0]), siluf_(y[1]), siluf_(y[2]), siluf_(y[3])}; *(LAS f32x4*)(dst + 4) = (f32x4){siluf_(y[4]), siluf_(y[5]), siluf_(y[6]), siluf_(y[7])}; } }
    }
    if (tid < 64) { const float a = bflo(P.ab), bb = bfhi(P.ab);
        float gg = -__expf(alog) * softplusf_(a + dtb);
#pragma unroll
        for (int o = 1; o < 64; o <<= 1) { const float y2 = __builtin_bit_cast(float, __builtin_amdgcn_ds_bpermute(((lane - o) & 63) << 2, __builtin_bit_cast(int, gg))); if (lane >= o) gg += y2; }
        GC[tid] = gg; EG[tid] = __expf(gg); BETA[tid] = sigmoidf_(bb); }
    if (has_next) gdn_prep_issue(N, A, l, nb_, nh_, nn_);
    __syncthreads();
    TMARK(31);
    {
        float va[16], vc[16], ss[16];
#pragma unroll
        for (int i = 0; i < 16; ++i) { const int rr = wid + 8 * i; const LAS float* p = (rr < 64 ? qf + rr * 128 : kf + (rr - 64) * 128); va[i] = p[lane * 2]; vc[i] = p[lane * 2 + 1]; ss[i] = va[i] * va[i] + vc[i] * vc[i]; }
#pragma unroll
        for (int i = 0; i < 16; ++i) ss[i] += swz_xor<1>(ss[i]);
#pragma unroll
        for (int i = 0; i < 16; ++i) ss[i] += swz_xor<2>(ss[i]);
#pragma unroll
        for (int i = 0; i < 16; ++i) ss[i] += swz_xor<4>(ss[i]);
#pragma unroll
        for (int i = 0; i < 16; ++i) ss[i] += swz_xor<8>(ss[i]);
#pragma unroll
        for (int i = 0; i < 16; ++i) ss[i] += swz_xor<16>(ss[i]);
#pragma unroll
        for (int i = 0; i < 16; ++i) ss[i] = half_sum(ss[i]);
#pragma unroll
        for (int i = 0; i < 16; ++i) { const int rr = wid + 8 * i; const bool isq = rr < 64; const int row = isq ? rr : rr - 64;
            const float sc = rsqrtf(ss[i] + 1e-6f); const float an = va[i] * sc, cn = vc[i] * sc;
            if (isq) { *(LAS unsigned*)(QB16 + row * S136 + lane * 4) = pk2(an, cn); const float f = 0.08838834764831845f * EG[row];
                *(unsigned*)(PJ + (row0 + row) * LP + oq + lane * 2) = pk2(an * f, cn * f); }
            else { LAS float* p = kf + row * 128; p[lane * 2] = an; p[lane * 2 + 1] = cn; *(LAS unsigned*)(KB16 + row * S136 + lane * 4) = pk2(an, cn); } }
    }
    __syncthreads();
    TMARK(32);
    {
        const int mb = wid >> 1;
        bf16x8 ak[4], aq[4];
#pragma unroll
        for (int ks = 0; ks < 4; ++ks) { ak[ks] = frag_rm(KB16, S136, mb, ks, l15, g); aq[ks] = frag_rm(QB16, S136, mb, ks, l15, g); }
#pragma unroll
        for (int j = 0; j < 2; ++j) { const int nb = 2 * (wid & 1) + j; f32x4 kk = (f32x4){0.f, 0.f, 0.f, 0.f}, qk = (f32x4){0.f, 0.f, 0.f, 0.f};
#pragma unroll
            for (int ks = 0; ks < 4; ++ks) { const bf16x8 bfr = frag_rm(KB16, S136, nb, ks, l15, g); kk = MFMA16(ak[ks], bfr, kk); qk = MFMA16(aq[ks], bfr, qk); }
            const int jj = nb * 16 + l15; const float gj = GC[jj];
#pragma unroll
            for (int r = 0; r < 4; ++r) { const int i = mb * 16 + 4 * g + r; const float dec = jj <= i ? __expf(GC[i] - gj) : 0.f;
                const float av = jj < i ? BETA[i] * kk[r] * dec : 0.f;
                *(LAS bf16*)(AOFF + i * S72 + jj * 2) = (bf16)f2bf(nb < mb ? av : 0.f);
                if (nb == mb) AKK[(mb * 16 + 4 * g + r) * 20 + l15] = av;
                *(LAS bf16*)(ATTS + i * S72 + jj * 2) = (bf16)f2bf(qk[r] * dec * 0.08838834764831845f); } }
        for (int i = tid; i < 64 * S40 / 16; i += 512) *(LAS u32x4*)(TD + i * 16) = (u32x4){0u, 0u, 0u, 0u};
    }
    __syncthreads();
    TMARK(33);
    if (tid < 64) { const int k = tid >> 4, c = tid & 15; const LAS float* ab = AKK + k * 16 * 20; float y[16];
#pragma unroll
        for (int i = 0; i < 16; ++i) { float s = (i == c) ? 1.f : 0.f;
#pragma unroll
            for (int m = 0; m < i; ++m) s -= ab[i * 20 + m] * y[m];
            y[i] = s; *(LAS bf16*)(TD + (k * 16 + i) * S40 + c * 2) = (bf16)f2bf(s); } }
    for (int it = tid; it < 8 * 256; it += 512) { const int col = it & 255, i0 = (it >> 8) * 8;
        const LAS float* sp = col < 128 ? vf + col : kf + (col - 128); float r[8];
#pragma unroll
        for (int e = 0; e < 8; ++e) { const int i = i0 + e; r[e] = BETA[i] * sp[i * 128]; if (col >= 128) r[e] *= EG[i]; }
        *(LAS u32x4*)(XT + col * S72 + i0 * 2) = (u32x4){pk2(r[0], r[1]), pk2(r[2], r[3]), pk2(r[4], r[5]), pk2(r[6], r[7])}; }
    __syncthreads();
    TMARK(34);
    {
        for (int i = lane; i < 32 * S40 / 16; i += 64) *(LAS u32x4*)(TT + wid * 32 * S40 + i * 16) = (u32x4){0u, 0u, 0u, 0u};
#pragma unroll
        for (int k = 0; k < 4; ++k) {
#pragma unroll
            for (int jn = 0; jn < 2; ++jn) { const int nb = 2 * wid + jn, col = nb * 16 + l15;
                f32x4 acc = (f32x4){0.f, 0.f, 0.f, 0.f};
                if (k > 0) { acc = MFMA16(frag_rm(AOFF, S72, k, 0, l15, g), frag_rm(XT, S72, nb, 0, l15, g), acc);
                    if (k == 3) acc = MFMA16(frag_rm(AOFF, S72, k, 1, l15, g), frag_rm(XT, S72, nb, 1, l15, g), acc); }
                const u32x2 rv = *(const LAS u32x2*)(XT + col * S72 + (16 * k + 4 * g) * 2);
                *(LAS u32x2*)(TT + col * S40 + (4 * g) * 2) = (u32x2){pk2(bflo(rv.x) - acc[0], bfhi(rv.x) - acc[1]), pk2(bflo(rv.y) - acc[2], bfhi(rv.y) - acc[3])};
                f32x4 x = MFMA16(frag_rm(TD, S40, k, 0, l15, g), frag_rm(TT, S40, nb, 0, l15, g), ((f32x4){0.f, 0.f, 0.f, 0.f}));
                *(LAS u32x2*)(XT + col * S72 + (16 * k + 4 * g) * 2) = (u32x2){pk2(x[0], x[1]), pk2(x[2], x[3])};
            }
        }
    }
    __syncthreads();
    {
        const int q4 = l15 >> 2, p4 = lane & 3;
#pragma unroll
        for (int j = 0; j < 4; ++j) { const int op = wid * 4 + j, which = op >> 4, ks = (op >> 2) & 3, nb = op & 3;
            const bf16x8 f = frag_tr(XT + which * 128 * S72, S72, ks, nb, g, q4, p4); const int row = 16 * nb + l15, cc = 32 * ks + 8 * g;
            if (which == 0) *(bf16x8*)(PJ + (row0 + row) * LP + ov + cc) = f; else *(bf16x8*)((bf16*)(rec + GP_W) + row * 128 + cc) = f; }
    }
    TMARK(35);
    {
        { const int row = tid >> 3, c8 = tid & 7; *(u32x4*)(rec + GP_ATT + row * 128 + c8 * 16) = *(const LAS u32x4*)(ATTS + row * S72 + c8 * 16); }
        { const int dk = tid & 127, qt = tid >> 7; const float gl = GC[63]; unsigned w[8];
#pragma unroll
          for (int i = 0; i < 8; ++i) { const int c0 = qt * 16 + 2 * i; w[i] = pk2(kf[c0 * 128 + dk] * __expf(gl - GC[c0]), kf[(c0 + 1) * 128 + dk] * __expf(gl - GC[c0 + 1])); }
          u32x4* kp = (u32x4*)(rec + GP_KDT + dk * 128 + qt * 32);
          kp[0] = (u32x4){w[0], w[1], w[2], w[3]}; kp[1] = (u32x4){w[4], w[5], w[6], w[7]}; }
        if (tid == 0) *(float*)(rec + GP_CD) = EG[63];
    }
    TMARK(36);
}

__device__ __forceinline__ void gdn_scan_chain(KArgP A, int l, LAS unsigned char* lds, int b, int h, int ocol = -1) {
    bf16* PJ = (bf16*)(A->ws + WS_PROJ);
    unsigned char* dsc = (unsigned char*)A->out;
    const int tid = otid(), lane = tid & 63, wid = tid >> 6, l15 = lane & 15, g = lane >> 4;
    constexpr int S136 = 272, S72 = 144;
    LAS unsigned char* Wl = lds; LAS unsigned char* QDl = lds + 17408; LAS unsigned char* Ul = lds + 34816; LAS unsigned char* KDTl = lds + 52224; LAS unsigned char* ATTl = lds + 70656;
    LAS unsigned char* STl = lds + 79872; LAS unsigned char* VNl = lds + 114688; LAS float* SSQ = (LAS float*)(lds + 133120);
    LAS unsigned char* OST = Wl;
    const float* nw = A->gdn_norm_w + l * 128;
    const int mb = wid >> 1, nb0 = 4 * (wid & 1);
    f32x4 S[8];
#pragma unroll
    for (int j = 0; j < 8; ++j) S[j] = (f32x4){0.f, 0.f, 0.f, 0.f};
    __syncthreads();
    for (int i = tid; i < 128 * S136 / 16; i += 512) *(LAS u32x4*)(STl + i * 16) = (u32x4){0u, 0u, 0u, 0u};
    u32x4 pw[2], pq[2], pu[2], pk[2], pa, pz[2], zc[2]; float cd = 0.f, cdn = 0.f;
#define GDN_ISSUE(nn) do { const unsigned char* rec_ = dsc + DO_GP + (size_t)((b * 4 + h) * 32 + (nn)) * GP_STRIDE; const size_t r0_ = (size_t)b * SEQ + (nn) * 64; \
        _Pragma("unroll") for (int q_ = 0; q_ < 2; ++q_) { const int c_ = tid + 512 * q_, row_ = c_ >> 4, c16_ = c_ & 15; \
            pw[q_] = *(const u32x4*)(rec_ + GP_W + row_ * 256 + c16_ * 16); \
            pq[q_] = *(const u32x4*)(PJ + (r0_ + row_) * LP + C_GQ + h * 128 + c16_ * 8); pu[q_] = *(const u32x4*)(PJ + (r0_ + row_) * LP + C_GV + h * 128 + c16_ * 8); \
            pk[q_] = *(const u32x4*)(rec_ + GP_KDT + (c_ >> 3) * 128 + (c_ & 7) * 16); pz[q_] = *(const u32x4*)(PJ + (r0_ + row_) * LP + C_OA + h * 128 + c16_ * 8); } \
        pa = *(const u32x4*)(rec_ + GP_ATT + (tid >> 3) * 128 + (tid & 7) * 16); cdn = *(const float*)(rec_ + GP_CD); } while (0)
    GDN_ISSUE(0);
    for (int n = 0; n < SEQ / 64; ++n) {
        const size_t row0 = (size_t)b * SEQ + n * 64;
        __syncthreads();
#pragma unroll
        for (int q = 0; q < 2; ++q) { const int c = tid + 512 * q, row = c >> 4, c16 = c & 15;
            *(LAS u32x4*)(Wl + row * S136 + c16 * 16) = pw[q]; *(LAS u32x4*)(QDl + row * S136 + c16 * 16) = pq[q]; *(LAS u32x4*)(Ul + row * S136 + c16 * 16) = pu[q];
            *(LAS u32x4*)(KDTl + (c >> 3) * S72 + (c & 7) * 16) = pk[q]; }
        *(LAS u32x4*)(ATTl + (tid >> 3) * S72 + (tid & 7) * 16) = pa; cd = cdn; zc[0] = pz[0]; zc[1] = pz[1];
        __syncthreads();
        if (n + 1 < SEQ / 64) GDN_ISSUE(n + 1);
        f32x4 accO[4];
        {
            bf16x8 aw[4], aq[4];
#pragma unroll
            for (int ks = 0; ks < 4; ++ks) { aw[ks] = frag_rm(Wl, S136, mb, ks, l15, g); aq[ks] = frag_rm(QDl, S136, mb, ks, l15, g); }
#pragma unroll
            for (int j = 0; j < 4; ++j) { const int nb = nb0 + j; f32x4 ws = (f32x4){0.f, 0.f, 0.f, 0.f}; accO[j] = (f32x4){0.f, 0.f, 0.f, 0.f};
#pragma unroll
                for (int ks = 0; ks < 4; ++ks) { const bf16x8 sf = frag_rm(STl, S136, nb, ks, l15, g); ws = MFMA16(aw[ks], sf, ws); accO[j] = MFMA16(aq[ks], sf, accO[j]); }
                float vn[4];
#pragma unroll
                for (int r = 0; r < 4; ++r) vn[r] = bf2f(*(const LAS bf16*)(Ul + (mb * 16 + 4 * g + r) * S136 + (nb * 16 + l15) * 2)) - ws[r];
                *(LAS u32x2*)(VNl + (nb * 16 + l15) * S72 + (mb * 16 + 4 * g) * 2) = (u32x2){pk2(vn[0], vn[1]), pk2(vn[2], vn[3])}; }
        }
        __syncthreads();
        {
            bf16x8 aa[2], ak[2];
#pragma unroll
            for (int ks = 0; ks < 2; ++ks) { aa[ks] = frag_rm(ATTl, S72, mb, ks, l15, g); ak[ks] = frag_rm(KDTl, S72, wid, ks, l15, g); }
#pragma unroll
            for (int j = 0; j < 4; ++j)
#pragma unroll
                for (int ks = 0; ks < 2; ++ks) accO[j] = MFMA16(aa[ks], frag_rm(VNl, S72, nb0 + j, ks, l15, g), accO[j]);
#pragma unroll
            for (int jb = 0; jb < 8; ++jb) { S[jb] = S[jb] * cd;
#pragma unroll
                for (int ks = 0; ks < 2; ++ks) S[jb] = MFMA16(ak[ks], frag_rm(VNl, S72, jb, ks, l15, g), S[jb]);
                *(LAS u32x2*)(STl + (jb * 16 + l15) * S136 + (wid * 16 + 4 * g) * 2) = (u32x2){pk2(S[jb][0], S[jb][1]), pk2(S[jb][2], S[jb][3])}; }
        }
        {
            float ss[4];
#pragma unroll
            for (int r = 0; r < 4; ++r) { float s = 0.f;
#pragma unroll
                for (int j = 0; j < 4; ++j) s += accO[j][r] * accO[j][r];
                s += swz_xor<1>(s); s += swz_xor<2>(s); s += swz_xor<4>(s); s += swz_xor<8>(s); ss[r] = s; }
            if (l15 == 0) {
#pragma unroll
                for (int r = 0; r < 4; ++r) SSQ[(mb * 16 + 4 * g + r) * 2 + (wid & 1)] = ss[r]; }
            __syncthreads();
#pragma unroll
            for (int r = 0; r < 4; ++r) { const int i = mb * 16 + 4 * g + r; const float sc = rsqrtf((SSQ[i * 2] + SSQ[i * 2 + 1]) * (1.f / 128.f) + 1e-6f);
#pragma unroll
                for (int j = 0; j < 4; ++j) { const int dv = (nb0 + j) * 16 + l15; *(LAS bf16*)(OST + i * S136 + dv * 2) = (bf16)f2bf(accO[j][r] * sc * nw[dv]); } }
            __syncthreads();
#pragma unroll
            for (int q = 0; q < 2; ++q) { const int it = tid + 512 * q, tt = it >> 4, c8 = it & 15;
                bf16* gp = PJ + (row0 + tt) * LP + C_OA + h * 128 + c8 * 8; const u32x4 rv = zc[q]; if (ocol >= 0) gp = PJ + (row0 + tt) * LP + ocol + c8 * 8; const u32x4 ov = *(const LAS u32x4*)(OST + tt * S136 + c8 * 16);
                u32x4 w; w.x = pk2(bflo(ov.x) * siluf_(bflo(rv.x)), bfhi(ov.x) * siluf_(bfhi(rv.x))); w.y = pk2(bflo(ov.y) * siluf_(bflo(rv.y)), bfhi(ov.y) * siluf_(bfhi(rv.y)));
                w.z = pk2(bflo(ov.z) * siluf_(bflo(rv.z)), bfhi(ov.z) * siluf_(bfhi(rv.z))); w.w = pk2(bflo(ov.w) * siluf_(bflo(rv.w)), bfhi(ov.w) * siluf_(bfhi(rv.w)));
                *(u32x4*)gp = w; }
        }
    }
#undef GDN_ISSUE
}

__device__ __forceinline__ unsigned char* gla_slot(KArgP A, int b, int h, int n) {
    const int s = (b * 4 + h) * 32 + n;
    return b < 13 ? A->ws + WS_KVS + (size_t)s * 16384 : (unsigned char*)A->out + DO_KVS + (size_t)(s - 13 * 128) * 16384;
}
struct GlaPre { u32x4 v[2], q, k; unsigned short lr[2]; };
__device__ __forceinline__ void gla_prep_issue(GlaPre& P, KArgP A, int b, int h, int n) {
    const bf16* PJ = (const bf16*)(A->ws + WS_PROJ); const int tid = otid(); const size_t row0 = (size_t)b * SEQ + n * 64;
#pragma unroll
    for (int q = 0; q < 2; ++q) { const int it = tid + 512 * q, tt = it >> 4, c = it & 15;
        P.lr[q] = PJ[(row0 + tt) * LP + C_SM + 16 + c]; P.v[q] = *(const u32x4*)(PJ + (row0 + tt) * LP + C_LV + h * 128 + c * 8); }
    const int tt0 = tid >> 3, c80 = tid & 7;
    P.q = *(const u32x4*)(PJ + (row0 + tt0) * LP + C_LQ + h * 64 + c80 * 8); P.k = *(const u32x4*)(PJ + (row0 + tt0) * LP + C_LK + h * 64 + c80 * 8);
}
__device__ __forceinline__ void gla_prep_task(KArgP A, int l, LAS unsigned char* lds, int b, int h, int n, GlaPre& P, bool has_next, int nb_, int nh_, int nn_, GlaPre& N) {
    bf16* PJ = (bf16*)(A->ws + WS_PROJ);
    const int tid = otid(), lane = tid & 63, wid = tid >> 6, l15 = lane & 15, g = lane >> 4, q4 = l15 >> 2, p4 = lane & 3;
    constexpr int S72 = 144, S136 = 272;
    LAS unsigned char* QT = lds; LAS unsigned char* KT = QT + 64 * S72; LAS unsigned char* KDT = KT + 64 * S72; LAS unsigned char* ATT = KDT + 64 * S72; LAS unsigned char* VV = ATT + 64 * S72;
    LAS float* LA = (LAS float*)(VV + 64 * S136); LAS float* LR = LA + 64 * 64; LAS float* SEG = LR + 64 * 16;
    const float* wg2 = A->gla_w_gate2 + (size_t)l * 16 * 256; const float* bg = A->gla_b_gate + l * 256;
    const size_t row0 = (size_t)b * SEQ + n * 64;
    const int mb = wid >> 1, nb0 = 4 * (wid & 1);
    float wcol[16]; const float bgv = bg[h * 64 + (tid & 63)];
#pragma unroll
    for (int r = 0; r < 16; ++r) wcol[r] = wg2[r * 256 + h * 64 + (tid & 63)];
    __syncthreads();
#pragma unroll
    for (int q = 0; q < 2; ++q) { const int it = tid + 512 * q; LR[it] = bf2f(P.lr[q]); *(LAS u32x4*)(VV + (it >> 4) * S136 + (it & 15) * 16) = P.v[q]; }
    const int tt0 = tid >> 3, c80 = tid & 7;
    const u32x4 qv = P.q, kv = P.k;
    if (has_next) gla_prep_issue(N, A, nb_, nh_, nn_);
    __syncthreads();
    for (int it = tid; it < 64 * 64; it += 512) { const int tt = it >> 6; float z = bgv;
        const LAS f32x4* lr4 = (const LAS f32x4*)(LR + tt * 16);
#pragma unroll
        for (int r4 = 0; r4 < 4; ++r4) { const f32x4 v = lr4[r4]; z += v[0] * wcol[4 * r4] + v[1] * wcol[4 * r4 + 1] + v[2] * wcol[4 * r4 + 2] + v[3] * wcol[4 * r4 + 3]; }
        LA[it] = (fminf(z, 0.f) - __logf(1.f + __expf(-fabsf(z)))) * (1.f / 16.f); }
    __syncthreads();
    { const int d = tid & 63, seg = tid >> 6; float run = 0.f;
#pragma unroll
      for (int i = 0; i < 8; ++i) { run += LA[(seg * 8 + i) * 64 + d]; LA[(seg * 8 + i) * 64 + d] = run; }
      SEG[seg * 64 + d] = run; }
    __syncthreads();
    { const int d = tid & 63, seg = tid >> 6; float pre = 0.f;
      for (int s2 = 0; s2 < seg; ++s2) pre += SEG[s2 * 64 + d];
#pragma unroll
      for (int i = 0; i < 8; ++i) LA[(seg * 8 + i) * 64 + d] += pre; }
    __syncthreads();
    {
        const float qf[8] = {bflo(qv.x), bfhi(qv.x), bflo(qv.y), bfhi(qv.y), bflo(qv.z), bfhi(qv.z), bflo(qv.w), bfhi(qv.w)};
        const float kf[8] = {bflo(kv.x), bfhi(kv.x), bflo(kv.y), bfhi(kv.y), bflo(kv.z), bfhi(kv.z), bflo(kv.w), bfhi(kv.w)};
        float qt[8], kt[8];
#pragma unroll
        for (int e = 0; e < 8; ++e) { const int d = c80 * 8 + e; const float cu = LA[tt0 * 64 + d], cl = LA[63 * 64 + d];
            qt[e] = qf[e] * 0.125f * __expf(cu); kt[e] = kf[e] * __expf(-cu);
            *(LAS bf16*)(KDT + d * S72 + tt0 * 2) = (bf16)f2bf(kf[e] * __expf(cl - cu)); }
        const u32x4 qw = (u32x4){pk2(qt[0], qt[1]), pk2(qt[2], qt[3]), pk2(qt[4], qt[5]), pk2(qt[6], qt[7])};
        *(LAS u32x4*)(QT + tt0 * S72 + c80 * 16) = qw;
        *(u32x4*)(PJ + (row0 + tt0) * LP + C_LQ + h * 64 + c80 * 8) = qw;
        *(LAS u32x4*)(KT + tt0 * S72 + c80 * 16) = (u32x4){pk2(kt[0], kt[1]), pk2(kt[2], kt[3]), pk2(kt[4], kt[5]), pk2(kt[6], kt[7])};
        if (tid < 64) ((float*)(A->ws + WS_CDB))[(size_t)((b * 4 + h) * 32 + n) * 64 + tid] = __expf(LA[63 * 64 + tid]);
    }
    __syncthreads();
    {
        bf16x8 af[2], kf2[2];
#pragma unroll
        for (int ks = 0; ks < 2; ++ks) { af[ks] = frag_rm(QT, S72, mb, ks, l15, g); kf2[ks] = frag_rm(KDT, S72, mb, ks, l15, g); }
#pragma unroll
        for (int j = 0; j < 2; ++j) { const int nb = 2 * (wid & 1) + j; f32x4 a = (f32x4){0.f, 0.f, 0.f, 0.f};
#pragma unroll
            for (int ks = 0; ks < 2; ++ks) a = MFMA16(af[ks], frag_rm(KT, S72, nb, ks, l15, g), a);
#pragma unroll
            for (int r = 0; r < 4; ++r) { const int i = mb * 16 + 4 * g + r, jj = nb * 16 + l15; *(LAS bf16*)(ATT + i * S72 + jj * 2) = (bf16)f2bf(jj <= i ? a[r] : 0.f); } }
        unsigned char* slot = gla_slot(A, b, h, n);
#pragma unroll
        for (int j = 0; j < 4; ++j) { f32x4 kvb = (f32x4){0.f, 0.f, 0.f, 0.f};
#pragma unroll
            for (int ks = 0; ks < 2; ++ks) kvb = MFMA16(kf2[ks], frag_tr(VV, S136, ks, nb0 + j, g, q4, p4), kvb);
            *(u32x2*)(slot + ((nb0 + j) * 16 + l15) * 128 + (mb * 16 + 4 * g) * 2) = (u32x2){pk2(kvb[0], kvb[1]), pk2(kvb[2], kvb[3])}; }
    }
    __syncthreads();
    { const int row = tid >> 3, c8 = tid & 7; *(u32x4*)(PJ + (row0 + row) * LP + C_LK + h * 64 + c8 * 8) = *(const LAS u32x4*)(ATT + row * S72 + c8 * 16); }
}
__device__ __forceinline__ void gla_state_scan(KArgP A) {
    for (int gt = obid() * 512 + otid(); gt < 64 * 2048; gt += ogrid() * 512) {
    const int ch = gt >> 11, e4 = gt & 2047, b = ch >> 2, h = ch & 3;
    const float* cdb = (const float*)(A->ws + WS_CDB) + (size_t)ch * 32 * 64 + (e4 & 15) * 4;
    float s0 = 0.f, s1 = 0.f, s2 = 0.f, s3 = 0.f;
#pragma unroll 8
    for (int n = 0; n < 32; ++n) {
        u32x2* p = (u32x2*)(gla_slot(A, b, h, n) + e4 * 8); const u32x2 kv = *p; const f32x4 cd = *(const f32x4*)(cdb + n * 64);
        *p = (u32x2){pk2(s0, s1), pk2(s2, s3)};
        s0 = cd[0] * s0 + bflo(kv.x); s1 = cd[1] * s1 + bfhi(kv.x); s2 = cd[2] * s2 + bflo(kv.y); s3 = cd[3] * s3 + bfhi(kv.y);
    }
    }
}
__device__ __forceinline__ void gla_out_task(KArgP A, int l, LAS unsigned char* lds, int b, int h, int n) {
    bf16* PJ = (bf16*)(A->ws + WS_PROJ);
    const int tid = otid(), lane = tid & 63, wid = tid >> 6, l15 = lane & 15, g = lane >> 4, q4 = l15 >> 2, p4 = lane & 3;
    constexpr int S72 = 144, S136 = 272;
    LAS unsigned char* QT = lds; LAS unsigned char* ATT = QT + 64 * S72; LAS unsigned char* VV = ATT + 64 * S72; LAS unsigned char* ST = VV + 64 * S136; LAS unsigned char* OST = ST + 128 * S72;
    LAS float* SSQ = (LAS float*)(OST + 64 * S136);
    const float* nw = A->gla_norm_w + l * 128;
    const size_t row0 = (size_t)b * SEQ + n * 64;
    const int mb = wid >> 1, nb0 = 4 * (wid & 1);
    const unsigned char* slot = gla_slot(A, b, h, n);
    u32x4 rpre[2];
#pragma unroll
    for (int q = 0; q < 2; ++q) { const int it = tid + 512 * q; rpre[q] = *(const u32x4*)(PJ + (row0 + (it >> 4)) * LP + C_OC + h * 128 + (it & 15) * 8); }
    __syncthreads();
    { const int row = tid >> 3, c8 = tid & 7;
      *(LAS u32x4*)(QT + row * S72 + c8 * 16) = *(const u32x4*)(PJ + (row0 + row) * LP + C_LQ + h * 64 + c8 * 8);
      *(LAS u32x4*)(ATT + row * S72 + c8 * 16) = *(const u32x4*)(PJ + (row0 + row) * LP + C_LK + h * 64 + c8 * 8); }
#pragma unroll
    for (int q = 0; q < 2; ++q) { const int c = tid + 512 * q;
        *(LAS u32x4*)(VV + (c >> 4) * S136 + (c & 15) * 16) = *(const u32x4*)(PJ + (row0 + (c >> 4)) * LP + C_LV + h * 128 + (c & 15) * 8);
        *(LAS u32x4*)(ST + (c >> 3) * S72 + (c & 7) * 16) = *(const u32x4*)(slot + (c >> 3) * 128 + (c & 7) * 16); }
    __syncthreads();
    f32x4 acc[4];
    {
        bf16x8 af[2], aa[2];
#pragma unroll
        for (int ks = 0; ks < 2; ++ks) { af[ks] = frag_rm(QT, S72, mb, ks, l15, g); aa[ks] = frag_rm(ATT, S72, mb, ks, l15, g); }
#pragma unroll
        for (int j = 0; j < 4; ++j) { acc[j] = (f32x4){0.f, 0.f, 0.f, 0.f};
#pragma unroll
            for (int ks = 0; ks < 2; ++ks) { acc[j] = MFMA16(af[ks], frag_rm(ST, S72, nb0 + j, ks, l15, g), acc[j]); acc[j] = MFMA16(aa[ks], frag_tr(VV, S136, ks, nb0 + j, g, q4, p4), acc[j]); } }
    }
    float ss[4];
#pragma unroll
    for (int r = 0; r < 4; ++r) { float s = 0.f;
#pragma unroll
        for (int j = 0; j < 4; ++j) s += acc[j][r] * acc[j][r];
        s += swz_xor<1>(s); s += swz_xor<2>(s); s += swz_xor<4>(s); s += swz_xor<8>(s); ss[r] = s; }
    if (l15 == 0) {
#pragma unroll
        for (int r = 0; r < 4; ++r) SSQ[(mb * 16 + 4 * g + r) * 2 + (wid & 1)] = ss[r]; }
    __syncthreads();
#pragma unroll
    for (int r = 0; r < 4; ++r) { const int i = mb * 16 + 4 * g + r; const float sc = rsqrtf((SSQ[i * 2] + SSQ[i * 2 + 1]) * (1.f / 128.f) + 1e-6f);
#pragma unroll
        for (int j = 0; j < 4; ++j) { const int dv = (nb0 + j) * 16 + l15; *(LAS bf16*)(OST + i * S136 + dv * 2) = (bf16)f2bf(acc[j][r] * sc * nw[dv]); } }
    __syncthreads();
#pragma unroll
    for (int q = 0; q < 2; ++q) { const int it = tid + 512 * q, tt = it >> 4, c8 = it & 15;
        bf16* gp = PJ + (row0 + tt) * LP + C_OC + h * 128 + c8 * 8; const u32x4 rv = rpre[q]; const u32x4 ov = *(const LAS u32x4*)(OST + tt * S136 + c8 * 16);
        u32x4 w; w.x = pk2(bflo(ov.x) * siluf_(bflo(rv.x)), bfhi(ov.x) * siluf_(bfhi(rv.x))); w.y = pk2(bflo(ov.y) * siluf_(bflo(rv.y)), bfhi(ov.y) * siluf_(bfhi(rv.y)));
        w.z = pk2(bflo(ov.z) * siluf_(bflo(rv.z)), bfhi(ov.z) * siluf_(bfhi(rv.z))); w.w = pk2(bflo(ov.w) * siluf_(bflo(rv.w)), bfhi(ov.w) * siluf_(bfhi(rv.w)));
        *(u32x4*)gp = w; }
}

struct LnRow { float v[16]; };
__device__ __forceinline__ void ln_normalize(LnRow& r, const float* g, const float* bta, int lane) {
    float s = 0.f;
#pragma unroll
    for (int i = 0; i < 16; ++i) s += r.v[i];
    const float mean = wave_sum(s) * (1.f / 1024.f); float q = 0.f;
#pragma unroll
    for (int i = 0; i < 16; ++i) { r.v[i] -= mean; q += r.v[i] * r.v[i]; }
    const float rstd = rsqrtf(wave_sum(q) * (1.f / 1024.f) + 1e-5f);
#pragma unroll
    for (int jj = 0; jj < 2; ++jj) { const int k = 8 * (lane + 64 * jj);
        const f32x4 g0 = *(const f32x4*)(g + k), g1 = *(const f32x4*)(g + k + 4), b0 = *(const f32x4*)(bta + k), b1 = *(const f32x4*)(bta + k + 4);
#pragma unroll
        for (int e = 0; e < 4; ++e) { r.v[jj * 8 + e] = r.v[jj * 8 + e] * rstd * g0[e] + b0[e]; r.v[jj * 8 + 4 + e] = r.v[jj * 8 + 4 + e] * rstd * g1[e] + b1[e]; } }
}
__device__ __forceinline__ void ln_load_bf16(LnRow& r, const bf16* row, int lane, float scale) {
#pragma unroll
    for (int jj = 0; jj < 2; ++jj) { const u32x4 t = *(const u32x4*)(row + 8 * (lane + 64 * jj));
        r.v[jj * 8 + 0] = scale * bflo(t.x); r.v[jj * 8 + 1] = scale * bfhi(t.x); r.v[jj * 8 + 2] = scale * bflo(t.y); r.v[jj * 8 + 3] = scale * bfhi(t.y);
        r.v[jj * 8 + 4] = scale * bflo(t.z); r.v[jj * 8 + 5] = scale * bfhi(t.z); r.v[jj * 8 + 6] = scale * bflo(t.w); r.v[jj * 8 + 7] = scale * bfhi(t.w); }
}
__device__ __forceinline__ void ln_add_bf16(LnRow& r, const bf16* row, int lane, float scale) {
#pragma unroll
    for (int jj = 0; jj < 2; ++jj) { const u32x4 t = *(const u32x4*)(row + 8 * (lane + 64 * jj));
        r.v[jj * 8 + 0] += scale * bflo(t.x); r.v[jj * 8 + 1] += scale * bfhi(t.x); r.v[jj * 8 + 2] += scale * bflo(t.y); r.v[jj * 8 + 3] += scale * bfhi(t.y);
        r.v[jj * 8 + 4] += scale * bflo(t.z); r.v[jj * 8 + 5] += scale * bfhi(t.z); r.v[jj * 8 + 6] += scale * bflo(t.w); r.v[jj * 8 + 7] += scale * bfhi(t.w); }
}
__device__ __forceinline__ void ln_store_bf16(const LnRow& r, bf16* row, int lane) {
#pragma unroll
    for (int jj = 0; jj < 2; ++jj) { u32x4 w; w.x = pk2(r.v[jj * 8], r.v[jj * 8 + 1]); w.y = pk2(r.v[jj * 8 + 2], r.v[jj * 8 + 3]); w.z = pk2(r.v[jj * 8 + 4], r.v[jj * 8 + 5]); w.w = pk2(r.v[jj * 8 + 6], r.v[jj * 8 + 7]);
        *(u32x4*)(row + 8 * (lane + 64 * jj)) = w; }
}
__device__ __forceinline__ void ln_store_f32(const LnRow& r, float* row, int lane) {
#pragma unroll
    for (int jj = 0; jj < 2; ++jj) { float* p = row + 8 * (lane + 64 * jj);
        *(f32x4*)p = (f32x4){r.v[jj * 8], r.v[jj * 8 + 1], r.v[jj * 8 + 2], r.v[jj * 8 + 3]}; *(f32x4*)(p + 4) = (f32x4){r.v[jj * 8 + 4], r.v[jj * 8 + 5], r.v[jj * 8 + 6], r.v[jj * 8 + 7]}; }
}

__device__ __forceinline__ KArgP argp() { KArgP p = (KArgP)__builtin_amdgcn_kernarg_segment_ptr(); asm volatile("" : "+s"(p)); return p; }
#define XB_TMO      128
#define XB_XCNT(j)  (256  + 64 * (j))
#define XB_XSUB(j)  (1280 + 64 * (j))
#define XB_XGEN(j)  (2304 + 64 * (j))
#define XB_TOP      3328
#define XB_TOPGEN   3392
#define XB_SPIN_CAP (1u << 20)
constexpr int CW_BAR = 4096;
__device__ __forceinline__ unsigned xb_ld(unsigned* p)              { return __hip_atomic_load(p, __ATOMIC_RELAXED, __HIP_MEMORY_SCOPE_AGENT); }
__device__ __forceinline__ unsigned xb_add(unsigned* p, unsigned v) { return __hip_atomic_fetch_add(p, v, __ATOMIC_RELAXED, __HIP_MEMORY_SCOPE_AGENT); }
__device__ __forceinline__ unsigned xb_xcc_id() { return (unsigned)__builtin_amdgcn_s_getreg((3 << 11) | 20) & 0xFu; }
#define XB_SPIN(cond, bar) do { unsigned _sp = 0; while (cond) { __builtin_amdgcn_s_sleep(1); \
    if ((++_sp & 255u) == 0u) { if (xb_ld(&(bar)[XB_TMO])) break; if (_sp > XB_SPIN_CAP) { atomicAdd(&(bar)[XB_TMO], 1u); break; } } } } while (0)
__device__ __forceinline__ void xcd_barrier_complete(unsigned* bar, unsigned x, unsigned& nloc, unsigned& nx) {
    const unsigned G = gridDim.x;
    unsigned sum, cnt, mine, sp = 0u;
    for (;;) {
        sum = 0u; cnt = 0u; mine = 0u;
#pragma unroll
        for (unsigned j = 0; j < 16; ++j) { const unsigned c = xb_ld(&bar[XB_XCNT(j)]); sum += c; cnt += (c > 0u) ? 1u : 0u; mine = (j == x) ? c : mine; }
        if (sum == G) break;
        __builtin_amdgcn_s_sleep(1);
        if ((++sp & 255u) == 0u) { if (xb_ld(&bar[XB_TMO])) break; if (sp > XB_SPIN_CAP) { atomicAdd(&bar[XB_TMO], 1u); break; } }
    }
    nloc = mine > 0u ? mine : 1u; nx = cnt > 0u ? cnt : 1u;
}
__device__ __forceinline__ void grid_barrier(LAS unsigned char* lds) {
    volatile LAS unsigned* st = (volatile LAS unsigned*)(lds + LDS_CTL + 2048);
    asm volatile("s_waitcnt vmcnt(0)" ::: "memory");
    __syncthreads();
    if (otid() == 0) {
        unsigned* bar = (unsigned*)(argp()->ws + WS_CTL) + CW_BAR;
        const unsigned x = xb_xcc_id();
        __builtin_amdgcn_s_waitcnt(0);
        unsigned nloc = st[0], nx = st[1];
        if (nloc == 0u) { xcd_barrier_complete(bar, x, nloc, nx); st[0] = nloc; st[1] = nx; }
        const unsigned old = xb_add(&bar[XB_XSUB(x)], 1u);
        const unsigned gen = old / nloc;
        if (old + 1u == (gen + 1u) * nloc) {
            __builtin_amdgcn_fence(__ATOMIC_RELEASE, "agent");
            asm volatile("s_waitcnt vmcnt(0)" ::: "memory");
            const unsigned og = xb_add(&bar[XB_TOP], 1u);
            const unsigned tg = og / nx;
            if (og + 1u == (tg + 1u) * nx) xb_add(&bar[XB_TOPGEN], 1u);
            else XB_SPIN(xb_ld(&bar[XB_TOPGEN]) == tg, bar);
            __builtin_amdgcn_fence(__ATOMIC_ACQUIRE, "agent");
            xb_add(&bar[XB_XGEN(x)], 1u);
            asm volatile("s_waitcnt vmcnt(0)" ::: "memory");
        } else {
            XB_SPIN(xb_ld(&bar[XB_XGEN(x)]) == gen, bar);
            __builtin_amdgcn_fence(__ATOMIC_ACQUIRE, "agent");
            asm volatile("s_waitcnt vmcnt(0)" ::: "memory");
        }
    }
    __syncthreads();
}

#define PH_COMMON \
    KArgP ap = argp(); unsigned char* ws = ap->ws; (void)ws; \
    const int tid = otid(), lane = tid & 63, wid = tid >> 6; (void)lane; (void)wid; \
    const int G = ogrid(), bx = obid(), gw = bx * 8 + wid, NGW = G * 8; (void)gw; (void)NGW; \
    unsigned char* wt = ws + WS_WT; (void)wt; bf16* XB = (bf16*)(ws + WS_XB); (void)XB; bf16* PJ = (bf16*)(ws + WS_PROJ); (void)PJ; \
    unsigned char* dsc = (unsigned char*)ap->out; bf16* Y = (bf16*)(dsc + DO_Y); (void)Y; bf16* KV = (bf16*)(dsc + DO_KV); (void)KV; bf16* MEMB = (bf16*)(dsc + DO_MEMB); (void)MEMB;

__device__ __forceinline__ void ph_input(LAS unsigned char* lds) { PH_COMMON
    convert_rows(ap->x, XB, (size_t)NTOK * DM);
    convert_rows(ap->mem, MEMB, (size_t)NMEM * DM);
}
__device__ __forceinline__ void ph_weights(LAS unsigned char* lds, int l) { KArgP A = argp(); phase_convert_weights(A, l, lds); }
__device__ __forceinline__ void ph_proj(LAS unsigned char* lds, int l) { PH_COMMON
    pg8::Gemm g{1024, 1024, 1024};
    RegSched S{NTOK / 256, LP / 256, (NTOK / 256) * (LP / 256), G, bx, (const char*)XB, (const char*)(wt + WT_WIN), (size_t)256 * 1024 * 2, (size_t)256 * 1024 * 2, 0};
    pg8::EpiProj E{PJ, LP, (bf16*)(dsc + DO_HALO)};
    pg8::gemm_phase(lds, g, S, E);
}
__device__ __forceinline__ void ph_kv(LAS unsigned char* lds, int l) { PH_COMMON
    pg8::Gemm g{1024, 1024, 1024};
    if (bx < G - 128) return;
    RegSched S2{NMEM / 256, 2048 / 256, (NMEM / 256) * (2048 / 256), G, bx - (G - 128), (const char*)MEMB, (const char*)(wt + WT_WKV), (size_t)256 * 1024 * 2, (size_t)256 * 1024 * 2, 0};
    pg8::EpiStore E2{KV, 2048, 1.f};
    pg8::gemm_phase(lds, g, S2, E2);
}
__device__ __forceinline__ void ph_gdn_prep(LAS unsigned char* lds, int l) {
    KArgP A = argp();
    const int G = ogrid(), bx = obid();
    TMARK(20);
    if (bx < NB * 8) fox_ck_task(A, l, lds, bx >> 3, bx & 7);
    { GdnPre P, N; if (bx < NB * 4 * 32) gdn_prep_issue(P, A, l, bx >> 7, (bx >> 5) & 3, bx & 31);
      for (int t = bx; t < NB * 4 * 32; t += G) { const int t2 = t + G; const bool hn = t2 < NB * 4 * 32;
          gdn_prep_task(A, l, lds, t >> 7, (t >> 5) & 3, t & 31, P, hn, t2 >> 7, (t2 >> 5) & 3, t2 & 31, N);
          P = N; } }
    TMARK(21);
    { GlaPre P, N; if (bx < NB * 4 * 32) gla_prep_issue(P, A, bx >> 7, (bx >> 5) & 3, bx & 31);
      for (int t = bx; t < NB * 4 * 32; t += G) { const int t2 = t + G; const bool hn = t2 < NB * 4 * 32;
          gla_prep_task(A, l, lds, t >> 7, (t >> 5) & 3, t & 31, P, hn, t2 >> 7, (t2 >> 5) & 3, t2 & 31, N);
          P = N; } }
    TMARK(22);
}
__device__ __forceinline__ void ph_gla_scan(LAS unsigned char* lds, int l) { KArgP A = argp(); gla_state_scan(A); }
__device__ __forceinline__ void ph_mix(LAS unsigned char* lds, int l) {
    KArgP A = argp();
    const int bx = obid();
    TMARK(23);
    if (bx < 64) gdn_scan_chain(A, l, lds, bx >> 2, bx & 3);
    TMARK(24);
    unsigned* ctr = (unsigned*)(A->ws + WS_CTL) + 128 + l;
    volatile LAS int* qw = (volatile LAS int*)(lds + LDS_CTL + 2400);
    for (;;) {
        __syncthreads();
        if (otid() == 0) qw[0] = (int)atomicAdd(ctr, 1u);
        __syncthreads();
        const int u = qw[0];
        if (u >= NB * 8 * 8 + NB * 4 * 32) break;
        if (u < NB * 8 * 8) { TMARK(26); const int qb = 7 - (u >> 7), bh = u & 127; fox_unit(A, l, lds, bh >> 3, bh & 7, qb); TMARK(27); }
        else { TMARK(28); const int t = u - NB * 8 * 8; gla_out_task(A, l, lds, t >> 7, (t >> 5) & 3, t & 31); TMARK(29); }
    }
    TMARK(25);
}
#ifndef PROBE_MIX
#define PROBE_MIX 0
#endif
__device__ __forceinline__ void ph_mix_probe(LAS unsigned char* lds, int l) {
    KArgP A = argp();
    const int bx = obid();
    if (PROBE_MIX == 1) {
        unsigned* ctr = (unsigned*)(A->ws + WS_CTL) + 132 + l;
        volatile LAS int* qw = (volatile LAS int*)(lds + LDS_CTL + 2400);
        for (;;) { __syncthreads(); if (otid() == 0) qw[0] = (int)atomicAdd(ctr, 1u); __syncthreads(); const int u = qw[0]; if (u >= NB * 8 * 8) break;
            const int qb = 7 - (u >> 7), bh = u & 127; fox_unit(A, l, lds, bh >> 3, bh & 7, qb, 5152); }
    }
    else if (PROBE_MIX == 3) { if (bx < 64) gdn_scan_chain(A, l, lds, bx >> 2, bx & 3, 5152); }
    else if (PROBE_MIX == 4) { const int G = ogrid(); GdnPre P, N; for (int t = bx; t < NB * 4 * 32; t += G) { gdn_prep_issue(P, A, l, t >> 7, (t >> 5) & 3, t & 31); gdn_prep_task(A, l, lds, t >> 7, (t >> 5) & 3, t & 31, P, false, 0, 0, 0, N, true); } }
}
__device__ __forceinline__ void ph_branch(LAS unsigned char* lds, int l) { PH_COMMON
    pg8::Gemm g{LP, 512, 512};
    BranchSched S{NTOK / 256, (NTOK / 256) * 12, G, bx, (const char*)PJ, (const char*)(wt + WT_P)};
    pg8::EpiStore E{PJ, LP, 1.f};
    pg8::gemm_phase(lds, g, S, E);
}
__device__ __forceinline__ void ph_gate(LAS unsigned char* lds, int l) { PH_COMMON
    pg8::Gemm g{1024, 1024, 1024};
    GateSched S{NTOK / 256, (NTOK / 256) * 4, G, bx, (const char*)XB, (const char*)(wt + WT_WIN + (size_t)LP * 1024 * 2)};
    pg8::EpiGate E{PJ, LP, ap->b_merge + (size_t)l * 3072};
    pg8::gemm_phase(lds, g, S, E);
}
__device__ __forceinline__ void ph_out(LAS unsigned char* lds, int l) { PH_COMMON
    pg8::Gemm g{LP, 1024, 1024};
    RegSched S{NTOK / 256, 4, (NTOK / 256) * 4, G, bx, (const char*)PJ, (const char*)(wt + WT_WOUT3), (size_t)256 * LP * 2, (size_t)256 * 1024 * 2, 0};
    pg8::EpiResid E{XB, Y, 1024};
    pg8::gemm_phase(lds, g, S, E);
}
__device__ __forceinline__ void ph_ln1(LAS unsigned char* lds, int l) { PH_COMMON
    const float* gg = ap->ln1_g + l * 1024; const float* bb = ap->ln1_b + l * 1024;
    for (int row = gw; row < NTOK; row += NGW) { LnRow r; ln_load_bf16(r, Y + (size_t)row * 1024, lane, 1.f); ln_normalize(r, gg, bb, lane); ln_store_bf16(r, XB + (size_t)row * 1024, lane); }
}
__device__ __forceinline__ void ph_q(LAS unsigned char* lds, int l) { PH_COMMON
    bf16* Qb = (bf16*)(ws + WS_PROJ + PJ_Q);
    pg8::Gemm g{1024, 1024, 1024};
    RegSched S{NTOK / 256, 4, (NTOK / 256) * 4, G, bx, (const char*)XB, (const char*)(wt + WT_WQ), (size_t)256 * 1024 * 2, (size_t)256 * 1024 * 2, 0};
    pg8::EpiStore E{Qb, 1024, 0.0625f * LOG2E};
    pg8::gemm_phase(lds, g, S, E);
}
__device__ __forceinline__ void ph_xattn(LAS unsigned char* lds, int l) { PH_COMMON
    bf16* Qb = (bf16*)(ws + WS_PROJ + PJ_Q); bf16* Ob = (bf16*)(ws + WS_PROJ + PJ_O);
    xattn_phase(lds, Qb, KV, Ob, G, bx);
}
__device__ __forceinline__ void ph_wo(LAS unsigned char* lds, int l) { PH_COMMON
    bf16* Ob = (bf16*)(ws + WS_PROJ + PJ_O);
    pg8::Gemm g{1024, 1024, 1024};
    RegSched S{NTOK / 256, 4, (NTOK / 256) * 4, G, bx, (const char*)Ob, (const char*)(wt + WT_WO), (size_t)256 * 1024 * 2, (size_t)256 * 1024 * 2, 0};
    pg8::EpiResid E{XB, Y, 1024};
    pg8::gemm_phase(lds, g, S, E);
}
__device__ __forceinline__ void ph_ln2_router(LAS unsigned char* lds, int l, int cnt_off = 0) { PH_COMMON
    unsigned* ctl = (unsigned*)(ws + WS_CTL);
    int* tokE = (int*)(ws + WS_SMALL + SM_TOKE); float* tokW = (float*)(ws + WS_SMALL + SM_TOKW); int* tokR = (int*)(ws + WS_SMALL + SM_TOKR);
    const int l15 = lane & 15, g = lane >> 4;
    constexpr int SX = 2064;
    LAS unsigned char* XH = lds; LAS unsigned char* XL = lds + 16 * SX;
    LAS float* PART = (LAS float*)(lds + 2 * 16 * SX);
    LAS float* LOG = PART + 8 * 16 * 48;
    unsigned* wcnt = ctl + 16384 + l * 8192 + cnt_off * 64;
    LAS unsigned* lcnt = (LAS unsigned*)(lds + LDS_CTL + 2560);
    const float* gg = ap->ln2_g + l * 1024; const float* bb = ap->ln2_b + l * 1024;
    const float* bgp = ap->moe_b_group + l * 4; const float* bep = ap->moe_b_expert + l * 32;
    bf16x8 bh[3][4], bl[3][4];
    { const bf16* RH = (const bf16*)(wt + WT_RWH); const bf16* RL = (const bf16*)(wt + WT_RWL);
#pragma unroll
      for (int nb = 0; nb < 3; ++nb)
#pragma unroll
          for (int kk = 0; kk < 4; ++kk) { const size_t off = (size_t)(nb * 16 + l15) * 1024 + (4 * wid + kk) * 32 + 8 * g; bh[nb][kk] = *(const bf16x8*)(RH + off); bl[nb][kk] = *(const bf16x8*)(RL + off); } }
    __syncthreads();
    if (tid < 32) lcnt[tid] = 0u;
    u32x4 yp[2][2];
    if (bx < NTOK / 16) {
#pragma unroll
        for (int q = 0; q < 2; ++q)
#pragma unroll
            for (int jj = 0; jj < 2; ++jj) yp[q][jj] = *(const u32x4*)(Y + ((size_t)bx * 16 + wid * 2 + q) * 1024 + 8 * (lane + 64 * jj)); }
    for (int bt = bx; bt < NTOK / 16; bt += G) {
#pragma unroll
        for (int q = 0; q < 2; ++q) { const int rl = wid * 2 + q; const size_t row = (size_t)bt * 16 + rl;
            LnRow r;
#pragma unroll
            for (int jj = 0; jj < 2; ++jj) { const u32x4 t = yp[q][jj];
                r.v[jj * 8 + 0] = bflo(t.x); r.v[jj * 8 + 1] = bfhi(t.x); r.v[jj * 8 + 2] = bflo(t.y); r.v[jj * 8 + 3] = bfhi(t.y);
                r.v[jj * 8 + 4] = bflo(t.z); r.v[jj * 8 + 5] = bfhi(t.z); r.v[jj * 8 + 6] = bflo(t.w); r.v[jj * 8 + 7] = bfhi(t.w); }
            if (bt + G < NTOK / 16) {
#pragma unroll
                for (int jj = 0; jj < 2; ++jj) yp[q][jj] = *(const u32x4*)(Y + ((size_t)(bt + G) * 16 + rl) * 1024 + 8 * (lane + 64 * jj)); }
            ln_normalize(r, gg, bb, lane); ln_store_bf16(r, XB + row * 1024, lane);
#pragma unroll
            for (int jj = 0; jj < 2; ++jj) { unsigned hw[4], lw[4];
#pragma unroll
                for (int e2 = 0; e2 < 4; ++e2) { const float a = r.v[jj * 8 + 2 * e2], c = r.v[jj * 8 + 2 * e2 + 1]; const unsigned ha = f2bf(a), hc = f2bf(c);
                    hw[e2] = ha | (hc << 16); lw[e2] = pk2(a - bf2f((unsigned short)ha), c - bf2f((unsigned short)hc)); }
                *(LAS u32x4*)(XH + rl * SX + (lane + 64 * jj) * 16) = (u32x4){hw[0], hw[1], hw[2], hw[3]};
                *(LAS u32x4*)(XL + rl * SX + (lane + 64 * jj) * 16) = (u32x4){lw[0], lw[1], lw[2], lw[3]}; } }
        __syncthreads();
        {
            f32x4 acc[3];
#pragma unroll
            for (int nb = 0; nb < 3; ++nb) acc[nb] = (f32x4){0.f, 0.f, 0.f, 0.f};
#pragma unroll
            for (int kk = 0; kk < 4; ++kk) { const bf16x8 ah = frag_rm(XH, SX, 0, 4 * wid + kk, l15, g), al = frag_rm(XL, SX, 0, 4 * wid + kk, l15, g);
#pragma unroll
                for (int nb = 0; nb < 3; ++nb) { acc[nb] = MFMA16(ah, bh[nb][kk], acc[nb]); acc[nb] = MFMA16(ah, bl[nb][kk], acc[nb]); acc[nb] = MFMA16(al, bh[nb][kk], acc[nb]); } }
#pragma unroll
            for (int nb = 0; nb < 3; ++nb)
#pragma unroll
                for (int r = 0; r < 4; ++r) PART[(wid * 16 + 4 * g + r) * 48 + nb * 16 + l15] = acc[nb][r];
        }
        __syncthreads();
        for (int p = tid; p < 16 * 48; p += 512) { float s = 0.f;
#pragma unroll
            for (int w = 0; w < 8; ++w) s += PART[w * 16 * 48 + p];
            LOG[p] = s; }
        __syncthreads();
        if (tid < 16) { const size_t row = (size_t)bt * 16 + tid; const LAS float* lg = LOG + tid * 48;
            float gl[4];
#pragma unroll
            for (int c = 0; c < 4; ++c) gl[c] = lg[c] + bgp[c];
            int gsel = 0; float gm = gl[0];
#pragma unroll
            for (int c = 1; c < 4; ++c) if (gl[c] > gm) { gm = gl[c]; gsel = c; }
            float gsum = 0.f;
#pragma unroll
            for (int c = 0; c < 4; ++c) gsum += __expf(gl[c] - gm);
            const float ptop = 1.f / gsum;
            float el[8];
#pragma unroll
            for (int jx = 0; jx < 8; ++jx) el[jx] = lg[4 + gsel * 8 + jx] + bep[gsel * 8 + jx];
            int e0 = 0; float m0 = el[0];
#pragma unroll
            for (int jx = 1; jx < 8; ++jx) if (el[jx] > m0) { m0 = el[jx]; e0 = jx; }
            int e1 = -1; float m1 = -3.0e38f;
#pragma unroll
            for (int jx = 0; jx < 8; ++jx) if (jx != e0 && el[jx] > m1) { m1 = el[jx]; e1 = jx; }
            const float ex = __expf(m1 - m0); const float w0 = ptop / (1.f + ex), w1 = ptop * ex / (1.f + ex);
            const int ge0 = gsel * 8 + e0, ge1 = gsel * 8 + e1;
            const int r0 = (int)__hip_atomic_fetch_add(lcnt + ge0, 1u, __ATOMIC_RELAXED, __HIP_MEMORY_SCOPE_WORKGROUP), r1 = (int)__hip_atomic_fetch_add(lcnt + ge1, 1u, __ATOMIC_RELAXED, __HIP_MEMORY_SCOPE_WORKGROUP);
            tokE[row * 2] = ge0; tokE[row * 2 + 1] = ge1; tokW[row * 2] = w0; tokW[row * 2 + 1] = w1; tokR[row * 2] = r0; tokR[row * 2 + 1] = r1; }
    }
    __syncthreads();
    if (tid < 32) wcnt[bx * 32 + tid] = lcnt[tid];
}
__device__ __forceinline__ void ph_dispatch(LAS unsigned char* lds, int l) { PH_COMMON
    unsigned* ctl = (unsigned*)(ws + WS_CTL);
    int* tokE = (int*)(ws + WS_SMALL + SM_TOKE); int* tokR = (int*)(ws + WS_SMALL + SM_TOKR); int* tokS = (int*)(ws + WS_SMALL + SM_TOKS);
    int* slotTok = (int*)(ws + WS_SMALL + SM_SLOTTOK);
    LAS int* tab = (LAS int*)(lds + LDS_CTL);
    __syncthreads();
    {
        const unsigned* wcnt = ctl + 16384 + l * 8192;
        LAS int* red = (LAS int*)lds;
        const int e = tid & 31, part = tid >> 5; int tot = 0, pre = 0;
        for (int w = part; w < G; w += 16) { const int c = (int)wcnt[w * 32 + e]; tot += c; if (w < bx) pre += c; }
        red[(part * 32 + e) * 2] = tot; red[(part * 32 + e) * 2 + 1] = pre;
        __syncthreads();
        if (tid < 32) { int t2 = 0, p2 = 0; for (int p = 0; p < 16; ++p) { t2 += red[(p * 32 + tid) * 2]; p2 += red[(p * 32 + tid) * 2 + 1]; } tab[360 + tid] = t2; tab[400 + tid] = p2; }
        __syncthreads();
    }
    if (tid == 0) { int ps = 0, nb = 0;
        for (int e = 0; e < 32; ++e) { const int c = tab[360 + e]; const int nbe = (c + 255) >> 8; tab[320 + e] = ps;
            for (int q = 0; q < nbe; ++q) tab[1 + nb + q] = e; nb += nbe; ps += nbe * 256; }
        tab[352] = ps; tab[0] = nb; }
    __syncthreads();
    for (int i = tid; ; i += 512) { const int bt = bx + (i >> 4) * G; if (bt >= NTOK / 16) break; const int row = bt * 16 + (i & 15);
        const int e0 = tokE[row * 2], e1 = tokE[row * 2 + 1]; const int s0 = tab[320 + e0] + tab[400 + e0] + tokR[row * 2], s1 = tab[320 + e1] + tab[400 + e1] + tokR[row * 2 + 1];
        tokS[row * 2] = s0; tokS[row * 2 + 1] = s1; slotTok[s0] = row; slotTok[s1] = row;
    }
    for (int e = 0; e < 32; ++e) { const int c = tab[360 + e], st = tab[320 + e] + c, en = tab[320 + e] + (((c + 255) >> 8) << 8);
        for (int rr = st + bx * 512 + tid; rr < en; rr += G * 512) slotTok[rr] = 0; }
}
__device__ __forceinline__ void ph_moe_gu(LAS unsigned char* lds, int l) { PH_COMMON
    bf16* Hb = (bf16*)(ws + WS_PROJ + PJ_H);
    const int* slotTok = (const int*)(ws + WS_SMALL + SM_SLOTTOK);
    const LAS int* tab = (const LAS int*)(lds + LDS_CTL);
    LAS int* gtab = (LAS int*)(lds + LDS_X);
    __syncthreads();
    { const int nu = tab[0] * 2;
      for (int j = 0; j < 4; ++j) { const int L = j * G + bx; if (L >= nu) break; const int rb = L >> 1; if (tid < 256) gtab[j * 256 + tid] = slotTok[rb * 256 + tid]; } }
    __syncthreads();
    pg8::Gemm g{1024, 1024, 1024};
    MoeSched S{2, G, bx, tab, (const char*)XB, 0, (const char*)(wt + WT_GU), (size_t)512 * 1024 * 2, (size_t)256 * 1024 * 2};
    pg8::EpiSwiglu E{Hb, 256};
    pg8::gemm_phase_gather(lds, g, S, E, (const char*)XB, gtab);
}
__device__ __forceinline__ void ph_moe_dn(LAS unsigned char* lds, int l) { PH_COMMON
    bf16* Hb = (bf16*)(ws + WS_PROJ + PJ_H); bf16* YS = (bf16*)(ws + WS_PROJ + PJ_YS);
    const LAS int* tab = (const LAS int*)(lds + LDS_CTL);
    pg8::Gemm g{256, 256, 256};
    MoeSched S{4, G, bx, tab, (const char*)Hb, (size_t)256 * 256 * 2, (const char*)(wt + WT_DN), (size_t)1024 * 256 * 2, (size_t)256 * 256 * 2};
    pg8::EpiStore E{YS, 1024, 1.f};
    pg8::gemm_phase(lds, g, S, E);
}
__device__ __forceinline__ void ph_ln3(LAS unsigned char* lds, int l) { PH_COMMON
    float* tokW = (float*)(ws + WS_SMALL + SM_TOKW); int* tokS = (int*)(ws + WS_SMALL + SM_TOKS);
    bf16* YS = (bf16*)(ws + WS_PROJ + PJ_YS);
    const float* gg = ap->ln3_g + l * 1024; const float* bb = ap->ln3_b + l * 1024;
    float* out = ap->out;
    for (int row = gw; row < NTOK; row += NGW) {
        LnRow r; ln_load_bf16(r, XB + (size_t)row * 1024, lane, ALPHA);
        ln_add_bf16(r, YS + (size_t)tokS[row * 2] * 1024, lane, tokW[row * 2]); ln_add_bf16(r, YS + (size_t)tokS[row * 2 + 1] * 1024, lane, tokW[row * 2 + 1]);
        ln_normalize(r, gg, bb, lane);
        if (l == DEPTH - 1) ln_store_f32(r, out + (size_t)row * 1024, lane); else ln_store_bf16(r, XB + (size_t)row * 1024, lane);
    }
}

#define GSYNC() grid_barrier(lds)
template <int l> __device__ __forceinline__ void layer_body(LAS unsigned char* lds) {

        TMARK(0);
        if (PH_MASK & 2) { ph_proj(lds, l); ph_kv(lds, l); }
        if (REP_MASK & 2) { GSYNC(); ph_proj(lds, l); ph_kv(lds, l); }
        GSYNC();
        TMARK(1);
        if (PH_MASK & 4) { if (PROBE_MIX == 4) { ph_mix_probe(lds, l); GSYNC(); } ph_gdn_prep(lds, l); GSYNC(); TMARK(2); ph_gla_scan(lds, l); GSYNC(); TMARK(3); if (PROBE_MIX && PROBE_MIX != 4) { ph_mix_probe(lds, l); GSYNC(); } ph_mix(lds, l); }
        GSYNC();
        TMARK(4);
        if (PH_MASK & 8) ph_branch(lds, l);
        if (REP_MASK & 8) { GSYNC(); ph_branch(lds, l); }
        GSYNC();
        TMARK(5);
        if (PH_MASK & 16) ph_gate(lds, l);
        if (REP_MASK & 16) { GSYNC(); ph_gate(lds, l); }
        GSYNC();
        TMARK(6);
        if (PH_MASK & 32) ph_out(lds, l);
        if (REP_MASK & 32) { GSYNC(); ph_out(lds, l); }
        GSYNC();
        TMARK(7);
        if (PH_MASK & 64) ph_ln1(lds, l);
        if (REP_MASK & 64) { GSYNC(); ph_ln1(lds, l); }
        GSYNC();
        TMARK(8);
        if (PH_MASK & 128) ph_q(lds, l);
        if (REP_MASK & 128) { GSYNC(); ph_q(lds, l); }
        GSYNC();
        TMARK(9);
        if (PH_MASK & 256) ph_xattn(lds, l);
        if (REP_MASK & 256) { GSYNC(); ph_xattn(lds, l); }
        GSYNC();
        TMARK(10);
        if (PH_MASK & 512) ph_wo(lds, l);
        if (REP_MASK & 512) { GSYNC(); ph_wo(lds, l); }
        GSYNC();
        TMARK(11);
        if (REP_MASK & 1024) { ph_ln2_router(lds, l, 512); GSYNC(); }
        if (PH_MASK & 1024) ph_ln2_router(lds, l);
        GSYNC();
        TMARK(12);
        if (PH_MASK & 2048) ph_dispatch(lds, l);
        if (REP_MASK & 2048) { GSYNC(); ph_dispatch(lds, l); }
        GSYNC();
        TMARK(13);
        if (PH_MASK & 4096) ph_moe_gu(lds, l);
        if (REP_MASK & 4096) { GSYNC(); ph_moe_gu(lds, l); }
        GSYNC();
        TMARK(14);
        if (PH_MASK & 8192) ph_moe_dn(lds, l);
        if (REP_MASK & 8192) { GSYNC(); ph_moe_dn(lds, l); }
        GSYNC();
        TMARK(15);
        if (PH_MASK & 16384) ph_ln3(lds, l);
        if ((REP_MASK & 16384) && l == DEPTH - 1) { GSYNC(); ph_ln3(lds, l); }
        if (l + 1 < DEPTH) { if (PH_MASK & 1) ph_weights(lds, l + 1); GSYNC(); }
        TMARK(16);
}

__global__ void __launch_bounds__(512, 2) mega_fwd(Args A_unused) {
    extern __shared__ __attribute__((aligned(16))) unsigned char lds_raw[];
    LAS unsigned char* lds = (LAS unsigned char*)lds_raw;
    cg::grid_group grid = cg::this_grid();
    {
        volatile LAS unsigned* st = (volatile LAS unsigned*)(lds + LDS_CTL + 2048);
        if (threadIdx.x < 2) st[threadIdx.x] = 0u;
        if (threadIdx.x == 0) { unsigned* bar = (unsigned*)(argp()->ws + WS_CTL) + CW_BAR; (void)xb_add(&bar[XB_XCNT(xb_xcc_id())], 1u); }
        __syncthreads();
    }
    ph_input(lds);
    if (PH_MASK & 1) ph_weights(lds, 0);
    if (argp()->ws == nullptr) grid.sync();
    GSYNC();
    if (TIMER_A >= 0 || TIMER_B >= 0) { if (otid() < 2) ((volatile LAS unsigned*)(lds + LDS_CTL + 2800))[otid()] = 0u; }
    layer_body<0>(lds);
    layer_body<1>(lds);
    if (TIMER_A >= 0 || TIMER_B >= 0) {
        GSYNC();
        if (obid() == TIMER_WG) { volatile LAS unsigned* tw = (volatile LAS unsigned*)(lds + LDS_CTL + 2800); float* out = argp()->out;
            if (TIMER_A >= 0) { const int nz = (tw[0] / 100u > (unsigned)TIMER_T) ? 16000 : 0; for (int i = otid(); i < nz * 1024; i += 512) out[i] = 0.f; }
            if (TIMER_B >= 0 && otid() == 0) out[(size_t)NTOK * 1024 - 1] = (float)(tw[1] / 100u) * 0.25f; }
    }
}

extern "C" void kernel_launch(void* const* d_in, const int* in_sizes, int n_in, void* d_out, int out_size, void* d_ws, size_t ws_size, hipStream_t stream) {
    static int grid = 0;
    if (grid == 0) {
        if (n_in != 32 || out_size != NTOK * DM || ws_size < WS_END) { fprintf(stderr, "kernel_launch: unexpected shapes (n_in %d out %d ws %zu)\n", n_in, out_size, ws_size); grid = -1; return; }
        int dev = 0, cus = 0, per_cu = 0;
        hipGetDevice(&dev); hipDeviceGetAttribute(&cus, hipDeviceAttributeMultiprocessorCount, dev);
        hipFuncSetAttribute((const void*)mega_fwd, hipFuncAttributeMaxDynamicSharedMemorySize, LDS_BYTES);
        hipOccupancyMaxActiveBlocksPerMultiprocessor(&per_cu, (const void*)mega_fwd, 512, LDS_BYTES);
        (void)hipGetLastError();
        if (per_cu < 1) { fprintf(stderr, "kernel_launch: occupancy query says %d blocks per CU\n", per_cu); grid = -1; return; }
        grid = cus;
        if (grid < 192) { fprintf(stderr, "kernel_launch: too few CUs (%d)\n", grid); grid = -1; return; }
    }
    if (grid < 0) return;
    hipMemsetAsync((char*)d_ws + WS_CTL, 0, 1 * MiB, stream);
    Args a{};
    const float** p = (const float**)&a;
    for (int i = 0; i < 32; ++i) p[i] = (const float*)d_in[i];
    a.out = (float*)d_out; a.ws = (unsigned char*)d_ws;
    void* args[] = {&a};
    hipError_t e = hipLaunchCooperativeKernel((const void*)mega_fwd, dim3(grid), dim3(512), args, LDS_BYTES, stream);
    if (e != hipSuccess) fprintf(stderr, "cooperative launch failed: %s (grid %d)\n", hipGetErrorString(e), grid);
}
```

```cpp
#include <hip/hip_runtime.h>
#include <hip/hip_cooperative_groups.h>
#include <cstdio>
#include <cstdint>
namespace cg = cooperative_groups;

#define LAS __attribute__((address_space(3)))
typedef unsigned short bf16;
typedef short bf16x8 __attribute__((ext_vector_type(8)));
typedef short s16x4 __attribute__((ext_vector_type(4)));
typedef float f32x4 __attribute__((ext_vector_type(4)));
typedef float f32x2 __attribute__((ext_vector_type(2)));
typedef unsigned u32x4 __attribute__((ext_vector_type(4)));
typedef unsigned u32x2 __attribute__((ext_vector_type(2)));

#ifndef PH_MASK
#define PH_MASK 0xFFFFFFFFu
#endif
#ifndef REP_MASK
#define REP_MASK 0u
#endif
constexpr int DM = 1024, NB = 16, SEQ = 2048, NTOK = NB * SEQ, MEMLEN = 256, NMEM = NB * MEMLEN, DEPTH = 2;
constexpr int N_IN = 8224;
constexpr int LP = 5376;
constexpr int C_OA = 0;
constexpr int C_OB = 512;
constexpr int C_OC = 1024;
constexpr int C_GQ = 1536, C_GK = 2048, C_GV = 2560;
constexpr int C_FK = 3072, C_FV = 3584;
constexpr int C_LQ = 4096, C_LK = 4352, C_LV = 4608;
constexpr int C_SM = 5120;
constexpr int C_T = 1536;
constexpr int NWIN = 8448;
constexpr float ALPHA = 1.4142135623730951f;
constexpr float LOG2E = 1.4426950408889634f;
constexpr int MAXSLOT = 73728;
constexpr int MAXBLK = MAXSLOT / 256;

constexpr size_t MiB = 1u << 20;
constexpr size_t WS_CTL = 0;
constexpr size_t WS_WT = 1 * MiB;
constexpr size_t WT_WIN = 0;
constexpr size_t WT_P = WT_WIN + (size_t)NWIN * 1024 * 2;
constexpr size_t WT_WOUT3 = WT_P + 3u * 1024 * 512 * 2;
constexpr size_t WT_WQ = WT_WOUT3 + (size_t)1024 * 3072 * 2;
constexpr size_t WT_WKV = WT_WQ + (size_t)1024 * 1024 * 2;
constexpr size_t WT_WO = WT_WKV + (size_t)2048 * 1024 * 2;
constexpr size_t WT_GU = WT_WO + (size_t)1024 * 1024 * 2;
constexpr size_t WT_DN = WT_GU + (size_t)32 * 512 * 1024 * 2;
constexpr size_t WT_RWH = WT_DN + (size_t)32 * 1024 * 256 * 2;
constexpr size_t WT_RWL = WT_RWH + 48 * 1024 * 2;
constexpr size_t WT_END = WT_RWL + 48 * 1024 * 2;
static_assert(WT_END <= 82 * MiB, "WT");
constexpr size_t WS_XB = 83 * MiB;
constexpr size_t WS_PROJ = 147 * MiB;
constexpr size_t WS_SMALL = 483 * MiB;
constexpr size_t SM_TOKE = 0;
constexpr size_t SM_TOKW = SM_TOKE + (size_t)NTOK * 8;
constexpr size_t SM_TOKR = SM_TOKW + (size_t)NTOK * 8;
constexpr size_t SM_TOKS = SM_TOKR + (size_t)NTOK * 8;
constexpr size_t SM_SLOTTOK = SM_TOKS + (size_t)NTOK * 8;
constexpr size_t WS_KVS = 485 * MiB;
constexpr size_t WS_CDB = 511 * MiB;
constexpr size_t WS_END = 512 * MiB;
constexpr size_t PJ_Q = 0, PJ_O = 64 * MiB;
constexpr size_t PJ_XG = 0, PJ_H = 144 * MiB, PJ_YS = 180 * MiB;
constexpr size_t DO_Y = 0, DO_KV = 88 * MiB, DO_MEMB = 104 * MiB, DO_HALO = 112 * MiB;
constexpr size_t DO_CKG = 118 * MiB;
constexpr size_t DO_KVS = 82 * MiB;
constexpr size_t DO_GP = 0;
constexpr int GP_W = 0, GP_KDT = 16384, GP_ATT = 32768, GP_CD = 40960, GP_STRIDE = 41216;

constexpr int RING_BYTES = 131072;
constexpr int LDS_X = 131072;
constexpr int LDS_CTL = 147456;
constexpr int LDS_BYTES = 151552;

__device__ __forceinline__ int otid() { int t = threadIdx.x; asm volatile("" : "+v"(t)); return t; }
__device__ __forceinline__ int obid() { int t = blockIdx.x; asm volatile("" : "+s"(t)); return t; }
__device__ __forceinline__ int ogrid() { int t = gridDim.x; asm volatile("" : "+s"(t)); return t; }
__device__ __forceinline__ unsigned f2bf(float f) { unsigned u = __builtin_bit_cast(unsigned, f); return (u + 0x7fffu + ((u >> 16) & 1u)) >> 16; }
typedef __bf16 hwbf16x2 __attribute__((ext_vector_type(2)));
__device__ __forceinline__ unsigned pk2(float lo, float hi) { const f32x2 v = {lo, hi}; return __builtin_bit_cast(unsigned, __builtin_convertvector(v, hwbf16x2)); }
__device__ __forceinline__ float bf2f(unsigned short b) { return __builtin_bit_cast(float, (unsigned)b << 16); }
__device__ __forceinline__ float bflo(unsigned w) { return __builtin_bit_cast(float, w << 16); }
__device__ __forceinline__ float bfhi(unsigned w) { return __builtin_bit_cast(float, w & 0xffff0000u); }
template <int M> __device__ __forceinline__ float swz_xor(float v) { return __builtin_bit_cast(float, __builtin_amdgcn_ds_swizzle(__builtin_bit_cast(int, v), 0x1f | (M << 10))); }
__device__ __forceinline__ float half_sum(float v) { const unsigned b = __builtin_bit_cast(unsigned, v); auto r = __builtin_amdgcn_permlane32_swap(b, b, false, false); return __builtin_bit_cast(float, (unsigned)r[0]) + __builtin_bit_cast(float, (unsigned)r[1]); }
__device__ __forceinline__ float wave_sum(float v) {
    v += swz_xor<1>(v); v += swz_xor<2>(v); v += swz_xor<4>(v); v += swz_xor<8>(v); v += swz_xor<16>(v);
    return half_sum(v);
}
__device__ __forceinline__ float sigmoidf_(float x) { return __builtin_amdgcn_rcpf(1.f + __builtin_amdgcn_exp2f(-LOG2E * x)); }
__device__ __forceinline__ float siluf_(float x) { return x * __builtin_amdgcn_rcpf(1.f + __builtin_amdgcn_exp2f(-LOG2E * x)); }
__device__ __forceinline__ float softplusf_(float x) { return fmaxf(x, 0.f) + log1pf(__expf(-fabsf(x))); }
__device__ __forceinline__ float logsigmoidf_(float x) { return fminf(x, 0.f) - log1pf(__expf(-fabsf(x))); }

namespace pg8 {
constexpr int BM = 256, BK = 64, HALF = 128, HTB = HALF * BK * 2, STAGE_BYTES = 8 * HTB;
__host__ __device__ __forceinline__ int lds_byte(int r, int c) { const int st = (r >> 4) * 2 + (c >> 5), rr = r & 15, cc = c & 31, ob = rr * 64 + cc * 2; return st * 1024 + (ob ^ (((ob >> 9) & 1) << 5)); }
__host__ __device__ __forceinline__ void stage_rc(int b, int& R, int& C) { const int st = b / 1024, sb = b % 1024, swz = sb ^ (((sb >> 9) & 1) << 5); R = (st >> 1) * 16 + swz / 64; C = (st & 1) * 32 + (swz % 64) / 2; }
__host__ __device__ __forceinline__ int perm32(int rho) { const int n = rho >> 4, i = rho & 15; return 8 * (i >> 2) + 4 * n + (i & 3); }

struct Unit { const char* a; const char* b; int row0, col0, aux, aux2; };
struct Gemm { int lda, ldb, K; };

template <class Epi, class Sched>
__device__ __forceinline__ void gemm_phase(LAS unsigned char* lds, const Gemm g, const Sched& S, const Epi& E) {
    const int tid = otid(), wid = __builtin_amdgcn_readfirstlane(tid >> 6), lane = tid & 63, wr = wid >> 2, wc = wid & 3, fr = lane & 15, fq = lane >> 4;
    int K = g.K; asm volatile("" : "+s"(K)); const int nt = K / BK;
    unsigned voffA[2], voffB[2];
#pragma unroll
    for (int i = 0; i < 2; ++i) { int R, C; stage_rc(tid * 16 + i * 8192, R, C); const int Rb = Epi::PERM ? ((R & ~31) + perm32(R & 31)) : R;
        voffA[i] = (unsigned)(R * g.lda + C) * 2u; voffB[i] = (unsigned)(Rb * g.ldb + C) * 2u; }
    const size_t kstep = (size_t)(BK * 2);
    const size_t hstepA = (size_t)HALF * g.lda * 2, hstepB = (size_t)HALF * g.ldb * 2;
    const unsigned ldsw = (unsigned)wid * 1024u;
    const int aoff = lds_byte(wr * 64 + fr, fq * 8), boff = lds_byte(wc * 32 + fr, fq * 8);
#define PG8_SA(b, h) (((b) * 2 + (h)) * HTB)
#define PG8_SB(b, h) ((4 + (b) * 2 + (h)) * HTB)
#define PG8_STAGE(bufoff, gbase, voff) do { _Pragma("unroll") for (int _i = 0; _i < 2; ++_i) \
        __builtin_amdgcn_global_load_lds((const unsigned*)((const char*)(gbase) + (voff)[_i]), (LAS unsigned*)(lds + (bufoff) + ldsw + _i * 8192), 16, 0, 0); } while (0)
#define PG8_LDA(dst, b, h) do { _Pragma("unroll") for (int m = 0; m < 4; ++m) _Pragma("unroll") for (int k = 0; k < 2; ++k) dst[m][k] = *(const LAS bf16x8*)(lds + PG8_SA(b, h) + aoff + m * 2048 + k * 1024); } while (0)
#define PG8_LDB(dst, b, h) do { _Pragma("unroll") for (int n = 0; n < 2; ++n) _Pragma("unroll") for (int k = 0; k < 2; ++k) dst[n][k] = *(const LAS bf16x8*)(lds + PG8_SB(b, h) + boff + n * 2048 + k * 1024); } while (0)
#define PG8_MMA(ai, bj, At, Bt) do { __builtin_amdgcn_s_setprio(1); _Pragma("unroll") for (int m = 0; m < 4; ++m) _Pragma("unroll") for (int n = 0; n < 2; ++n) _Pragma("unroll") for (int k = 0; k < 2; ++k) \
        acc[ai][bj][m][n] = __builtin_amdgcn_mfma_f32_16x16x32_bf16(Bt[n][k], At[m][k], acc[ai][bj][m][n], 0, 0, 0); __builtin_amdgcn_s_setprio(0); } while (0)
#define PG8_WAIT_V(n) asm volatile("s_waitcnt vmcnt(" #n ")" ::: "memory")
#define PG8_WAIT_L(n) asm volatile("s_waitcnt lgkmcnt(" #n ")" ::: "memory")
#define PG8_BAR __builtin_amdgcn_s_barrier()
#define PG8_SCHED __builtin_amdgcn_sched_barrier(0)
    Unit cur, nxt; int ui = 0;
    if (!S.next(0, cur)) return;
    f32x4 acc[2][2][4][2];
#pragma unroll
    for (int a = 0; a < 2; ++a)
#pragma unroll
        for (int b = 0; b < 2; ++b)
#pragma unroll
            for (int m = 0; m < 4; ++m)
#pragma unroll
                for (int n = 0; n < 2; ++n) acc[a][b][m][n] = (f32x4){0.f, 0.f, 0.f, 0.f};
    bf16x8 At[4][2], B0[2][2], B1[2][2];
    const char* cA = cur.a; const char* cB = cur.b;
    PG8_STAGE(PG8_SB(0, 0), cB, voffB); PG8_STAGE(PG8_SB(0, 1), cB + hstepB, voffB); PG8_STAGE(PG8_SA(0, 0), cA, voffA); PG8_STAGE(PG8_SA(0, 1), cA + hstepA, voffA);
    if (wr == 1) PG8_BAR;
    PG8_WAIT_V(2); PG8_BAR;
    PG8_STAGE(PG8_SB(1, 0), cB + kstep, voffB); PG8_STAGE(PG8_SA(1, 0), cA + kstep, voffA); PG8_STAGE(PG8_SB(1, 1), cB + hstepB + kstep, voffB);
    PG8_WAIT_V(6); PG8_BAR;
    for (;;) {
        const bool has_next = S.next(ui + 1, nxt);
        const char* nA = has_next ? nxt.a : cA; const char* nB = has_next ? nxt.b : cB;
        for (int t = 0; t < nt; t += 2) {
            const bool last = (t == nt - 2);
            const char* a1 = cA + (size_t)(t + 1) * kstep;
            const char* a2 = last ? nA : cA + (size_t)(t + 2) * kstep; const char* b2 = last ? nB : cB + (size_t)(t + 2) * kstep;
            const char* a3 = a2 + kstep; const char* b3 = b2 + kstep;
            PG8_LDB(B0, 0, 0); PG8_LDB(B1, 0, 1); PG8_SCHED; PG8_LDA(At, 0, 0); PG8_STAGE(PG8_SA(1, 1), a1 + hstepA, voffA);
            PG8_WAIT_V(8); PG8_WAIT_L(0); PG8_BAR; PG8_MMA(0, 0, At, B0); PG8_MMA(0, 1, At, B1); PG8_BAR; PG8_SCHED;
            PG8_LDA(At, 0, 1); PG8_STAGE(PG8_SB(0, 0), b2, voffB); PG8_STAGE(PG8_SB(0, 1), b2 + hstepB, voffB); PG8_STAGE(PG8_SA(0, 0), a2, voffA);
            PG8_WAIT_V(8); PG8_WAIT_L(0); PG8_BAR; PG8_MMA(1, 0, At, B0); PG8_MMA(1, 1, At, B1); PG8_BAR; PG8_SCHED;
            PG8_LDB(B0, 1, 0); PG8_LDB(B1, 1, 1); PG8_SCHED; PG8_LDA(At, 1, 0); PG8_STAGE(PG8_SA(0, 1), a2 + hstepA, voffA);
            PG8_WAIT_V(8); PG8_WAIT_L(0); PG8_BAR; PG8_MMA(0, 0, At, B0); PG8_MMA(0, 1, At, B1); PG8_BAR; PG8_SCHED;
            PG8_LDA(At, 1, 1); PG8_STAGE(PG8_SB(1, 0), b3, voffB); PG8_STAGE(PG8_SB(1, 1), b3 + hstepB, voffB); PG8_STAGE(PG8_SA(1, 0), a3, voffA);
            PG8_WAIT_V(8); PG8_WAIT_L(0); PG8_BAR; PG8_MMA(1, 0, At, B0); PG8_MMA(1, 1, At, B1); PG8_BAR; PG8_SCHED;
        }
        if (wr == 0) PG8_BAR;
        E(acc, cur, wr, wc, fr, fq);
        if (!has_next) break;
#pragma unroll
        for (int a = 0; a < 2; ++a)
#pragma unroll
            for (int b = 0; b < 2; ++b)
#pragma unroll
                for (int m = 0; m < 4; ++m)
#pragma unroll
                    for (int n = 0; n < 2; ++n) acc[a][b][m][n] = (f32x4){0.f, 0.f, 0.f, 0.f};
        cur = nxt; cA = nA; cB = nB; ++ui;
        if (wr == 1) PG8_BAR;
    }
    PG8_WAIT_V(0);
    PG8_BAR;
#undef PG8_SA
#undef PG8_SB
#undef PG8_STAGE
#undef PG8_LDA
#undef PG8_LDB
#undef PG8_MMA
#undef PG8_WAIT_V
#undef PG8_WAIT_L
#undef PG8_BAR
#undef PG8_SCHED
}

template <class Epi, class Sched>
__device__ __forceinline__ void gemm_phase_gather(LAS unsigned char* lds, const Gemm g, const Sched& S, const Epi& E, const char* xbase, const LAS int* gtab) {
    const int tid = otid(), wid = __builtin_amdgcn_readfirstlane(tid >> 6), lane = tid & 63, wr = wid >> 2, wc = wid & 3, fr = lane & 15, fq = lane >> 4;
    int K = g.K; asm volatile("" : "+s"(K)); const int nt = K / BK;
    unsigned voffA[2], voffB[2], cofs[2];
#pragma unroll
    for (int i = 0; i < 2; ++i) { int R, C; stage_rc(tid * 16 + i * 8192, R, C); const int Rb = Epi::PERM ? ((R & ~31) + perm32(R & 31)) : R;
        voffA[i] = (unsigned)R; voffB[i] = (unsigned)(Rb * g.ldb + C) * 2u; cofs[i] = (unsigned)C * 2u; }
    const size_t kstep = (size_t)(BK * 2);
    const size_t hstepA = (size_t)HALF * g.lda * 2, hstepB = (size_t)HALF * g.ldb * 2;
    const unsigned ldsw = (unsigned)wid * 1024u;
    const int aoff = lds_byte(wr * 64 + fr, fq * 8), boff = lds_byte(wc * 32 + fr, fq * 8);
#define PG8_SA(b, h) (((b) * 2 + (h)) * HTB)
#define PG8_SB(b, h) ((4 + (b) * 2 + (h)) * HTB)
#define PG8_STAGE(bufoff, gbase, voff) do { _Pragma("unroll") for (int _i = 0; _i < 2; ++_i) \
        __builtin_amdgcn_global_load_lds((const unsigned*)((const char*)(gbase) + (voff)[_i]), (LAS unsigned*)(lds + (bufoff) + ldsw + _i * 8192), 16, 0, 0); } while (0)
#define PG8_LDA(dst, b, h) do { _Pragma("unroll") for (int m = 0; m < 4; ++m) _Pragma("unroll") for (int k = 0; k < 2; ++k) dst[m][k] = *(const LAS bf16x8*)(lds + PG8_SA(b, h) + aoff + m * 2048 + k * 1024); } while (0)
#define PG8_LDB(dst, b, h) do { _Pragma("unroll") for (int n = 0; n < 2; ++n) _Pragma("unroll") for (int k = 0; k < 2; ++k) dst[n][k] = *(const LAS bf16x8*)(lds + PG8_SB(b, h) + boff + n * 2048 + k * 1024); } while (0)
#define PG8_MMA(ai, bj, At, Bt) do { __builtin_amdgcn_s_setprio(1); _Pragma("unroll") for (int m = 0; m < 4; ++m) _Pragma("unroll") for (int n = 0; n < 2; ++n) _Pragma("unroll") for (int k = 0; k < 2; ++k) \
        acc[ai][bj][m][n] = __builtin_amdgcn_mfma_f32_16x16x32_bf16(Bt[n][k], At[m][k], acc[ai][bj][m][n], 0, 0, 0); __builtin_amdgcn_s_setprio(0); } while (0)
#define PG8_WAIT_V(n) asm volatile("s_waitcnt vmcnt(" #n ")" ::: "memory")
#define PG8_WAIT_L(n) asm volatile("s_waitcnt lgkmcnt(" #n ")" ::: "memory")
#define PG8_BAR __builtin_amdgcn_s_barrier()
#define PG8_SCHED __builtin_amdgcn_sched_barrier(0)
    Unit cur, nxt; int ui = 0;
    if (!S.next(0, cur)) return;
    f32x4 acc[2][2][4][2];
#pragma unroll
    for (int a = 0; a < 2; ++a)
#pragma unroll
        for (int b = 0; b < 2; ++b)
#pragma unroll
            for (int m = 0; m < 4; ++m)
#pragma unroll
                for (int n = 0; n < 2; ++n) acc[a][b][m][n] = (f32x4){0.f, 0.f, 0.f, 0.f};
    bf16x8 At[4][2], B0[2][2], B1[2][2];
    const char* cB = cur.b;
    unsigned gC[2][2], gN[2][2];
#define PG8_GOFF(dst, un) do { _Pragma("unroll") for (int h_ = 0; h_ < 2; ++h_) _Pragma("unroll") for (int i_ = 0; i_ < 2; ++i_) dst[h_][i_] = (unsigned)gtab[(un).aux2 * 256 + h_ * 128 + (int)voffA[i_]] * (unsigned)(g.lda * 2) + cofs[i_]; } while (0)
    PG8_GOFF(gC, cur);
    PG8_STAGE(PG8_SB(0, 0), cB, voffB); PG8_STAGE(PG8_SB(0, 1), cB + hstepB, voffB); PG8_STAGE(PG8_SA(0, 0), xbase, gC[0]); PG8_STAGE(PG8_SA(0, 1), xbase, gC[1]);
    if (wr == 1) PG8_BAR;
    PG8_WAIT_V(2); PG8_BAR;
    PG8_STAGE(PG8_SB(1, 0), cB + kstep, voffB); PG8_STAGE(PG8_SA(1, 0), xbase + kstep, gC[0]); PG8_STAGE(PG8_SB(1, 1), cB + hstepB + kstep, voffB);
    PG8_WAIT_V(6); PG8_BAR;
    for (;;) {
        const bool has_next = S.next(ui + 1, nxt);
        const char* nB = has_next ? nxt.b : cB;
        if (has_next) { PG8_GOFF(gN, nxt); } else { gN[0][0] = gC[0][0]; gN[0][1] = gC[0][1]; gN[1][0] = gC[1][0]; gN[1][1] = gC[1][1]; }
        for (int t = 0; t < nt; t += 2) {
            const bool last = (t == nt - 2);
            const char* a1 = xbase + (size_t)(t + 1) * kstep;
            const char* a2 = last ? xbase : xbase + (size_t)(t + 2) * kstep; const char* b2 = last ? nB : cB + (size_t)(t + 2) * kstep;
            const char* a3 = a2 + kstep; const char* b3 = b2 + kstep;
            unsigned g2[2][2];
            g2[0][0] = last ? gN[0][0] : gC[0][0]; g2[0][1] = last ? gN[0][1] : gC[0][1]; g2[1][0] = last ? gN[1][0] : gC[1][0]; g2[1][1] = last ? gN[1][1] : gC[1][1];
            PG8_LDB(B0, 0, 0); PG8_LDB(B1, 0, 1); PG8_SCHED; PG8_LDA(At, 0, 0); PG8_STAGE(PG8_SA(1, 1), a1, gC[1]);
            PG8_WAIT_V(8); PG8_WAIT_L(0); PG8_BAR; PG8_MMA(0, 0, At, B0); PG8_MMA(0, 1, At, B1); PG8_BAR; PG8_SCHED;
            PG8_LDA(At, 0, 1); PG8_STAGE(PG8_SB(0, 0), b2, voffB); PG8_STAGE(PG8_SB(0, 1), b2 + hstepB, voffB); PG8_STAGE(PG8_SA(0, 0), a2, g2[0]);
            PG8_WAIT_V(8); PG8_WAIT_L(0); PG8_BAR; PG8_MMA(1, 0, At, B0); PG8_MMA(1, 1, At, B1); PG8_BAR; PG8_SCHED;
            PG8_LDB(B0, 1, 0); PG8_LDB(B1, 1, 1); PG8_SCHED; PG8_LDA(At, 1, 0); PG8_STAGE(PG8_SA(0, 1), a2, g2[1]);
            PG8_WAIT_V(8); PG8_WAIT_L(0); PG8_BAR; PG8_MMA(0, 0, At, B0); PG8_MMA(0, 1, At, B1); PG8_BAR; PG8_SCHED;
            PG8_LDA(At, 1, 1); PG8_STAGE(PG8_SB(1, 0), b3, voffB); PG8_STAGE(PG8_SB(1, 1), b3 + hstepB, voffB); PG8_STAGE(PG8_SA(1, 0), a3, g2[0]);
            PG8_WAIT_V(8); PG8_WAIT_L(0); PG8_BAR; PG8_MMA(1, 0, At, B0); PG8_MMA(1, 1, At, B1); PG8_BAR; PG8_SCHED;
        }
        if (wr == 0) PG8_BAR;
        E(acc, cur, wr, wc, fr, fq);
        if (!has_next) break;
#pragma unroll
        for (int a = 0; a < 2; ++a)
#pragma unroll
            for (int b = 0; b < 2; ++b)
#pragma unroll
                for (int m = 0; m < 4; ++m)
#pragma unroll
                    for (int n = 0; n < 2; ++n) acc[a][b][m][n] = (f32x4){0.f, 0.f, 0.f, 0.f};
        cur = nxt; cB = nB; ++ui;
        gC[0][0] = gN[0][0]; gC[0][1] = gN[0][1]; gC[1][0] = gN[1][0]; gC[1][1] = gN[1][1];
        if (wr == 1) PG8_BAR;
    }
    PG8_WAIT_V(0);
    PG8_BAR;
#undef PG8_GOFF
#undef PG8_SA
#undef PG8_SB
#undef PG8_STAGE
#undef PG8_LDA
#undef PG8_LDB
#undef PG8_MMA
#undef PG8_WAIT_V
#undef PG8_WAIT_L
#undef PG8_BAR
#undef PG8_SCHED
}

#define EPI_LOOP_BEGIN \
    _Pragma("unroll") for (int ai = 0; ai < 2; ++ai) _Pragma("unroll") for (int m = 0; m < 4; ++m) { const int row = u.row0 + ai * HALF + wr * 64 + m * 16 + fr; \
    _Pragma("unroll") for (int bj = 0; bj < 2; ++bj) { const int col = u.col0 + bj * HALF + wc * 32 + 8 * fq; const f32x4 v0 = acc[ai][bj][m][0], v1 = acc[ai][bj][m][1];
#define EPI_LOOP_END } }

struct EpiStore {
    static constexpr bool PERM = true;
    bf16* O; int ldc; float scale;
    __device__ __forceinline__ void operator()(const f32x4 (&acc)[2][2][4][2], const Unit& u, int wr, int wc, int fr, int fq) const {
        EPI_LOOP_BEGIN
            u32x4 w; w.x = pk2(v0[0] * scale, v0[1] * scale); w.y = pk2(v0[2] * scale, v0[3] * scale); w.z = pk2(v1[0] * scale, v1[1] * scale); w.w = pk2(v1[2] * scale, v1[3] * scale);
            *(u32x4*)(O + (size_t)row * ldc + col) = w;
        EPI_LOOP_END
    }
};
struct EpiProj {
    static constexpr bool PERM = true;
    bf16* O; int ldc; bf16* halo;
    __device__ __forceinline__ void operator()(const f32x4 (&acc)[2][2][4][2], const Unit& u, int wr, int wc, int fr, int fq) const {
        const bool hz = (u.col0 >= C_GQ) && (u.col0 < C_GQ + 1536);
        const float sc = (u.col0 >= C_OB && u.col0 < C_OB + 512) ? 0.125f * LOG2E : 1.f;
        EPI_LOOP_BEGIN
            u32x4 w; w.x = pk2(v0[0] * sc, v0[1] * sc); w.y = pk2(v0[2] * sc, v0[3] * sc); w.z = pk2(v1[0] * sc, v1[1] * sc); w.w = pk2(v1[2] * sc, v1[3] * sc);
            *(u32x4*)(O + (size_t)row * ldc + col) = w;
            if (hz && m == 3 && fr >= 13) *(u32x4*)(halo + ((size_t)(row >> 6) * 3 + (fr - 13)) * 1536 + (col - C_GQ)) = w;
        EPI_LOOP_END
    }
};
struct EpiGate {
    static constexpr bool PERM = true;
    bf16* PJ; int ldc; const float* bias;
    __device__ __forceinline__ void operator()(const f32x4 (&acc)[2][2][4][2], const Unit& u, int wr, int wc, int fr, int fq) const {
        const bool first = u.aux < 1024;
        f32x4 bv[2][2];
#pragma unroll
        for (int bj = 0; bj < 2; ++bj) { const int gc = u.aux + bj * HALF + wc * 32 + 8 * fq; bv[bj][0] = *(const f32x4*)(bias + gc); bv[bj][1] = *(const f32x4*)(bias + gc + 4); }
#pragma unroll
        for (int ai = 0; ai < 2; ++ai) {
            u32x4 tv[4][2], mv[4][2];
#pragma unroll
            for (int m = 0; m < 4; ++m)
#pragma unroll
                for (int bj = 0; bj < 2; ++bj) { const size_t ro = (size_t)(u.row0 + ai * HALF + wr * 64 + m * 16 + fr) * ldc; const int cc = bj * HALF + wc * 32 + 8 * fq;
                    tv[m][bj] = *(const u32x4*)(PJ + ro + C_T + u.aux + cc);
                    if (!first) mv[m][bj] = *(const u32x4*)(PJ + ro + u.col0 + cc); else mv[m][bj] = (u32x4){0u, 0u, 0u, 0u}; }
#pragma unroll
            for (int m = 0; m < 4; ++m)
#pragma unroll
                for (int bj = 0; bj < 2; ++bj) { const size_t ro = (size_t)(u.row0 + ai * HALF + wr * 64 + m * 16 + fr) * ldc; const int cc = bj * HALF + wc * 32 + 8 * fq;
                    const f32x4 v0 = acc[ai][bj][m][0], v1 = acc[ai][bj][m][1]; const f32x4 b0 = bv[bj][0], b1 = bv[bj][1]; const u32x4 t = tv[m][bj], mm = mv[m][bj];
                    u32x4 w;
                    w.x = pk2(bflo(mm.x) + sigmoidf_(v0[0] + b0[0]) * bflo(t.x), bfhi(mm.x) + sigmoidf_(v0[1] + b0[1]) * bfhi(t.x));
                    w.y = pk2(bflo(mm.y) + sigmoidf_(v0[2] + b0[2]) * bflo(t.y), bfhi(mm.y) + sigmoidf_(v0[3] + b0[3]) * bfhi(t.y));
                    w.z = pk2(bflo(mm.z) + sigmoidf_(v1[0] + b1[0]) * bflo(t.z), bfhi(mm.z) + sigmoidf_(v1[1] + b1[1]) * bfhi(t.z));
                    w.w = pk2(bflo(mm.w) + sigmoidf_(v1[2] + b1[2]) * bflo(t.w), bfhi(mm.w) + sigmoidf_(v1[3] + b1[3]) * bfhi(t.w));
                    *(u32x4*)(PJ + ro + u.col0 + cc) = w; }
        }
    }
};
struct EpiResid {
    static constexpr bool PERM = true;
    const bf16* X; bf16* Y; int ldc;
    __device__ __forceinline__ void operator()(const f32x4 (&acc)[2][2][4][2], const Unit& u, int wr, int wc, int fr, int fq) const {
#pragma unroll
        for (int ai = 0; ai < 2; ++ai) {
            u32x4 xv[4][2];
#pragma unroll
            for (int m = 0; m < 4; ++m)
#pragma unroll
                for (int bj = 0; bj < 2; ++bj) xv[m][bj] = *(const u32x4*)(X + (size_t)(u.row0 + ai * HALF + wr * 64 + m * 16 + fr) * ldc + u.col0 + bj * HALF + wc * 32 + 8 * fq);
#pragma unroll
            for (int m = 0; m < 4; ++m)
#pragma unroll
                for (int bj = 0; bj < 2; ++bj) { const f32x4 v0 = acc[ai][bj][m][0], v1 = acc[ai][bj][m][1]; const u32x4 t = xv[m][bj];
                    u32x4 w;
                    w.x = pk2(ALPHA * bflo(t.x) + v0[0], ALPHA * bfhi(t.x) + v0[1]); w.y = pk2(ALPHA * bflo(t.y) + v0[2], ALPHA * bfhi(t.y) + v0[3]);
                    w.z = pk2(ALPHA * bflo(t.z) + v1[0], ALPHA * bfhi(t.z) + v1[1]); w.w = pk2(ALPHA * bflo(t.w) + v1[2], ALPHA * bfhi(t.w) + v1[3]);
                    *(u32x4*)(Y + (size_t)(u.row0 + ai * HALF + wr * 64 + m * 16 + fr) * ldc + u.col0 + bj * HALF + wc * 32 + 8 * fq) = w; }
        }
    }
};
struct EpiSwiglu {
    static constexpr bool PERM = true;
    bf16* H; int ldc;
    __device__ __forceinline__ void operator()(const f32x4 (&acc)[2][2][4][2], const Unit& u, int wr, int wc, int fr, int fq) const {
        EPI_LOOP_BEGIN
            u32x2 w; w.x = pk2(siluf_(v0[0]) * v1[0], siluf_(v0[1]) * v1[1]); w.y = pk2(siluf_(v0[2]) * v1[2], siluf_(v0[3]) * v1[3]);
            *(u32x2*)(H + (size_t)row * ldc + (col >> 1)) = w;
        EPI_LOOP_END
    }
};
}

struct Args {
    const float* x; const float* mem; const float* w_in; const float* gdn_conv_w; const float* gdn_a_log; const float* gdn_dt_bias; const float* gdn_norm_w; const float* fox_f_bias;
    const float* gla_w_gate2; const float* gla_b_gate; const float* gla_norm_w; const float* p_gdn; const float* p_fox; const float* p_gla; const float* b_merge; const float* w_out;
    const float* ln1_g; const float* ln1_b; const float* xa_wq; const float* xa_wkv; const float* xa_wo; const float* ln2_g; const float* ln2_b;
    const float* moe_w_group; const float* moe_b_group; const float* moe_w_expert; const float* moe_b_expert; const float* moe_w_gate; const float* moe_w_up; const float* moe_w_down;
    const float* ln3_g; const float* ln3_b;
    float* out; unsigned char* ws;
};

typedef const __attribute__((address_space(4))) Args* KArgP;

__device__ __forceinline__ int tr_srccol(int mode, int c0, int n) {
    if (mode != 3) return c0 + n;
    return n < 4 ? 1536 + n : n < 8 ? 1540 + (n - 4) : n < 16 ? 3592 + (n - 8) : 5136 + (n - 16);
}
__device__ __forceinline__ int tr_dstrow(int mode, int r0, int nn) {
    if (mode == 1) return r0 + 8 * (nn >> 2) + (nn & 3);
    if (mode == 2) return r0 + 8 * (nn >> 2) + 4 + (nn & 3);
    return r0 + nn;
}
__device__ __forceinline__ void tr_item(const float* W, int ldw, int c0, int ncols, bf16* T, int ldt, int r0, int koff, int mode, LAS float* scr, int item, int lane) {
    const int nblk = ncols / 32, kb = item / nblk, nb = item % nblk, k0 = 64 * kb, n0 = 32 * nb;
    if (mode != 3) {
        const int sc4 = c0 + n0 + 4 * (lane & 7);
#pragma unroll
        for (int i = 0; i < 8; ++i) { const int kk = 8 * i + (lane >> 3); const f32x4 v = *(const f32x4*)(W + (size_t)(k0 + kk) * ldw + sc4);
            LAS float* d = scr + kk * 33 + 4 * (lane & 7); d[0] = v[0]; d[1] = v[1]; d[2] = v[2]; d[3] = v[3]; }
    } else {
        const int sc = tr_srccol(mode, c0, n0 + (lane & 31));
#pragma unroll 8
        for (int i = 0; i < 32; ++i) { const int kk = 2 * i + (lane >> 5); scr[kk * 33 + (lane & 31)] = W[(size_t)(k0 + kk) * ldw + sc]; }
    }
    asm volatile("s_waitcnt lgkmcnt(0)" ::: "memory");
    const int c = lane & 7;
#pragma unroll
    for (int j = 0; j < 4; ++j) { const int n = (lane >> 3) + 8 * j; const LAS float* s = scr + (8 * c) * 33 + n;
        u32x4 o; o.x = pk2(s[0 * 33], s[1 * 33]); o.y = pk2(s[2 * 33], s[3 * 33]); o.z = pk2(s[4 * 33], s[5 * 33]); o.w = pk2(s[6 * 33], s[7 * 33]);
        *(u32x4*)(T + (size_t)tr_dstrow(mode, r0, n0 + n) * ldt + koff + k0 + 8 * c) = o; }
    asm volatile("s_waitcnt lgkmcnt(0)" ::: "memory");
}
__device__ __forceinline__ void tr_job(const float* W, int ldw, int K, int c0, int ncols, size_t wstride, bf16* T, int ldt, int r0, int koff, int mode, size_t tstride, int nmat,
                                       LAS float* scr, int lane, int gw, int NGW, int& run) {
    const int per = (K / 64) * (ncols / 32), n = per * nmat;
    int first = gw - (run % NGW); if (first < 0) first += NGW;
    for (int it = first; it < n; it += NGW) { const int e = it / per, li = it % per; tr_item(W + (size_t)e * wstride, ldw, c0, ncols, T + (size_t)e * tstride, ldt, r0, koff, mode, scr, li, lane); }
    run += n;
}
__device__ __forceinline__ void phase_convert_weights(KArgP A, int l, LAS unsigned char* lds) {
    const int tid = otid(), lane = tid & 63, wid = tid >> 6;
    LAS float* scr = (LAS float*)(lds + wid * 16384);
    const int gw = obid() * 8 + wid, NGW = ogrid() * 8; int run = 0;
    unsigned char* wt = A->ws + WS_WT;
    bf16* WIN = (bf16*)(wt + WT_WIN);
    const float* w_in = A->w_in + (size_t)l * 1024 * N_IN;
    tr_job(w_in, N_IN, 1024, 1544, 512, 0, WIN, 1024, C_OA, 0, 0, 0, 1, scr, lane, gw, NGW, run);
    tr_job(w_in, N_IN, 1024, 2056, 512, 0, WIN, 1024, C_OB, 0, 0, 0, 1, scr, lane, gw, NGW, run);
    tr_job(w_in, N_IN, 1024, 4624, 512, 0, WIN, 1024, C_OC, 0, 0, 0, 1, scr, lane, gw, NGW, run);
    tr_job(w_in, N_IN, 1024, 0, 1536, 0, WIN, 1024, C_GQ, 0, 0, 0, 1, scr, lane, gw, NGW, run);
    tr_job(w_in, N_IN, 1024, 2568, 1024, 0, WIN, 1024, C_FK, 0, 0, 0, 1, scr, lane, gw, NGW, run);
    tr_job(w_in, N_IN, 1024, 3600, 1024, 0, WIN, 1024, C_LQ, 0, 0, 0, 1, scr, lane, gw, NGW, run);
    tr_job(w_in, N_IN, 1024, 0, 32, 0, WIN, 1024, C_SM, 0, 3, 0, 1, scr, lane, gw, NGW, run);
    tr_job(w_in, N_IN, 1024, 5152, 3072, 0, WIN, 1024, LP, 0, 0, 0, 1, scr, lane, gw, NGW, run);
    { u32x4 z = {0u, 0u, 0u, 0u}; asm volatile("" : "+v"(z)); u32x4* p = (u32x4*)(WIN + (size_t)5152 * 1024); const int n16 = 224 * 1024 * 2 / 16;
      for (int i = obid() * 512 + tid; i < n16; i += ogrid() * 512) p[i] = z; }
    bf16* PT = (bf16*)(wt + WT_P);
    tr_job(A->p_gdn + (size_t)l * 512 * 1024, 1024, 512, 0, 1024, 0, PT, 512, 0, 0, 0, 0, 1, scr, lane, gw, NGW, run);
    tr_job(A->p_fox + (size_t)l * 512 * 1024, 1024, 512, 0, 1024, 0, PT + 1024 * 512, 512, 0, 0, 0, 0, 1, scr, lane, gw, NGW, run);
    tr_job(A->p_gla + (size_t)l * 512 * 1024, 1024, 512, 0, 1024, 0, PT + 2 * 1024 * 512, 512, 0, 0, 0, 0, 1, scr, lane, gw, NGW, run);
    bf16* WO3 = (bf16*)(wt + WT_WOUT3);
    tr_job(A->w_out + (size_t)l * 1024 * 1024, 1024, 1024, 0, 1024, 0, WO3, 1024, 0, 0, 0, 0, 1, scr, lane, gw, NGW, run);
    tr_job(A->xa_wq + (size_t)l * 1024 * 1024, 1024, 1024, 0, 1024, 0, (bf16*)(wt + WT_WQ), 1024, 0, 0, 0, 0, 1, scr, lane, gw, NGW, run);
    tr_job(A->xa_wkv + (size_t)l * 1024 * 2048, 2048, 1024, 0, 2048, 0, (bf16*)(wt + WT_WKV), 1024, 0, 0, 0, 0, 1, scr, lane, gw, NGW, run);
    tr_job(A->xa_wo + (size_t)l * 1024 * 1024, 1024, 1024, 0, 1024, 0, (bf16*)(wt + WT_WO), 1024, 0, 0, 0, 0, 1, scr, lane, gw, NGW, run);
    tr_job(A->moe_w_gate + (size_t)l * 32 * 1024 * 256, 256, 1024, 0, 256, (size_t)1024 * 256, (bf16*)(wt + WT_GU), 1024, 0, 0, 1, (size_t)512 * 1024, 32, scr, lane, gw, NGW, run);
    tr_job(A->moe_w_up + (size_t)l * 32 * 1024 * 256, 256, 1024, 0, 256, (size_t)1024 * 256, (bf16*)(wt + WT_GU), 1024, 0, 0, 2, (size_t)512 * 1024, 32, scr, lane, gw, NGW, run);
    tr_job(A->moe_w_down + (size_t)l * 32 * 256 * 1024, 1024, 256, 0, 1024, (size_t)256 * 1024, (bf16*)(wt + WT_DN), 256, 0, 0, 0, (size_t)1024 * 256, 32, scr, lane, gw, NGW, run);
    {
        const float* wg = A->moe_w_group + (size_t)l * 1024 * 4; const float* we = A->moe_w_expert + (size_t)l * 1024 * 32;
        bf16* RH = (bf16*)(wt + WT_RWH); bf16* RL = (bf16*)(wt + WT_RWL);
        for (int i = obid() * 512 + tid; i < 48 * 1024; i += ogrid() * 512) { const int n = i >> 10, k = i & 1023;
            const float w = n < 4 ? wg[k * 4 + n] : n < 36 ? we[k * 32 + (n - 4)] : 0.f; const unsigned h = f2bf(w); RH[i] = (bf16)h; RL[i] = (bf16)f2bf(w - bf2f((unsigned short)h)); }
    }
}
__device__ __forceinline__ void convert_rows(const float* src, bf16* dst, size_t n) {
    const size_t n8 = n / 8;
    for (size_t i = (size_t)obid() * 512 + otid(); i < n8; i += (size_t)ogrid() * 512) {
        const f32x4 a = *(const f32x4*)(src + i * 8), b = *(const f32x4*)(src + i * 8 + 4);
        u32x4 w; w.x = pk2(a[0], a[1]); w.y = pk2(a[2], a[3]); w.z = pk2(b[0], b[1]); w.w = pk2(b[2], b[3]);
        *(u32x4*)(dst + i * 8) = w;
    }
}

struct RegSched {
    int nM, nN, nwg, G, c; const char* A; const char* B; size_t astride, bstride; int col_base;
    __device__ __forceinline__ bool next(int i, pg8::Unit& u) const {
        const long L = (long)i * G + c; if (L >= nwg) return false;
        int wgid = (int)L; { const int q = nwg / 8, r = nwg % 8, xcd = wgid % 8, off = wgid / 8; wgid = (xcd < r ? xcd * (q + 1) : r * (q + 1) + (xcd - r) * q) + off; }
        const int nig = 8 * nN, gid = wgid / nig, fm = gid * 8, gsz = (nM - fm) < 8 ? (nM - fm) : 8;
        const int pm = fm + ((wgid % nig) % gsz), pn = (wgid % nig) / gsz;
        u.a = A + (size_t)pm * astride; u.b = B + (size_t)pn * bstride; u.row0 = pm * 256; u.col0 = col_base + pn * 256; u.aux = pn * 256; return true;
    }
};
struct BranchSched {
    int nM, nwg, G, c; const char* A; const char* B;
    __device__ __forceinline__ bool next(int i, pg8::Unit& u) const {
        const long L = (long)i * G + c; if (L >= nwg) return false;
        int wgid = (int)L; { const int q = nwg / 8, r = nwg % 8, xcd = wgid % 8, off = wgid / 8; wgid = (xcd < r ? xcd * (q + 1) : r * (q + 1) + (xcd - r) * q) + off; }
        const int nN = 12, nig = 8 * nN, gid = wgid / nig, fm = gid * 8, gsz = (nM - fm) < 8 ? (nM - fm) : 8;
        const int pm = fm + ((wgid % nig) % gsz), pn = (wgid % nig) / gsz, br = pn >> 2;
        u.a = A + ((size_t)pm * 256 * LP + br * 512) * 2; u.b = B + ((size_t)br * 1024 * 512 + (size_t)(pn & 3) * 256 * 512) * 2; u.row0 = pm * 256; u.col0 = C_T + pn * 256; u.aux = 0; return true;
    }
};
struct GateSched {
    int nM, nwg, G, c; const char* A; const char* B;
    __device__ __forceinline__ bool next(int i, pg8::Unit& u) const {
        const int rnd = i / 3, br = i - 3 * rnd;
        const long L = (long)rnd * G + c; if (L >= nwg) return false;
        int wgid = (int)L; { const int q = nwg / 8, r = nwg % 8, xcd = wgid % 8, off = wgid / 8; wgid = (xcd < r ? xcd * (q + 1) : r * (q + 1) + (xcd - r) * q) + off; }
        const int nN = 4, nig = 8 * nN, gid = wgid / nig, fm = gid * 8, gsz = (nM - fm) < 8 ? (nM - fm) : 8;
        const int pm = fm + ((wgid % nig) % gsz), pn = (wgid % nig) / gsz;
        u.a = A + (size_t)pm * 256 * 1024 * 2; u.b = B + ((size_t)br * 1024 + (size_t)pn * 256) * 1024 * 2; u.row0 = pm * 256; u.col0 = pn * 256; u.aux = br * 1024 + pn * 256; return true;
    }
};
struct MoeSched {
    int nct, G, c; const LAS int* tab;
    const char* A; size_t astride; const char* B; size_t bexp, bct;
    __device__ __forceinline__ bool next(int i, pg8::Unit& u) const {
        const long L = (long)i * G + c; const int nblk = tab[0]; if (L >= (long)nblk * nct) return false;
        const int rb = (int)(L / nct), ct = (int)(L % nct), e = tab[1 + rb];
        u.a = A + (size_t)rb * astride; u.b = B + (size_t)e * bexp + (size_t)ct * bct; u.row0 = rb * 256; u.col0 = ct * 256; u.aux = e; u.aux2 = i; return true;
    }
};

__device__ __forceinline__ bf16x8 frag_rm(const LAS unsigned char* base, int stride, int blk, int ks, int l15, int g) { return *(const LAS bf16x8*)(base + (blk * 16 + l15) * stride + (ks * 32 + 8 * g) * 2); }
__device__ __forceinline__ bf16x8 frag_tr(const LAS unsigned char* base, int stride, int ks, int nb, int g, int q4, int p4) {
    const s16x4 lo = __builtin_amdgcn_ds_read_tr16_b64_v4i16((LAS s16x4*)(base + (32 * ks + 8 * g + q4) * stride + (16 * nb + 4 * p4) * 2));
    const s16x4 hi = __builtin_amdgcn_ds_read_tr16_b64_v4i16((LAS s16x4*)(base + (32 * ks + 8 * g + 4 + q4) * stride + (16 * nb + 4 * p4) * 2));
    return (bf16x8){lo[0], lo[1], lo[2], lo[3], hi[0], hi[1], hi[2], hi[3]};
}
#define MFMA16(a, b, c) __builtin_amdgcn_mfma_f32_16x16x32_bf16((a), (b), (c), 0, 0, 0)

#ifndef TIMER_A
#define TIMER_A (-1)
#endif
#ifndef TIMER_B
#define TIMER_B (-1)
#endif
#ifndef TIMER_T
#define TIMER_T 0
#endif
#ifndef TIMER_WG
#define TIMER_WG 0
#endif
#define TMARK(id) do { if (TIMER_A >= 0 || TIMER_B >= 0) { const unsigned long long t_ = __builtin_amdgcn_s_memrealtime(); volatile LAS unsigned* tw_ = (volatile LAS unsigned*)(lds + LDS_CTL + 2800); \
    if (otid() == 0) { if ((id) == TIMER_A) tw_[0] -= (unsigned)t_; if ((id) == TIMER_A + 1) tw_[0] += (unsigned)t_; if ((id) == TIMER_B) tw_[1] -= (unsigned)t_; if ((id) == TIMER_B + 1) tw_[1] += (unsigned)t_; } } } while (0)
__device__ __forceinline__ void xattn_phase(LAS unsigned char* lds, const bf16* Qb, const bf16* KV, bf16* Ob, int G, int bx) {
    const int tid = otid(), lane = tid & 63, wid = tid >> 6, l15 = lane & 15, g = lane >> 4, q4 = l15 >> 2, p4 = lane & 3;
    constexpr int D = 256, KST = (D + 8) * 2, NU = NB * 4 * 16;
    LAS unsigned char* KS = lds; LAS unsigned char* VS = lds + 64 * KST; LAS unsigned char* PS = lds + 2 * 64 * KST + wid * 2304;
    LAS unsigned char* OS = lds + 2 * 64 * KST + 8 * 2304 + wid * 4352;
    const int nun = (NU - bx + G - 1) / G, NT = nun * 4;
    u32x4 kreg[4], vreg[4];
#define XA_ISSUE(tt_) do { const int u_ = bx + ((tt_) >> 2) * G, t_ = (tt_) & 3, b_ = u_ >> 6, h_ = (u_ >> 4) & 3; \
        _Pragma("unroll") for (int j_ = 0; j_ < 4; ++j_) { const int c_ = tid + 512 * j_, row_ = c_ >> 5, ch_ = c_ & 31; \
            const bf16* kp_ = KV + (size_t)(b_ * MEMLEN + t_ * 64 + row_) * 2048 + h_ * 256 + ch_ * 8; kreg[j_] = *(const u32x4*)kp_; vreg[j_] = *(const u32x4*)(kp_ + 1024); } } while (0)
    if (NT > 0) XA_ISSUE(0);
    bf16x8 qf[8]; f32x4 o[16]; float mrow[4], lrow[4];
    for (int tt = 0; tt < NT; ++tt) {
        TMARK(55);
        const int u = bx + (tt >> 2) * G, t = tt & 3, b = u >> 6, h = (u >> 4) & 3, qb = u & 15;
        const size_t rowq = (size_t)b * SEQ + qb * 128;
        if (t == 0) {
            if (tt == 0) { const bf16* qrow = Qb + (rowq + wid * 16 + l15) * 1024 + h * 256 + 8 * g;
#pragma unroll
                for (int ks = 0; ks < 8; ++ks) qf[ks] = *(const bf16x8*)(qrow + ks * 32); }
#pragma unroll
            for (int i = 0; i < 16; ++i) o[i] = (f32x4){0.f, 0.f, 0.f, 0.f};
#pragma unroll
            for (int r = 0; r < 4; ++r) { mrow[r] = -1e30f; lrow[r] = 0.f; }
        }
        TMARK(50);
        __syncthreads();
#pragma unroll
        for (int j = 0; j < 4; ++j) { const int c = tid + 512 * j, row = c >> 5, ch = c & 31; *(LAS u32x4*)(KS + row * KST + ch * 16) = kreg[j]; *(LAS u32x4*)(VS + row * KST + ch * 16) = vreg[j]; }
        __syncthreads();
        if (tt + 1 < NT) XA_ISSUE(tt + 1);
        TMARK(51);
        f32x4 s[4];
#pragma unroll
        for (int nb = 0; nb < 4; ++nb) { s[nb] = (f32x4){0.f, 0.f, 0.f, 0.f};
#pragma unroll
            for (int ks = 0; ks < 8; ++ks) s[nb] = MFMA16(qf[ks], *(const LAS bf16x8*)(KS + (nb * 16 + l15) * KST + (ks * 32 + 8 * g) * 2), s[nb]); }
        if (t == 3 && tt + 1 < NT) {
            asm volatile("" : "+v"(s[0]), "+v"(s[1]), "+v"(s[2]), "+v"(s[3]));
            const int u2 = u + G, b2 = u2 >> 6, h2 = (u2 >> 4) & 3, qb2 = u2 & 15;
            const bf16* qrow = Qb + ((size_t)b2 * SEQ + qb2 * 128 + wid * 16 + l15) * 1024 + h2 * 256 + 8 * g;
#pragma unroll
            for (int ks = 0; ks < 8; ++ks) qf[ks] = *(const bf16x8*)(qrow + ks * 32); }
        TMARK(52);
        float mx[4], al[4];
#pragma unroll
        for (int r = 0; r < 4; ++r) mx[r] = fmaxf(fmaxf(s[0][r], s[1][r]), fmaxf(s[2][r], s[3][r]));
#pragma unroll
        for (int r = 0; r < 4; ++r) mx[r] = fmaxf(mx[r], swz_xor<1>(mx[r]));
#pragma unroll
        for (int r = 0; r < 4; ++r) mx[r] = fmaxf(mx[r], swz_xor<2>(mx[r]));
#pragma unroll
        for (int r = 0; r < 4; ++r) mx[r] = fmaxf(mx[r], swz_xor<4>(mx[r]));
#pragma unroll
        for (int r = 0; r < 4; ++r) mx[r] = fmaxf(mx[r], swz_xor<8>(mx[r]));
        bool moved = false;
#pragma unroll
        for (int r = 0; r < 4; ++r) { const float mn = fmaxf(mrow[r], mx[r]); al[r] = __builtin_amdgcn_exp2f(mrow[r] - mn); moved |= (mn != mrow[r]); mrow[r] = mn; lrow[r] *= al[r]; }
        if (__any(moved)) {
#pragma unroll
            for (int i = 0; i < 16; ++i)
#pragma unroll
                for (int r = 0; r < 4; ++r) o[i][r] *= al[r]; }
#pragma unroll
        for (int r = 0; r < 4; ++r) { float ps = 0.f;
#pragma unroll
            for (int nb = 0; nb < 4; ++nb) { const float p = __builtin_amdgcn_exp2f(s[nb][r] - mrow[r]); ps += p; *(LAS bf16*)(PS + ((4 * g + r) * 72 + nb * 16 + l15) * 2) = (bf16)f2bf(p); }
            lrow[r] += ps; }
        TMARK(53);
        bf16x8 pf[2];
#pragma unroll
        for (int ks = 0; ks < 2; ++ks) pf[ks] = *(const LAS bf16x8*)(PS + (l15 * 72 + ks * 32 + 8 * g) * 2);
#pragma unroll
        for (int nb = 0; nb < 16; ++nb)
#pragma unroll
            for (int ks = 0; ks < 2; ++ks) o[nb] = MFMA16(pf[ks], frag_tr(VS, KST, ks, nb, g, q4, p4), o[nb]);
        TMARK(54);
        if (t == 3) {
            float inv[4];
#pragma unroll
            for (int r = 0; r < 4; ++r) { float l = lrow[r]; l += swz_xor<1>(l); l += swz_xor<2>(l); l += swz_xor<4>(l); l += swz_xor<8>(l); inv[r] = __builtin_amdgcn_rcpf(l); }
#pragma unroll
            for (int hf = 0; hf < 2; ++hf) {
#pragma unroll
                for (int nb = 0; nb < 8; ++nb)
#pragma unroll
                    for (int r = 0; r < 4; ++r) *(LAS bf16*)(OS + ((4 * g + r) * 136 + nb * 16 + l15) * 2) = (bf16)f2bf(o[hf * 8 + nb][r] * inv[r]);
#pragma unroll
                for (int j = 0; j < 4; ++j) { const int c = lane + 64 * j, row = c >> 4, ch = c & 15;
                    *(u32x4*)(Ob + (rowq + wid * 16 + row) * 1024 + h * 256 + hf * 128 + ch * 8) = *(const LAS u32x4*)(OS + row * 272 + ch * 16); }
            }
        }
    }
#undef XA_ISSUE
}

namespace fox_body {
using bf16=unsigned short;
using bf16x8=__attribute__((ext_vector_type(8)))short;
using s16x4=__attribute__((ext_vector_type(4)))short;
using f32x16=__attribute__((ext_vector_type(16)))float;
using u32x4=__attribute__((ext_vector_type(4)))unsigned;
constexpr int BATCH=16,NHEAD=8,SEQ=2048,D=64,DM=5376;
constexpr int NW=8,QBLK=32,QB=QBLK*NW,KVBLK=64,NQB=SEQ/QB;
constexpr int ATTN_PITCH=DM, ATTN_UNIT_ROWS=QB;
__device__ __forceinline__ int crow(int r,int hi){return (r&3)+8*(r>>2)+4*hi;}
#define SBAR() __builtin_amdgcn_sched_barrier(0)
__device__ __forceinline__ void cmask(f32x16&p0,f32x16&p1,int jb,int qrel,int hi){
  const float NEG=-INFINITY; int kb=64*jb+4*hi;
  #pragma unroll
  for(int r=0;r<16;++r){int kv=kb+(r&3)+8*(r>>2); if(kv>qrel)p0[r]=NEG; if(kv+32>qrel)p1[r]=NEG;}
}

constexpr int NSLOT=3, SLOTB=8192;
constexpr int LDS_K=0, LDS_V=NSLOT*SLOTB, LDS_WS=2*NSLOT*SLOTB, LDS_OST=LDS_WS+NW*64*4, LDS_BYTES=LDS_OST+NW*4096;
constexpr float C2=0.125f*1.4426950408889634f;
__device__ __forceinline__ void glds16(const void*gsrc,unsigned lds_dst){unsigned keep;
  asm volatile("s_mov_b32 %0, m0\n\ts_mov_b32 m0, %2\n\ts_nop 0\n\tglobal_load_lds_dwordx4 %1, off\n\ts_mov_b32 m0, %0":"=&s"(keep):"v"(gsrc),"s"(lds_dst):"memory");}
__device__ __forceinline__ float max3f(float a,float b,float c){float r;asm("v_max3_f32 %0, %1, %2, %3":"=v"(r):"v"(a),"v"(b),"v"(c));return r;}
__device__ __forceinline__ float max2f(float a,float b){float r;asm("v_max_f32_e32 %0, %1, %2":"=v"(r):"v"(a),"v"(b));return r;}
__device__ __forceinline__ float fadd_s(float a,float b){float r;asm("v_add_f32_e32 %0, %1, %2":"=v"(r):"v"(a),"v"(b));return r;}
__device__ __forceinline__ float fsub_s(float a,float b){float r;asm("v_sub_f32_e32 %0, %1, %2":"=v"(r):"v"(a),"v"(b));return r;}
typedef float f32x2_t __attribute__((ext_vector_type(2))); typedef __bf16 bf16x2_t __attribute__((ext_vector_type(2)));
__device__ __forceinline__ unsigned cvtpk_s(float lo,float hi){f32x2_t v={lo,hi};bf16x2_t b=__builtin_convertvector(v,bf16x2_t);return __builtin_bit_cast(unsigned,b);}
#define WAIT_BAR(N) asm volatile("s_waitcnt vmcnt(" #N ") lgkmcnt(0)\n\ts_barrier":::"memory")

__device__ __forceinline__ void qkt(f32x16&p0,f32x16&p1,const char*Kslot,const bf16x8*qr,const f32x16&n0,const f32x16&n1,int r32,int hi){
  const char*kb=Kslot+hi*1024+r32*16;
  #pragma unroll
  for(int d0=0;d0<4;++d0){
    const bf16x8 b0=*reinterpret_cast<const bf16x8*>(kb+d0*2048);
    const bf16x8 b1=*reinterpret_cast<const bf16x8*>(kb+d0*2048+512);
    if(d0==0){p0=__builtin_amdgcn_mfma_f32_32x32x16_bf16(b0,qr[0],n0,0,0,0);p1=__builtin_amdgcn_mfma_f32_32x32x16_bf16(b1,qr[0],n1,0,0,0);}
    else{p0=__builtin_amdgcn_mfma_f32_32x32x16_bf16(b0,qr[d0],p0,0,0,0);p1=__builtin_amdgcn_mfma_f32_32x32x16_bf16(b1,qr[d0],p1,0,0,0);}}
}
typedef __attribute__((address_space(3))) const char* lds_cptr;
typedef short v4i16_t __attribute__((ext_vector_type(4)));
__device__ __forceinline__ void kload8(bf16x8*kf,lds_cptr kp){
  kf[0]=*(const __attribute__((address_space(3))) bf16x8*)(kp);      kf[1]=*(const __attribute__((address_space(3))) bf16x8*)(kp+512);
  kf[2]=*(const __attribute__((address_space(3))) bf16x8*)(kp+2048); kf[3]=*(const __attribute__((address_space(3))) bf16x8*)(kp+2560);
  kf[4]=*(const __attribute__((address_space(3))) bf16x8*)(kp+4096); kf[5]=*(const __attribute__((address_space(3))) bf16x8*)(kp+4608);
  kf[6]=*(const __attribute__((address_space(3))) bf16x8*)(kp+6144); kf[7]=*(const __attribute__((address_space(3))) bf16x8*)(kp+6656);
}
__device__ __forceinline__ void kload2(bf16x8*kf,lds_cptr kp,int j){ kf[2*j]=*(const __attribute__((address_space(3))) bf16x8*)(kp+j*2048); kf[2*j+1]=*(const __attribute__((address_space(3))) bf16x8*)(kp+j*2048+512); }
__device__ __forceinline__ s16x4 vtr(lds_cptr p){ return __builtin_bit_cast(s16x4,__builtin_amdgcn_ds_read_tr16_b64_v4i16((__attribute__((address_space(3))) v4i16_t*)p)); }
__device__ __forceinline__ float rowmax(const f32x16&p0,const f32x16&p1){
  float a=max3f(p0[0],p0[1],p1[0]),b=max3f(p0[2],p0[3],p1[1]);a=max3f(a,p1[2],p1[3]);
  #pragma unroll
  for(int r=4;r<16;r+=4){a=max3f(a,p0[r],p0[r+1]);b=max3f(b,p0[r+2],p0[r+3]);a=max3f(a,p1[r],p1[r+1]);b=max3f(b,p1[r+2],p1[r+3]);}
  const float m=max2f(a,b);
  auto rr=__builtin_amdgcn_permlane32_swap(__float_as_uint(m),__float_as_uint(m),false,false);
  return max2f(__uint_as_float(rr[0]),__uint_as_float(rr[1]));
}
__device__ __forceinline__ void pv(f32x16*o,int vb,bf16x8 pa0,bf16x8 pa1,bf16x8 pa2,bf16x8 pa3){
  #pragma unroll
  for(int d0=0;d0<2;++d0){s16x4 lo[4],hi[4];
    #pragma unroll
    for(int ks=0;ks<4;++ks){
      asm volatile("ds_read_b64_tr_b16 %0,%1 offset:%c2":"=&v"(lo[ks]):"v"(vb),"i"(d0*4096+ks*1024):"memory");
      asm volatile("ds_read_b64_tr_b16 %0,%1 offset:%c2":"=&v"(hi[ks]):"v"(vb),"i"(d0*4096+ks*1024+512):"memory");}
    asm volatile("s_waitcnt lgkmcnt(0)":::"memory");SBAR();
    #define PK(k) (bf16x8){lo[k][0],lo[k][1],lo[k][2],lo[k][3],hi[k][0],hi[k][1],hi[k][2],hi[k][3]}
    o[d0]=__builtin_amdgcn_mfma_f32_32x32x16_bf16(pa0,PK(0),o[d0],0,0,0);
    o[d0]=__builtin_amdgcn_mfma_f32_32x32x16_bf16(pa1,PK(1),o[d0],0,0,0);
    o[d0]=__builtin_amdgcn_mfma_f32_32x32x16_bf16(pa2,PK(2),o[d0],0,0,0);
    o[d0]=__builtin_amdgcn_mfma_f32_32x32x16_bf16(pa3,PK(3),o[d0],0,0,0);
    #undef PK
  }
}

#ifndef ATTN_STORE16
#define ATTN_STORE16(p,v) (*(u32x4*)(p)=(v))
#endif
template<int THRL> __device__ __forceinline__ void attn_unit(int b,int h,int qb,const bf16*Q,const bf16*__restrict__ K,const bf16*__restrict__ V,bf16*O,char*shm,const __attribute__((address_space(3))) float*CKL){
  const int tid=otid(),lane=tid&63,r32=lane&31,hi=lane>>5; const int wid=__builtin_amdgcn_readfirstlane(tid>>6);
  const long rowbase=(long)b*SEQ; const int q0=qb*QB;
  const bf16*Qw=Q+(rowbase+q0+wid*QBLK)*DM;
  const bf16*Kh=K+rowbase*DM,*Vh=V+rowbase*DM;
  const unsigned lds0=(unsigned)(uintptr_t)shm;
  float*wsf=(float*)(shm+LDS_WS)+wid*64;
  const bf16*ksrc=Kh+(long)lane*DM+wid*8;
  const bf16*vsrc=Vh+(long)(16*(wid&3)+(lane>>2))*DM+(wid>>2)*32+(lane&3)*8;
  const unsigned kdst=lds0+LDS_K+wid*1024, vdst=lds0+LDS_V+wid*1024;
  #define DMA_K(t,slot) glds16(ksrc+(long)(t)*KVBLK*DM,(unsigned)__builtin_amdgcn_readfirstlane(kdst+(slot)))
  #define DMA_V(t,slot) glds16(vsrc+(long)(t)*KVBLK*DM,(unsigned)__builtin_amdgcn_readfirstlane(vdst+(slot)))
  const int vb0=(int)(lds0+LDS_V)+((lane>>4)&1)*32+(lane&3)*8+(4*hi+((lane&15)>>2))*64;
  const char*Kbase=shm+LDS_K; bf16x8 kf[8];
  const lds_cptr shm3=(lds_cptr)shm; const lds_cptr kp0=shm3+LDS_K+hi*1024+r32*16; const lds_cptr vp0=shm3+LDS_V+((lane>>4)&1)*32+(lane&3)*8+(4*hi+((lane&15)>>2))*64;
  const int NT=(q0+QB)/KVBLK;
  DMA_K(0,0);DMA_V(0,0);DMA_K(1,SLOTB);
  bf16x8 qr[4];
  #pragma unroll
  for(int d0=0;d0<4;++d0)qr[d0]=*reinterpret_cast<const bf16x8*>(&Qw[(long)r32*DM+d0*16+hi*8]);
  float mhat=0.f,l_reg=0.f;f32x16 o[2];o[0]=f32x16{};o[1]=f32x16{};f32x16 negm=f32x16{};asm volatile("":"+v"(negm));
  const int qrel=wid*QBLK+r32;
  #define KBIAS(N0,N1,t) do{ const __attribute__((address_space(3))) float*cb_=CKL+64*(t)+4*hi; \
    _Pragma("unroll") for(int q_=0;q_<4;++q_){ const f32x4 a_=*(const __attribute__((address_space(3))) f32x4*)(cb_+8*q_), b_=*(const __attribute__((address_space(3))) f32x4*)(cb_+32+8*q_); \
      _Pragma("unroll") for(int e_=0;e_<4;++e_){ N0[4*q_+e_]=negm[4*q_+e_]-a_[e_]; N1[4*q_+e_]=negm[4*q_+e_]-b_[e_]; } } }while(0)
  #define CMASK(P0,P1,t) do{int jb_=(t)-(NT-4); if(jb_>=0)cmask(P0,P1,jb_,qrel,hi);}while(0)
  bool resc=false;
  #define START(P0,P1) do{ const float rm=rowmax(P0,P1); resc=false; \
    { const float dl=rm; mhat=fadd_s(mhat,dl); \
      _Pragma("unroll") for(int r=0;r<16;++r){P0[r]=fsub_s(P0[r],dl);P1[r]=fsub_s(P1[r],dl);} \
      _Pragma("unroll") for(int r=0;r<16;++r)negm[r]=-mhat; asm volatile("":"+v"(negm)); } \
    _Pragma("unroll") for(int r=0;r<16;++r)P0[r]=__builtin_amdgcn_exp2f(P0[r]); }while(0)
  #define RESC() do{ if(resc){ asm volatile("s_waitcnt lgkmcnt(0)":::"memory"); \
      _Pragma("unroll") for(int d_=0;d_<2;++d_) _Pragma("unroll") for(int r=0;r<16;++r)o[d_][r]*=wsf[crow(r,hi)]; } }while(0)
  f32x16 pA0,pA1,pB0,pB1;
  int sl_prev=0,sl_cur=0,sl_next=SLOTB;
  #define ROT() do{sl_prev=sl_cur;sl_cur=sl_next;sl_next=(sl_next==(NSLOT-1)*SLOTB)?0:sl_next+SLOTB;}while(0)
  DMA_K(2,2*SLOTB);
  WAIT_BAR(3);
  { f32x16 n0_,n1_; KBIAS(n0_,n1_,0); qkt(pA0,pA1,Kbase,qr,n0_,n1_,r32,hi); } asm volatile("s_nop 15\n\ts_nop 7":"+v"(pA0),"+v"(pA1));CMASK(pA0,pA1,0);
  START(pA0,pA1);
  _Pragma("unroll") for(int r=0;r<16;++r)pA1[r]=__builtin_amdgcn_exp2f(pA1[r]);
  WAIT_BAR(0);
  DMA_K(3,0);DMA_V(1,SLOTB);
  ROT();
  kload8(kf,kp0+sl_cur);
  WAIT_BAR(2);
  s16x4 vlo[8],vhi[8]; u32x4 pw0,pw1,pw2,pw3;
  #define PKW(P,B) cvtpk_s(P[B],P[B+1])
  #define PAF(k) __builtin_bit_cast(bf16x8,pw##k)
  #define VFR(i) (bf16x8){vlo[i][0],vlo[i][1],vlo[i][2],vlo[i][3],vhi[i][0],vhi[i][1],vhi[i][2],vhi[i][3]}
  #define PIN(x) asm volatile("":"+v"(x))
  #define MX3(a,b,c) __builtin_fmaxf(__builtin_fmaxf((a),(b)),(c))
  #define GAPA(MF,A0,A1,A2,A3,W0,W1,PW) do{ MF; sacc+=A0; sacc+=A1; sacc+=A2; sacc+=A3; PIN(sacc); W0; W1; PIN(PW); SBAR(); }while(0)
  #define EX(v) __builtin_amdgcn_exp2f(v)
  #define GAPB(MF,X,B) do{ MF; X[B]=EX(X[B]); X[B+1]=EX(X[B+1]); X[B+2]=EX(X[B+2]); X[B+3]=EX(X[B+3]); PIN(X); SBAR(); }while(0)
  #define VRD(i) do{ vlo[i]=vtr(vp_+(((i)>>2)*4096+((i)&3)*1024)); vhi[i]=vtr(vp_+(((i)>>2)*4096+((i)&3)*1024+512)); }while(0)
  #define KRD(G,j) do{ if(G){ kload2(kf,kp0+sl_next,j); SBAR(); } }while(0)
  #define STEP(C0,C1,P0,P1,t,GK,GV,GL) do{ SBAR(); \
    KBIAS(C0,C1,t); SBAR(); \
    const lds_cptr vp_=vp0+sl_prev; \
    VRD(0); SBAR(); float sacc=(P0[0]+P0[1]); \
    GAPA(C0=__builtin_amdgcn_mfma_f32_32x32x16_bf16(kf[0],qr[0],C0,0,0,0), P0[2],P0[3],P0[4],P0[5],     pw0[0]=PKW(P0,0), pw0[1]=PKW(P0,2), pw0); \
    VRD(4); SBAR(); GAPA(C1=__builtin_amdgcn_mfma_f32_32x32x16_bf16(kf[1],qr[0],C1,0,0,0), P0[6],P0[7],P0[8],P0[9],     pw0[2]=PKW(P0,4), pw0[3]=PKW(P0,6), pw0); \
    VRD(1); SBAR(); GAPA(C0=__builtin_amdgcn_mfma_f32_32x32x16_bf16(kf[2],qr[1],C0,0,0,0),   P0[10],P0[11],P0[12],P0[13], pw1[0]=PKW(P0,8), pw1[1]=PKW(P0,10), pw1); \
    VRD(5); SBAR(); GAPA(C1=__builtin_amdgcn_mfma_f32_32x32x16_bf16(kf[3],qr[1],C1,0,0,0),   P0[14],P0[15],P1[0],P1[1],   pw1[2]=PKW(P0,12),pw1[3]=PKW(P0,14), pw1); \
    VRD(2); SBAR(); GAPA(C0=__builtin_amdgcn_mfma_f32_32x32x16_bf16(kf[4],qr[2],C0,0,0,0),   P1[2],P1[3],P1[4],P1[5],     pw2[0]=PKW(P1,0), pw2[1]=PKW(P1,2), pw2); \
    VRD(6); SBAR(); GAPA(C1=__builtin_amdgcn_mfma_f32_32x32x16_bf16(kf[5],qr[2],C1,0,0,0),   P1[6],P1[7],P1[8],P1[9],     pw2[2]=PKW(P1,4), pw2[3]=PKW(P1,6), pw2); \
    VRD(3); SBAR(); GAPA(C0=__builtin_amdgcn_mfma_f32_32x32x16_bf16(kf[6],qr[3],C0,0,0,0),   P1[10],P1[11],P1[12],P1[13], pw3[0]=PKW(P1,8), pw3[1]=PKW(P1,10), pw3); \
    VRD(7); SBAR(); GAPA(C1=__builtin_amdgcn_mfma_f32_32x32x16_bf16(kf[7],qr[3],C1,0,0,0),   P1[14],P1[15],0.f,0.f,       pw3[2]=PKW(P1,12),pw3[3]=PKW(P1,14), pw3); \
    l_reg+=sacc; \
    if(GK){DMA_K((t)+3,sl_cur);} if(GV){DMA_V((t)+1,sl_next);} \
    CMASK(C0,C1,t); \
    { float a=MX3(C0[0],C0[1],C1[0]),b=MX3(C0[2],C0[3],C1[1]); a=MX3(a,C1[2],C1[3]); \
      _Pragma("unroll") for(int r=4;r<16;r+=4){a=MX3(a,C0[r],C0[r+1]);b=MX3(b,C0[r+2],C0[r+3]);a=MX3(a,C1[r],C1[r+1]);b=MX3(b,C1[r+2],C1[r+3]);} \
      float rm=__builtin_fmaxf(a,b); { auto rr=__builtin_amdgcn_permlane32_swap(__float_as_uint(rm),__float_as_uint(rm),false,false); rm=__builtin_fmaxf(__uint_as_float(rr[0]),__uint_as_float(rr[1])); } \
      resc=false; \
      if(__builtin_expect(__any(rm>(float)THRL),0)){ const float dl=__builtin_fmaxf(rm,0.f); mhat+=dl; \
        _Pragma("unroll") for(int r=0;r<16;++r){C0[r]-=dl;C1[r]-=dl;} \
        _Pragma("unroll") for(int r=0;r<16;++r)negm[r]=-mhat; asm volatile("":"+v"(negm)); \
        const float f=__builtin_amdgcn_exp2f(-dl); l_reg*=f; if(hi==0)wsf[r32]=f; resc=true; } } \
    SBAR(); \
    GAPB(o[0]=__builtin_amdgcn_mfma_f32_32x32x16_bf16(PAF(0),VFR(0),o[0],0,0,0), C0,0); \
    GAPB(o[1]=__builtin_amdgcn_mfma_f32_32x32x16_bf16(PAF(0),VFR(4),o[1],0,0,0), C0,4); \
    KRD(GL,0); GAPB(o[0]=__builtin_amdgcn_mfma_f32_32x32x16_bf16(PAF(1),VFR(1),o[0],0,0,0), C0,8); \
    KRD(GL,1); GAPB(o[1]=__builtin_amdgcn_mfma_f32_32x32x16_bf16(PAF(1),VFR(5),o[1],0,0,0), C0,12); \
    KRD(GL,2); GAPB(o[0]=__builtin_amdgcn_mfma_f32_32x32x16_bf16(PAF(2),VFR(2),o[0],0,0,0), C1,0); \
    KRD(GL,3); GAPB(o[1]=__builtin_amdgcn_mfma_f32_32x32x16_bf16(PAF(2),VFR(6),o[1],0,0,0), C1,4); \
    GAPB(o[0]=__builtin_amdgcn_mfma_f32_32x32x16_bf16(PAF(3),VFR(3),o[0],0,0,0), C1,8); \
    GAPB(o[1]=__builtin_amdgcn_mfma_f32_32x32x16_bf16(PAF(3),VFR(7),o[1],0,0,0), C1,12); \
    }while(0)
  int t=1;
  #undef CMASK
  #define CMASK(P0,P1,t) do{}while(0)
  for(;t+5<NT;t+=2){
    STEP(pB0,pB1,pA0,pA1,t,true,true,true);     WAIT_BAR(2); RESC(); ROT();
    STEP(pA0,pA1,pB0,pB1,t+1,true,true,true);   WAIT_BAR(2); RESC(); ROT();
  }
  #undef CMASK
  #define CMASK(P0,P1,t) do{int jb_=(t)-(NT-4); if(jb_>=0)cmask(P0,P1,jb_,qrel,hi);}while(0)
  #define ENDW(tt) do{ if((tt)+3<NT){WAIT_BAR(2);} else if((tt)+2<NT){WAIT_BAR(1);} else {WAIT_BAR(0);} }while(0)
  for(;t+1<NT;t+=2){
    STEP(pB0,pB1,pA0,pA1,t,(t+3<NT),(t+1<NT),(t+1<NT));       ENDW(t);   RESC(); ROT();
    STEP(pA0,pA1,pB0,pB1,t+1,(t+4<NT),(t+2<NT),(t+2<NT));     ENDW(t+1); RESC(); ROT();
  }
  STEP(pB0,pB1,pA0,pA1,NT-1,false,false,false); RESC();
  { float sacc=pB0[0]+pB0[1]; _Pragma("unroll") for(int r=2;r<16;++r)sacc+=pB0[r]; _Pragma("unroll") for(int r=0;r<16;++r)sacc+=pB1[r]; l_reg+=sacc;
    pw0=(u32x4){PKW(pB0,0),PKW(pB0,2),PKW(pB0,4),PKW(pB0,6)};pw1=(u32x4){PKW(pB0,8),PKW(pB0,10),PKW(pB0,12),PKW(pB0,14)};pw2=(u32x4){PKW(pB1,0),PKW(pB1,2),PKW(pB1,4),PKW(pB1,6)};pw3=(u32x4){PKW(pB1,8),PKW(pB1,10),PKW(pB1,12),PKW(pB1,14)};
    SBAR(); pv(o,vb0+sl_cur,PAF(0),PAF(1),PAF(2),PAF(3)); }
  #undef PKW
  #undef PAF
  #undef VFR
  #undef PIN
  #undef MX3
  #undef GAPA
  #undef GAPB
  #undef EX
  #undef VRD
  #undef KRD
  #undef STEP
  #undef ENDW
  {auto rr=__builtin_amdgcn_permlane32_swap(__float_as_uint(l_reg),__float_as_uint(l_reg),false,false);l_reg=__uint_as_float(rr[0])+__uint_as_float(rr[1]);}
  if(hi==0)wsf[32+r32]=l_reg;asm volatile("s_waitcnt lgkmcnt(0)":::"memory");
  float rli[16];
  #pragma unroll
  for(int r=0;r<16;++r)rli[r]=__builtin_amdgcn_rcpf(wsf[32+crow(r,hi)]);
  bf16*Ow=O+(rowbase+q0+wid*QBLK)*DM;
  { bf16*stg=(bf16*)(shm+LDS_OST)+wid*2048;
    #pragma unroll
    for(int r=0;r<16;++r){const int orow=crow(r,hi);
      #pragma unroll
      for(int d0=0;d0<2;++d0)stg[orow*64+d0*32+r32]=(bf16)f2bf(o[d0][r]*rli[r]);}
    asm volatile("s_waitcnt lgkmcnt(0)":::"memory");
    #pragma unroll
    for(int i=0;i<4;++i){const int row=i*8+(lane>>3),ch=lane&7; const u32x4 v=*(const u32x4*)(stg+row*64+ch*8); ATTN_STORE16(Ow+(long)row*DM+ch*8,v);} }
  asm volatile("s_waitcnt lgkmcnt(0)\n\ts_barrier":::"memory");
  #undef KBIAS
  #undef DMA_K
  #undef DMA_V
  #undef CMASK
  #undef START
  #undef RESC
  #undef ROT
}
constexpr int ATTN_LDS_BYTES=LDS_BYTES;
#undef SBAR
#undef WAIT_BAR
}

__device__ __forceinline__ void fox_ck_task(KArgP A, int l, LAS unsigned char* lds, int b, int h) {
    const bf16* PJ = (const bf16*)(A->ws + WS_PROJ);
    float* CKG = (float*)((unsigned char*)A->out + DO_CKG) + (size_t)(b * 8 + h) * SEQ;
    const int tid = otid(), lane = tid & 63, wid = tid >> 6;
    LAS float* WT = (LAS float*)lds;
    const float fb = A->fox_f_bias[l * 8 + h];
    float v[4]; float run = 0.f;
#pragma unroll
    for (int i = 0; i < 4; ++i) v[i] = bf2f(PJ[(size_t)(b * SEQ + tid * 4 + i) * LP + C_SM + 8 + h]);
#pragma unroll
    for (int i = 0; i < 4; ++i) { run += LOG2E * logsigmoidf_(v[i] + fb); v[i] = run; }
    float inc = run;
#pragma unroll
    for (int o = 1; o < 64; o <<= 1) { const float y = __builtin_bit_cast(float, __builtin_amdgcn_ds_bpermute(((lane - o) & 63) << 2, __builtin_bit_cast(int, inc))); if (lane >= o) inc += y; }
    __syncthreads();
    if (lane == 63) WT[wid] = inc;
    __syncthreads();
    float base = inc - run;
    for (int w = 0; w < wid; ++w) base += WT[w];
    *(f32x4*)(CKG + tid * 4) = (f32x4){base + v[0], base + v[1], base + v[2], base + v[3]};
}
__device__ __forceinline__ void fox_unit(KArgP A, int l, LAS unsigned char* lds, int b, int h, int qb, int ocol = -1) {
    bf16* PJ = (bf16*)(A->ws + WS_PROJ);
    const float* CKG = (const float*)((unsigned char*)A->out + DO_CKG) + (size_t)(b * 8 + h) * SEQ;
    const int tid = otid();
    LAS float* CK = (LAS float*)(lds + fox_body::LDS_BYTES);
    const f32x4 ck4 = (tid * 4 < 256 * (qb + 1)) ? *(const f32x4*)(CKG + tid * 4) : (f32x4){0.f, 0.f, 0.f, 0.f};
    __syncthreads();
    *(LAS f32x4*)(CK + tid * 4) = ck4;
    __syncthreads();
    fox_body::attn_unit<8>(b, h, qb, PJ + C_OB + h * 64, PJ + C_FK + h * 64, PJ + C_FV + h * 64, PJ + (ocol < 0 ? C_OB + h * 64 : ocol), (char*)lds, CK);
}

struct GdnPre { u32x4 xr[10]; f32x4 w0[4], w1[4]; unsigned ab; };
__device__ __forceinline__ void gdn_prep_issue(GdnPre& P, KArgP A, int l, int b, int h, int n) {
    const bf16* PJ = (const bf16*)(A->ws + WS_PROJ); const bf16* HALO = (const bf16*)((unsigned char*)A->out + DO_HALO);
    const float* cw = A->gdn_conv_w + (size_t)l * 4 * 1536;
    const int tid = otid(); const size_t row0 = (size_t)b * SEQ + n * 64;
    if (tid < 480) { const int pc = tid % 48, grp = tid / 48, part = pc >> 4, c8 = pc & 15, c = part * 512 + h * 128 + c8 * 8;
#pragma unroll
        for (int i = 0; i < 10; ++i) { const int tr = 7 * grp - 3 + i; P.xr[i] = (u32x4){0u, 0u, 0u, 0u};
            if (tr >= 0) { if (tr < 64) P.xr[i] = *(const u32x4*)(PJ + (row0 + tr) * LP + C_GQ + c); }
            else if (n > 0) P.xr[i] = *(const u32x4*)(HALO + ((size_t)(b * 32 + n - 1) * 3 + (3 + tr)) * 1536 + c); }
#pragma unroll
        for (int i = 0; i < 4; ++i) { P.w0[i] = *(const f32x4*)(cw + i * 1536 + c); P.w1[i] = *(const f32x4*)(cw + i * 1536 + c + 4); } }
    if (tid < 64) { const size_t r = (row0 + tid) * LP + C_SM; P.ab = (unsigned)PJ[r + 4 + h] | ((unsigned)PJ[r + h] << 16); }
}
__device__ __forceinline__ void gdn_prep_task(KArgP A, int l, LAS unsigned char* lds, int b, int h, int n, GdnPre& P, bool has_next, int nb_, int nh_, int nn_, GdnPre& N, bool dummy = false) {
    bf16* PJ = (bf16*)(A->ws + WS_PROJ);
    unsigned char* dsc = (unsigned char*)A->out; const bf16* HALO = (const bf16*)(dsc + DO_HALO);
    unsigned char* rec = dsc + DO_GP + (size_t)(dummy ? 2048 : ((b * 4 + h) * 32 + n)) * GP_STRIDE;
    const int tid = otid(), lane = tid & 63, wid = tid >> 6, l15 = lane & 15, g = lane >> 4;
    constexpr int S136 = 272, S72 = 144, S40 = 80;
    const int oq = dummy ? 5152 : C_GQ + h * 128, ov = dummy ? 5152 : C_GV + h * 128;
    LAS float* qf = (LAS float*)lds; LAS float* kf = qf + 64 * 128; LAS float* vf = kf + 64 * 128;
    LAS unsigned char* KB16 = lds + 98304; LAS unsigned char* QB16 = lds + 115712;
    LAS float* GC = (LAS float*)(lds + 146432); LAS float* BETA = GC + 64; LAS float* EG = BETA + 64;
    LAS unsigned char* AOFF = lds;
    LAS unsigned char* ATTS = lds + 9216;
    LAS float* AKK = (LAS float*)(lds + 18432);
    LAS unsigned char* TD = lds + 23552;
    LAS unsigned char* XT = lds + 98304;
    LAS unsigned char* TT = lds + 65536;
    const float* cw = A->gdn_conv_w + (size_t)l * 4 * 1536;
    const float alog = A->gdn_a_log[l * 4 + h], dtb = A->gdn_dt_bias[l * 4 + h];
    const int t0 = n * 64; const size_t row0 = (size_t)b * SEQ + t0;
    __syncthreads();
    TMARK(30);
    if (tid < 480) {
        const int pc = tid % 48, grp = tid / 48, part = pc >> 4, c8 = pc & 15;
        LAS float* dbase = (part == 0 ? qf : part == 1 ? kf : vf) + c8 * 8;
#pragma unroll
        for (int j = 0; j < 7; ++j) { const int tt = 7 * grp + j;
            if (tt < 64) { float y[8];
#pragma unroll
                for (int e2 = 0; e2 < 8; ++e2) y[e2] = 0.f;
#pragma unroll
                for (int i = 0; i < 4; ++i) { const u32x4 xv = P.xr[j + i];
                    y[0] += P.w0[i][0] * bflo(xv.x); y[1] += P.w0[i][1] * bfhi(xv.x); y[2] += P.w0[i][2] * bflo(xv.y); y[3] += P.w0[i][3] * bfhi(xv.y);
                    y[4] += P.w1[i][0] * bflo(xv.z); y[5] += P.w1[i][1] * bfhi(xv.z); y[6] += P.w1[i][2] * bflo(xv.w); y[7] += P.w1[i][3] * bfhi(xv.w); }
                LAS float* dst = dbase + tt * 128;
                *(LAS f32x4*)dst = (f32x4){siluf_(y[0]), siluf_(y[1]), siluf_(y[2]), siluf_(y[3])}; *(LAS f32x4*)(dst + 4) = (f32x4){siluf_(y[4]), siluf_(y[5]), siluf_(y[6]), siluf_(y[7])}; } }
    }
    if (tid < 64) { const float a = bflo(P.ab), bb = bfhi(P.ab);
        float gg = -__expf(alog) * softplusf_(a + dtb);
#pragma unroll
        for (int o = 1; o < 64; o <<= 1) { const float y2 = __builtin_bit_cast(float, __builtin_amdgcn_ds_bpermute(((lane - o) & 63) << 2, __builtin_bit_cast(int, gg))); if (lane >= o) gg += y2; }
        GC[tid] = gg; EG[tid] = __expf(gg); BETA[tid] = sigmoidf_(bb); }
    if (has_next) gdn_prep_issue(N, A, l, nb_, nh_, nn_);
    __syncthreads();
    TMARK(31);
    {
        float va[16], vc[16], ss[16];
#pragma unroll
        for (int i = 0; i < 16; ++i) { const int rr = wid + 8 * i; const LAS float* p = (rr < 64 ? qf + rr * 128 : kf + (rr - 64) * 128); va[i] = p[lane * 2]; vc[i] = p[lane * 2 + 1]; ss[i] = va[i] * va[i] + vc[i] * vc[i]; }
#pragma unroll
        for (int i = 0; i < 16; ++i) ss[i] += swz_xor<1>(ss[i]);
#pragma unroll
        for (int i = 0; i < 16; ++i) ss[i] += swz_xor<2>(ss[i]);
#pragma unroll
        for (int i = 0; i < 16; ++i) ss[i] += swz_xor<4>(ss[i]);
#pragma unroll
        for (int i = 0; i < 16; ++i) ss[i] += swz_xor<8>(ss[i]);
#pragma unroll
        for (int i = 0; i < 16; ++i) ss[i] += swz_xor<16>(ss[i]);
#pragma unroll
        for (int i = 0; i < 16; ++i) ss[i] = half_sum(ss[i]);
#pragma unroll
        for (int i = 0; i < 16; ++i) { const int rr = wid + 8 * i; const bool isq = rr < 64; const int row = isq ? rr : rr - 64;
            const float sc = rsqrtf(ss[i] + 1e-6f); const float an = va[i] * sc, cn = vc[i] * sc;
            if (isq) { *(LAS unsigned*)(QB16 + row * S136 + lane * 4) = pk2(an, cn); const float f = 0.08838834764831845f * EG[row];
                *(unsigned*)(PJ + (row0 + row) * LP + oq + lane * 2) = pk2(an * f, cn * f); }
            else { LAS float* p = kf + row * 128; p[lane * 2] = an; p[lane * 2 + 1] = cn; *(LAS unsigned*)(KB16 + row * S136 + lane * 4) = pk2(an, cn); } }
    }
    __syncthreads();
    TMARK(32);
    {
        const int mb = wid >> 1;
        bf16x8 ak[4], aq[4];
#pragma unroll
        for (int ks = 0; ks < 4; ++ks) { ak[ks] = frag_rm(KB16, S136, mb, ks, l15, g); aq[ks] = frag_rm(QB16, S136, mb, ks, l15, g); }
#pragma unroll
        for (int j = 0; j < 2; ++j) { const int nb = 2 * (wid & 1) + j; f32x4 kk = (f32x4){0.f, 0.f, 0.f, 0.f}, qk = (f32x4){0.f, 0.f, 0.f, 0.f};
#pragma unroll
            for (int ks = 0; ks < 4; ++ks) { const bf16x8 bfr = frag_rm(KB16, S136, nb, ks, l15, g); kk = MFMA16(ak[ks], bfr, kk); qk = MFMA16(aq[ks], bfr, qk); }
            const int jj = nb * 16 + l15; const float gj = GC[jj];
#pragma unroll
            for (int r = 0; r < 4; ++r) { const int i = mb * 16 + 4 * g + r; const float dec = jj <= i ? __expf(GC[i] - gj) : 0.f;
                const float av = jj < i ? BETA[i] * kk[r] * dec : 0.f;
                *(LAS bf16*)(AOFF + i * S72 + jj * 2) = (bf16)f2bf(nb < mb ? av : 0.f);
                if (nb == mb) AKK[(mb * 16 + 4 * g + r) * 20 + l15] = av;
                *(LAS bf16*)(ATTS + i * S72 + jj * 2) = (bf16)f2bf(qk[r] * dec * 0.08838834764831845f); } }
        for (int i = tid; i < 64 * S40 / 16; i += 512) *(LAS u32x4*)(TD + i * 16) = (u32x4){0u, 0u, 0u, 0u};
    }
    __syncthreads();
    TMARK(33);
    if (tid < 64) { const int k = tid >> 4, c = tid & 15; const LAS float* ab = AKK + k * 16 * 20; float y[16];
#pragma unroll
        for (int i = 0; i < 16; ++i) { float s = (i == c) ? 1.f : 0.f;
#pragma unroll
            for (int m = 0; m < i; ++m) s -= ab[i * 20 + m] * y[m];
            y[i] = s; *(LAS bf16*)(TD + (k * 16 + i) * S40 + c * 2) = (bf16)f2bf(s); } }
    for (int it = tid; it < 8 * 256; it += 512) { const int col = it & 255, i0 = (it >> 8) * 8;
        const LAS float* sp = col < 128 ? vf + col : kf + (col - 128); float r[8];
#pragma unroll
        for (int e = 0; e < 8; ++e) { const int i = i0 + e; r[e] = BETA[i] * sp[i * 128]; if (col >= 128) r[e] *= EG[i]; }
        *(LAS u32x4*)(XT + col * S72 + i0 * 2) = (u32x4){pk2(r[0], r[1]), pk2(r[2], r[3]), pk2(r[4], r[5]), pk2(r[6], r[7])}; }
    __syncthreads();
    TMARK(34);
    {
        for (int i = lane; i < 32 * S40 / 16; i += 64) *(LAS u32x4*)(TT + wid * 32 * S40 + i * 16) = (u32x4){0u, 0u, 0u, 0u};
#pragma unroll
        for (int k = 0; k < 4; ++k) {
#pragma unroll
            for (int jn = 0; jn < 2; ++jn) { const int nb = 2 * wid + jn, col = nb * 16 + l15;
                f32x4 acc = (f32x4){0.f, 0.f, 0.f, 0.f};
                if (k > 0) { acc = MFMA16(frag_rm(AOFF, S72, k, 0, l15, g), frag_rm(XT, S72, nb, 0, l15, g), acc);
                    if (k == 3) acc = MFMA16(frag_rm(AOFF, S72, k, 1, l15, g), frag_rm(XT, S72, nb, 1, l15, g), acc); }
                const u32x2 rv = *(const LAS u32x2*)(XT + col * S72 + (16 * k + 4 * g) * 2);
                *(LAS u32x2*)(TT + col * S40 + (4 * g) * 2) = (u32x2){pk2(bflo(rv.x) - acc[0], bfhi(rv.x) - acc[1]), pk2(bflo(rv.y) - acc[2], bfhi(rv.y) - acc[3])};
                f32x4 x = MFMA16(frag_rm(TD, S40, k, 0, l15, g), frag_rm(TT, S40, nb, 0, l15, g), ((f32x4){0.f, 0.f, 0.f, 0.f}));
                *(LAS u32x2*)(XT + col * S72 + (16 * k + 4 * g) * 2) = (u32x2){pk2(x[0], x[1]), pk2(x[2], x[3])};
            }
        }
    }
    __syncthreads();
    {
        const int q4 = l15 >> 2, p4 = lane & 3;
#pragma unroll
        for (int j = 0; j < 4; ++j) { const int op = wid * 4 + j, which = op >> 4, ks = (op >> 2) & 3, nb = op & 3;
            const bf16x8 f = frag_tr(XT + which * 128 * S72, S72, ks, nb, g, q4, p4); const int row = 16 * nb + l15, cc = 32 * ks + 8 * g;
            if (which == 0) *(bf16x8*)(PJ + (row0 + row) * LP + ov + cc) = f; else *(bf16x8*)((bf16*)(rec + GP_W) + row * 128 + cc) = f; }
    }
    TMARK(35);
    {
        { const int row = tid >> 3, c8 = tid & 7; *(u32x4*)(rec + GP_ATT + row * 128 + c8 * 16) = *(const LAS u32x4*)(ATTS + row * S72 + c8 * 16); }
        { const int dk = tid & 127, qt = tid >> 7; const float gl = GC[63]; unsigned w[8];
#pragma unroll
          for (int i = 0; i < 8; ++i) { const int c0 = qt * 16 + 2 * i; w[i] = pk2(kf[c0 * 128 + dk] * __expf(gl - GC[c0]), kf[(c0 + 1) * 128 + dk] * __expf(gl - GC[c0 + 1])); }
          u32x4* kp = (u32x4*)(rec + GP_KDT + dk * 128 + qt * 32);
          kp[0] = (u32x4){w[0], w[1], w[2], w[3]}; kp[1] = (u32x4){w[4], w[5], w[6], w[7]}; }
        if (tid == 0) *(float*)(rec + GP_CD) = EG[63];
    }
    TMARK(36);
}

__device__ __forceinline__ void gdn_scan_chain(KArgP A, int l, LAS unsigned char* lds, int b, int h, int ocol = -1) {
    bf16* PJ = (bf16*)(A->ws + WS_PROJ);
    unsigned char* dsc = (unsigned char*)A->out;
    const int tid = otid(), lane = tid & 63, wid = tid >> 6, l15 = lane & 15, g = lane >> 4;
    constexpr int S136 = 272, S72 = 144;
    LAS unsigned char* Wl = lds; LAS unsigned char* QDl = lds + 17408; LAS unsigned char* Ul = lds + 34816; LAS unsigned char* KDTl = lds + 52224; LAS unsigned char* ATTl = lds + 70656;
    LAS unsigned char* STl = lds + 79872; LAS unsigned char* VNl = lds + 114688; LAS float* SSQ = (LAS float*)(lds + 133120);
    LAS unsigned char* OST = Wl;
    const float* nw = A->gdn_norm_w + l * 128;
    const int mb = wid >> 1, nb0 = 4 * (wid & 1);
    f32x4 S[8];
#pragma unroll
    for (int j = 0; j < 8; ++j) S[j] = (f32x4){0.f, 0.f, 0.f, 0.f};
    __syncthreads();
    for (int i = tid; i < 128 * S136 / 16; i += 512) *(LAS u32x4*)(STl + i * 16) = (u32x4){0u, 0u, 0u, 0u};
    u32x4 pw[2], pq[2], pu[2], pk[2], pa, pz[2], zc[2]; float cd = 0.f, cdn = 0.f;
#define GDN_ISSUE(nn) do { const unsigned char* rec_ = dsc + DO_GP + (size_t)((b * 4 + h) * 32 + (nn)) * GP_STRIDE; const size_t r0_ = (size_t)b * SEQ + (nn) * 64; \
        _Pragma("unroll") for (int q_ = 0; q_ < 2; ++q_) { const int c_ = tid + 512 * q_, row_ = c_ >> 4, c16_ = c_ & 15; \
            pw[q_] = *(const u32x4*)(rec_ + GP_W + row_ * 256 + c16_ * 16); \
            pq[q_] = *(const u32x4*)(PJ + (r0_ + row_) * LP + C_GQ + h * 128 + c16_ * 8); pu[q_] = *(const u32x4*)(PJ + (r0_ + row_) * LP + C_GV + h * 128 + c16_ * 8); \
            pk[q_] = *(const u32x4*)(rec_ + GP_KDT + (c_ >> 3) * 128 + (c_ & 7) * 16); pz[q_] = *(const u32x4*)(PJ + (r0_ + row_) * LP + C_OA + h * 128 + c16_ * 8); } \
        pa = *(const u32x4*)(rec_ + GP_ATT + (tid >> 3) * 128 + (tid & 7) * 16); cdn = *(const float*)(rec_ + GP_CD); } while (0)
    GDN_ISSUE(0);
    for (int n = 0; n < SEQ / 64; ++n) {
        const size_t row0 = (size_t)b * SEQ + n * 64;
        __syncthreads();
#pragma unroll
        for (int q = 0; q < 2; ++q) { const int c = tid + 512 * q, row = c >> 4, c16 = c & 15;
            *(LAS u32x4*)(Wl + row * S136 + c16 * 16) = pw[q]; *(LAS u32x4*)(QDl + row * S136 + c16 * 16) = pq[q]; *(LAS u32x4*)(Ul + row * S136 + c16 * 16) = pu[q];
            *(LAS u32x4*)(KDTl + (c >> 3) * S72 + (c & 7) * 16) = pk[q]; }
        *(LAS u32x4*)(ATTl + (tid >> 3) * S72 + (tid & 7) * 16) = pa; cd = cdn; zc[0] = pz[0]; zc[1] = pz[1];
        __syncthreads();
        if (n + 1 < SEQ / 64) GDN_ISSUE(n + 1);
        f32x4 accO[4];
        {
            bf16x8 aw[4], aq[4];
#pragma unroll
            for (int ks = 0; ks < 4; ++ks) { aw[ks] = frag_rm(Wl, S136, mb, ks, l15, g); aq[ks] = frag_rm(QDl, S136, mb, ks, l15, g); }
#pragma unroll
            for (int j = 0; j < 4; ++j) { const int nb = nb0 + j; f32x4 ws = (f32x4){0.f, 0.f, 0.f, 0.f}; accO[j] = (f32x4){0.f, 0.f, 0.f, 0.f};
#pragma unroll
                for (int ks = 0; ks < 4; ++ks) { const bf16x8 sf = frag_rm(STl, S136, nb, ks, l15, g); ws = MFMA16(aw[ks], sf, ws); accO[j] = MFMA16(aq[ks], sf, accO[j]); }
                float vn[4];
#pragma unroll
                for (int r = 0; r < 4; ++r) vn[r] = bf2f(*(const LAS bf16*)(Ul + (mb * 16 + 4 * g + r) * S136 + (nb * 16 + l15) * 2)) - ws[r];
                *(LAS u32x2*)(VNl + (nb * 16 + l15) * S72 + (mb * 16 + 4 * g) * 2) = (u32x2){pk2(vn[0], vn[1]), pk2(vn[2], vn[3])}; }
        }
        __syncthreads();
        {
            bf16x8 aa[2], ak[2];
#pragma unroll
            for (int ks = 0; ks < 2; ++ks) { aa[ks] = frag_rm(ATTl, S72, mb, ks, l15, g); ak[ks] = frag_rm(KDTl, S72, wid, ks, l15, g); }
#pragma unroll
            for (int j = 0; j < 4; ++j)
#pragma unroll
                for (int ks = 0; ks < 2; ++ks) accO[j] = MFMA16(aa[ks], frag_rm(VNl, S72, nb0 + j, ks, l15, g), accO[j]);
#pragma unroll
            for (int jb = 0; jb < 8; ++jb) { S[jb] = S[jb] * cd;
#pragma unroll
                for (int ks = 0; ks < 2; ++ks) S[jb] = MFMA16(ak[ks], frag_rm(VNl, S72, jb, ks, l15, g), S[jb]);
                *(LAS u32x2*)(STl + (jb * 16 + l15) * S136 + (wid * 16 + 4 * g) * 2) = (u32x2){pk2(S[jb][0], S[jb][1]), pk2(S[jb][2], S[jb][3])}; }
        }
        {
            float ss[4];
#pragma unroll
            for (int r = 0; r < 4; ++r) { float s = 0.f;
#pragma unroll
                for (int j = 0; j < 4; ++j) s += accO[j][r] * accO[j][r];
                s += swz_xor<1>(s); s += swz_xor<2>(s); s += swz_xor<4>(s); s += swz_xor<8>(s); ss[r] = s; }
            if (l15 == 0) {
#pragma unroll
                for (int r = 0; r < 4; ++r) SSQ[(mb * 16 + 4 * g + r) * 2 + (wid & 1)] = ss[r]; }
            __syncthreads();
#pragma unroll
            for (int r = 0; r < 4; ++r) { const int i = mb * 16 + 4 * g + r; const float sc = rsqrtf((SSQ[i * 2] + SSQ[i * 2 + 1]) * (1.f / 128.f) + 1e-6f);
#pragma unroll
                for (int j = 0; j < 4; ++j) { const int dv = (nb0 + j) * 16 + l15; *(LAS bf16*)(OST + i * S136 + dv * 2) = (bf16)f2bf(accO[j][r] * sc * nw[dv]); } }
            __syncthreads();
#pragma unroll
            for (int q = 0; q < 2; ++q) { const int it = tid + 512 * q, tt = it >> 4, c8 = it & 15;
                bf16* gp = PJ + (row0 + tt) * LP + C_OA + h * 128 + c8 * 8; const u32x4 rv = zc[q]; if (ocol >= 0) gp = PJ + (row0 + tt) * LP + ocol + c8 * 8; const u32x4 ov = *(const LAS u32x4*)(OST + tt * S136 + c8 * 16);
                u32x4 w; w.x = pk2(bflo(ov.x) * siluf_(bflo(rv.x)), bfhi(ov.x) * siluf_(bfhi(rv.x))); w.y = pk2(bflo(ov.y) * siluf_(bflo(rv.y)), bfhi(ov.y) * siluf_(bfhi(rv.y)));
                w.z = pk2(bflo(ov.z) * siluf_(bflo(rv.z)), bfhi(ov.z) * siluf_(bfhi(rv.z))); w.w = pk2(bflo(ov.w) * siluf_(bflo(rv.w)), bfhi(ov.w) * siluf_(bfhi(rv.w)));
                *(u32x4*)gp = w; }
        }
    }
#undef GDN_ISSUE
}

__device__ __forceinline__ unsigned char* gla_slot(KArgP A, int b, int h, int n) {
    const int s = (b * 4 + h) * 32 + n;
    return b < 13 ? A->ws + WS_KVS + (size_t)s * 16384 : (unsigned char*)A->out + DO_KVS + (size_t)(s - 13 * 128) * 16384;
}
struct GlaPre { u32x4 v[2], q, k; unsigned short lr[2]; };
__device__ __forceinline__ void gla_prep_issue(GlaPre& P, KArgP A, int b, int h, int n) {
    const bf16* PJ = (const bf16*)(A->ws + WS_PROJ); const int tid = otid(); const size_t row0 = (size_t)b * SEQ + n * 64;
#pragma unroll
    for (int q = 0; q < 2; ++q) { const int it = tid + 512 * q, tt = it >> 4, c = it & 15;
        P.lr[q] = PJ[(row0 + tt) * LP + C_SM + 16 + c]; P.v[q] = *(const u32x4*)(PJ + (row0 + tt) * LP + C_LV + h * 128 + c * 8); }
    const int tt0 = tid >> 3, c80 = tid & 7;
    P.q = *(const u32x4*)(PJ + (row0 + tt0) * LP + C_LQ + h * 64 + c80 * 8); P.k = *(const u32x4*)(PJ + (row0 + tt0) * LP + C_LK + h * 64 + c80 * 8);
}
__device__ __forceinline__ void gla_prep_task(KArgP A, int l, LAS unsigned char* lds, int b, int h, int n, GlaPre& P, bool has_next, int nb_, int nh_, int nn_, GlaPre& N) {
    bf16* PJ = (bf16*)(A->ws + WS_PROJ);
    const int tid = otid(), lane = tid & 63, wid = tid >> 6, l15 = lane & 15, g = lane >> 4, q4 = l15 >> 2, p4 = lane & 3;
    constexpr int S72 = 144, S136 = 272;
    LAS unsigned char* QT = lds; LAS unsigned char* KT = QT + 64 * S72; LAS unsigned char* KDT = KT + 64 * S72; LAS unsigned char* ATT = KDT + 64 * S72; LAS unsigned char* VV = ATT + 64 * S72;
    LAS float* LA = (LAS float*)(VV + 64 * S136); LAS float* LR = LA + 64 * 64; LAS float* SEG = LR + 64 * 16;
    const float* wg2 = A->gla_w_gate2 + (size_t)l * 16 * 256; const float* bg = A->gla_b_gate + l * 256;
    const size_t row0 = (size_t)b * SEQ + n * 64;
    const int mb = wid >> 1, nb0 = 4 * (wid & 1);
    float wcol[16]; const float bgv = bg[h * 64 + (tid & 63)];
#pragma unroll
    for (int r = 0; r < 16; ++r) wcol[r] = wg2[r * 256 + h * 64 + (tid & 63)];
    __syncthreads();
#pragma unroll
    for (int q = 0; q < 2; ++q) { const int it = tid + 512 * q; LR[it] = bf2f(P.lr[q]); *(LAS u32x4*)(VV + (it >> 4) * S136 + (it & 15) * 16) = P.v[q]; }
    const int tt0 = tid >> 3, c80 = tid & 7;
    const u32x4 qv = P.q, kv = P.k;
    if (has_next) gla_prep_issue(N, A, nb_, nh_, nn_);
    __syncthreads();
    for (int it = tid; it < 64 * 64; it += 512) { const int tt = it >> 6; float z = bgv;
        const LAS f32x4* lr4 = (const LAS f32x4*)(LR + tt * 16);
#pragma unroll
        for (int r4 = 0; r4 < 4; ++r4) { const f32x4 v = lr4[r4]; z += v[0] * wcol[4 * r4] + v[1] * wcol[4 * r4 + 1] + v[2] * wcol[4 * r4 + 2] + v[3] * wcol[4 * r4 + 3]; }
        LA[it] = (fminf(z, 0.f) - __logf(1.f + __expf(-fabsf(z)))) * (1.f / 16.f); }
    __syncthreads();
    { const int d = tid & 63, seg = tid >> 6; float run = 0.f;
#pragma unroll
      for (int i = 0; i < 8; ++i) { run += LA[(seg * 8 + i) * 64 + d]; LA[(seg * 8 + i) * 64 + d] = run; }
      SEG[seg * 64 + d] = run; }
    __syncthreads();
    { const int d = tid & 63, seg = tid >> 6; float pre = 0.f;
      for (int s2 = 0; s2 < seg; ++s2) pre += SEG[s2 * 64 + d];
#pragma unroll
      for (int i = 0; i < 8; ++i) LA[(seg * 8 + i) * 64 + d] += pre; }
    __syncthreads();
    {
        const float qf[8] = {bflo(qv.x), bfhi(qv.x), bflo(qv.y), bfhi(qv.y), bflo(qv.z), bfhi(qv.z), bflo(qv.w), bfhi(qv.w)};
        const float kf[8] = {bflo(kv.x), bfhi(kv.x), bflo(kv.y), bfhi(kv.y), bflo(kv.z), bfhi(kv.z), bflo(kv.w), bfhi(kv.w)};
        float qt[8], kt[8];
#pragma unroll
        for (int e = 0; e < 8; ++e) { const int d = c80 * 8 + e; const float cu = LA[tt0 * 64 + d], cl = LA[63 * 64 + d];
            qt[e] = qf[e] * 0.125f * __expf(cu); kt[e] = kf[e] * __expf(-cu);
            *(LAS bf16*)(KDT + d * S72 + tt0 * 2) = (bf16)f2bf(kf[e] * __expf(cl - cu)); }
        const u32x4 qw = (u32x4){pk2(qt[0], qt[1]), pk2(qt[2], qt[3]), pk2(qt[4], qt[5]), pk2(qt[6], qt[7])};
        *(LAS u32x4*)(QT + tt0 * S72 + c80 * 16) = qw;
        *(u32x4*)(PJ + (row0 + tt0) * LP + C_LQ + h * 64 + c80 * 8) = qw;
        *(LAS u32x4*)(KT + tt0 * S72 + c80 * 16) = (u32x4){pk2(kt[0], kt[1]), pk2(kt[2], kt[3]), pk2(kt[4], kt[5]), pk2(kt[6], kt[7])};
        if (tid < 64) ((float*)(A->ws + WS_CDB))[(size_t)((b * 4 + h) * 32 + n) * 64 + tid] = __expf(LA[63 * 64 + tid]);
    }
    __syncthreads();
    {
        bf16x8 af[2], kf2[2];
#pragma unroll
        for (int ks = 0; ks < 2; ++ks) { af[ks] = frag_rm(QT, S72, mb, ks, l15, g); kf2[ks] = frag_rm(KDT, S72, mb, ks, l15, g); }
#pragma unroll
        for (int j = 0; j < 2; ++j) { const int nb = 2 * (wid & 1) + j; f32x4 a = (f32x4){0.f, 0.f, 0.f, 0.f};
#pragma unroll
            for (int ks = 0; ks < 2; ++ks) a = MFMA16(af[ks], frag_rm(KT, S72, nb, ks, l15, g), a);
#pragma unroll
            for (int r = 0; r < 4; ++r) { const int i = mb * 16 + 4 * g + r, jj = nb * 16 + l15; *(LAS bf16*)(ATT + i * S72 + jj * 2) = (bf16)f2bf(jj <= i ? a[r] : 0.f); } }
        unsigned char* slot = gla_slot(A, b, h, n);
#pragma unroll
        for (int j = 0; j < 4; ++j) { f32x4 kvb = (f32x4){0.f, 0.f, 0.f, 0.f};
#pragma unroll
            for (int ks = 0; ks < 2; ++ks) kvb = MFMA16(kf2[ks], frag_tr(VV, S136, ks, nb0 + j, g, q4, p4), kvb);
            *(u32x2*)(slot + ((nb0 + j) * 16 + l15) * 128 + (mb * 16 + 4 * g) * 2) = (u32x2){pk2(kvb[0], kvb[1]), pk2(kvb[2], kvb[3])}; }
    }
    __syncthreads();
    { const int row = tid >> 3, c8 = tid & 7; *(u32x4*)(PJ + (row0 + row) * LP + C_LK + h * 64 + c8 * 8) = *(const LAS u32x4*)(ATT + row * S72 + c8 * 16); }
}
__device__ __forceinline__ void gla_state_scan(KArgP A) {
    for (int gt = obid() * 512 + otid(); gt < 64 * 2048; gt += ogrid() * 512) {
    const int ch = gt >> 11, e4 = gt & 2047, b = ch >> 2, h = ch & 3;
    const float* cdb = (const float*)(A->ws + WS_CDB) + (size_t)ch * 32 * 64 + (e4 & 15) * 4;
    float s0 = 0.f, s1 = 0.f, s2 = 0.f, s3 = 0.f;
#pragma unroll 8
    for (int n = 0; n < 32; ++n) {
        u32x2* p = (u32x2*)(gla_slot(A, b, h, n) + e4 * 8); const u32x2 kv = *p; const f32x4 cd = *(const f32x4*)(cdb + n * 64);
        *p = (u32x2){pk2(s0, s1), pk2(s2, s3)};
        s0 = cd[0] * s0 + bflo(kv.x); s1 = cd[1] * s1 + bfhi(kv.x); s2 = cd[2] * s2 + bflo(kv.y); s3 = cd[3] * s3 + bfhi(kv.y);
    }
    }
}
__device__ __forceinline__ void gla_out_task(KArgP A, int l, LAS unsigned char* lds, int b, int h, int n) {
    bf16* PJ = (bf16*)(A->ws + WS_PROJ);
    const int tid = otid(), lane = tid & 63, wid = tid >> 6, l15 = lane & 15, g = lane >> 4, q4 = l15 >> 2, p4 = lane & 3;
    constexpr int S72 = 144, S136 = 272;
    LAS unsigned char* QT = lds; LAS unsigned char* ATT = QT + 64 * S72; LAS unsigned char* VV = ATT + 64 * S72; LAS unsigned char* ST = VV + 64 * S136; LAS unsigned char* OST = ST + 128 * S72;
    LAS float* SSQ = (LAS float*)(OST + 64 * S136);
    const float* nw = A->gla_norm_w + l * 128;
    const size_t row0 = (size_t)b * SEQ + n * 64;
    const int mb = wid >> 1, nb0 = 4 * (wid & 1);
    const unsigned char* slot = gla_slot(A, b, h, n);
    u32x4 rpre[2];
#pragma unroll
    for (int q = 0; q < 2; ++q) { const int it = tid + 512 * q; rpre[q] = *(const u32x4*)(PJ + (row0 + (it >> 4)) * LP + C_OC + h * 128 + (it & 15) * 8); }
    __syncthreads();
    { const int row = tid >> 3, c8 = tid & 7;
      *(LAS u32x4*)(QT + row * S72 + c8 * 16) = *(const u32x4*)(PJ + (row0 + row) * LP + C_LQ + h * 64 + c8 * 8);
      *(LAS u32x4*)(ATT + row * S72 + c8 * 16) = *(const u32x4*)(PJ + (row0 + row) * LP + C_LK + h * 64 + c8 * 8); }
#pragma unroll
    for (int q = 0; q < 2; ++q) { const int c = tid + 512 * q;
        *(LAS u32x4*)(VV + (c >> 4) * S136 + (c & 15) * 16) = *(const u32x4*)(PJ + (row0 + (c >> 4)) * LP + C_LV + h * 128 + (c & 15) * 8);
        *(LAS u32x4*)(ST + (c >> 3) * S72 + (c & 7) * 16) = *(const u32x4*)(slot + (c >> 3) * 128 + (c & 7) * 16); }
    __syncthreads();
    f32x4 acc[4];
    {
        bf16x8 af[2], aa[2];
#pragma unroll
        for (int ks = 0; ks < 2; ++ks) { af[ks] = frag_rm(QT, S72, mb, ks, l15, g); aa[ks] = frag_rm(ATT, S72, mb, ks, l15, g); }
#pragma unroll
        for (int j = 0; j < 4; ++j) { acc[j] = (f32x4){0.f, 0.f, 0.f, 0.f};
#pragma unroll
            for (int ks = 0; ks < 2; ++ks) { acc[j] = MFMA16(af[ks], frag_rm(ST, S72, nb0 + j, ks, l15, g), acc[j]); acc[j] = MFMA16(aa[ks], frag_tr(VV, S136, ks, nb0 + j, g, q4, p4), acc[j]); } }
    }
    float ss[4];
#pragma unroll
    for (int r = 0; r < 4; ++r) { float s = 0.f;
#pragma unroll
        for (int j = 0; j < 4; ++j) s += acc[j][r] * acc[j][r];
        s += swz_xor<1>(s); s += swz_xor<2>(s); s += swz_xor<4>(s); s += swz_xor<8>(s); ss[r] = s; }
    if (l15 == 0) {
#pragma unroll
        for (int r = 0; r < 4; ++r) SSQ[(mb * 16 + 4 * g + r) * 2 + (wid & 1)] = ss[r]; }
    __syncthreads();
#pragma unroll
    for (int r = 0; r < 4; ++r) { const int i = mb * 16 + 4 * g + r; const float sc = rsqrtf((SSQ[i * 2] + SSQ[i * 2 + 1]) * (1.f / 128.f) + 1e-6f);
#pragma unroll
        for (int j = 0; j < 4; ++j) { const int dv = (nb0 + j) * 16 + l15; *(LAS bf16*)(OST + i * S136 + dv * 2) = (bf16)f2bf(acc[j][r] * sc * nw[dv]); } }
    __syncthreads();
#pragma unroll
    for (int q = 0; q < 2; ++q) { const int it = tid + 512 * q, tt = it >> 4, c8 = it & 15;
        bf16* gp = PJ + (row0 + tt) * LP + C_OC + h * 128 + c8 * 8; const u32x4 rv = rpre[q]; const u32x4 ov = *(const LAS u32x4*)(OST + tt * S136 + c8 * 16);
        u32x4 w; w.x = pk2(bflo(ov.x) * siluf_(bflo(rv.x)), bfhi(ov.x) * siluf_(bfhi(rv.x))); w.y = pk2(bflo(ov.y) * siluf_(bflo(rv.y)), bfhi(ov.y) * siluf_(bfhi(rv.y)));
        w.z = pk2(bflo(ov.z) * siluf_(bflo(rv.z)), bfhi(ov.z) * siluf_(bfhi(rv.z))); w.w = pk2(bflo(ov.w) * siluf_(bflo(rv.w)), bfhi(ov.w) * siluf_(bfhi(rv.w)));
        *(u32x4*)gp = w; }
}

struct LnRow { float v[16]; };
__device__ __forceinline__ void ln_normalize(LnRow& r, const float* g, const float* bta, int lane) {
    float s = 0.f;
#pragma unroll
    for (int i = 0; i < 16; ++i) s += r.v[i];
    const float mean = wave_sum(s) * (1.f / 1024.f); float q = 0.f;
#pragma unroll
    for (int i = 0; i < 16; ++i) { r.v[i] -= mean; q += r.v[i] * r.v[i]; }
    const float rstd = rsqrtf(wave_sum(q) * (1.f / 1024.f) + 1e-5f);
#pragma unroll
    for (int jj = 0; jj < 2; ++jj) { const int k = 8 * (lane + 64 * jj);
        const f32x4 g0 = *(const f32x4*)(g + k), g1 = *(const f32x4*)(g + k + 4), b0 = *(const f32x4*)(bta + k), b1 = *(const f32x4*)(bta + k + 4);
#pragma unroll
        for (int e = 0; e < 4; ++e) { r.v[jj * 8 + e] = r.v[jj * 8 + e] * rstd * g0[e] + b0[e]; r.v[jj * 8 + 4 + e] = r.v[jj * 8 + 4 + e] * rstd * g1[e] + b1[e]; } }
}
struct LnW { float g[16], b[16]; };
__device__ __forceinline__ void ln_weights(LnW& W, const float* g, const float* bta, int lane) {
#pragma unroll
    for (int jj = 0; jj < 2; ++jj) { const int k = 8 * (lane + 64 * jj);
        const f32x4 g0 = *(const f32x4*)(g + k), g1 = *(const f32x4*)(g + k + 4), b0 = *(const f32x4*)(bta + k), b1 = *(const f32x4*)(bta + k + 4);
#pragma unroll
        for (int e = 0; e < 4; ++e) { W.g[jj * 8 + e] = g0[e]; W.g[jj * 8 + 4 + e] = g1[e]; W.b[jj * 8 + e] = b0[e]; W.b[jj * 8 + 4 + e] = b1[e]; } }
}
__device__ __forceinline__ void ln_normalize_w(LnRow& r, const LnW& W) {
    float s = 0.f;
#pragma unroll
    for (int i = 0; i < 16; ++i) s += r.v[i];
    const float mean = wave_sum(s) * (1.f / 1024.f); float q = 0.f;
#pragma unroll
    for (int i = 0; i < 16; ++i) { r.v[i] -= mean; q += r.v[i] * r.v[i]; }
    const float rstd = rsqrtf(wave_sum(q) * (1.f / 1024.f) + 1e-5f);
#pragma unroll
    for (int i = 0; i < 16; ++i) r.v[i] = r.v[i] * rstd * W.g[i] + W.b[i];
}
__device__ __forceinline__ void ln_unpack(LnRow& r, const u32x4 (&t)[2], float scale) {
#pragma unroll
    for (int jj = 0; jj < 2; ++jj) {
        r.v[jj * 8 + 0] = scale * bflo(t[jj].x); r.v[jj * 8 + 1] = scale * bfhi(t[jj].x); r.v[jj * 8 + 2] = scale * bflo(t[jj].y); r.v[jj * 8 + 3] = scale * bfhi(t[jj].y);
        r.v[jj * 8 + 4] = scale * bflo(t[jj].z); r.v[jj * 8 + 5] = scale * bfhi(t[jj].z); r.v[jj * 8 + 6] = scale * bflo(t[jj].w); r.v[jj * 8 + 7] = scale * bfhi(t[jj].w); }
}
__device__ __forceinline__ void ln_unpack_add(LnRow& r, const u32x4 (&t)[2], float scale) {
#pragma unroll
    for (int jj = 0; jj < 2; ++jj) {
        r.v[jj * 8 + 0] += scale * bflo(t[jj].x); r.v[jj * 8 + 1] += scale * bfhi(t[jj].x); r.v[jj * 8 + 2] += scale * bflo(t[jj].y); r.v[jj * 8 + 3] += scale * bfhi(t[jj].y);
        r.v[jj * 8 + 4] += scale * bflo(t[jj].z); r.v[jj * 8 + 5] += scale * bfhi(t[jj].z); r.v[jj * 8 + 6] += scale * bflo(t[jj].w); r.v[jj * 8 + 7] += scale * bfhi(t[jj].w); }
}
__device__ __forceinline__ void ln_fetch(u32x4 (&t)[2], const bf16* row, int lane) { t[0] = *(const u32x4*)(row + 8 * lane); t[1] = *(const u32x4*)(row + 8 * (lane + 64)); }
__device__ __forceinline__ void ln_load_bf16(LnRow& r, const bf16* row, int lane, float scale) {
#pragma unroll
    for (int jj = 0; jj < 2; ++jj) { const u32x4 t = *(const u32x4*)(row + 8 * (lane + 64 * jj));
        r.v[jj * 8 + 0] = scale * bflo(t.x); r.v[jj * 8 + 1] = scale * bfhi(t.x); r.v[jj * 8 + 2] = scale * bflo(t.y); r.v[jj * 8 + 3] = scale * bfhi(t.y);
        r.v[jj * 8 + 4] = scale * bflo(t.z); r.v[jj * 8 + 5] = scale * bfhi(t.z); r.v[jj * 8 + 6] = scale * bflo(t.w); r.v[jj * 8 + 7] = scale * bfhi(t.w); }
}
__device__ __forceinline__ void ln_add_bf16(LnRow& r, const bf16* row, int lane, float scale) {
#pragma unroll
    for (int jj = 0; jj < 2; ++jj) { const u32x4 t = *(const u32x4*)(row + 8 * (lane + 64 * jj));
        r.v[jj * 8 + 0] += scale * bflo(t.x); r.v[jj * 8 + 1] += scale * bfhi(t.x); r.v[jj * 8 + 2] += scale * bflo(t.y); r.v[jj * 8 + 3] += scale * bfhi(t.y);
        r.v[jj * 8 + 4] += scale * bflo(t.z); r.v[jj * 8 + 5] += scale * bfhi(t.z); r.v[jj * 8 + 6] += scale * bflo(t.w); r.v[jj * 8 + 7] += scale * bfhi(t.w); }
}
__device__ __forceinline__ void ln_store_bf16(const LnRow& r, bf16* row, int lane) {
#pragma unroll
    for (int jj = 0; jj < 2; ++jj) { u32x4 w; w.x = pk2(r.v[jj * 8], r.v[jj * 8 + 1]); w.y = pk2(r.v[jj * 8 + 2], r.v[jj * 8 + 3]); w.z = pk2(r.v[jj * 8 + 4], r.v[jj * 8 + 5]); w.w = pk2(r.v[jj * 8 + 6], r.v[jj * 8 + 7]);
        *(u32x4*)(row + 8 * (lane + 64 * jj)) = w; }
}
__device__ __forceinline__ void ln_store_f32(const LnRow& r, float* row, int lane) {
#pragma unroll
    for (int jj = 0; jj < 2; ++jj) { float* p = row + 8 * (lane + 64 * jj);
        *(f32x4*)p = (f32x4){r.v[jj * 8], r.v[jj * 8 + 1], r.v[jj * 8 + 2], r.v[jj * 8 + 3]}; *(f32x4*)(p + 4) = (f32x4){r.v[jj * 8 + 4], r.v[jj * 8 + 5], r.v[jj * 8 + 6], r.v[jj * 8 + 7]}; }
}

__device__ __forceinline__ KArgP argp() { KArgP p = (KArgP)__builtin_amdgcn_kernarg_segment_ptr(); asm volatile("" : "+s"(p)); return p; }
#define XB_TMO      128
#define XB_XCNT(j)  (256  + 64 * (j))
#define XB_XSUB(j)  (1280 + 64 * (j))
#define XB_XGEN(j)  (2304 + 64 * (j))
#define XB_TOP      3328
#define XB_TOPGEN   3392
#define XB_SPIN_CAP (1u << 20)
constexpr int CW_BAR = 4096;
__device__ __forceinline__ unsigned xb_ld(unsigned* p)              { return __hip_atomic_load(p, __ATOMIC_RELAXED, __HIP_MEMORY_SCOPE_AGENT); }
__device__ __forceinline__ unsigned xb_add(unsigned* p, unsigned v) { return __hip_atomic_fetch_add(p, v, __ATOMIC_RELAXED, __HIP_MEMORY_SCOPE_AGENT); }
__device__ __forceinline__ unsigned xb_xcc_id() { return (unsigned)__builtin_amdgcn_s_getreg((3 << 11) | 20) & 0xFu; }
#define XB_SPIN(cond, bar) do { unsigned _sp = 0; while (cond) { __builtin_amdgcn_s_sleep(1); \
    if ((++_sp & 255u) == 0u) { if (xb_ld(&(bar)[XB_TMO])) break; if (_sp > XB_SPIN_CAP) { atomicAdd(&(bar)[XB_TMO], 1u); break; } } } } while (0)
__device__ __forceinline__ void xcd_barrier_complete(unsigned* bar, unsigned x, unsigned& nloc, unsigned& nx) {
    const unsigned G = gridDim.x;
    unsigned sum, cnt, mine, sp = 0u;
    for (;;) {
        sum = 0u; cnt = 0u; mine = 0u;
#pragma unroll
        for (unsigned j = 0; j < 16; ++j) { const unsigned c = xb_ld(&bar[XB_XCNT(j)]); sum += c; cnt += (c > 0u) ? 1u : 0u; mine = (j == x) ? c : mine; }
        if (sum == G) break;
        __builtin_amdgcn_s_sleep(1);
        if ((++sp & 255u) == 0u) { if (xb_ld(&bar[XB_TMO])) break; if (sp > XB_SPIN_CAP) { atomicAdd(&bar[XB_TMO], 1u); break; } }
    }
    nloc = mine > 0u ? mine : 1u; nx = cnt > 0u ? cnt : 1u;
}
__device__ __forceinline__ void grid_barrier(LAS unsigned char* lds) {
    volatile LAS unsigned* st = (volatile LAS unsigned*)(lds + LDS_CTL + 2048);
    asm volatile("s_waitcnt vmcnt(0)" ::: "memory");
    __syncthreads();
    if (otid() == 0) {
        unsigned* bar = (unsigned*)(argp()->ws + WS_CTL) + CW_BAR;
        const unsigned x = xb_xcc_id();
        __builtin_amdgcn_s_waitcnt(0);
        unsigned nloc = st[0], nx = st[1];
        if (nloc == 0u) { xcd_barrier_complete(bar, x, nloc, nx); st[0] = nloc; st[1] = nx; }
        const unsigned old = xb_add(&bar[XB_XSUB(x)], 1u);
        const unsigned gen = old / nloc;
        if (old + 1u == (gen + 1u) * nloc) {
            __builtin_amdgcn_fence(__ATOMIC_RELEASE, "agent");
            asm volatile("s_waitcnt vmcnt(0)" ::: "memory");
            const unsigned og = xb_add(&bar[XB_TOP], 1u);
            const unsigned tg = og / nx;
            if (og + 1u == (tg + 1u) * nx) xb_add(&bar[XB_TOPGEN], 1u);
            else XB_SPIN(xb_ld(&bar[XB_TOPGEN]) == tg, bar);
            __builtin_amdgcn_fence(__ATOMIC_ACQUIRE, "agent");
            xb_add(&bar[XB_XGEN(x)], 1u);
            asm volatile("s_waitcnt vmcnt(0)" ::: "memory");
        } else {
            XB_SPIN(xb_ld(&bar[XB_XGEN(x)]) == gen, bar);
            __builtin_amdgcn_fence(__ATOMIC_ACQUIRE, "agent");
            asm volatile("s_waitcnt vmcnt(0)" ::: "memory");
        }
    }
    __syncthreads();
}

#define PH_COMMON \
    KArgP ap = argp(); unsigned char* ws = ap->ws; (void)ws; \
    const int tid = otid(), lane = tid & 63, wid = tid >> 6; (void)lane; (void)wid; \
    const int G = ogrid(), bx = obid(), gw = bx * 8 + wid, NGW = G * 8; (void)gw; (void)NGW; \
    unsigned char* wt = ws + WS_WT; (void)wt; bf16* XB = (bf16*)(ws + WS_XB); (void)XB; bf16* PJ = (bf16*)(ws + WS_PROJ); (void)PJ; \
    unsigned char* dsc = (unsigned char*)ap->out; bf16* Y = (bf16*)(dsc + DO_Y); (void)Y; bf16* KV = (bf16*)(dsc + DO_KV); (void)KV; bf16* MEMB = (bf16*)(dsc + DO_MEMB); (void)MEMB;

__device__ __forceinline__ void ph_input(LAS unsigned char* lds) { PH_COMMON
    convert_rows(ap->x, XB, (size_t)NTOK * DM);
    convert_rows(ap->mem, MEMB, (size_t)NMEM * DM);
}
__device__ __forceinline__ void ph_weights(LAS unsigned char* lds, int l) { KArgP A = argp(); phase_convert_weights(A, l, lds); }
__device__ __forceinline__ void ph_proj(LAS unsigned char* lds, int l) { PH_COMMON
    pg8::Gemm g{1024, 1024, 1024};
    RegSched S{NTOK / 256, LP / 256, (NTOK / 256) * (LP / 256), G, bx, (const char*)XB, (const char*)(wt + WT_WIN), (size_t)256 * 1024 * 2, (size_t)256 * 1024 * 2, 0};
    pg8::EpiProj E{PJ, LP, (bf16*)(dsc + DO_HALO)};
    pg8::gemm_phase(lds, g, S, E);
}
__device__ __forceinline__ void ph_kv(LAS unsigned char* lds, int l) { PH_COMMON
    pg8::Gemm g{1024, 1024, 1024};
    if (bx < G - 128) return;
    RegSched S2{NMEM / 256, 2048 / 256, (NMEM / 256) * (2048 / 256), G, bx - (G - 128), (const char*)MEMB, (const char*)(wt + WT_WKV), (size_t)256 * 1024 * 2, (size_t)256 * 1024 * 2, 0};
    pg8::EpiStore E2{KV, 2048, 1.f};
    pg8::gemm_phase(lds, g, S2, E2);
}
__device__ __forceinline__ void ph_gdn_prep(LAS unsigned char* lds, int l) {
    KArgP A = argp();
    const int G = ogrid(), bx = obid();
    TMARK(20);
    if (bx < NB * 8) fox_ck_task(A, l, lds, bx >> 3, bx & 7);
    { GdnPre P, N; if (bx < NB * 4 * 32) gdn_prep_issue(P, A, l, bx >> 7, (bx >> 5) & 3, bx & 31);
      for (int t = bx; t < NB * 4 * 32; t += G) { const int t2 = t + G; const bool hn = t2 < NB * 4 * 32;
          gdn_prep_task(A, l, lds, t >> 7, (t >> 5) & 3, t & 31, P, hn, t2 >> 7, (t2 >> 5) & 3, t2 & 31, N);
          P = N; } }
    TMARK(21);
    { GlaPre P, N; if (bx < NB * 4 * 32) gla_prep_issue(P, A, bx >> 7, (bx >> 5) & 3, bx & 31);
      for (int t = bx; t < NB * 4 * 32; t += G) { const int t2 = t + G; const bool hn = t2 < NB * 4 * 32;
          gla_prep_task(A, l, lds, t >> 7, (t >> 5) & 3, t & 31, P, hn, t2 >> 7, (t2 >> 5) & 3, t2 & 31, N);
          P = N; } }
    TMARK(22);
}
__device__ __forceinline__ void ph_gla_scan(LAS unsigned char* lds, int l) { KArgP A = argp(); gla_state_scan(A); }
__device__ __forceinline__ void ph_mix(LAS unsigned char* lds, int l) {
    KArgP A = argp();
    const int bx = obid();
    TMARK(23);
    if (bx < 64) gdn_scan_chain(A, l, lds, bx >> 2, bx & 3);
    TMARK(24);
    unsigned* ctr = (unsigned*)(A->ws + WS_CTL) + 128 + l;
    volatile LAS int* qw = (volatile LAS int*)(lds + LDS_CTL + 2400);
    for (;;) {
        __syncthreads();
        if (otid() == 0) qw[0] = (int)atomicAdd(ctr, 1u);
        __syncthreads();
        const int u = qw[0];
        if (u >= NB * 8 * 8 + NB * 4 * 32) break;
        if (u < NB * 8 * 8) { TMARK(26); const int qb = 7 - (u >> 7), bh = u & 127; fox_unit(A, l, lds, bh >> 3, bh & 7, qb); TMARK(27); }
        else { TMARK(28); const int t = u - NB * 8 * 8; gla_out_task(A, l, lds, t >> 7, (t >> 5) & 3, t & 31); TMARK(29); }
    }
    TMARK(25);
}
#ifndef PROBE_MIX
#define PROBE_MIX 0
#endif
__device__ __forceinline__ void ph_mix_probe(LAS unsigned char* lds, int l) {
    KArgP A = argp();
    const int bx = obid();
    if (PROBE_MIX == 1) {
        unsigned* ctr = (unsigned*)(A->ws + WS_CTL) + 132 + l;
        volatile LAS int* qw = (volatile LAS int*)(lds + LDS_CTL + 2400);
        for (;;) { __syncthreads(); if (otid() == 0) qw[0] = (int)atomicAdd(ctr, 1u); __syncthreads(); const int u = qw[0]; if (u >= NB * 8 * 8) break;
            const int qb = 7 - (u >> 7), bh = u & 127; fox_unit(A, l, lds, bh >> 3, bh & 7, qb, 5152); }
    }
    else if (PROBE_MIX == 3) { if (bx < 64) gdn_scan_chain(A, l, lds, bx >> 2, bx & 3, 5152); }
    else if (PROBE_MIX == 4) { const int G = ogrid(); GdnPre P, N; for (int t = bx; t < NB * 4 * 32; t += G) { gdn_prep_issue(P, A, l, t >> 7, (t >> 5) & 3, t & 31); gdn_prep_task(A, l, lds, t >> 7, (t >> 5) & 3, t & 31, P, false, 0, 0, 0, N, true); } }
}
__device__ __forceinline__ void ph_branch(LAS unsigned char* lds, int l) { PH_COMMON
    pg8::Gemm g{LP, 512, 512};
    BranchSched S{NTOK / 256, (NTOK / 256) * 12, G, bx, (const char*)PJ, (const char*)(wt + WT_P)};
    pg8::EpiStore E{PJ, LP, 1.f};
    pg8::gemm_phase(lds, g, S, E);
}
__device__ __forceinline__ void ph_gate(LAS unsigned char* lds, int l) { PH_COMMON
    pg8::Gemm g{1024, 1024, 1024};
    GateSched S{NTOK / 256, (NTOK / 256) * 4, G, bx, (const char*)XB, (const char*)(wt + WT_WIN + (size_t)LP * 1024 * 2)};
    pg8::EpiGate E{PJ, LP, ap->b_merge + (size_t)l * 3072};
    pg8::gemm_phase(lds, g, S, E);
}
__device__ __forceinline__ void ph_out(LAS unsigned char* lds, int l) { PH_COMMON
    pg8::Gemm g{LP, 1024, 1024};
    RegSched S{NTOK / 256, 4, (NTOK / 256) * 4, G, bx, (const char*)PJ, (const char*)(wt + WT_WOUT3), (size_t)256 * LP * 2, (size_t)256 * 1024 * 2, 0};
    pg8::EpiResid E{XB, Y, 1024};
    pg8::gemm_phase(lds, g, S, E);
}
__device__ __forceinline__ void ph_ln1(LAS unsigned char* lds, int l) { PH_COMMON
    const float* gg = ap->ln1_g + l * 1024; const float* bb = ap->ln1_b + l * 1024;
    LnW W; ln_weights(W, gg, bb, lane);
    for (int row = gw; row < NTOK; row += NGW) { LnRow r; ln_load_bf16(r, Y + (size_t)row * 1024, lane, 1.f); ln_normalize_w(r, W); ln_store_bf16(r, XB + (size_t)row * 1024, lane); }
}
__device__ __forceinline__ void ph_q(LAS unsigned char* lds, int l) { PH_COMMON
    bf16* Qb = (bf16*)(ws + WS_PROJ + PJ_Q);
    pg8::Gemm g{1024, 1024, 1024};
    RegSched S{NTOK / 256, 4, (NTOK / 256) * 4, G, bx, (const char*)XB, (const char*)(wt + WT_WQ), (size_t)256 * 1024 * 2, (size_t)256 * 1024 * 2, 0};
    pg8::EpiStore E{Qb, 1024, 0.0625f * LOG2E};
    pg8::gemm_phase(lds, g, S, E);
}
__device__ __forceinline__ void ph_xattn(LAS unsigned char* lds, int l) { PH_COMMON
    bf16* Qb = (bf16*)(ws + WS_PROJ + PJ_Q); bf16* Ob = (bf16*)(ws + WS_PROJ + PJ_O);
    xattn_phase(lds, Qb, KV, Ob, G, bx);
}
__device__ __forceinline__ void ph_wo(LAS unsigned char* lds, int l) { PH_COMMON
    bf16* Ob = (bf16*)(ws + WS_PROJ + PJ_O);
    pg8::Gemm g{1024, 1024, 1024};
    RegSched S{NTOK / 256, 4, (NTOK / 256) * 4, G, bx, (const char*)Ob, (const char*)(wt + WT_WO), (size_t)256 * 1024 * 2, (size_t)256 * 1024 * 2, 0};
    pg8::EpiResid E{XB, Y, 1024};
    pg8::gemm_phase(lds, g, S, E);
}
__device__ __forceinline__ void ph_ln2_router(LAS unsigned char* lds, int l, int cnt_off = 0) { PH_COMMON
    unsigned* ctl = (unsigned*)(ws + WS_CTL);
    int* tokE = (int*)(ws + WS_SMALL + SM_TOKE); float* tokW = (float*)(ws + WS_SMALL + SM_TOKW); int* tokR = (int*)(ws + WS_SMALL + SM_TOKR);
    const int l15 = lane & 15, g = lane >> 4;
    constexpr int SX = 2064;
    LAS unsigned char* XH = lds; LAS unsigned char* XL = lds + 16 * SX;
    LAS float* PART = (LAS float*)(lds + 2 * 16 * SX);
    LAS float* LOG = PART + 8 * 16 * 48;
    unsigned* wcnt = ctl + 16384 + l * 8192 + cnt_off * 64;
    LAS unsigned* lcnt = (LAS unsigned*)(lds + LDS_CTL + 2560);
    const float* gg = ap->ln2_g + l * 1024; const float* bb = ap->ln2_b + l * 1024;
    const float* bgp = ap->moe_b_group + l * 4; const float* bep = ap->moe_b_expert + l * 32;
    bf16x8 bh[3][4], bl[3][4];
    { const bf16* RH = (const bf16*)(wt + WT_RWH); const bf16* RL = (const bf16*)(wt + WT_RWL);
#pragma unroll
      for (int nb = 0; nb < 3; ++nb)
#pragma unroll
          for (int kk = 0; kk < 4; ++kk) { const size_t off = (size_t)(nb * 16 + l15) * 1024 + (4 * wid + kk) * 32 + 8 * g; bh[nb][kk] = *(const bf16x8*)(RH + off); bl[nb][kk] = *(const bf16x8*)(RL + off); } }
    __syncthreads();
    if (tid < 32) lcnt[tid] = 0u;
    LnW LW; ln_weights(LW, gg, bb, lane);
    u32x4 yp[2][2];
    if (bx < NTOK / 16) {
#pragma unroll
        for (int q = 0; q < 2; ++q)
#pragma unroll
            for (int jj = 0; jj < 2; ++jj) yp[q][jj] = *(const u32x4*)(Y + ((size_t)bx * 16 + wid * 2 + q) * 1024 + 8 * (lane + 64 * jj)); }
    for (int bt = bx; bt < NTOK / 16; bt += G) {
#pragma unroll
        for (int q = 0; q < 2; ++q) { const int rl = wid * 2 + q; const size_t row = (size_t)bt * 16 + rl;
            LnRow r;
#pragma unroll
            for (int jj = 0; jj < 2; ++jj) { const u32x4 t = yp[q][jj];
                r.v[jj * 8 + 0] = bflo(t.x); r.v[jj * 8 + 1] = bfhi(t.x); r.v[jj * 8 + 2] = bflo(t.y); r.v[jj * 8 + 3] = bfhi(t.y);
                r.v[jj * 8 + 4] = bflo(t.z); r.v[jj * 8 + 5] = bfhi(t.z); r.v[jj * 8 + 6] = bflo(t.w); r.v[jj * 8 + 7] = bfhi(t.w); }
            if (bt + G < NTOK / 16) {
#pragma unroll
                for (int jj = 0; jj < 2; ++jj) yp[q][jj] = *(const u32x4*)(Y + ((size_t)(bt + G) * 16 + rl) * 1024 + 8 * (lane + 64 * jj)); }
            ln_normalize_w(r, LW); ln_store_bf16(r, XB + row * 1024, lane);
#pragma unroll
            for (int jj = 0; jj < 2; ++jj) { unsigned hw[4], lw[4];
#pragma unroll
                for (int e2 = 0; e2 < 4; ++e2) { const float a = r.v[jj * 8 + 2 * e2], c = r.v[jj * 8 + 2 * e2 + 1]; const unsigned ha = f2bf(a), hc = f2bf(c);
                    hw[e2] = ha | (hc << 16); lw[e2] = pk2(a - bf2f((unsigned short)ha), c - bf2f((unsigned short)hc)); }
                *(LAS u32x4*)(XH + rl * SX + (lane + 64 * jj) * 16) = (u32x4){hw[0], hw[1], hw[2], hw[3]};
                *(LAS u32x4*)(XL + rl * SX + (lane + 64 * jj) * 16) = (u32x4){lw[0], lw[1], lw[2], lw[3]}; } }
        __syncthreads();
        {
            f32x4 acc[3];
#pragma unroll
            for (int nb = 0; nb < 3; ++nb) acc[nb] = (f32x4){0.f, 0.f, 0.f, 0.f};
#pragma unroll
            for (int kk = 0; kk < 4; ++kk) { const bf16x8 ah = frag_rm(XH, SX, 0, 4 * wid + kk, l15, g), al = frag_rm(XL, SX, 0, 4 * wid + kk, l15, g);
#pragma unroll
                for (int nb = 0; nb < 3; ++nb) { acc[nb] = MFMA16(ah, bh[nb][kk], acc[nb]); acc[nb] = MFMA16(ah, bl[nb][kk], acc[nb]); acc[nb] = MFMA16(al, bh[nb][kk], acc[nb]); } }
#pragma unroll
            for (int nb = 0; nb < 3; ++nb)
#pragma unroll
                for (int r = 0; r < 4; ++r) PART[(wid * 16 + 4 * g + r) * 48 + nb * 16 + l15] = acc[nb][r];
        }
        __syncthreads();
        for (int p = tid; p < 16 * 48; p += 512) { float s = 0.f;
#pragma unroll
            for (int w = 0; w < 8; ++w) s += PART[w * 16 * 48 + p];
            LOG[p] = s; }
        __syncthreads();
        if (tid < 16) { const size_t row = (size_t)bt * 16 + tid; const LAS float* lg = LOG + tid * 48;
            float gl[4];
#pragma unroll
            for (int c = 0; c < 4; ++c) gl[c] = lg[c] + bgp[c];
            int gsel = 0; float gm = gl[0];
#pragma unroll
            for (int c = 1; c < 4; ++c) if (gl[c] > gm) { gm = gl[c]; gsel = c; }
            float gsum = 0.f;
#pragma unroll
            for (int c = 0; c < 4; ++c) gsum += __expf(gl[c] - gm);
            const float ptop = 1.f / gsum;
            float el[8];
#pragma unroll
            for (int jx = 0; jx < 8; ++jx) el[jx] = lg[4 + gsel * 8 + jx] + bep[gsel * 8 + jx];
            int e0 = 0; float m0 = el[0];
#pragma unroll
            for (int jx = 1; jx < 8; ++jx) if (el[jx] > m0) { m0 = el[jx]; e0 = jx; }
            int e1 = -1; float m1 = -3.0e38f;
#pragma unroll
            for (int jx = 0; jx < 8; ++jx) if (jx != e0 && el[jx] > m1) { m1 = el[jx]; e1 = jx; }
            const float ex = __expf(m1 - m0); const float w0 = ptop / (1.f + ex), w1 = ptop * ex / (1.f + ex);
            const int ge0 = gsel * 8 + e0, ge1 = gsel * 8 + e1;
            const int r0 = (int)__hip_atomic_fetch_add(lcnt + ge0, 1u, __ATOMIC_RELAXED, __HIP_MEMORY_SCOPE_WORKGROUP), r1 = (int)__hip_atomic_fetch_add(lcnt + ge1, 1u, __ATOMIC_RELAXED, __HIP_MEMORY_SCOPE_WORKGROUP);
            tokE[row * 2] = ge0; tokE[row * 2 + 1] = ge1; tokW[row * 2] = w0; tokW[row * 2 + 1] = w1; tokR[row * 2] = r0; tokR[row * 2 + 1] = r1; }
    }
    __syncthreads();
    if (tid < 32) wcnt[bx * 32 + tid] = lcnt[tid];
}
__device__ __forceinline__ void ph_dispatch(LAS unsigned char* lds, int l) { PH_COMMON
    unsigned* ctl = (unsigned*)(ws + WS_CTL);
    int* tokE = (int*)(ws + WS_SMALL + SM_TOKE); int* tokR = (int*)(ws + WS_SMALL + SM_TOKR); int* tokS = (int*)(ws + WS_SMALL + SM_TOKS);
    int* slotTok = (int*)(ws + WS_SMALL + SM_SLOTTOK);
    LAS int* tab = (LAS int*)(lds + LDS_CTL);
    __syncthreads();
    {
        const unsigned* wcnt = ctl + 16384 + l * 8192;
        LAS int* red = (LAS int*)lds;
        const int e = tid & 31, part = tid >> 5; int tot = 0, pre = 0;
        for (int w = part; w < G; w += 16) { const int c = (int)wcnt[w * 32 + e]; tot += c; if (w < bx) pre += c; }
        red[(part * 32 + e) * 2] = tot; red[(part * 32 + e) * 2 + 1] = pre;
        __syncthreads();
        if (tid < 32) { int t2 = 0, p2 = 0; for (int p = 0; p < 16; ++p) { t2 += red[(p * 32 + tid) * 2]; p2 += red[(p * 32 + tid) * 2 + 1]; } tab[360 + tid] = t2; tab[400 + tid] = p2; }
        __syncthreads();
    }
    if (tid == 0) { int ps = 0, nb = 0;
        for (int e = 0; e < 32; ++e) { const int c = tab[360 + e]; const int nbe = (c + 255) >> 8; tab[320 + e] = ps;
            for (int q = 0; q < nbe; ++q) tab[1 + nb + q] = e; nb += nbe; ps += nbe * 256; }
        tab[352] = ps; tab[0] = nb; }
    __syncthreads();
    for (int i = tid; ; i += 512) { const int bt = bx + (i >> 4) * G; if (bt >= NTOK / 16) break; const int row = bt * 16 + (i & 15);
        const int e0 = tokE[row * 2], e1 = tokE[row * 2 + 1]; const int s0 = tab[320 + e0] + tab[400 + e0] + tokR[row * 2], s1 = tab[320 + e1] + tab[400 + e1] + tokR[row * 2 + 1];
        tokS[row * 2] = s0; tokS[row * 2 + 1] = s1; slotTok[s0] = row; slotTok[s1] = row;
    }
    for (int e = 0; e < 32; ++e) { const int c = tab[360 + e], st = tab[320 + e] + c, en = tab[320 + e] + (((c + 255) >> 8) << 8);
        for (int rr = st + bx * 512 + tid; rr < en; rr += G * 512) slotTok[rr] = 0; }
}
__device__ __forceinline__ void ph_moe_gu(LAS unsigned char* lds, int l) { PH_COMMON
    bf16* Hb = (bf16*)(ws + WS_PROJ + PJ_H);
    const int* slotTok = (const int*)(ws + WS_SMALL + SM_SLOTTOK);
    const LAS int* tab = (const LAS int*)(lds + LDS_CTL);
    LAS int* gtab = (LAS int*)(lds + LDS_X);
    __syncthreads();
    { const int nu = tab[0] * 2;
      for (int j = 0; j < 4; ++j) { const int L = j * G + bx; if (L >= nu) break; const int rb = L >> 1; if (tid < 256) gtab[j * 256 + tid] = slotTok[rb * 256 + tid]; } }
    __syncthreads();
    pg8::Gemm g{1024, 1024, 1024};
    MoeSched S{2, G, bx, tab, (const char*)XB, 0, (const char*)(wt + WT_GU), (size_t)512 * 1024 * 2, (size_t)256 * 1024 * 2};
    pg8::EpiSwiglu E{Hb, 256};
    pg8::gemm_phase_gather(lds, g, S, E, (const char*)XB, gtab);
}
__device__ __forceinline__ void ph_moe_dn(LAS unsigned char* lds, int l) { PH_COMMON
    bf16* Hb = (bf16*)(ws + WS_PROJ + PJ_H); bf16* YS = (bf16*)(ws + WS_PROJ + PJ_YS);
    const LAS int* tab = (const LAS int*)(lds + LDS_CTL);
    pg8::Gemm g{256, 256, 256};
    MoeSched S{4, G, bx, tab, (const char*)Hb, (size_t)256 * 256 * 2, (const char*)(wt + WT_DN), (size_t)1024 * 256 * 2, (size_t)256 * 256 * 2};
    pg8::EpiStore E{YS, 1024, 1.f};
    pg8::gemm_phase(lds, g, S, E);
}
__device__ __forceinline__ void ph_ln3(LAS unsigned char* lds, int l) { PH_COMMON
    float* tokW = (float*)(ws + WS_SMALL + SM_TOKW); int* tokS = (int*)(ws + WS_SMALL + SM_TOKS);
    bf16* YS = (bf16*)(ws + WS_PROJ + PJ_YS);
    const float* gg = ap->ln3_g + l * 1024; const float* bb = ap->ln3_b + l * 1024;
    float* out = ap->out;
    LnW W; ln_weights(W, gg, bb, lane);
    for (int row = gw; row < NTOK; row += NGW) {
        LnRow r; ln_load_bf16(r, XB + (size_t)row * 1024, lane, ALPHA);
        ln_add_bf16(r, YS + (size_t)tokS[row * 2] * 1024, lane, tokW[row * 2]); ln_add_bf16(r, YS + (size_t)tokS[row * 2 + 1] * 1024, lane, tokW[row * 2 + 1]);
        ln_normalize_w(r, W);
        if (l == DEPTH - 1) ln_store_f32(r, out + (size_t)row * 1024, lane); else ln_store_bf16(r, XB + (size_t)row * 1024, lane);
    }
}

#define GSYNC() grid_barrier(lds)
template <int l> __device__ __forceinline__ void layer_body(LAS unsigned char* lds) {

        TMARK(0);
        if (PH_MASK & 2) { ph_proj(lds, l); ph_kv(lds, l); }
        if (REP_MASK & 2) { GSYNC(); ph_proj(lds, l); ph_kv(lds, l); }
        GSYNC();
        TMARK(1);
        if (PH_MASK & 4) { if (PROBE_MIX == 4) { ph_mix_probe(lds, l); GSYNC(); } ph_gdn_prep(lds, l); GSYNC(); TMARK(2); ph_gla_scan(lds, l); GSYNC(); TMARK(3); if (PROBE_MIX && PROBE_MIX != 4) { ph_mix_probe(lds, l); GSYNC(); } ph_mix(lds, l); }
        GSYNC();
        TMARK(4);
        if (PH_MASK & 8) ph_branch(lds, l);
        if (REP_MASK & 8) { GSYNC(); ph_branch(lds, l); }
        GSYNC();
        TMARK(5);
        if (PH_MASK & 16) ph_gate(lds, l);
        if (REP_MASK & 16) { GSYNC(); ph_gate(lds, l); }
        GSYNC();
        TMARK(6);
        if (PH_MASK & 32) ph_out(lds, l);
        if (REP_MASK & 32) { GSYNC(); ph_out(lds, l); }
        GSYNC();
        TMARK(7);
        if (PH_MASK & 64) ph_ln1(lds, l);
        if (REP_MASK & 64) { GSYNC(); ph_ln1(lds, l); }
        GSYNC();
        TMARK(8);
        if (PH_MASK & 128) ph_q(lds, l);
        if (REP_MASK & 128) { GSYNC(); ph_q(lds, l); }
        GSYNC();
        TMARK(9);
        if (PH_MASK & 256) ph_xattn(lds, l);
        if (REP_MASK & 256) { GSYNC(); ph_xattn(lds, l); }
        GSYNC();
        TMARK(10);
        if (PH_MASK & 512) ph_wo(lds, l);
        if (REP_MASK & 512) { GSYNC(); ph_wo(lds, l); }
        GSYNC();
        TMARK(11);
        if (REP_MASK & 1024) { ph_ln2_router(lds, l, 512); GSYNC(); }
        if (PH_MASK & 1024) ph_ln2_router(lds, l);
        GSYNC();
        TMARK(12);
        if (PH_MASK & 2048) ph_dispatch(lds, l);
        if (REP_MASK & 2048) { GSYNC(); ph_dispatch(lds, l); }
        GSYNC();
        TMARK(13);
        if (PH_MASK & 4096) ph_moe_gu(lds, l);
        if (REP_MASK & 4096) { GSYNC(); ph_moe_gu(lds, l); }
        GSYNC();
        TMARK(14);
        if (PH_MASK & 8192) ph_moe_dn(lds, l);
        if (REP_MASK & 8192) { GSYNC(); ph_moe_dn(lds, l); }
        GSYNC();
        TMARK(15);
        if (PH_MASK & 16384) ph_ln3(lds, l);
        if ((REP_MASK & 16384) && l == DEPTH - 1) { GSYNC(); ph_ln3(lds, l); }
        if (l + 1 < DEPTH) { if (PH_MASK & 1) ph_weights(lds, l + 1); GSYNC(); }
        TMARK(16);
}

__global__ void __launch_bounds__(512, 2) mega_fwd(Args A_unused) {
    extern __shared__ __attribute__((aligned(16))) unsigned char lds_raw[];
    LAS unsigned char* lds = (LAS unsigned char*)lds_raw;
    cg::grid_group grid = cg::this_grid();
    {
        volatile LAS unsigned* st = (volatile LAS unsigned*)(lds + LDS_CTL + 2048);
        if (threadIdx.x < 2) st[threadIdx.x] = 0u;
        if (threadIdx.x == 0) { unsigned* bar = (unsigned*)(argp()->ws + WS_CTL) + CW_BAR; (void)xb_add(&bar[XB_XCNT(xb_xcc_id())], 1u); }
        __syncthreads();
    }
    ph_input(lds);
    if (PH_MASK & 1) ph_weights(lds, 0);
    if (argp()->ws == nullptr) grid.sync();
    GSYNC();
    if (TIMER_A >= 0 || TIMER_B >= 0) { if (otid() < 2) ((volatile LAS unsigned*)(lds + LDS_CTL + 2800))[otid()] = 0u; }
    layer_body<0>(lds);
    layer_body<1>(lds);
    if (TIMER_A >= 0 || TIMER_B >= 0) {
        GSYNC();
        if (obid() == TIMER_WG) { volatile LAS unsigned* tw = (volatile LAS unsigned*)(lds + LDS_CTL + 2800); float* out = argp()->out;
            if (TIMER_A >= 0) { const int nz = (tw[0] / 100u > (unsigned)TIMER_T) ? 16000 : 0; for (int i = otid(); i < nz * 1024; i += 512) out[i] = 0.f; }
            if (TIMER_B >= 0 && otid() == 0) out[(size_t)NTOK * 1024 - 1] = (float)(tw[1] / 100u) * 0.25f; }
    }
}

extern "C" void kernel_launch(void* const* d_in, const int* in_sizes, int n_in, void* d_out, int out_size, void* d_ws, size_t ws_size, hipStream_t stream) {
    static int grid = 0;
    if (grid == 0) {
        if (n_in != 32 || out_size != NTOK * DM || ws_size < WS_END) { fprintf(stderr, "kernel_launch: unexpected shapes (n_in %d out %d ws %zu)\n", n_in, out_size, ws_size); grid = -1; return; }
        int dev = 0, cus = 0, per_cu = 0;
        hipGetDevice(&dev); hipDeviceGetAttribute(&cus, hipDeviceAttributeMultiprocessorCount, dev);
        hipFuncSetAttribute((const void*)mega_fwd, hipFuncAttributeMaxDynamicSharedMemorySize, LDS_BYTES);
        hipOccupancyMaxActiveBlocksPerMultiprocessor(&per_cu, (const void*)mega_fwd, 512, LDS_BYTES);
        (void)hipGetLastError();
        if (per_cu < 1) { fprintf(stderr, "kernel_launch: occupancy query says %d blocks per CU\n", per_cu); grid = -1; return; }
        grid = cus;
        if (grid < 192) { fprintf(stderr, "kernel_launch: too few CUs (%d)\n", grid); grid = -1; return; }
    }
    if (grid < 0) return;
    hipMemsetAsync((char*)d_ws + WS_CTL, 0, 1 * MiB, stream);
    Args a{};
    const float** p = (const float**)&a;
    for (int i = 0; i < 32; ++i) p[i] = (const float*)d_in[i];
    a.out = (float*)d_out; a.ws = (unsigned char*)d_ws;
    void* args[] = {&a};
    hipError_t e = hipLaunchCooperativeKernel((const void*)mega_fwd, dim3(grid), dim3(512), args, LDS_BYTES, stream);
    if (e != hipSuccess) fprintf(stderr, "cooperative launch failed: %s (grid %d)\n", hipGetErrorString(e), grid);
}
```

```cpp
#include <hip/hip_runtime.h>
#include <hip/hip_cooperative_groups.h>
#include <cstdio>
#include <cstdint>
namespace cg = cooperative_groups;

#define LAS __attribute__((address_space(3)))
typedef unsigned short bf16;
typedef short bf16x8 __attribute__((ext_vector_type(8)));
typedef short s16x4 __attribute__((ext_vector_type(4)));
typedef float f32x4 __attribute__((ext_vector_type(4)));
typedef float f32x2 __attribute__((ext_vector_type(2)));
typedef unsigned u32x4 __attribute__((ext_vector_type(4)));
typedef unsigned u32x2 __attribute__((ext_vector_type(2)));

#ifndef PH_MASK
#define PH_MASK 0xFFFFFFFFu
#endif
#ifndef REP_MASK
#define REP_MASK 0u
#endif
constexpr int DM = 1024, NB = 16, SEQ = 2048, NTOK = NB * SEQ, MEMLEN = 256, NMEM = NB * MEMLEN, DEPTH = 2;
constexpr int N_IN = 8224;
constexpr int LP = 5376;
constexpr int C_OA = 0;
constexpr int C_OB = 512;
constexpr int C_OC = 1024;
constexpr int C_GQ = 1536, C_GK = 2048, C_GV = 2560;
constexpr int C_FK = 3072, C_FV = 3584;
constexpr int C_LQ = 4096, C_LK = 4352, C_LV = 4608;
constexpr int C_SM = 5120;
constexpr int C_T = 1536;
constexpr int NWIN = 8448;
constexpr float ALPHA = 1.4142135623730951f;
constexpr float LOG2E = 1.4426950408889634f;
constexpr int MAXSLOT = 73728;
constexpr int MAXBLK = MAXSLOT / 256;

constexpr size_t MiB = 1u << 20;
constexpr size_t WS_CTL = 0;
constexpr size_t WS_WT = 1 * MiB;
constexpr size_t WT_WIN = 0;
constexpr size_t WT_P = WT_WIN + (size_t)NWIN * 1024 * 2;
constexpr size_t WT_WOUT3 = WT_P + 3u * 1024 * 512 * 2;
constexpr size_t WT_WQ = WT_WOUT3 + (size_t)1024 * 3072 * 2;
constexpr size_t WT_WKV = WT_WQ + (size_t)1024 * 1024 * 2;
constexpr size_t WT_WO = WT_WKV + (size_t)2048 * 1024 * 2;
constexpr size_t WT_GU = WT_WO + (size_t)1024 * 1024 * 2;
constexpr size_t WT_DN = WT_GU + (size_t)32 * 512 * 1024 * 2;
constexpr size_t WT_RWH = WT_DN + (size_t)32 * 1024 * 256 * 2;
constexpr size_t WT_RWL = WT_RWH + 48 * 1024 * 2;
constexpr size_t WT_END = WT_RWL + 48 * 1024 * 2;
static_assert(WT_END <= 82 * MiB, "WT");
constexpr size_t WS_XB = 83 * MiB;
constexpr size_t WS_PROJ = 147 * MiB;
constexpr size_t WS_SMALL = 483 * MiB;
constexpr size_t SM_TOKE = 0;
constexpr size_t SM_TOKW = SM_TOKE + (size_t)NTOK * 8;
constexpr size_t SM_TOKR = SM_TOKW + (size_t)NTOK * 8;
constexpr size_t SM_TOKS = SM_TOKR + (size_t)NTOK * 8;
constexpr size_t SM_SLOTTOK = SM_TOKS + (size_t)NTOK * 8;
constexpr size_t WS_KVS = 485 * MiB;
constexpr size_t WS_CDB = 511 * MiB;
constexpr size_t WS_END = 512 * MiB;
constexpr size_t PJ_Q = 0, PJ_O = 64 * MiB;
constexpr size_t PJ_XG = 0, PJ_H = 144 * MiB, PJ_YS = 180 * MiB;
constexpr size_t DO_Y = 0, DO_KV = 88 * MiB, DO_MEMB = 104 * MiB, DO_HALO = 112 * MiB;
constexpr size_t DO_CKG = 118 * MiB;
constexpr size_t DO_KVS = 82 * MiB;
constexpr size_t DO_GP = 0;
constexpr size_t DO_STAT = 120 * MiB;
constexpr size_t DO_CD = 124 * MiB;
constexpr size_t DO_LIST = 125 * MiB;
constexpr int GP_W = 0, GP_KDT = 16384, GP_ATT = 32768, GP_CD = 40960, GP_STRIDE = 41216;

constexpr int RING_BYTES = 131072;
constexpr int LDS_X = 131072;
constexpr int LDS_CTL = 147456;
constexpr int LDS_BYTES = 151552;

__device__ __forceinline__ int otid() { int t = threadIdx.x; asm volatile("" : "+v"(t)); return t; }
__device__ __forceinline__ int obid() { int t = blockIdx.x; asm volatile("" : "+s"(t)); return t; }
__device__ __forceinline__ int ogrid() { int t = gridDim.x; asm volatile("" : "+s"(t)); return t; }
__device__ __forceinline__ unsigned f2bf(float f) { unsigned u = __builtin_bit_cast(unsigned, f); return (u + 0x7fffu + ((u >> 16) & 1u)) >> 16; }
typedef __bf16 hwbf16x2 __attribute__((ext_vector_type(2)));
__device__ __forceinline__ unsigned pk2(float lo, float hi) { const f32x2 v = {lo, hi}; return __builtin_bit_cast(unsigned, __builtin_convertvector(v, hwbf16x2)); }
__device__ __forceinline__ float bf2f(unsigned short b) { return __builtin_bit_cast(float, (unsigned)b << 16); }
__device__ __forceinline__ float bflo(unsigned w) { return __builtin_bit_cast(float, w << 16); }
__device__ __forceinline__ float bfhi(unsigned w) { return __builtin_bit_cast(float, w & 0xffff0000u); }
template <int M> __device__ __forceinline__ float swz_xor(float v) { return __builtin_bit_cast(float, __builtin_amdgcn_ds_swizzle(__builtin_bit_cast(int, v), 0x1f | (M << 10))); }
__device__ __forceinline__ float half_sum(float v) { const unsigned b = __builtin_bit_cast(unsigned, v); auto r = __builtin_amdgcn_permlane32_swap(b, b, false, false); return __builtin_bit_cast(float, (unsigned)r[0]) + __builtin_bit_cast(float, (unsigned)r[1]); }
__device__ __forceinline__ float wave_sum(float v) {
    v += swz_xor<1>(v); v += swz_xor<2>(v); v += swz_xor<4>(v); v += swz_xor<8>(v); v += swz_xor<16>(v);
    return half_sum(v);
}
__device__ __forceinline__ float sigmoidf_(float x) { return __builtin_amdgcn_rcpf(1.f + __builtin_amdgcn_exp2f(-LOG2E * x)); }
__device__ __forceinline__ float siluf_(float x) { return x * __builtin_amdgcn_rcpf(1.f + __builtin_amdgcn_exp2f(-LOG2E * x)); }
__device__ __forceinline__ float softplusf_(float x) { return fmaxf(x, 0.f) + __logf(1.f + __expf(-fabsf(x))); }
__device__ __forceinline__ float logsigmoidf_(float x) { return fminf(x, 0.f) - __logf(1.f + __expf(-fabsf(x))); }

namespace pg8 {
constexpr int BM = 256, BK = 64, HALF = 128, HTB = HALF * BK * 2, STAGE_BYTES = 8 * HTB;
__host__ __device__ __forceinline__ int lds_byte(int r, int c) { const int st = (r >> 4) * 2 + (c >> 5), rr = r & 15, cc = c & 31, ob = rr * 64 + cc * 2; return st * 1024 + (ob ^ (((ob >> 9) & 1) << 5)); }
__host__ __device__ __forceinline__ void stage_rc(int b, int& R, int& C) { const int st = b / 1024, sb = b % 1024, swz = sb ^ (((sb >> 9) & 1) << 5); R = (st >> 1) * 16 + swz / 64; C = (st & 1) * 32 + (swz % 64) / 2; }
__host__ __device__ __forceinline__ int perm32(int rho) { const int n = rho >> 4, i = rho & 15; return 8 * (i >> 2) + 4 * n + (i & 3); }

struct Unit { const char* a; const char* b; int row0, col0, aux, aux2; };
struct Gemm { int lda, ldb, K; };

template <class Epi, class Sched>
__device__ __forceinline__ void gemm_phase(LAS unsigned char* lds, const Gemm g, const Sched& S, const Epi& E) {
    const int tid = otid(), wid = __builtin_amdgcn_readfirstlane(tid >> 6), lane = tid & 63, wr = wid >> 2, wc = wid & 3, fr = lane & 15, fq = lane >> 4;
    int K = g.K; asm volatile("" : "+s"(K)); const int nt = K / BK;
    unsigned voffA[2], voffB[2];
#pragma unroll
    for (int i = 0; i < 2; ++i) { int R, C; stage_rc(tid * 16 + i * 8192, R, C); const int Rb = Epi::PERM ? ((R & ~31) + perm32(R & 31)) : R;
        voffA[i] = (unsigned)(R * g.lda + C) * 2u; voffB[i] = (unsigned)(Rb * g.ldb + C) * 2u; }
    const size_t kstep = (size_t)(BK * 2);
    const size_t hstepA = (size_t)HALF * g.lda * 2, hstepB = (size_t)HALF * g.ldb * 2;
    const unsigned ldsw = (unsigned)wid * 1024u;
    const int aoff = lds_byte(wr * 64 + fr, fq * 8), boff = lds_byte(wc * 32 + fr, fq * 8);
#define PG8_SA(b, h) (((b) * 2 + (h)) * HTB)
#define PG8_SB(b, h) ((4 + (b) * 2 + (h)) * HTB)
#define PG8_STAGE(bufoff, gbase, voff) do { _Pragma("unroll") for (int _i = 0; _i < 2; ++_i) \
        __builtin_amdgcn_global_load_lds((const unsigned*)((const char*)(gbase) + (voff)[_i]), (LAS unsigned*)(lds + (bufoff) + ldsw + _i * 8192), 16, 0, 0); } while (0)
#define PG8_LDA(dst, b, h) do { _Pragma("unroll") for (int m = 0; m < 4; ++m) _Pragma("unroll") for (int k = 0; k < 2; ++k) dst[m][k] = *(const LAS bf16x8*)(lds + PG8_SA(b, h) + aoff + m * 2048 + k * 1024); } while (0)
#define PG8_LDB(dst, b, h) do { _Pragma("unroll") for (int n = 0; n < 2; ++n) _Pragma("unroll") for (int k = 0; k < 2; ++k) dst[n][k] = *(const LAS bf16x8*)(lds + PG8_SB(b, h) + boff + n * 2048 + k * 1024); } while (0)
#define PG8_MMA(ai, bj, At, Bt) do { __builtin_amdgcn_s_setprio(1); _Pragma("unroll") for (int m = 0; m < 4; ++m) _Pragma("unroll") for (int n = 0; n < 2; ++n) _Pragma("unroll") for (int k = 0; k < 2; ++k) \
        acc[ai][bj][m][n] = __builtin_amdgcn_mfma_f32_16x16x32_bf16(Bt[n][k], At[m][k], acc[ai][bj][m][n], 0, 0, 0); __builtin_amdgcn_s_setprio(0); } while (0)
#define PG8_WAIT_V(n) asm volatile("s_waitcnt vmcnt(" #n ")" ::: "memory")
#define PG8_WAIT_L(n) asm volatile("s_waitcnt lgkmcnt(" #n ")" ::: "memory")
#define PG8_BAR __builtin_amdgcn_s_barrier()
#define PG8_SCHED __builtin_amdgcn_sched_barrier(0)
    Unit cur, nxt; int ui = 0;
    if (!S.next(0, cur)) return;
    f32x4 acc[2][2][4][2];
#pragma unroll
    for (int a = 0; a < 2; ++a)
#pragma unroll
        for (int b = 0; b < 2; ++b)
#pragma unroll
            for (int m = 0; m < 4; ++m)
#pragma unroll
                for (int n = 0; n < 2; ++n) acc[a][b][m][n] = (f32x4){0.f, 0.f, 0.f, 0.f};
    bf16x8 At[4][2], B0[2][2], B1[2][2];
    const char* cA = cur.a; const char* cB = cur.b;
    PG8_STAGE(PG8_SB(0, 0), cB, voffB); PG8_STAGE(PG8_SB(0, 1), cB + hstepB, voffB); PG8_STAGE(PG8_SA(0, 0), cA, voffA); PG8_STAGE(PG8_SA(0, 1), cA + hstepA, voffA);
    if (wr == 1) PG8_BAR;
    PG8_WAIT_V(2); PG8_BAR;
    PG8_STAGE(PG8_SB(1, 0), cB + kstep, voffB); PG8_STAGE(PG8_SA(1, 0), cA + kstep, voffA); PG8_STAGE(PG8_SB(1, 1), cB + hstepB + kstep, voffB);
    PG8_WAIT_V(6); PG8_BAR;
    for (;;) {
        const bool has_next = S.next(ui + 1, nxt);
        const char* nA = has_next ? nxt.a : cA; const char* nB = has_next ? nxt.b : cB;
        asm volatile(".p2align 6" ::: "memory");
        for (int t = 0; t < nt; t += 2) {
            const bool last = (t == nt - 2);
            const char* a1 = cA + (size_t)(t + 1) * kstep;
            const char* a2 = last ? nA : cA + (size_t)(t + 2) * kstep; const char* b2 = last ? nB : cB + (size_t)(t + 2) * kstep;
            const char* a3 = a2 + kstep; const char* b3 = b2 + kstep;
            PG8_LDB(B0, 0, 0); PG8_LDB(B1, 0, 1); PG8_SCHED; PG8_LDA(At, 0, 0); PG8_STAGE(PG8_SA(1, 1), a1 + hstepA, voffA);
            PG8_WAIT_V(8); PG8_WAIT_L(0); PG8_BAR; PG8_MMA(0, 0, At, B0); PG8_MMA(0, 1, At, B1); PG8_BAR; PG8_SCHED;
            PG8_LDA(At, 0, 1); PG8_STAGE(PG8_SB(0, 0), b2, voffB); PG8_STAGE(PG8_SB(0, 1), b2 + hstepB, voffB); PG8_STAGE(PG8_SA(0, 0), a2, voffA);
            PG8_WAIT_V(8); PG8_WAIT_L(0); PG8_BAR; PG8_MMA(1, 0, At, B0); PG8_MMA(1, 1, At, B1); PG8_BAR; PG8_SCHED;
            PG8_LDB(B0, 1, 0); PG8_LDB(B1, 1, 1); PG8_SCHED; PG8_LDA(At, 1, 0); PG8_STAGE(PG8_SA(0, 1), a2 + hstepA, voffA);
            PG8_WAIT_V(8); PG8_WAIT_L(0); PG8_BAR; PG8_MMA(0, 0, At, B0); PG8_MMA(0, 1, At, B1); PG8_BAR; PG8_SCHED;
            PG8_LDA(At, 1, 1); PG8_STAGE(PG8_SB(1, 0), b3, voffB); PG8_STAGE(PG8_SB(1, 1), b3 + hstepB, voffB); PG8_STAGE(PG8_SA(1, 0), a3, voffA);
            PG8_WAIT_V(8); PG8_WAIT_L(0); PG8_BAR; PG8_MMA(1, 0, At, B0); PG8_MMA(1, 1, At, B1); PG8_BAR; PG8_SCHED;
        }
        if (wr == 0) PG8_BAR;
        E(acc, cur, wr, wc, fr, fq);
        if (!has_next) break;
#pragma unroll
        for (int a = 0; a < 2; ++a)
#pragma unroll
            for (int b = 0; b < 2; ++b)
#pragma unroll
                for (int m = 0; m < 4; ++m)
#pragma unroll
                    for (int n = 0; n < 2; ++n) acc[a][b][m][n] = (f32x4){0.f, 0.f, 0.f, 0.f};
        cur = nxt; cA = nA; cB = nB; ++ui;
        if (wr == 1) PG8_BAR;
    }
    PG8_WAIT_V(0);
    PG8_BAR;
#undef PG8_SA
#undef PG8_SB
#undef PG8_STAGE
#undef PG8_LDA
#undef PG8_LDB
#undef PG8_MMA
#undef PG8_WAIT_V
#undef PG8_WAIT_L
#undef PG8_BAR
#undef PG8_SCHED
}

template <class Epi0, class Epi1, class Sched>
__device__ __forceinline__ void gemm_phase_mix(LAS unsigned char* lds, const Gemm g0, const Gemm g1, const Sched& S, const Epi0& E0, const Epi1& E1) {
    const int tid = otid(), wid = __builtin_amdgcn_readfirstlane(tid >> 6), lane = tid & 63, wr = wid >> 2, wc = wid & 3, fr = lane & 15, fq = lane >> 4;
    int K0 = g0.K, K1 = g1.K; asm volatile("" : "+s"(K0), "+s"(K1)); int ntc = K0 / BK, ntn = K1 / BK;
    unsigned vAc[2], vBc[2], vAn[2], vBn[2];
#pragma unroll
    for (int i = 0; i < 2; ++i) { int R, C; stage_rc(tid * 16 + i * 8192, R, C); const int Rb = (R & ~31) + perm32(R & 31);
        vAc[i] = (unsigned)(R * g0.lda + C) * 2u; vBc[i] = (unsigned)(Rb * g0.ldb + C) * 2u; vAn[i] = (unsigned)(R * g1.lda + C) * 2u; vBn[i] = (unsigned)(Rb * g1.ldb + C) * 2u; }
    const size_t kstep = (size_t)(BK * 2);
    size_t hAc = (size_t)HALF * g0.lda * 2, hBc = (size_t)HALF * g0.ldb * 2, hAn = (size_t)HALF * g1.lda * 2, hBn = (size_t)HALF * g1.ldb * 2;
    int kind = 0;
    const unsigned ldsw = (unsigned)wid * 1024u;
    const int aoff = lds_byte(wr * 64 + fr, fq * 8), boff = lds_byte(wc * 32 + fr, fq * 8);
#define PG8_SA(b, h) (((b) * 2 + (h)) * HTB)
#define PG8_SB(b, h) ((4 + (b) * 2 + (h)) * HTB)
#define PG8_STAGE(bufoff, gbase, voff) do { _Pragma("unroll") for (int _i = 0; _i < 2; ++_i) \
        __builtin_amdgcn_global_load_lds((const unsigned*)((const char*)(gbase) + (voff)[_i]), (LAS unsigned*)(lds + (bufoff) + ldsw + _i * 8192), 16, 0, 0); } while (0)
#define PG8_LDA(dst, b, h) do { _Pragma("unroll") for (int m = 0; m < 4; ++m) _Pragma("unroll") for (int k = 0; k < 2; ++k) dst[m][k] = *(const LAS bf16x8*)(lds + PG8_SA(b, h) + aoff + m * 2048 + k * 1024); } while (0)
#define PG8_LDB(dst, b, h) do { _Pragma("unroll") for (int n = 0; n < 2; ++n) _Pragma("unroll") for (int k = 0; k < 2; ++k) dst[n][k] = *(const LAS bf16x8*)(lds + PG8_SB(b, h) + boff + n * 2048 + k * 1024); } while (0)
#define PG8_MMA(ai, bj, At, Bt) do { __builtin_amdgcn_s_setprio(1); _Pragma("unroll") for (int m = 0; m < 4; ++m) _Pragma("unroll") for (int n = 0; n < 2; ++n) _Pragma("unroll") for (int k = 0; k < 2; ++k) \
        acc[ai][bj][m][n] = __builtin_amdgcn_mfma_f32_16x16x32_bf16(Bt[n][k], At[m][k], acc[ai][bj][m][n], 0, 0, 0); __builtin_amdgcn_s_setprio(0); } while (0)
#define PG8_WAIT_V(n) asm volatile("s_waitcnt vmcnt(" #n ")" ::: "memory")
#define PG8_WAIT_L(n) asm volatile("s_waitcnt lgkmcnt(" #n ")" ::: "memory")
#define PG8_BAR __builtin_amdgcn_s_barrier()
#define PG8_SCHED __builtin_amdgcn_sched_barrier(0)
    Unit cur, nxt; int ui = 0;
    if (!S.next(0, cur)) return;
    f32x4 acc[2][2][4][2];
#pragma unroll
    for (int a = 0; a < 2; ++a)
#pragma unroll
        for (int b = 0; b < 2; ++b)
#pragma unroll
            for (int m = 0; m < 4; ++m)
#pragma unroll
                for (int n = 0; n < 2; ++n) acc[a][b][m][n] = (f32x4){0.f, 0.f, 0.f, 0.f};
    bf16x8 At[4][2], B0[2][2], B1[2][2];
    const char* cA = cur.a; const char* cB = cur.b;
    PG8_STAGE(PG8_SB(0, 0), cB, vBc); PG8_STAGE(PG8_SB(0, 1), cB + hBc, vBc); PG8_STAGE(PG8_SA(0, 0), cA, vAc); PG8_STAGE(PG8_SA(0, 1), cA + hAc, vAc);
    if (wr == 1) PG8_BAR;
    PG8_WAIT_V(2); PG8_BAR;
    PG8_STAGE(PG8_SB(1, 0), cB + kstep, vBc); PG8_STAGE(PG8_SA(1, 0), cA + kstep, vAc); PG8_STAGE(PG8_SB(1, 1), cB + hBc + kstep, vBc);
    PG8_WAIT_V(6); PG8_BAR;
    for (;;) {
        const bool has_next = S.next(ui + 1, nxt);
        const char* nA = has_next ? nxt.a : cA; const char* nB = has_next ? nxt.b : cB;
        asm volatile(".p2align 6" ::: "memory");
        for (int t = 0; t < ntc; t += 2) {
            const bool last = (t == ntc - 2);
            const char* a1 = cA + (size_t)(t + 1) * kstep;
            const char* a2 = last ? nA : cA + (size_t)(t + 2) * kstep; const char* b2 = last ? nB : cB + (size_t)(t + 2) * kstep;
            const char* a3 = a2 + kstep; const char* b3 = b2 + kstep;
            unsigned vA2[2], vB2[2]; vA2[0] = last ? vAn[0] : vAc[0]; vA2[1] = last ? vAn[1] : vAc[1]; vB2[0] = last ? vBn[0] : vBc[0]; vB2[1] = last ? vBn[1] : vBc[1];
            const size_t hA2 = last ? hAn : hAc, hB2 = last ? hBn : hBc;
            PG8_LDB(B0, 0, 0); PG8_LDB(B1, 0, 1); PG8_SCHED; PG8_LDA(At, 0, 0); PG8_STAGE(PG8_SA(1, 1), a1 + hAc, vAc);
            PG8_WAIT_V(8); PG8_WAIT_L(0); PG8_BAR; PG8_MMA(0, 0, At, B0); PG8_MMA(0, 1, At, B1); PG8_BAR; PG8_SCHED;
            PG8_LDA(At, 0, 1); PG8_STAGE(PG8_SB(0, 0), b2, vB2); PG8_STAGE(PG8_SB(0, 1), b2 + hB2, vB2); PG8_STAGE(PG8_SA(0, 0), a2, vA2);
            PG8_WAIT_V(8); PG8_WAIT_L(0); PG8_BAR; PG8_MMA(1, 0, At, B0); PG8_MMA(1, 1, At, B1); PG8_BAR; PG8_SCHED;
            PG8_LDB(B0, 1, 0); PG8_LDB(B1, 1, 1); PG8_SCHED; PG8_LDA(At, 1, 0); PG8_STAGE(PG8_SA(0, 1), a2 + hA2, vA2);
            PG8_WAIT_V(8); PG8_WAIT_L(0); PG8_BAR; PG8_MMA(0, 0, At, B0); PG8_MMA(0, 1, At, B1); PG8_BAR; PG8_SCHED;
            PG8_LDA(At, 1, 1); PG8_STAGE(PG8_SB(1, 0), b3, vB2); PG8_STAGE(PG8_SB(1, 1), b3 + hB2, vB2); PG8_STAGE(PG8_SA(1, 0), a3, vA2);
            PG8_WAIT_V(8); PG8_WAIT_L(0); PG8_BAR; PG8_MMA(1, 0, At, B0); PG8_MMA(1, 1, At, B1); PG8_BAR; PG8_SCHED;
        }
        if (wr == 0) PG8_BAR;
        if (kind == 0) E0(acc, cur, wr, wc, fr, fq); else E1(acc, cur, wr, wc, fr, fq);
        if (!has_next) break;
#pragma unroll
        for (int a = 0; a < 2; ++a)
#pragma unroll
            for (int b = 0; b < 2; ++b)
#pragma unroll
                for (int m = 0; m < 4; ++m)
#pragma unroll
                    for (int n = 0; n < 2; ++n) acc[a][b][m][n] = (f32x4){0.f, 0.f, 0.f, 0.f};
        cur = nxt; cA = nA; cB = nB; ++ui; kind ^= 1;
        { unsigned x; x = vAc[0]; vAc[0] = vAn[0]; vAn[0] = x; x = vAc[1]; vAc[1] = vAn[1]; vAn[1] = x; x = vBc[0]; vBc[0] = vBn[0]; vBn[0] = x; x = vBc[1]; vBc[1] = vBn[1]; vBn[1] = x;
          size_t y; y = hAc; hAc = hAn; hAn = y; y = hBc; hBc = hBn; hBn = y; const int z = ntc; ntc = ntn; ntn = z; }
        if (wr == 1) PG8_BAR;
    }
    PG8_WAIT_V(0);
    PG8_BAR;
#undef PG8_SA
#undef PG8_SB
#undef PG8_STAGE
#undef PG8_LDA
#undef PG8_LDB
#undef PG8_MMA
#undef PG8_WAIT_V
#undef PG8_WAIT_L
#undef PG8_BAR
#undef PG8_SCHED
}

template <class Epi, class Sched>
__device__ __forceinline__ void gemm_phase_gather(LAS unsigned char* lds, const Gemm g, const Sched& S, const Epi& E, const char* xbase, const LAS int* gtab) {
    const int tid = otid(), wid = __builtin_amdgcn_readfirstlane(tid >> 6), lane = tid & 63, wr = wid >> 2, wc = wid & 3, fr = lane & 15, fq = lane >> 4;
    int K = g.K; asm volatile("" : "+s"(K)); const int nt = K / BK;
    unsigned voffA[2], voffB[2], cofs[2];
#pragma unroll
    for (int i = 0; i < 2; ++i) { int R, C; stage_rc(tid * 16 + i * 8192, R, C); const int Rb = Epi::PERM ? ((R & ~31) + perm32(R & 31)) : R;
        voffA[i] = (unsigned)R; voffB[i] = (unsigned)(Rb * g.ldb + C) * 2u; cofs[i] = (unsigned)C * 2u; }
    const size_t kstep = (size_t)(BK * 2);
    const size_t hstepA = (size_t)HALF * g.lda * 2, hstepB = (size_t)HALF * g.ldb * 2;
    const unsigned ldsw = (unsigned)wid * 1024u;
    const int aoff = lds_byte(wr * 64 + fr, fq * 8), boff = lds_byte(wc * 32 + fr, fq * 8);
#define PG8_SA(b, h) (((b) * 2 + (h)) * HTB)
#define PG8_SB(b, h) ((4 + (b) * 2 + (h)) * HTB)
#define PG8_STAGE(bufoff, gbase, voff) do { _Pragma("unroll") for (int _i = 0; _i < 2; ++_i) \
        __builtin_amdgcn_global_load_lds((const unsigned*)((const char*)(gbase) + (voff)[_i]), (LAS unsigned*)(lds + (bufoff) + ldsw + _i * 8192), 16, 0, 0); } while (0)
#define PG8_LDA(dst, b, h) do { _Pragma("unroll") for (int m = 0; m < 4; ++m) _Pragma("unroll") for (int k = 0; k < 2; ++k) dst[m][k] = *(const LAS bf16x8*)(lds + PG8_SA(b, h) + aoff + m * 2048 + k * 1024); } while (0)
#define PG8_LDB(dst, b, h) do { _Pragma("unroll") for (int n = 0; n < 2; ++n) _Pragma("unroll") for (int k = 0; k < 2; ++k) dst[n][k] = *(const LAS bf16x8*)(lds + PG8_SB(b, h) + boff + n * 2048 + k * 1024); } while (0)
#define PG8_MMA(ai, bj, At, Bt) do { __builtin_amdgcn_s_setprio(1); _Pragma("unroll") for (int m = 0; m < 4; ++m) _Pragma("unroll") for (int n = 0; n < 2; ++n) _Pragma("unroll") for (int k = 0; k < 2; ++k) \
        acc[ai][bj][m][n] = __builtin_amdgcn_mfma_f32_16x16x32_bf16(Bt[n][k], At[m][k], acc[ai][bj][m][n], 0, 0, 0); __builtin_amdgcn_s_setprio(0); } while (0)
#define PG8_WAIT_V(n) asm volatile("s_waitcnt vmcnt(" #n ")" ::: "memory")
#define PG8_WAIT_L(n) asm volatile("s_waitcnt lgkmcnt(" #n ")" ::: "memory")
#define PG8_BAR __builtin_amdgcn_s_barrier()
#define PG8_SCHED __builtin_amdgcn_sched_barrier(0)
    Unit cur, nxt; int ui = 0;
    if (!S.next(0, cur)) return;
    f32x4 acc[2][2][4][2];
#pragma unroll
    for (int a = 0; a < 2; ++a)
#pragma unroll
        for (int b = 0; b < 2; ++b)
#pragma unroll
            for (int m = 0; m < 4; ++m)
#pragma unroll
                for (int n = 0; n < 2; ++n) acc[a][b][m][n] = (f32x4){0.f, 0.f, 0.f, 0.f};
    bf16x8 At[4][2], B0[2][2], B1[2][2];
    const char* cB = cur.b;
    unsigned gC[2][2], gN[2][2];
#define PG8_GOFF(dst, un) do { _Pragma("unroll") for (int h_ = 0; h_ < 2; ++h_) _Pragma("unroll") for (int i_ = 0; i_ < 2; ++i_) dst[h_][i_] = (unsigned)gtab[(un).aux2 * 256 + h_ * 128 + (int)voffA[i_]] * (unsigned)(g.lda * 2) + cofs[i_]; } while (0)
    PG8_GOFF(gC, cur);
    PG8_STAGE(PG8_SB(0, 0), cB, voffB); PG8_STAGE(PG8_SB(0, 1), cB + hstepB, voffB); PG8_STAGE(PG8_SA(0, 0), xbase, gC[0]); PG8_STAGE(PG8_SA(0, 1), xbase, gC[1]);
    if (wr == 1) PG8_BAR;
    PG8_WAIT_V(2); PG8_BAR;
    PG8_STAGE(PG8_SB(1, 0), cB + kstep, voffB); PG8_STAGE(PG8_SA(1, 0), xbase + kstep, gC[0]); PG8_STAGE(PG8_SB(1, 1), cB + hstepB + kstep, voffB);
    PG8_WAIT_V(6); PG8_BAR;
    for (;;) {
        const bool has_next = S.next(ui + 1, nxt);
        const char* nB = has_next ? nxt.b : cB;
        if (has_next) { PG8_GOFF(gN, nxt); } else { gN[0][0] = gC[0][0]; gN[0][1] = gC[0][1]; gN[1][0] = gC[1][0]; gN[1][1] = gC[1][1]; }
        asm volatile(".p2align 6" ::: "memory");
        for (int t = 0; t < nt; t += 2) {
            const bool last = (t == nt - 2);
            const char* a1 = xbase + (size_t)(t + 1) * kstep;
            const char* a2 = last ? xbase : xbase + (size_t)(t + 2) * kstep; const char* b2 = last ? nB : cB + (size_t)(t + 2) * kstep;
            const char* a3 = a2 + kstep; const char* b3 = b2 + kstep;
            unsigned g2[2][2];
            g2[0][0] = last ? gN[0][0] : gC[0][0]; g2[0][1] = last ? gN[0][1] : gC[0][1]; g2[1][0] = last ? gN[1][0] : gC[1][0]; g2[1][1] = last ? gN[1][1] : gC[1][1];
            PG8_LDB(B0, 0, 0); PG8_LDB(B1, 0, 1); PG8_SCHED; PG8_LDA(At, 0, 0); PG8_STAGE(PG8_SA(1, 1), a1, gC[1]);
            PG8_WAIT_V(8); PG8_WAIT_L(0); PG8_BAR; PG8_MMA(0, 0, At, B0); PG8_MMA(0, 1, At, B1); PG8_BAR; PG8_SCHED;
            PG8_LDA(At, 0, 1); PG8_STAGE(PG8_SB(0, 0), b2, voffB); PG8_STAGE(PG8_SB(0, 1), b2 + hstepB, voffB); PG8_STAGE(PG8_SA(0, 0), a2, g2[0]);
            PG8_WAIT_V(8); PG8_WAIT_L(0); PG8_BAR; PG8_MMA(1, 0, At, B0); PG8_MMA(1, 1, At, B1); PG8_BAR; PG8_SCHED;
            PG8_LDB(B0, 1, 0); PG8_LDB(B1, 1, 1); PG8_SCHED; PG8_LDA(At, 1, 0); PG8_STAGE(PG8_SA(0, 1), a2, g2[1]);
            PG8_WAIT_V(8); PG8_WAIT_L(0); PG8_BAR; PG8_MMA(0, 0, At, B0); PG8_MMA(0, 1, At, B1); PG8_BAR; PG8_SCHED;
            PG8_LDA(At, 1, 1); PG8_STAGE(PG8_SB(1, 0), b3, voffB); PG8_STAGE(PG8_SB(1, 1), b3 + hstepB, voffB); PG8_STAGE(PG8_SA(1, 0), a3, g2[0]);
            PG8_WAIT_V(8); PG8_WAIT_L(0); PG8_BAR; PG8_MMA(1, 0, At, B0); PG8_MMA(1, 1, At, B1); PG8_BAR; PG8_SCHED;
        }
        if (wr == 0) PG8_BAR;
        E(acc, cur, wr, wc, fr, fq);
        if (!has_next) break;
#pragma unroll
        for (int a = 0; a < 2; ++a)
#pragma unroll
            for (int b = 0; b < 2; ++b)
#pragma unroll
                for (int m = 0; m < 4; ++m)
#pragma unroll
                    for (int n = 0; n < 2; ++n) acc[a][b][m][n] = (f32x4){0.f, 0.f, 0.f, 0.f};
        cur = nxt; cB = nB; ++ui;
        gC[0][0] = gN[0][0]; gC[0][1] = gN[0][1]; gC[1][0] = gN[1][0]; gC[1][1] = gN[1][1];
        if (wr == 1) PG8_BAR;
    }
    PG8_WAIT_V(0);
    PG8_BAR;
#undef PG8_GOFF
#undef PG8_SA
#undef PG8_SB
#undef PG8_STAGE
#undef PG8_LDA
#undef PG8_LDB
#undef PG8_MMA
#undef PG8_WAIT_V
#undef PG8_WAIT_L
#undef PG8_BAR
#undef PG8_SCHED
}

#define EPI_LOOP_BEGIN \
    _Pragma("unroll") for (int ai = 0; ai < 2; ++ai) _Pragma("unroll") for (int m = 0; m < 4; ++m) { const int row = u.row0 + ai * HALF + wr * 64 + m * 16 + fr; \
    _Pragma("unroll") for (int bj = 0; bj < 2; ++bj) { const int col = u.col0 + bj * HALF + wc * 32 + 8 * fq; const f32x4 v0 = acc[ai][bj][m][0], v1 = acc[ai][bj][m][1];
#define EPI_LOOP_END } }

struct EpiStore {
    static constexpr bool PERM = true;
    bf16* O; int ldc; float scale;
    __device__ __forceinline__ void operator()(const f32x4 (&acc)[2][2][4][2], const Unit& u, int wr, int wc, int fr, int fq) const {
        EPI_LOOP_BEGIN
            u32x4 w; w.x = pk2(v0[0] * scale, v0[1] * scale); w.y = pk2(v0[2] * scale, v0[3] * scale); w.z = pk2(v1[0] * scale, v1[1] * scale); w.w = pk2(v1[2] * scale, v1[3] * scale);
            *(u32x4*)(O + (size_t)row * ldc + col) = w;
        EPI_LOOP_END
    }
};
struct EpiProj {
    static constexpr bool PERM = true;
    bf16* O; int ldc; bf16* halo;
    __device__ __forceinline__ void operator()(const f32x4 (&acc)[2][2][4][2], const Unit& u, int wr, int wc, int fr, int fq) const {
        const bool hz = (u.col0 >= C_GQ) && (u.col0 < C_GQ + 1536);
        const float sc = (u.col0 >= C_OB && u.col0 < C_OB + 512) ? 0.125f * LOG2E : 1.f;
        EPI_LOOP_BEGIN
            u32x4 w; w.x = pk2(v0[0] * sc, v0[1] * sc); w.y = pk2(v0[2] * sc, v0[3] * sc); w.z = pk2(v1[0] * sc, v1[1] * sc); w.w = pk2(v1[2] * sc, v1[3] * sc);
            *(u32x4*)(O + (size_t)row * ldc + col) = w;
            if (hz && m == 3 && fr >= 13) *(u32x4*)(halo + ((size_t)(row >> 6) * 3 + (fr - 13)) * 1536 + (col - C_GQ)) = w;
        EPI_LOOP_END
    }
};
struct EpiGate {
    static constexpr bool PERM = true;
    bf16* PJ; int ldc; const float* bias;
    __device__ __forceinline__ void operator()(const f32x4 (&acc)[2][2][4][2], const Unit& u, int wr, int wc, int fr, int fq) const {
        const bool first = u.aux < 1024;
        f32x4 bv[2][2];
#pragma unroll
        for (int bj = 0; bj < 2; ++bj) { const int gc = u.aux + bj * HALF + wc * 32 + 8 * fq; bv[bj][0] = *(const f32x4*)(bias + gc); bv[bj][1] = *(const f32x4*)(bias + gc + 4); }
#pragma unroll
        for (int ai = 0; ai < 2; ++ai) {
            u32x4 tv[4][2], mv[4][2];
#pragma unroll
            for (int m = 0; m < 4; ++m)
#pragma unroll
                for (int bj = 0; bj < 2; ++bj) { const size_t ro = (size_t)(u.row0 + ai * HALF + wr * 64 + m * 16 + fr) * ldc; const int cc = bj * HALF + wc * 32 + 8 * fq;
                    tv[m][bj] = *(const u32x4*)(PJ + ro + C_T + u.aux + cc);
                    if (!first) mv[m][bj] = *(const u32x4*)(PJ + ro + C_T + u.col0 + cc); else mv[m][bj] = (u32x4){0u, 0u, 0u, 0u}; }
#pragma unroll
            for (int m = 0; m < 4; ++m)
#pragma unroll
                for (int bj = 0; bj < 2; ++bj) { const size_t ro = (size_t)(u.row0 + ai * HALF + wr * 64 + m * 16 + fr) * ldc; const int cc = bj * HALF + wc * 32 + 8 * fq;
                    const f32x4 v0 = acc[ai][bj][m][0], v1 = acc[ai][bj][m][1]; const f32x4 b0 = bv[bj][0], b1 = bv[bj][1]; const u32x4 t = tv[m][bj], mm = mv[m][bj];
                    u32x4 w;
                    w.x = pk2(bflo(mm.x) + sigmoidf_(v0[0] + b0[0]) * bflo(t.x), bfhi(mm.x) + sigmoidf_(v0[1] + b0[1]) * bfhi(t.x));
                    w.y = pk2(bflo(mm.y) + sigmoidf_(v0[2] + b0[2]) * bflo(t.y), bfhi(mm.y) + sigmoidf_(v0[3] + b0[3]) * bfhi(t.y));
                    w.z = pk2(bflo(mm.z) + sigmoidf_(v1[0] + b1[0]) * bflo(t.z), bfhi(mm.z) + sigmoidf_(v1[1] + b1[1]) * bfhi(t.z));
                    w.w = pk2(bflo(mm.w) + sigmoidf_(v1[2] + b1[2]) * bflo(t.w), bfhi(mm.w) + sigmoidf_(v1[3] + b1[3]) * bfhi(t.w));
                    *(u32x4*)(PJ + ro + C_T + u.col0 + cc) = w; }
        }
    }
};
struct EpiResid {
    static constexpr bool PERM = true;
    const bf16* X; bf16* Y; int ldc;
    __device__ __forceinline__ void operator()(const f32x4 (&acc)[2][2][4][2], const Unit& u, int wr, int wc, int fr, int fq) const {
#pragma unroll
        for (int ai = 0; ai < 2; ++ai) {
            u32x4 xv[4][2];
#pragma unroll
            for (int m = 0; m < 4; ++m)
#pragma unroll
                for (int bj = 0; bj < 2; ++bj) xv[m][bj] = *(const u32x4*)(X + (size_t)(u.row0 + ai * HALF + wr * 64 + m * 16 + fr) * ldc + u.col0 + bj * HALF + wc * 32 + 8 * fq);
#pragma unroll
            for (int m = 0; m < 4; ++m)
#pragma unroll
                for (int bj = 0; bj < 2; ++bj) { const f32x4 v0 = acc[ai][bj][m][0], v1 = acc[ai][bj][m][1]; const u32x4 t = xv[m][bj];
                    u32x4 w;
                    w.x = pk2(ALPHA * bflo(t.x) + v0[0], ALPHA * bfhi(t.x) + v0[1]); w.y = pk2(ALPHA * bflo(t.y) + v0[2], ALPHA * bfhi(t.y) + v0[3]);
                    w.z = pk2(ALPHA * bflo(t.z) + v1[0], ALPHA * bfhi(t.z) + v1[1]); w.w = pk2(ALPHA * bflo(t.w) + v1[2], ALPHA * bfhi(t.w) + v1[3]);
                    *(u32x4*)(Y + (size_t)(u.row0 + ai * HALF + wr * 64 + m * 16 + fr) * ldc + u.col0 + bj * HALF + wc * 32 + 8 * fq) = w; }
        }
    }
};
struct EpiSwiglu {
    static constexpr bool PERM = true;
    bf16* H; int ldc;
    __device__ __forceinline__ void operator()(const f32x4 (&acc)[2][2][4][2], const Unit& u, int wr, int wc, int fr, int fq) const {
        EPI_LOOP_BEGIN
            u32x2 w; w.x = pk2(siluf_(v0[0]) * v1[0], siluf_(v0[1]) * v1[1]); w.y = pk2(siluf_(v0[2]) * v1[2], siluf_(v0[3]) * v1[3]);
            *(u32x2*)(H + (size_t)row * ldc + (col >> 1)) = w;
        EPI_LOOP_END
    }
};
}

struct Args {
    const float* x; const float* mem; const float* w_in; const float* gdn_conv_w; const float* gdn_a_log; const float* gdn_dt_bias; const float* gdn_norm_w; const float* fox_f_bias;
    const float* gla_w_gate2; const float* gla_b_gate; const float* gla_norm_w; const float* p_gdn; const float* p_fox; const float* p_gla; const float* b_merge; const float* w_out;
    const float* ln1_g; const float* ln1_b; const float* xa_wq; const float* xa_wkv; const float* xa_wo; const float* ln2_g; const float* ln2_b;
    const float* moe_w_group; const float* moe_b_group; const float* moe_w_expert; const float* moe_b_expert; const float* moe_w_gate; const float* moe_w_up; const float* moe_w_down;
    const float* ln3_g; const float* ln3_b;
    float* out; unsigned char* ws;
};

typedef const __attribute__((address_space(4))) Args* KArgP;

__device__ __forceinline__ int tr_srccol(int mode, int c0, int n) {
    if (mode != 3) return c0 + n;
    return n < 4 ? 1536 + n : n < 8 ? 1540 + (n - 4) : n < 16 ? 3592 + (n - 8) : 5136 + (n - 16);
}
__device__ __forceinline__ int tr_dstrow(int mode, int r0, int nn) {
    if (mode == 1) return r0 + 8 * (nn >> 2) + (nn & 3);
    if (mode == 2) return r0 + 8 * (nn >> 2) + 4 + (nn & 3);
    return r0 + nn;
}
__device__ __forceinline__ void tr_item(const float* W, int ldw, int c0, int ncols, bf16* T, int ldt, int r0, int koff, int mode, LAS float* scr, int item, int lane, const float* ksc = nullptr) {
    const int nblk = ncols / 32, kb = item / nblk, nb = item % nblk, k0 = 64 * kb, n0 = 32 * nb;
    if (mode != 3) {
        const int sc4 = c0 + n0 + 4 * (lane & 7);
#pragma unroll
        for (int i = 0; i < 8; ++i) { const int kk = 8 * i + (lane >> 3); const f32x4 v = *(const f32x4*)(W + (size_t)(k0 + kk) * ldw + sc4);
            LAS float* d = scr + kk * 33 + 4 * (lane & 7); d[0] = v[0]; d[1] = v[1]; d[2] = v[2]; d[3] = v[3]; }
    } else {
        const int sc = tr_srccol(mode, c0, n0 + (lane & 31));
#pragma unroll 8
        for (int i = 0; i < 32; ++i) { const int kk = 2 * i + (lane >> 5); scr[kk * 33 + (lane & 31)] = W[(size_t)(k0 + kk) * ldw + sc]; }
    }
    asm volatile("s_waitcnt lgkmcnt(0)" ::: "memory");
    const int c = lane & 7;
    f32x4 k0s = (f32x4){1.f, 1.f, 1.f, 1.f}, k1s = (f32x4){1.f, 1.f, 1.f, 1.f};
    if (ksc) { k0s = *(const f32x4*)(ksc + k0 + 8 * c); k1s = *(const f32x4*)(ksc + k0 + 8 * c + 4); }
#pragma unroll
    for (int j = 0; j < 4; ++j) { const int n = (lane >> 3) + 8 * j; const LAS float* s = scr + (8 * c) * 33 + n;
        u32x4 o; o.x = pk2(s[0 * 33] * k0s[0], s[1 * 33] * k0s[1]); o.y = pk2(s[2 * 33] * k0s[2], s[3 * 33] * k0s[3]); o.z = pk2(s[4 * 33] * k1s[0], s[5 * 33] * k1s[1]); o.w = pk2(s[6 * 33] * k1s[2], s[7 * 33] * k1s[3]);
        *(u32x4*)(T + (size_t)tr_dstrow(mode, r0, n0 + n) * ldt + koff + k0 + 8 * c) = o; }
    asm volatile("s_waitcnt lgkmcnt(0)" ::: "memory");
}
__device__ __forceinline__ void tr_job(const float* W, int ldw, int K, int c0, int ncols, size_t wstride, bf16* T, int ldt, int r0, int koff, int mode, size_t tstride, int nmat,
                                       LAS float* scr, int lane, int gw, int NGW, int& run, const float* ksc = nullptr) {
    const int per = (K / 64) * (ncols / 32), n = per * nmat;
    int first = gw - (run % NGW); if (first < 0) first += NGW;
    for (int it = first; it < n; it += NGW) { const int e = it / per, li = it % per; tr_item(W + (size_t)e * wstride, ldw, c0, ncols, T + (size_t)e * tstride, ldt, r0, koff, mode, scr, li, lane, ksc); }
    run += n;
}
__device__ __forceinline__ void phase_convert_weights(KArgP A, int l, LAS unsigned char* lds) {
    const int tid = otid(), lane = tid & 63, wid = tid >> 6;
    LAS float* scr = (LAS float*)(lds + wid * 16384);
    const int gw = obid() * 8 + wid, NGW = ogrid() * 8; int run = 0;
    unsigned char* wt = A->ws + WS_WT;
    bf16* WIN = (bf16*)(wt + WT_WIN);
    const float* w_in = A->w_in + (size_t)l * 1024 * N_IN;
    tr_job(w_in, N_IN, 1024, 1544, 512, 0, WIN, 1024, C_OA, 0, 0, 0, 1, scr, lane, gw, NGW, run);
    tr_job(w_in, N_IN, 1024, 2056, 512, 0, WIN, 1024, C_OB, 0, 0, 0, 1, scr, lane, gw, NGW, run);
    tr_job(w_in, N_IN, 1024, 4624, 512, 0, WIN, 1024, C_OC, 0, 0, 0, 1, scr, lane, gw, NGW, run);
    tr_job(w_in, N_IN, 1024, 0, 1536, 0, WIN, 1024, C_GQ, 0, 0, 0, 1, scr, lane, gw, NGW, run);
    tr_job(w_in, N_IN, 1024, 2568, 1024, 0, WIN, 1024, C_FK, 0, 0, 0, 1, scr, lane, gw, NGW, run);
    tr_job(w_in, N_IN, 1024, 3600, 1024, 0, WIN, 1024, C_LQ, 0, 0, 0, 1, scr, lane, gw, NGW, run);
    tr_job(w_in, N_IN, 1024, 0, 32, 0, WIN, 1024, C_SM, 0, 3, 0, 1, scr, lane, gw, NGW, run);
    tr_job(w_in, N_IN, 1024, 5152, 3072, 0, WIN, 1024, LP, 0, 0, 0, 1, scr, lane, gw, NGW, run);
    { u32x4 z = {0u, 0u, 0u, 0u}; asm volatile("" : "+v"(z)); u32x4* p = (u32x4*)(WIN + (size_t)5152 * 1024); const int n16 = 224 * 1024 * 2 / 16;
      for (int i = obid() * 512 + tid; i < n16; i += ogrid() * 512) p[i] = z; }
    bf16* PT = (bf16*)(wt + WT_P);
    tr_job(A->p_gdn + (size_t)l * 512 * 1024, 1024, 512, 0, 1024, 0, PT, 512, 0, 0, 0, 0, 1, scr, lane, gw, NGW, run);
    tr_job(A->p_fox + (size_t)l * 512 * 1024, 1024, 512, 0, 1024, 0, PT + 1024 * 512, 512, 0, 0, 0, 0, 1, scr, lane, gw, NGW, run);
    tr_job(A->p_gla + (size_t)l * 512 * 1024, 1024, 512, 0, 1024, 0, PT + 2 * 1024 * 512, 512, 0, 0, 0, 0, 1, scr, lane, gw, NGW, run);
    bf16* WO3 = (bf16*)(wt + WT_WOUT3);
    tr_job(A->w_out + (size_t)l * 1024 * 1024, 1024, 1024, 0, 1024, 0, WO3, 1024, 0, 0, 0, 0, 1, scr, lane, gw, NGW, run);
    tr_job(A->xa_wq + (size_t)l * 1024 * 1024, 1024, 1024, 0, 1024, 0, (bf16*)(wt + WT_WQ), 1024, 0, 0, 0, 0, 1, scr, lane, gw, NGW, run, A->ln1_g + l * 1024);
    tr_job(A->xa_wkv + (size_t)l * 1024 * 2048, 2048, 1024, 0, 2048, 0, (bf16*)(wt + WT_WKV), 1024, 0, 0, 0, 0, 1, scr, lane, gw, NGW, run);
    tr_job(A->xa_wo + (size_t)l * 1024 * 1024, 1024, 1024, 0, 1024, 0, (bf16*)(wt + WT_WO), 1024, 0, 0, 0, 0, 1, scr, lane, gw, NGW, run);
    tr_job(A->moe_w_gate + (size_t)l * 32 * 1024 * 256, 256, 1024, 0, 256, (size_t)1024 * 256, (bf16*)(wt + WT_GU), 1024, 0, 0, 1, (size_t)512 * 1024, 32, scr, lane, gw, NGW, run);
    tr_job(A->moe_w_up + (size_t)l * 32 * 1024 * 256, 256, 1024, 0, 256, (size_t)1024 * 256, (bf16*)(wt + WT_GU), 1024, 0, 0, 2, (size_t)512 * 1024, 32, scr, lane, gw, NGW, run);
    tr_job(A->moe_w_down + (size_t)l * 32 * 256 * 1024, 1024, 256, 0, 1024, (size_t)256 * 1024, (bf16*)(wt + WT_DN), 256, 0, 0, 0, (size_t)1024 * 256, 32, scr, lane, gw, NGW, run);
    {
        const float* wg = A->moe_w_group + (size_t)l * 1024 * 4; const float* we = A->moe_w_expert + (size_t)l * 1024 * 32;
        bf16* RH = (bf16*)(wt + WT_RWH); bf16* RL = (bf16*)(wt + WT_RWL);
        for (int i = obid() * 512 + tid; i < 48 * 1024; i += ogrid() * 512) { const int n = i >> 10, k = i & 1023;
            const float w = n < 4 ? wg[k * 4 + n] : n < 36 ? we[k * 32 + (n - 4)] : 0.f; const unsigned h = f2bf(w); RH[i] = (bf16)h; RL[i] = (bf16)f2bf(w - bf2f((unsigned short)h)); }
    }
    {
        const int G = ogrid();
        for (int w = G - 1 - obid(); w < 32; w += G) {
            const int nn = tid & 31, kg = tid >> 5, n = w * 32 + nn;
            const float* wq = A->xa_wq + (size_t)l * 1024 * 1024; const float* g1 = A->ln1_g + l * 1024; const float* b1 = A->ln1_b + l * 1024;
            float c = 0.f, d = 0.f;
#pragma unroll 8
            for (int i = 0; i < 64; ++i) { const int k = kg * 64 + i; const float wv = wq[(size_t)k * 1024 + n]; c += bflo(pk2(g1[k] * wv, 0.f)); d += b1[k] * wv; }
            __syncthreads();
            LAS float* red = (LAS float*)lds;
            red[(kg * 32 + nn) * 2] = c; red[(kg * 32 + nn) * 2 + 1] = d;
            __syncthreads();
            if (tid < 32) { float cs = 0.f, ds = 0.f;
                for (int q = 0; q < 16; ++q) { cs += red[(q * 32 + tid) * 2]; ds += red[(q * 32 + tid) * 2 + 1]; }
                float* cd = (float*)((unsigned char*)A->out + DO_CD) + l * 2048; cd[w * 32 + tid] = cs; cd[1024 + w * 32 + tid] = ds; }
            __syncthreads();
        }
    }
}
__device__ __forceinline__ void convert_rows(const float* src, bf16* dst, size_t n) {
    const size_t n8 = n / 8;
    for (size_t i = (size_t)obid() * 512 + otid(); i < n8; i += (size_t)ogrid() * 512) {
        const f32x4 a = *(const f32x4*)(src + i * 8), b = *(const f32x4*)(src + i * 8 + 4);
        u32x4 w; w.x = pk2(a[0], a[1]); w.y = pk2(a[2], a[3]); w.z = pk2(b[0], b[1]); w.w = pk2(b[2], b[3]);
        *(u32x4*)(dst + i * 8) = w;
    }
}

struct RegSched {
    int nM, nN, nwg, G, c; const char* A; const char* B; size_t astride, bstride; int col_base;
    __device__ __forceinline__ bool next(int i, pg8::Unit& u) const {
        const long L = (long)i * G + c; if (L >= nwg) return false;
        int wgid = (int)L; { const int q = nwg / 8, r = nwg % 8, xcd = wgid % 8, off = wgid / 8; wgid = (xcd < r ? xcd * (q + 1) : r * (q + 1) + (xcd - r) * q) + off; }
        const int nig = 8 * nN, gid = wgid / nig, fm = gid * 8, gsz = (nM - fm) < 8 ? (nM - fm) : 8;
        const int pm = fm + ((wgid % nig) % gsz), pn = (wgid % nig) / gsz;
        u.a = A + (size_t)pm * astride; u.b = B + (size_t)pn * bstride; u.row0 = pm * 256; u.col0 = col_base + pn * 256; u.aux = pn * 256; return true;
    }
};
struct BranchSched {
    int nM, nwg, G, c; const char* A; const char* B;
    __device__ __forceinline__ bool next(int i, pg8::Unit& u) const {
        const long L = (long)i * G + c; if (L >= nwg) return false;
        int wgid = (int)L; { const int q = nwg / 8, r = nwg % 8, xcd = wgid % 8, off = wgid / 8; wgid = (xcd < r ? xcd * (q + 1) : r * (q + 1) + (xcd - r) * q) + off; }
        const int nN = 12, nig = 8 * nN, gid = wgid / nig, fm = gid * 8, gsz = (nM - fm) < 8 ? (nM - fm) : 8;
        const int pm = fm + ((wgid % nig) % gsz), pn = (wgid % nig) / gsz, br = pn >> 2;
        u.a = A + ((size_t)pm * 256 * LP + br * 512) * 2; u.b = B + ((size_t)br * 1024 * 512 + (size_t)(pn & 3) * 256 * 512) * 2; u.row0 = pm * 256; u.col0 = C_T + pn * 256; u.aux = 0; return true;
    }
};
struct GateSched {
    int nM, nwg, G, c; const char* A; const char* B;
    __device__ __forceinline__ bool next(int i, pg8::Unit& u) const {
        const int rnd = i / 3, br = i - 3 * rnd;
        const long L = (long)rnd * G + c; if (L >= nwg) return false;
        int wgid = (int)L; { const int q = nwg / 8, r = nwg % 8, xcd = wgid % 8, off = wgid / 8; wgid = (xcd < r ? xcd * (q + 1) : r * (q + 1) + (xcd - r) * q) + off; }
        const int nN = 4, nig = 8 * nN, gid = wgid / nig, fm = gid * 8, gsz = (nM - fm) < 8 ? (nM - fm) : 8;
        const int pm = fm + ((wgid % nig) % gsz), pn = (wgid % nig) / gsz;
        u.a = A + (size_t)pm * 256 * 1024 * 2; u.b = B + ((size_t)br * 1024 + (size_t)pn * 256) * 1024 * 2; u.row0 = pm * 256; u.col0 = pn * 256; u.aux = br * 1024 + pn * 256; return true;
    }
};
struct MixSched {
    int nM, nwg, G, c; const char* PJb; const char* Pw; const char* X; const char* Wm;
    __device__ __forceinline__ bool next(int i, pg8::Unit& u) const {
        const int rnd = i / 6, j = i - 6 * rnd, br = j >> 1, kind = j & 1;
        const long L = (long)rnd * G + c; if (L >= nwg) return false;
        int wgid = (int)L; { const int q = nwg / 8, r = nwg % 8, xcd = wgid % 8, off = wgid / 8; wgid = (xcd < r ? xcd * (q + 1) : r * (q + 1) + (xcd - r) * q) + off; }
        const int nN = 4, nig = 8 * nN, gid = wgid / nig, fm = gid * 8, gsz = (nM - fm) < 8 ? (nM - fm) : 8;
        const int pm = fm + ((wgid % nig) % gsz), pn = (wgid % nig) / gsz;
        if (kind == 0) { u.a = PJb + ((size_t)pm * 256 * LP + br * 512) * 2; u.b = Pw + ((size_t)br * 1024 * 512 + (size_t)pn * 256 * 512) * 2; u.row0 = pm * 256; u.col0 = C_T + (br * 4 + pn) * 256; u.aux = 0; }
        else { u.a = X + (size_t)pm * 256 * 1024 * 2; u.b = Wm + ((size_t)br * 1024 + (size_t)pn * 256) * 1024 * 2; u.row0 = pm * 256; u.col0 = pn * 256; u.aux = br * 1024 + pn * 256; }
        u.aux2 = kind; return true;
    }
};
struct MoeSched {
    int nct, G, c; const LAS int* tab;
    const char* A; size_t astride; const char* B; size_t bexp, bct;
    __device__ __forceinline__ bool next(int i, pg8::Unit& u) const {
        const long L = (long)i * G + c; const int nblk = tab[0]; if (L >= (long)nblk * nct) return false;
        const int rb = (int)(L / nct), ct = (int)(L % nct), e = tab[1 + rb];
        u.a = A + (size_t)rb * astride; u.b = B + (size_t)e * bexp + (size_t)ct * bct; u.row0 = rb * 256; u.col0 = ct * 256; u.aux = e; u.aux2 = i; return true;
    }
};

__device__ __forceinline__ bf16x8 frag_rm(const LAS unsigned char* base, int stride, int blk, int ks, int l15, int g) { return *(const LAS bf16x8*)(base + (blk * 16 + l15) * stride + (ks * 32 + 8 * g) * 2); }
__device__ __forceinline__ bf16x8 frag_tr(const LAS unsigned char* base, int stride, int ks, int nb, int g, int q4, int p4) {
    const s16x4 lo = __builtin_amdgcn_ds_read_tr16_b64_v4i16((LAS s16x4*)(base + (32 * ks + 8 * g + q4) * stride + (16 * nb + 4 * p4) * 2));
    const s16x4 hi = __builtin_amdgcn_ds_read_tr16_b64_v4i16((LAS s16x4*)(base + (32 * ks + 8 * g + 4 + q4) * stride + (16 * nb + 4 * p4) * 2));
    return (bf16x8){lo[0], lo[1], lo[2], lo[3], hi[0], hi[1], hi[2], hi[3]};
}
#define MFMA16(a, b, c) __builtin_amdgcn_mfma_f32_16x16x32_bf16((a), (b), (c), 0, 0, 0)

#ifndef TIMER_A
#define TIMER_A (-1)
#endif
#ifndef TIMER_B
#define TIMER_B (-1)
#endif
#ifndef TIMER_T
#define TIMER_T 0
#endif
#ifndef TIMER_WG
#define TIMER_WG 0
#endif
#define TMARK(id) do { if (TIMER_A >= 0 || TIMER_B >= 0) { const unsigned long long t_ = __builtin_amdgcn_s_memrealtime(); volatile LAS unsigned* tw_ = (volatile LAS unsigned*)(lds + LDS_CTL + 2800); \
    if (otid() == 0) { if ((id) == TIMER_A) tw_[0] -= (unsigned)t_; if ((id) == TIMER_A + 1) tw_[0] += (unsigned)t_; if ((id) == TIMER_B) tw_[1] -= (unsigned)t_; if ((id) == TIMER_B + 1) tw_[1] += (unsigned)t_; } } } while (0)
__device__ __forceinline__ void xattn_phase(LAS unsigned char* lds, const bf16* Qb, const bf16* KV, bf16* Ob, int G, int bx) {
    const int tid = otid(), lane = tid & 63, wid = tid >> 6, l15 = lane & 15, g = lane >> 4, q4 = l15 >> 2, p4 = lane & 3;
    constexpr int D = 256, KST = (D + 8) * 2, NU = NB * 4 * 16;
    LAS unsigned char* KS = lds; LAS unsigned char* VS = lds + 64 * KST; LAS unsigned char* PS = lds + 2 * 64 * KST + wid * 2304;
    LAS unsigned char* OS = lds + 2 * 64 * KST + 8 * 2304 + wid * 4352;
    const RegSched QS{NTOK / 256, 4, (NTOK / 256) * 4, G, bx, nullptr, nullptr, 0, 0, 0};
    int nq = 0; { pg8::Unit tu; while (QS.next(nq, tu)) ++nq; }
    const int nun = nq * 2, NT = nun * 4; (void)NU;
#define XA_UNIT(k_, uo_) do { pg8::Unit tu_; QS.next((k_) >> 1, tu_); const int r0_ = tu_.row0 + ((k_) & 1) * 128; uo_ = ((r0_ >> 11) << 6) | ((tu_.aux >> 8) << 4) | ((r0_ & 2047) >> 7); } while (0)
    u32x4 kreg[4], vreg[4];
#define XA_ISSUE(tt_) do { int u_; XA_UNIT((tt_) >> 2, u_); const int t_ = (tt_) & 3, b_ = u_ >> 6, h_ = (u_ >> 4) & 3; \
        _Pragma("unroll") for (int j_ = 0; j_ < 4; ++j_) { const int c_ = tid + 512 * j_, row_ = c_ >> 5, ch_ = c_ & 31; \
            const bf16* kp_ = KV + (size_t)(b_ * MEMLEN + t_ * 64 + row_) * 2048 + h_ * 256 + ch_ * 8; kreg[j_] = *(const u32x4*)kp_; vreg[j_] = *(const u32x4*)(kp_ + 1024); } } while (0)
    if (NT > 0) XA_ISSUE(0);
    bf16x8 qf[8]; f32x4 o[16]; float mrow[4], lrow[4];
    for (int tt = 0; tt < NT; ++tt) {
        TMARK(55);
        int u; XA_UNIT(tt >> 2, u); const int t = tt & 3, b = u >> 6, h = (u >> 4) & 3, qb = u & 15;
        const size_t rowq = (size_t)b * SEQ + qb * 128;
        if (t == 0) {
            if (tt == 0) { const bf16* qrow = Qb + (rowq + wid * 16 + l15) * 1024 + h * 256 + 8 * g;
#pragma unroll
                for (int ks = 0; ks < 8; ++ks) qf[ks] = *(const bf16x8*)(qrow + ks * 32); }
#pragma unroll
            for (int i = 0; i < 16; ++i) o[i] = (f32x4){0.f, 0.f, 0.f, 0.f};
#pragma unroll
            for (int r = 0; r < 4; ++r) { mrow[r] = -1e30f; lrow[r] = 0.f; }
        }
        TMARK(50);
        __syncthreads();
#pragma unroll
        for (int j = 0; j < 4; ++j) { const int c = tid + 512 * j, row = c >> 5, ch = c & 31; *(LAS u32x4*)(KS + row * 512 + ((ch ^ (row & 15)) << 4)) = kreg[j]; *(LAS u32x4*)(VS + row * KST + ch * 16) = vreg[j]; }
        __syncthreads();
        if (tt + 1 < NT) XA_ISSUE(tt + 1);
        TMARK(51);
        f32x4 s[4];
#pragma unroll
        for (int nb = 0; nb < 4; ++nb) { s[nb] = (f32x4){0.f, 0.f, 0.f, 0.f};
#pragma unroll
            for (int ks = 0; ks < 8; ++ks) s[nb] = MFMA16(qf[ks], *(const LAS bf16x8*)(KS + (nb * 16 + l15) * 512 + (((ks * 4 + g) ^ l15) << 4)), s[nb]); }
        if (t == 3 && tt + 1 < NT) {
            asm volatile("" : "+v"(s[0]), "+v"(s[1]), "+v"(s[2]), "+v"(s[3]));
            int u2; XA_UNIT((tt >> 2) + 1, u2); const int b2 = u2 >> 6, h2 = (u2 >> 4) & 3, qb2 = u2 & 15;
            const bf16* qrow = Qb + ((size_t)b2 * SEQ + qb2 * 128 + wid * 16 + l15) * 1024 + h2 * 256 + 8 * g;
#pragma unroll
            for (int ks = 0; ks < 8; ++ks) qf[ks] = *(const bf16x8*)(qrow + ks * 32); }
        TMARK(52);
        float mx[4], al[4];
#pragma unroll
        for (int r = 0; r < 4; ++r) mx[r] = fmaxf(fmaxf(s[0][r], s[1][r]), fmaxf(s[2][r], s[3][r]));
#pragma unroll
        for (int r = 0; r < 4; ++r) mx[r] = fmaxf(mx[r], swz_xor<1>(mx[r]));
#pragma unroll
        for (int r = 0; r < 4; ++r) mx[r] = fmaxf(mx[r], swz_xor<2>(mx[r]));
#pragma unroll
        for (int r = 0; r < 4; ++r) mx[r] = fmaxf(mx[r], swz_xor<4>(mx[r]));
#pragma unroll
        for (int r = 0; r < 4; ++r) mx[r] = fmaxf(mx[r], swz_xor<8>(mx[r]));
        bool moved = false;
#pragma unroll
        for (int r = 0; r < 4; ++r) { const float mn = fmaxf(mrow[r], mx[r]); al[r] = __builtin_amdgcn_exp2f(mrow[r] - mn); moved |= (mn != mrow[r]); mrow[r] = mn; lrow[r] *= al[r]; }
        if (__any(moved)) {
#pragma unroll
            for (int i = 0; i < 16; ++i)
#pragma unroll
                for (int r = 0; r < 4; ++r) o[i][r] *= al[r]; }
#pragma unroll
        for (int r = 0; r < 4; ++r) { float ps = 0.f;
#pragma unroll
            for (int nb = 0; nb < 4; ++nb) { const float p = __builtin_amdgcn_exp2f(s[nb][r] - mrow[r]); ps += p; *(LAS bf16*)(PS + ((4 * g + r) * 72 + nb * 16 + l15) * 2) = (bf16)f2bf(p); }
            lrow[r] += ps; }
        TMARK(53);
        bf16x8 pf[2];
#pragma unroll
        for (int ks = 0; ks < 2; ++ks) pf[ks] = *(const LAS bf16x8*)(PS + (l15 * 72 + ks * 32 + 8 * g) * 2);
#pragma unroll
        for (int nb = 0; nb < 16; ++nb)
#pragma unroll
            for (int ks = 0; ks < 2; ++ks) o[nb] = MFMA16(pf[ks], frag_tr(VS, KST, ks, nb, g, q4, p4), o[nb]);
        TMARK(54);
        if (t == 3) {
            float inv[4];
#pragma unroll
            for (int r = 0; r < 4; ++r) { float l = lrow[r]; l += swz_xor<1>(l); l += swz_xor<2>(l); l += swz_xor<4>(l); l += swz_xor<8>(l); inv[r] = __builtin_amdgcn_rcpf(l); }
#pragma unroll
            for (int hf = 0; hf < 2; ++hf) {
#pragma unroll
                for (int nb = 0; nb < 8; ++nb)
#pragma unroll
                    for (int r = 0; r < 4; ++r) *(LAS bf16*)(OS + ((4 * g + r) * 136 + nb * 16 + l15) * 2) = (bf16)f2bf(o[hf * 8 + nb][r] * inv[r]);
#pragma unroll
                for (int j = 0; j < 4; ++j) { const int c = lane + 64 * j, row = c >> 4, ch = c & 15;
                    *(u32x4*)(Ob + (rowq + wid * 16 + row) * 1024 + h * 256 + hf * 128 + ch * 8) = *(const LAS u32x4*)(OS + row * 272 + ch * 16); }
            }
        }
    }
#undef XA_ISSUE
#undef XA_UNIT
}

namespace fox_body {
using bf16=unsigned short;
using bf16x8=__attribute__((ext_vector_type(8)))short;
using s16x4=__attribute__((ext_vector_type(4)))short;
using f32x16=__attribute__((ext_vector_type(16)))float;
using u32x4=__attribute__((ext_vector_type(4)))unsigned;
constexpr int BATCH=16,NHEAD=8,SEQ=2048,D=64,DM=5376;
constexpr int NW=8,QBLK=32,QB=QBLK*NW,KVBLK=64,NQB=SEQ/QB;
constexpr int ATTN_PITCH=DM, ATTN_UNIT_ROWS=QB;
__device__ __forceinline__ int crow(int r,int hi){return (r&3)+8*(r>>2)+4*hi;}
#define SBAR() __builtin_amdgcn_sched_barrier(0)
__device__ __forceinline__ void cmask(f32x16&p0,f32x16&p1,int jb,int qrel,int hi){
  const float NEG=-INFINITY; int kb=64*jb+4*hi;
  #pragma unroll
  for(int r=0;r<16;++r){int kv=kb+(r&3)+8*(r>>2); if(kv>qrel)p0[r]=NEG; if(kv+32>qrel)p1[r]=NEG;}
}

constexpr int NSLOT=3, SLOTB=8192;
constexpr int LDS_K=0, LDS_V=NSLOT*SLOTB, LDS_WS=2*NSLOT*SLOTB, LDS_OST=LDS_WS+NW*64*4, LDS_BYTES=LDS_OST+NW*4096;
constexpr float C2=0.125f*1.4426950408889634f;
__device__ __forceinline__ void glds16(const void*gsrc,unsigned lds_dst){unsigned keep;
  asm volatile("s_mov_b32 %0, m0\n\ts_mov_b32 m0, %2\n\ts_nop 0\n\tglobal_load_lds_dwordx4 %1, off\n\ts_mov_b32 m0, %0":"=&s"(keep):"v"(gsrc),"s"(lds_dst):"memory");}
__device__ __forceinline__ float max3f(float a,float b,float c){float r;asm("v_max3_f32 %0, %1, %2, %3":"=v"(r):"v"(a),"v"(b),"v"(c));return r;}
__device__ __forceinline__ float max2f(float a,float b){float r;asm("v_max_f32_e32 %0, %1, %2":"=v"(r):"v"(a),"v"(b));return r;}
__device__ __forceinline__ float fadd_s(float a,float b){float r;asm("v_add_f32_e32 %0, %1, %2":"=v"(r):"v"(a),"v"(b));return r;}
__device__ __forceinline__ float fsub_s(float a,float b){float r;asm("v_sub_f32_e32 %0, %1, %2":"=v"(r):"v"(a),"v"(b));return r;}
typedef float f32x2_t __attribute__((ext_vector_type(2))); typedef __bf16 bf16x2_t __attribute__((ext_vector_type(2)));
__device__ __forceinline__ unsigned cvtpk_s(float lo,float hi){f32x2_t v={lo,hi};bf16x2_t b=__builtin_convertvector(v,bf16x2_t);return __builtin_bit_cast(unsigned,b);}
#define WAIT_BAR(N) asm volatile("s_waitcnt vmcnt(" #N ") lgkmcnt(0)\n\ts_barrier":::"memory")

__device__ __forceinline__ void qkt(f32x16&p0,f32x16&p1,const char*Kslot,const bf16x8*qr,const f32x16&n0,const f32x16&n1,int r32,int hi){
  const char*kb=Kslot+hi*1024+r32*16;
  #pragma unroll
  for(int d0=0;d0<4;++d0){
    const bf16x8 b0=*reinterpret_cast<const bf16x8*>(kb+d0*2048);
    const bf16x8 b1=*reinterpret_cast<const bf16x8*>(kb+d0*2048+512);
    if(d0==0){p0=__builtin_amdgcn_mfma_f32_32x32x16_bf16(b0,qr[0],n0,0,0,0);p1=__builtin_amdgcn_mfma_f32_32x32x16_bf16(b1,qr[0],n1,0,0,0);}
    else{p0=__builtin_amdgcn_mfma_f32_32x32x16_bf16(b0,qr[d0],p0,0,0,0);p1=__builtin_amdgcn_mfma_f32_32x32x16_bf16(b1,qr[d0],p1,0,0,0);}}
}
typedef __attribute__((address_space(3))) const char* lds_cptr;
typedef short v4i16_t __attribute__((ext_vector_type(4)));
__device__ __forceinline__ void kload8(bf16x8*kf,lds_cptr kp){
  kf[0]=*(const __attribute__((address_space(3))) bf16x8*)(kp);      kf[1]=*(const __attribute__((address_space(3))) bf16x8*)(kp+512);
  kf[2]=*(const __attribute__((address_space(3))) bf16x8*)(kp+2048); kf[3]=*(const __attribute__((address_space(3))) bf16x8*)(kp+2560);
  kf[4]=*(const __attribute__((address_space(3))) bf16x8*)(kp+4096); kf[5]=*(const __attribute__((address_space(3))) bf16x8*)(kp+4608);
  kf[6]=*(const __attribute__((address_space(3))) bf16x8*)(kp+6144); kf[7]=*(const __attribute__((address_space(3))) bf16x8*)(kp+6656);
}
__device__ __forceinline__ void kload2(bf16x8*kf,lds_cptr kp,int j){ kf[2*j]=*(const __attribute__((address_space(3))) bf16x8*)(kp+j*2048); kf[2*j+1]=*(const __attribute__((address_space(3))) bf16x8*)(kp+j*2048+512); }
__device__ __forceinline__ s16x4 vtr(lds_cptr p){ return __builtin_bit_cast(s16x4,__builtin_amdgcn_ds_read_tr16_b64_v4i16((__attribute__((address_space(3))) v4i16_t*)p)); }
__device__ __forceinline__ float rowmax(const f32x16&p0,const f32x16&p1){
  float a=max3f(p0[0],p0[1],p1[0]),b=max3f(p0[2],p0[3],p1[1]);a=max3f(a,p1[2],p1[3]);
  #pragma unroll
  for(int r=4;r<16;r+=4){a=max3f(a,p0[r],p0[r+1]);b=max3f(b,p0[r+2],p0[r+3]);a=max3f(a,p1[r],p1[r+1]);b=max3f(b,p1[r+2],p1[r+3]);}
  const float m=max2f(a,b);
  auto rr=__builtin_amdgcn_permlane32_swap(__float_as_uint(m),__float_as_uint(m),false,false);
  return max2f(__uint_as_float(rr[0]),__uint_as_float(rr[1]));
}
__device__ __forceinline__ void pv(f32x16*o,int vb,bf16x8 pa0,bf16x8 pa1,bf16x8 pa2,bf16x8 pa3){
  #pragma unroll
  for(int d0=0;d0<2;++d0){s16x4 lo[4],hi[4];
    #pragma unroll
    for(int ks=0;ks<4;++ks){
      asm volatile("ds_read_b64_tr_b16 %0,%1 offset:%c2":"=&v"(lo[ks]):"v"(vb),"i"(d0*4096+ks*1024):"memory");
      asm volatile("ds_read_b64_tr_b16 %0,%1 offset:%c2":"=&v"(hi[ks]):"v"(vb),"i"(d0*4096+ks*1024+512):"memory");}
    asm volatile("s_waitcnt lgkmcnt(0)":::"memory");SBAR();
    #define PK(k) (bf16x8){lo[k][0],lo[k][1],lo[k][2],lo[k][3],hi[k][0],hi[k][1],hi[k][2],hi[k][3]}
    o[d0]=__builtin_amdgcn_mfma_f32_32x32x16_bf16(pa0,PK(0),o[d0],0,0,0);
    o[d0]=__builtin_amdgcn_mfma_f32_32x32x16_bf16(pa1,PK(1),o[d0],0,0,0);
    o[d0]=__builtin_amdgcn_mfma_f32_32x32x16_bf16(pa2,PK(2),o[d0],0,0,0);
    o[d0]=__builtin_amdgcn_mfma_f32_32x32x16_bf16(pa3,PK(3),o[d0],0,0,0);
    #undef PK
  }
}

#ifndef ATTN_STORE16
#define ATTN_STORE16(p,v) (*(u32x4*)(p)=(v))
#endif
template<int THRL> __device__ __forceinline__ void attn_unit(int b,int h,int qb,const bf16*Q,const bf16*__restrict__ K,const bf16*__restrict__ V,bf16*O,char*shm,const __attribute__((address_space(3))) float*CKL){
  const int tid=otid(),lane=tid&63,r32=lane&31,hi=lane>>5; const int wid=__builtin_amdgcn_readfirstlane(tid>>6);
  const long rowbase=(long)b*SEQ; const int q0=qb*QB;
  const bf16*Qw=Q+(rowbase+q0+wid*QBLK)*DM;
  const bf16*Kh=K+rowbase*DM,*Vh=V+rowbase*DM;
  const unsigned lds0=(unsigned)(uintptr_t)shm;
  float*wsf=(float*)(shm+LDS_WS)+wid*64;
  const bf16*ksrc=Kh+(long)lane*DM+wid*8;
  const bf16*vsrc=Vh+(long)(16*(wid&3)+(lane>>2))*DM+(wid>>2)*32+(lane&3)*8;
  const unsigned kdst=lds0+LDS_K+wid*1024, vdst=lds0+LDS_V+wid*1024;
  #define DMA_K(t,slot) glds16(ksrc+(long)(t)*KVBLK*DM,(unsigned)__builtin_amdgcn_readfirstlane(kdst+(slot)))
  #define DMA_V(t,slot) glds16(vsrc+(long)(t)*KVBLK*DM,(unsigned)__builtin_amdgcn_readfirstlane(vdst+(slot)))
  const int vb0=(int)(lds0+LDS_V)+((lane>>4)&1)*32+(lane&3)*8+(4*hi+((lane&15)>>2))*64;
  const char*Kbase=shm+LDS_K; bf16x8 kf[8];
  const lds_cptr shm3=(lds_cptr)shm; const lds_cptr kp0=shm3+LDS_K+hi*1024+r32*16; const lds_cptr vp0=shm3+LDS_V+((lane>>4)&1)*32+(lane&3)*8+(4*hi+((lane&15)>>2))*64;
  const int NT=(q0+QB)/KVBLK;
  DMA_K(0,0);DMA_V(0,0);DMA_K(1,SLOTB);
  bf16x8 qr[4];
  #pragma unroll
  for(int d0=0;d0<4;++d0)qr[d0]=*reinterpret_cast<const bf16x8*>(&Qw[(long)r32*DM+d0*16+hi*8]);
  float mhat=0.f,l_reg=0.f;f32x16 o[2];o[0]=f32x16{};o[1]=f32x16{};f32x16 negm=f32x16{};asm volatile("":"+v"(negm));
  const int qrel=wid*QBLK+r32;
  #define KBIAS(N0,N1,t) do{ const __attribute__((address_space(3))) float*cb_=CKL+64*(t)+4*hi; \
    _Pragma("unroll") for(int q_=0;q_<4;++q_){ const f32x4 a_=*(const __attribute__((address_space(3))) f32x4*)(cb_+8*q_), b_=*(const __attribute__((address_space(3))) f32x4*)(cb_+32+8*q_); \
      _Pragma("unroll") for(int e_=0;e_<4;++e_){ N0[4*q_+e_]=negm[4*q_+e_]-a_[e_]; N1[4*q_+e_]=negm[4*q_+e_]-b_[e_]; } } }while(0)
  #define CMASK(P0,P1,t) do{int jb_=(t)-(NT-4); if(jb_>=0)cmask(P0,P1,jb_,qrel,hi);}while(0)
  bool resc=false;
  const float refq_=8.0f-CKL[q0+qrel];
  #define START(P0,P1) do{ const float rm=__builtin_fmaxf(rowmax(P0,P1),refq_); resc=false; \
    { const float dl=rm; mhat=fadd_s(mhat,dl); \
      _Pragma("unroll") for(int r=0;r<16;++r){P0[r]=fsub_s(P0[r],dl);P1[r]=fsub_s(P1[r],dl);} \
      _Pragma("unroll") for(int r=0;r<16;++r)negm[r]=-mhat; asm volatile("":"+v"(negm)); } \
    _Pragma("unroll") for(int r=0;r<16;++r)P0[r]=__builtin_amdgcn_exp2f(P0[r]); }while(0)
  #define RESC() do{ if(resc){ asm volatile("s_waitcnt lgkmcnt(0)":::"memory"); \
      _Pragma("unroll") for(int d_=0;d_<2;++d_) _Pragma("unroll") for(int r=0;r<16;++r)o[d_][r]*=wsf[crow(r,hi)]; } }while(0)
  f32x16 pA0,pA1,pB0,pB1;
  int sl_prev=0,sl_cur=0,sl_next=SLOTB;
  #define ROT() do{sl_prev=sl_cur;sl_cur=sl_next;sl_next=(sl_next==(NSLOT-1)*SLOTB)?0:sl_next+SLOTB;}while(0)
  DMA_K(2,2*SLOTB);
  WAIT_BAR(3);
  { f32x16 n0_,n1_; KBIAS(n0_,n1_,0); qkt(pA0,pA1,Kbase,qr,n0_,n1_,r32,hi); } asm volatile("s_nop 15\n\ts_nop 7":"+v"(pA0),"+v"(pA1));CMASK(pA0,pA1,0);
  START(pA0,pA1);
  _Pragma("unroll") for(int r=0;r<16;++r)pA1[r]=__builtin_amdgcn_exp2f(pA1[r]);
  WAIT_BAR(0);
  DMA_K(3,0);DMA_V(1,SLOTB);
  ROT();
  kload8(kf,kp0+sl_cur);
  WAIT_BAR(2);
  s16x4 vlo[8],vhi[8]; u32x4 pw0,pw1,pw2,pw3;
  #define PKW(P,B) cvtpk_s(P[B],P[B+1])
  #define PAF(k) __builtin_bit_cast(bf16x8,pw##k)
  #define VFR(i) (bf16x8){vlo[i][0],vlo[i][1],vlo[i][2],vlo[i][3],vhi[i][0],vhi[i][1],vhi[i][2],vhi[i][3]}
  #define PIN(x) asm volatile("":"+v"(x))
  #define MX3(a,b,c) __builtin_fmaxf(__builtin_fmaxf((a),(b)),(c))
  #define GAPA(MF,A0,A1,A2,A3,W0,W1,PW) do{ MF; sacc+=A0; sacc+=A1; sacc+=A2; sacc+=A3; PIN(sacc); W0; W1; PIN(PW); SBAR(); }while(0)
  #define EX(v) __builtin_amdgcn_exp2f(v)
  #define GAPB(MF,X,B) do{ MF; X[B]=EX(X[B]); X[B+1]=EX(X[B+1]); X[B+2]=EX(X[B+2]); X[B+3]=EX(X[B+3]); PIN(X); SBAR(); }while(0)
  #define VRD(i) do{ vlo[i]=vtr(vp_+(((i)>>2)*4096+((i)&3)*1024)); vhi[i]=vtr(vp_+(((i)>>2)*4096+((i)&3)*1024+512)); }while(0)
  #define KRD(G,j) do{ if(G){ kload2(kf,kp0+sl_next,j); SBAR(); } }while(0)
  #define STEP(C0,C1,P0,P1,t,GK,GV,GL) do{ SBAR(); \
    KBIAS(C0,C1,t); SBAR(); \
    const lds_cptr vp_=vp0+sl_prev; \
    VRD(0); SBAR(); float sacc=(P0[0]+P0[1]); \
    GAPA(C0=__builtin_amdgcn_mfma_f32_32x32x16_bf16(kf[0],qr[0],C0,0,0,0), P0[2],P0[3],P0[4],P0[5],     pw0[0]=PKW(P0,0), pw0[1]=PKW(P0,2), pw0); \
    VRD(4); SBAR(); GAPA(C1=__builtin_amdgcn_mfma_f32_32x32x16_bf16(kf[1],qr[0],C1,0,0,0), P0[6],P0[7],P0[8],P0[9],     pw0[2]=PKW(P0,4), pw0[3]=PKW(P0,6), pw0); \
    VRD(1); SBAR(); GAPA(C0=__builtin_amdgcn_mfma_f32_32x32x16_bf16(kf[2],qr[1],C0,0,0,0),   P0[10],P0[11],P0[12],P0[13], pw1[0]=PKW(P0,8), pw1[1]=PKW(P0,10), pw1); \
    VRD(5); SBAR(); GAPA(C1=__builtin_amdgcn_mfma_f32_32x32x16_bf16(kf[3],qr[1],C1,0,0,0),   P0[14],P0[15],P1[0],P1[1],   pw1[2]=PKW(P0,12),pw1[3]=PKW(P0,14), pw1); \
    VRD(2); SBAR(); GAPA(C0=__builtin_amdgcn_mfma_f32_32x32x16_bf16(kf[4],qr[2],C0,0,0,0),   P1[2],P1[3],P1[4],P1[5],     pw2[0]=PKW(P1,0), pw2[1]=PKW(P1,2), pw2); \
    VRD(6); SBAR(); GAPA(C1=__builtin_amdgcn_mfma_f32_32x32x16_bf16(kf[5],qr[2],C1,0,0,0),   P1[6],P1[7],P1[8],P1[9],     pw2[2]=PKW(P1,4), pw2[3]=PKW(P1,6), pw2); \
    VRD(3); SBAR(); GAPA(C0=__builtin_amdgcn_mfma_f32_32x32x16_bf16(kf[6],qr[3],C0,0,0,0),   P1[10],P1[11],P1[12],P1[13], pw3[0]=PKW(P1,8), pw3[1]=PKW(P1,10), pw3); \
    VRD(7); SBAR(); GAPA(C1=__builtin_amdgcn_mfma_f32_32x32x16_bf16(kf[7],qr[3],C1,0,0,0),   P1[14],P1[15],0.f,0.f,       pw3[2]=PKW(P1,12),pw3[3]=PKW(P1,14), pw3); \
    l_reg+=sacc; \
    if(GK){DMA_K((t)+3,sl_cur);} if(GV){DMA_V((t)+1,sl_next);} \
    CMASK(C0,C1,t); \
    { float a=MX3(C0[0],C0[1],C1[0]),b=MX3(C0[2],C0[3],C1[1]); a=MX3(a,C1[2],C1[3]); \
      _Pragma("unroll") for(int r=4;r<16;r+=4){a=MX3(a,C0[r],C0[r+1]);b=MX3(b,C0[r+2],C0[r+3]);a=MX3(a,C1[r],C1[r+1]);b=MX3(b,C1[r+2],C1[r+3]);} \
      float rm=__builtin_fmaxf(a,b); { auto rr=__builtin_amdgcn_permlane32_swap(__float_as_uint(rm),__float_as_uint(rm),false,false); rm=__builtin_fmaxf(__uint_as_float(rr[0]),__uint_as_float(rr[1])); } \
      resc=false; \
      if(__builtin_expect(__any(rm>(float)THRL),0)){ const float dl=__builtin_fmaxf(rm,0.f); mhat+=dl; \
        _Pragma("unroll") for(int r=0;r<16;++r){C0[r]-=dl;C1[r]-=dl;} \
        _Pragma("unroll") for(int r=0;r<16;++r)negm[r]=-mhat; asm volatile("":"+v"(negm)); \
        const float f=__builtin_amdgcn_exp2f(-dl); l_reg*=f; if(hi==0)wsf[r32]=f; resc=true; } } \
    SBAR(); \
    GAPB(o[0]=__builtin_amdgcn_mfma_f32_32x32x16_bf16(PAF(0),VFR(0),o[0],0,0,0), C0,0); \
    GAPB(o[1]=__builtin_amdgcn_mfma_f32_32x32x16_bf16(PAF(0),VFR(4),o[1],0,0,0), C0,4); \
    KRD(GL,0); GAPB(o[0]=__builtin_amdgcn_mfma_f32_32x32x16_bf16(PAF(1),VFR(1),o[0],0,0,0), C0,8); \
    KRD(GL,1); GAPB(o[1]=__builtin_amdgcn_mfma_f32_32x32x16_bf16(PAF(1),VFR(5),o[1],0,0,0), C0,12); \
    KRD(GL,2); GAPB(o[0]=__builtin_amdgcn_mfma_f32_32x32x16_bf16(PAF(2),VFR(2),o[0],0,0,0), C1,0); \
    KRD(GL,3); GAPB(o[1]=__builtin_amdgcn_mfma_f32_32x32x16_bf16(PAF(2),VFR(6),o[1],0,0,0), C1,4); \
    GAPB(o[0]=__builtin_amdgcn_mfma_f32_32x32x16_bf16(PAF(3),VFR(3),o[0],0,0,0), C1,8); \
    GAPB(o[1]=__builtin_amdgcn_mfma_f32_32x32x16_bf16(PAF(3),VFR(7),o[1],0,0,0), C1,12); \
    }while(0)
  int t=1;
  #undef CMASK
  #define CMASK(P0,P1,t) do{}while(0)
  for(;t+5<NT;t+=2){
    STEP(pB0,pB1,pA0,pA1,t,true,true,true);     WAIT_BAR(2); RESC(); ROT();
    STEP(pA0,pA1,pB0,pB1,t+1,true,true,true);   WAIT_BAR(2); RESC(); ROT();
  }
  #undef CMASK
  #define CMASK(P0,P1,t) do{int jb_=(t)-(NT-4); if(jb_>=0)cmask(P0,P1,jb_,qrel,hi);}while(0)
  #define ENDW(tt) do{ if((tt)+3<NT){WAIT_BAR(2);} else if((tt)+2<NT){WAIT_BAR(1);} else {WAIT_BAR(0);} }while(0)
  for(;t+1<NT;t+=2){
    STEP(pB0,pB1,pA0,pA1,t,(t+3<NT),(t+1<NT),(t+1<NT));       ENDW(t);   RESC(); ROT();
    STEP(pA0,pA1,pB0,pB1,t+1,(t+4<NT),(t+2<NT),(t+2<NT));     ENDW(t+1); RESC(); ROT();
  }
  STEP(pB0,pB1,pA0,pA1,NT-1,false,false,false); RESC();
  { float sacc=pB0[0]+pB0[1]; _Pragma("unroll") for(int r=2;r<16;++r)sacc+=pB0[r]; _Pragma("unroll") for(int r=0;r<16;++r)sacc+=pB1[r]; l_reg+=sacc;
    pw0=(u32x4){PKW(pB0,0),PKW(pB0,2),PKW(pB0,4),PKW(pB0,6)};pw1=(u32x4){PKW(pB0,8),PKW(pB0,10),PKW(pB0,12),PKW(pB0,14)};pw2=(u32x4){PKW(pB1,0),PKW(pB1,2),PKW(pB1,4),PKW(pB1,6)};pw3=(u32x4){PKW(pB1,8),PKW(pB1,10),PKW(pB1,12),PKW(pB1,14)};
    SBAR(); pv(o,vb0+sl_cur,PAF(0),PAF(1),PAF(2),PAF(3)); }
  #undef PKW
  #undef PAF
  #undef VFR
  #undef PIN
  #undef MX3
  #undef GAPA
  #undef GAPB
  #undef EX
  #undef VRD
  #undef KRD
  #undef STEP
  #undef ENDW
  {auto rr=__builtin_amdgcn_permlane32_swap(__float_as_uint(l_reg),__float_as_uint(l_reg),false,false);l_reg=__uint_as_float(rr[0])+__uint_as_float(rr[1]);}
  if(hi==0)wsf[32+r32]=l_reg;asm volatile("s_waitcnt lgkmcnt(0)":::"memory");
  float rli[16];
  #pragma unroll
  for(int r=0;r<16;++r)rli[r]=__builtin_amdgcn_rcpf(wsf[32+crow(r,hi)]);
  bf16*Ow=O+(rowbase+q0+wid*QBLK)*DM;
  { bf16*stg=(bf16*)(shm+LDS_OST)+wid*2048;
    #pragma unroll
    for(int r=0;r<16;++r){const int orow=crow(r,hi);
      #pragma unroll
      for(int d0=0;d0<2;++d0)stg[orow*64+d0*32+r32]=(bf16)f2bf(o[d0][r]*rli[r]);}
    asm volatile("s_waitcnt lgkmcnt(0)":::"memory");
    #pragma unroll
    for(int i=0;i<4;++i){const int row=i*8+(lane>>3),ch=lane&7; const u32x4 v=*(const u32x4*)(stg+row*64+ch*8); ATTN_STORE16(Ow+(long)row*DM+ch*8,v);} }
  asm volatile("s_waitcnt lgkmcnt(0)\n\ts_barrier":::"memory");
  #undef KBIAS
  #undef DMA_K
  #undef DMA_V
  #undef CMASK
  #undef START
  #undef RESC
  #undef ROT
}
constexpr int ATTN_LDS_BYTES=LDS_BYTES;
#undef SBAR
#undef WAIT_BAR
}

__device__ __forceinline__ void fox_ck_task(KArgP A, int l, LAS unsigned char* lds, int b, int h) {
    const bf16* PJ = (const bf16*)(A->ws + WS_PROJ);
    float* CKG = (float*)((unsigned char*)A->out + DO_CKG) + (size_t)(b * 8 + h) * SEQ;
    const int tid = otid(), lane = tid & 63, wid = tid >> 6;
    LAS float* WT = (LAS float*)lds;
    const float fb = A->fox_f_bias[l * 8 + h];
    float v[4]; float run = 0.f;
#pragma unroll
    for (int i = 0; i < 4; ++i) v[i] = bf2f(PJ[(size_t)(b * SEQ + tid * 4 + i) * LP + C_SM + 8 + h]);
#pragma unroll
    for (int i = 0; i < 4; ++i) { run += LOG2E * logsigmoidf_(v[i] + fb); v[i] = run; }
    float inc = run;
#pragma unroll
    for (int o = 1; o < 64; o <<= 1) { const float y = __builtin_bit_cast(float, __builtin_amdgcn_ds_bpermute(((lane - o) & 63) << 2, __builtin_bit_cast(int, inc))); if (lane >= o) inc += y; }
    __syncthreads();
    if (lane == 63) WT[wid] = inc;
    __syncthreads();
    float base = inc - run;
    for (int w = 0; w < wid; ++w) base += WT[w];
    *(f32x4*)(CKG + tid * 4) = (f32x4){base + v[0], base + v[1], base + v[2], base + v[3]};
}
__device__ __forceinline__ void fox_unit(KArgP A, int l, LAS unsigned char* lds, int b, int h, int qb, int ocol = -1) {
    bf16* PJ = (bf16*)(A->ws + WS_PROJ);
    const float* CKG = (const float*)((unsigned char*)A->out + DO_CKG) + (size_t)(b * 8 + h) * SEQ;
    const int tid = otid();
    LAS float* CK = (LAS float*)(lds + fox_body::LDS_BYTES);
    const f32x4 ck4 = (tid * 4 < 256 * (qb + 1)) ? *(const f32x4*)(CKG + tid * 4) : (f32x4){0.f, 0.f, 0.f, 0.f};
    __syncthreads();
    *(LAS f32x4*)(CK + tid * 4) = ck4;
    __syncthreads();
    fox_body::attn_unit<8>(b, h, qb, PJ + C_OB + h * 64, PJ + C_FK + h * 64, PJ + C_FV + h * 64, PJ + (ocol < 0 ? C_OB + h * 64 : ocol), (char*)lds, CK);
}

struct GdnPre { u32x4 xr[10]; f32x4 w0[4], w1[4]; unsigned ab; };
__device__ __forceinline__ void gdn_prep_issue(GdnPre& P, KArgP A, int l, int b, int h, int n) {
    const bf16* PJ = (const bf16*)(A->ws + WS_PROJ); const bf16* HALO = (const bf16*)((unsigned char*)A->out + DO_HALO);
    const float* cw = A->gdn_conv_w + (size_t)l * 4 * 1536;
    const int tid = otid(); const size_t row0 = (size_t)b * SEQ + n * 64;
    if (tid < 480) { const int pc = tid % 48, grp = tid / 48, part = pc >> 4, c8 = pc & 15, c = part * 512 + h * 128 + c8 * 8;
#pragma unroll
        for (int i = 0; i < 10; ++i) { const int tr = 7 * grp - 3 + i; P.xr[i] = (u32x4){0u, 0u, 0u, 0u};
            if (tr >= 0) { if (tr < 64) P.xr[i] = *(const u32x4*)(PJ + (row0 + tr) * LP + C_GQ + c); }
            else if (n > 0) P.xr[i] = *(const u32x4*)(HALO + ((size_t)(b * 32 + n - 1) * 3 + (3 + tr)) * 1536 + c); }
#pragma unroll
        for (int i = 0; i < 4; ++i) { P.w0[i] = *(const f32x4*)(cw + i * 1536 + c); P.w1[i] = *(const f32x4*)(cw + i * 1536 + c + 4); } }
    if (tid < 64) { const size_t r = (row0 + tid) * LP + C_SM; P.ab = (unsigned)PJ[r + 4 + h] | ((unsigned)PJ[r + h] << 16); }
}
__device__ __forceinline__ void gdn_prep_task(KArgP A, int l, LAS unsigned char* lds, int b, int h, int n, GdnPre& P, bool has_next, int nb_, int nh_, int nn_, GdnPre& N, bool dummy = false) {
    bf16* PJ = (bf16*)(A->ws + WS_PROJ);
    unsigned char* dsc = (unsigned char*)A->out; const bf16* HALO = (const bf16*)(dsc + DO_HALO);
    unsigned char* rec = dsc + DO_GP + (size_t)(dummy ? 2048 : ((b * 4 + h) * 32 + n)) * GP_STRIDE;
    const int tid = otid(), lane = tid & 63, wid = tid >> 6, l15 = lane & 15, g = lane >> 4;
    constexpr int S136 = 272, S72 = 144, S40 = 80;
    const int oq = dummy ? 5152 : C_GQ + h * 128, ov = dummy ? 5152 : C_GV + h * 128;
    LAS float* qf = (LAS float*)lds; LAS float* kf = qf + 64 * 128; LAS float* vf = kf + 64 * 128;
    LAS unsigned char* KB16 = lds + 98304; LAS unsigned char* QB16 = lds + 115712;
    LAS float* GC = (LAS float*)(lds + 146432); LAS float* BETA = GC + 64; LAS float* EG = BETA + 64;
    LAS unsigned char* AOFF = lds;
    LAS unsigned char* ATTS = lds + 9216;
    LAS float* AKK = (LAS float*)(lds + 18432);
    LAS unsigned char* TD = lds + 23552;
    LAS unsigned char* XT = lds + 98304;
    LAS unsigned char* TT = lds + 65536;
    const float* cw = A->gdn_conv_w + (size_t)l * 4 * 1536;
    const float alog = A->gdn_a_log[l * 4 + h], dtb = A->gdn_dt_bias[l * 4 + h];
    const int t0 = n * 64; const size_t row0 = (size_t)b * SEQ + t0;
    __syncthreads();
    TMARK(30);
    if (tid < 480) {
        const int pc = tid % 48, grp = tid / 48, part = pc >> 4, c8 = pc & 15;
        LAS float* dbase = (part == 0 ? qf : part == 1 ? kf : vf) + c8 * 8;
#pragma unroll
        for (int j = 0; j < 7; ++j) { const int tt = 7 * grp + j;
            if (tt < 64) { float y[8];
#pragma unroll
                for (int e2 = 0; e2 < 8; ++e2) y[e2] = 0.f;
#pragma unroll
                for (int i = 0; i < 4; ++i) { const u32x4 xv = P.xr[j + i];
                    y[0] += P.w0[i][0] * bflo(xv.x); y[1] += P.w0[i][1] * bfhi(xv.x); y[2] += P.w0[i][2] * bflo(xv.y); y[3] += P.w0[i][3] * bfhi(xv.y);
                    y[4] += P.w1[i][0] * bflo(xv.z); y[5] += P.w1[i][1] * bfhi(xv.z); y[6] += P.w1[i][2] * bflo(xv.w); y[7] += P.w1[i][3] * bfhi(xv.w); }
                LAS float* dst = dbase + tt * 128;
                *(LAS f32x4*)dst = (f32x4){siluf_(y[0]), siluf_(y[1]), siluf_(y[2]), siluf_(y[3])}; *(LAS f32x4*)(dst + 4) = (f32x4){siluf_(y[4]), siluf_(y[5]), siluf_(y[6]), siluf_(y[7])}; } }
    }
    if (tid < 64) { const float a = bflo(P.ab), bb = bfhi(P.ab);
        float gg = -__expf(alog) * softplusf_(a + dtb);
#pragma unroll
        for (int o = 1; o < 64; o <<= 1) { const float y2 = __builtin_bit_cast(float, __builtin_amdgcn_ds_bpermute(((lane - o) & 63) << 2, __builtin_bit_cast(int, gg))); if (lane >= o) gg += y2; }
        GC[tid] = gg; EG[tid] = __expf(gg); BETA[tid] = sigmoidf_(bb); }
    if (has_next) gdn_prep_issue(N, A, l, nb_, nh_, nn_);
    __syncthreads();
    TMARK(31);
    {
        float va[16], vc[16], ss[16];
#pragma unroll
        for (int i = 0; i < 16; ++i) { const int rr = wid + 8 * i; const LAS float* p = (rr < 64 ? qf + rr * 128 : kf + (rr - 64) * 128); va[i] = p[lane * 2]; vc[i] = p[lane * 2 + 1]; ss[i] = va[i] * va[i] + vc[i] * vc[i]; }
#pragma unroll
        for (int i = 0; i < 16; ++i) ss[i] += swz_xor<1>(ss[i]);
#pragma unroll
        for (int i = 0; i < 16; ++i) ss[i] += swz_xor<2>(ss[i]);
#pragma unroll
        for (int i = 0; i < 16; ++i) ss[i] += swz_xor<4>(ss[i]);
#pragma unroll
        for (int i = 0; i < 16; ++i) ss[i] += swz_xor<8>(ss[i]);
#pragma unroll
        for (int i = 0; i < 16; ++i) ss[i] += swz_xor<16>(ss[i]);
#pragma unroll
        for (int i = 0; i < 16; ++i) ss[i] = half_sum(ss[i]);
#pragma unroll
        for (int i = 0; i < 16; ++i) { const int rr = wid + 8 * i; const bool isq = rr < 64; const int row = isq ? rr : rr - 64;
            const float sc = rsqrtf(ss[i] + 1e-6f); const float an = va[i] * sc, cn = vc[i] * sc;
            if (isq) { *(LAS unsigned*)(QB16 + row * S136 + lane * 4) = pk2(an, cn); const float f = 0.08838834764831845f * EG[row];
                *(unsigned*)(PJ + (row0 + row) * LP + oq + lane * 2) = pk2(an * f, cn * f); }
            else { LAS float* p = kf + row * 128; p[lane * 2] = an; p[lane * 2 + 1] = cn; *(LAS unsigned*)(KB16 + row * S136 + lane * 4) = pk2(an, cn); } }
    }
    __syncthreads();
    TMARK(32);
    {
        const int mb = wid >> 1;
        bf16x8 ak[4], aq[4];
#pragma unroll
        for (int ks = 0; ks < 4; ++ks) { ak[ks] = frag_rm(KB16, S136, mb, ks, l15, g); aq[ks] = frag_rm(QB16, S136, mb, ks, l15, g); }
#pragma unroll
        for (int j = 0; j < 2; ++j) { const int nb = 2 * (wid & 1) + j; f32x4 kk = (f32x4){0.f, 0.f, 0.f, 0.f}, qk = (f32x4){0.f, 0.f, 0.f, 0.f};
#pragma unroll
            for (int ks = 0; ks < 4; ++ks) { const bf16x8 bfr = frag_rm(KB16, S136, nb, ks, l15, g); kk = MFMA16(ak[ks], bfr, kk); qk = MFMA16(aq[ks], bfr, qk); }
            const int jj = nb * 16 + l15; const float gj = GC[jj];
#pragma unroll
            for (int r = 0; r < 4; ++r) { const int i = mb * 16 + 4 * g + r; const float dec = jj <= i ? __expf(GC[i] - gj) : 0.f;
                const float av = jj < i ? BETA[i] * kk[r] * dec : 0.f;
                *(LAS bf16*)(AOFF + i * S72 + jj * 2) = (bf16)f2bf(nb < mb ? av : 0.f);
                if (nb == mb) AKK[(mb * 16 + 4 * g + r) * 20 + l15] = av;
                *(LAS bf16*)(ATTS + i * S72 + jj * 2) = (bf16)f2bf(qk[r] * dec * 0.08838834764831845f); } }
        for (int i = tid; i < 64 * S40 / 16; i += 512) *(LAS u32x4*)(TD + i * 16) = (u32x4){0u, 0u, 0u, 0u};
    }
    __syncthreads();
    TMARK(33);
    if (tid < 64) { const int k = tid >> 4, c = tid & 15; const LAS float* ab = AKK + k * 16 * 20; float y[16];
#pragma unroll
        for (int i = 0; i < 16; ++i) { float s = (i == c) ? 1.f : 0.f;
#pragma unroll
            for (int m = 0; m < i; ++m) s -= ab[i * 20 + m] * y[m];
            y[i] = s; *(LAS bf16*)(TD + (k * 16 + i) * S40 + c * 2) = (bf16)f2bf(s); } }
    for (int it = tid; it < 8 * 256; it += 512) { const int col = it & 255, i0 = (it >> 8) * 8;
        const LAS float* sp = col < 128 ? vf + col : kf + (col - 128); float r[8];
#pragma unroll
        for (int e = 0; e < 8; ++e) { const int i = i0 + e; r[e] = BETA[i] * sp[i * 128]; if (col >= 128) r[e] *= EG[i]; }
        *(LAS u32x4*)(XT + col * S72 + i0 * 2) = (u32x4){pk2(r[0], r[1]), pk2(r[2], r[3]), pk2(r[4], r[5]), pk2(r[6], r[7])}; }
    __syncthreads();
    TMARK(34);
    {
        for (int i = lane; i < 32 * S40 / 16; i += 64) *(LAS u32x4*)(TT + wid * 32 * S40 + i * 16) = (u32x4){0u, 0u, 0u, 0u};
#pragma unroll
        for (int k = 0; k < 4; ++k) {
#pragma unroll
            for (int jn = 0; jn < 2; ++jn) { const int nb = 2 * wid + jn, col = nb * 16 + l15;
                f32x4 acc = (f32x4){0.f, 0.f, 0.f, 0.f};
                if (k > 0) { acc = MFMA16(frag_rm(AOFF, S72, k, 0, l15, g), frag_rm(XT, S72, nb, 0, l15, g), acc);
                    if (k == 3) acc = MFMA16(frag_rm(AOFF, S72, k, 1, l15, g), frag_rm(XT, S72, nb, 1, l15, g), acc); }
                const u32x2 rv = *(const LAS u32x2*)(XT + col * S72 + (16 * k + 4 * g) * 2);
                *(LAS u32x2*)(TT + col * S40 + (4 * g) * 2) = (u32x2){pk2(bflo(rv.x) - acc[0], bfhi(rv.x) - acc[1]), pk2(bflo(rv.y) - acc[2], bfhi(rv.y) - acc[3])};
                f32x4 x = MFMA16(frag_rm(TD, S40, k, 0, l15, g), frag_rm(TT, S40, nb, 0, l15, g), ((f32x4){0.f, 0.f, 0.f, 0.f}));
                *(LAS u32x2*)(XT + col * S72 + (16 * k + 4 * g) * 2) = (u32x2){pk2(x[0], x[1]), pk2(x[2], x[3])};
            }
        }
    }
    __syncthreads();
    {
        const int q4 = l15 >> 2, p4 = lane & 3;
#pragma unroll
        for (int j = 0; j < 4; ++j) { const int op = wid * 4 + j, which = op >> 4, ks = (op >> 2) & 3, nb = op & 3;
            const bf16x8 f = frag_tr(XT + which * 128 * S72, S72, ks, nb, g, q4, p4); const int row = 16 * nb + l15, cc = 32 * ks + 8 * g;
            if (which == 0) *(bf16x8*)(PJ + (row0 + row) * LP + ov + cc) = f; else *(bf16x8*)((bf16*)(rec + GP_W) + row * 128 + cc) = f; }
    }
    TMARK(35);
    {
        { const int row = tid >> 3, c8 = tid & 7; *(u32x4*)(rec + GP_ATT + row * 128 + c8 * 16) = *(const LAS u32x4*)(ATTS + row * S72 + c8 * 16); }
        { const int dk = tid & 127, qt = tid >> 7; const float gl = GC[63]; unsigned w[8];
#pragma unroll
          for (int i = 0; i < 8; ++i) { const int c0 = qt * 16 + 2 * i; w[i] = pk2(kf[c0 * 128 + dk] * __expf(gl - GC[c0]), kf[(c0 + 1) * 128 + dk] * __expf(gl - GC[c0 + 1])); }
          u32x4* kp = (u32x4*)(rec + GP_KDT + dk * 128 + qt * 32);
          kp[0] = (u32x4){w[0], w[1], w[2], w[3]}; kp[1] = (u32x4){w[4], w[5], w[6], w[7]}; }
        if (tid == 0) *(float*)(rec + GP_CD) = EG[63];
    }
    TMARK(36);
}

__device__ __forceinline__ void gdn_scan_chain(KArgP A, int l, LAS unsigned char* lds, int b, int h, int ocol = -1) {
    bf16* PJ = (bf16*)(A->ws + WS_PROJ);
    unsigned char* dsc = (unsigned char*)A->out;
    const int tid = otid(), lane = tid & 63, wid = tid >> 6, l15 = lane & 15, g = lane >> 4;
    constexpr int S136 = 272, S72 = 144;
    LAS unsigned char* Wl = lds; LAS unsigned char* QDl = lds + 17408; LAS unsigned char* Ul = lds + 34816; LAS unsigned char* KDTl = lds + 52224; LAS unsigned char* ATTl = lds + 70656;
    LAS unsigned char* STl = lds + 79872; LAS unsigned char* VNl = lds + 114688; LAS float* SSQ = (LAS float*)(lds + 133120);
    LAS unsigned char* OST = Wl;
    const float* nw = A->gdn_norm_w + l * 128;
    const int mb = wid >> 1, nb0 = 4 * (wid & 1);
    f32x4 S[8];
#pragma unroll
    for (int j = 0; j < 8; ++j) S[j] = (f32x4){0.f, 0.f, 0.f, 0.f};
    __syncthreads();
    for (int i = tid; i < 128 * S136 / 16; i += 512) *(LAS u32x4*)(STl + i * 16) = (u32x4){0u, 0u, 0u, 0u};
    u32x4 pw[2], pq[2], pu[2], pk[2], pa, pz[2], zc[2]; float cd = 0.f, cdn = 0.f;
#define GDN_ISSUE(nn) do { const unsigned char* rec_ = dsc + DO_GP + (size_t)((b * 4 + h) * 32 + (nn)) * GP_STRIDE; const size_t r0_ = (size_t)b * SEQ + (nn) * 64; \
        _Pragma("unroll") for (int q_ = 0; q_ < 2; ++q_) { const int c_ = tid + 512 * q_, row_ = c_ >> 4, c16_ = c_ & 15; \
            pw[q_] = *(const u32x4*)(rec_ + GP_W + row_ * 256 + c16_ * 16); \
            pq[q_] = *(const u32x4*)(PJ + (r0_ + row_) * LP + C_GQ + h * 128 + c16_ * 8); pu[q_] = *(const u32x4*)(PJ + (r0_ + row_) * LP + C_GV + h * 128 + c16_ * 8); \
            pk[q_] = *(const u32x4*)(rec_ + GP_KDT + (c_ >> 3) * 128 + (c_ & 7) * 16); pz[q_] = *(const u32x4*)(PJ + (r0_ + row_) * LP + C_OA + h * 128 + c16_ * 8); } \
        pa = *(const u32x4*)(rec_ + GP_ATT + (tid >> 3) * 128 + (tid & 7) * 16); cdn = *(const float*)(rec_ + GP_CD); } while (0)
    GDN_ISSUE(0);
    for (int n = 0; n < SEQ / 64; ++n) {
        const size_t row0 = (size_t)b * SEQ + n * 64;
        __syncthreads();
#pragma unroll
        for (int q = 0; q < 2; ++q) { const int c = tid + 512 * q, row = c >> 4, c16 = c & 15;
            *(LAS u32x4*)(Wl + row * S136 + c16 * 16) = pw[q]; *(LAS u32x4*)(QDl + row * S136 + c16 * 16) = pq[q]; *(LAS u32x4*)(Ul + row * S136 + c16 * 16) = pu[q];
            *(LAS u32x4*)(KDTl + (c >> 3) * S72 + (c & 7) * 16) = pk[q]; }
        *(LAS u32x4*)(ATTl + (tid >> 3) * S72 + (tid & 7) * 16) = pa; cd = cdn; zc[0] = pz[0]; zc[1] = pz[1];
        __syncthreads();
        if (n + 1 < SEQ / 64) GDN_ISSUE(n + 1);
        f32x4 accO[4];
        {
            bf16x8 aw[4], aq[4];
#pragma unroll
            for (int ks = 0; ks < 4; ++ks) { aw[ks] = frag_rm(Wl, S136, mb, ks, l15, g); aq[ks] = frag_rm(QDl, S136, mb, ks, l15, g); }
#pragma unroll
            for (int j = 0; j < 4; ++j) { const int nb = nb0 + j; f32x4 ws = (f32x4){0.f, 0.f, 0.f, 0.f}; accO[j] = (f32x4){0.f, 0.f, 0.f, 0.f};
#pragma unroll
                for (int ks = 0; ks < 4; ++ks) { const bf16x8 sf = frag_rm(STl, S136, nb, ks, l15, g); ws = MFMA16(aw[ks], sf, ws); accO[j] = MFMA16(aq[ks], sf, accO[j]); }
                float vn[4];
#pragma unroll
                for (int r = 0; r < 4; ++r) vn[r] = bf2f(*(const LAS bf16*)(Ul + (mb * 16 + 4 * g + r) * S136 + (nb * 16 + l15) * 2)) - ws[r];
                *(LAS u32x2*)(VNl + (nb * 16 + l15) * S72 + (mb * 16 + 4 * g) * 2) = (u32x2){pk2(vn[0], vn[1]), pk2(vn[2], vn[3])}; }
        }
        __syncthreads();
        {
            bf16x8 aa[2], ak[2];
#pragma unroll
            for (int ks = 0; ks < 2; ++ks) { aa[ks] = frag_rm(ATTl, S72, mb, ks, l15, g); ak[ks] = frag_rm(KDTl, S72, wid, ks, l15, g); }
#pragma unroll
            for (int j = 0; j < 4; ++j)
#pragma unroll
                for (int ks = 0; ks < 2; ++ks) accO[j] = MFMA16(aa[ks], frag_rm(VNl, S72, nb0 + j, ks, l15, g), accO[j]);
#pragma unroll
            for (int jb = 0; jb < 8; ++jb) { S[jb] = S[jb] * cd;
#pragma unroll
                for (int ks = 0; ks < 2; ++ks) S[jb] = MFMA16(ak[ks], frag_rm(VNl, S72, jb, ks, l15, g), S[jb]);
                *(LAS u32x2*)(STl + (jb * 16 + l15) * S136 + (wid * 16 + 4 * g) * 2) = (u32x2){pk2(S[jb][0], S[jb][1]), pk2(S[jb][2], S[jb][3])}; }
        }
        {
            float ss[4];
#pragma unroll
            for (int r = 0; r < 4; ++r) { float s = 0.f;
#pragma unroll
                for (int j = 0; j < 4; ++j) s += accO[j][r] * accO[j][r];
                s += swz_xor<1>(s); s += swz_xor<2>(s); s += swz_xor<4>(s); s += swz_xor<8>(s); ss[r] = s; }
            if (l15 == 0) {
#pragma unroll
                for (int r = 0; r < 4; ++r) SSQ[(mb * 16 + 4 * g + r) * 2 + (wid & 1)] = ss[r]; }
            __syncthreads();
#pragma unroll
            for (int r = 0; r < 4; ++r) { const int i = mb * 16 + 4 * g + r; const float sc = rsqrtf((SSQ[i * 2] + SSQ[i * 2 + 1]) * (1.f / 128.f) + 1e-6f);
#pragma unroll
                for (int j = 0; j < 4; ++j) { const int dv = (nb0 + j) * 16 + l15; *(LAS bf16*)(OST + i * S136 + dv * 2) = (bf16)f2bf(accO[j][r] * sc * nw[dv]); } }
            __syncthreads();
#pragma unroll
            for (int q = 0; q < 2; ++q) { const int it = tid + 512 * q, tt = it >> 4, c8 = it & 15;
                bf16* gp = PJ + (row0 + tt) * LP + C_OA + h * 128 + c8 * 8; const u32x4 rv = zc[q]; if (ocol >= 0) gp = PJ + (row0 + tt) * LP + ocol + c8 * 8; const u32x4 ov = *(const LAS u32x4*)(OST + tt * S136 + c8 * 16);
                u32x4 w; w.x = pk2(bflo(ov.x) * siluf_(bflo(rv.x)), bfhi(ov.x) * siluf_(bfhi(rv.x))); w.y = pk2(bflo(ov.y) * siluf_(bflo(rv.y)), bfhi(ov.y) * siluf_(bfhi(rv.y)));
                w.z = pk2(bflo(ov.z) * siluf_(bflo(rv.z)), bfhi(ov.z) * siluf_(bfhi(rv.z))); w.w = pk2(bflo(ov.w) * siluf_(bflo(rv.w)), bfhi(ov.w) * siluf_(bfhi(rv.w)));
                *(u32x4*)gp = w; }
        }
    }
#undef GDN_ISSUE
}

__device__ __forceinline__ unsigned char* gla_slot(KArgP A, int b, int h, int n) {
    const int s = (b * 4 + h) * 32 + n;
    return b < 13 ? A->ws + WS_KVS + (size_t)s * 16384 : (unsigned char*)A->out + DO_KVS + (size_t)(s - 13 * 128) * 16384;
}
struct GlaPre { u32x4 v[2], q, k; unsigned short lr[2]; };
__device__ __forceinline__ void gla_prep_issue(GlaPre& P, KArgP A, int b, int h, int n) {
    const bf16* PJ = (const bf16*)(A->ws + WS_PROJ); const int tid = otid(); const size_t row0 = (size_t)b * SEQ + n * 64;
#pragma unroll
    for (int q = 0; q < 2; ++q) { const int it = tid + 512 * q, tt = it >> 4, c = it & 15;
        P.lr[q] = PJ[(row0 + tt) * LP + C_SM + 16 + c]; P.v[q] = *(const u32x4*)(PJ + (row0 + tt) * LP + C_LV + h * 128 + c * 8); }
    const int tt0 = tid >> 3, c80 = tid & 7;
    P.q = *(const u32x4*)(PJ + (row0 + tt0) * LP + C_LQ + h * 64 + c80 * 8); P.k = *(const u32x4*)(PJ + (row0 + tt0) * LP + C_LK + h * 64 + c80 * 8);
}
__device__ __forceinline__ void gla_prep_task(KArgP A, int l, LAS unsigned char* lds, int b, int h, int n, GlaPre& P, bool has_next, int nb_, int nh_, int nn_, GlaPre& N) {
    bf16* PJ = (bf16*)(A->ws + WS_PROJ);
    const int tid = otid(), lane = tid & 63, wid = tid >> 6, l15 = lane & 15, g = lane >> 4, q4 = l15 >> 2, p4 = lane & 3;
    constexpr int S72 = 144, S136 = 272;
    LAS unsigned char* QT = lds; LAS unsigned char* KT = QT + 64 * S72; LAS unsigned char* KDT = KT + 64 * S72; LAS unsigned char* ATT = KDT + 64 * S72; LAS unsigned char* VV = ATT + 64 * S72;
    LAS float* LA = (LAS float*)(VV + 64 * S136); LAS float* LR = LA + 64 * 64; LAS float* SEG = LR + 64 * 16;
    const float* wg2 = A->gla_w_gate2 + (size_t)l * 16 * 256; const float* bg = A->gla_b_gate + l * 256;
    const size_t row0 = (size_t)b * SEQ + n * 64;
    const int mb = wid >> 1, nb0 = 4 * (wid & 1);
    float wcol[16]; const float bgv = bg[h * 64 + (tid & 63)];
#pragma unroll
    for (int r = 0; r < 16; ++r) wcol[r] = wg2[r * 256 + h * 64 + (tid & 63)];
    __syncthreads();
#pragma unroll
    for (int q = 0; q < 2; ++q) { const int it = tid + 512 * q; LR[it] = bf2f(P.lr[q]); *(LAS u32x4*)(VV + (it >> 4) * S136 + (it & 15) * 16) = P.v[q]; }
    const int tt0 = tid >> 3, c80 = tid & 7;
    const u32x4 qv = P.q, kv = P.k;
    if (has_next) gla_prep_issue(N, A, nb_, nh_, nn_);
    __syncthreads();
    for (int it = tid; it < 64 * 64; it += 512) { const int tt = it >> 6; float z = bgv;
        const LAS f32x4* lr4 = (const LAS f32x4*)(LR + tt * 16);
#pragma unroll
        for (int r4 = 0; r4 < 4; ++r4) { const f32x4 v = lr4[r4]; z += v[0] * wcol[4 * r4] + v[1] * wcol[4 * r4 + 1] + v[2] * wcol[4 * r4 + 2] + v[3] * wcol[4 * r4 + 3]; }
        LA[it] = (fminf(z, 0.f) - __logf(1.f + __expf(-fabsf(z)))) * (1.f / 16.f); }
    __syncthreads();
    { const int d = tid & 63, seg = tid >> 6; float run = 0.f;
#pragma unroll
      for (int i = 0; i < 8; ++i) { run += LA[(seg * 8 + i) * 64 + d]; LA[(seg * 8 + i) * 64 + d] = run; }
      SEG[seg * 64 + d] = run; }
    __syncthreads();
    { const int d = tid & 63, seg = tid >> 6; float pre = 0.f;
      for (int s2 = 0; s2 < seg; ++s2) pre += SEG[s2 * 64 + d];
#pragma unroll
      for (int i = 0; i < 8; ++i) LA[(seg * 8 + i) * 64 + d] += pre; }
    __syncthreads();
    {
        const float qf[8] = {bflo(qv.x), bfhi(qv.x), bflo(qv.y), bfhi(qv.y), bflo(qv.z), bfhi(qv.z), bflo(qv.w), bfhi(qv.w)};
        const float kf[8] = {bflo(kv.x), bfhi(kv.x), bflo(kv.y), bfhi(kv.y), bflo(kv.z), bfhi(kv.z), bflo(kv.w), bfhi(kv.w)};
        float qt[8], kt[8];
#pragma unroll
        for (int e = 0; e < 8; ++e) { const int d = c80 * 8 + e; const float cu = LA[tt0 * 64 + d], cl = LA[63 * 64 + d];
            qt[e] = qf[e] * 0.125f * __expf(cu); kt[e] = kf[e] * __expf(-cu);
            *(LAS bf16*)(KDT + d * S72 + tt0 * 2) = (bf16)f2bf(kf[e] * __expf(cl - cu)); }
        const u32x4 qw = (u32x4){pk2(qt[0], qt[1]), pk2(qt[2], qt[3]), pk2(qt[4], qt[5]), pk2(qt[6], qt[7])};
        *(LAS u32x4*)(QT + tt0 * S72 + c80 * 16) = qw;
        *(u32x4*)(PJ + (row0 + tt0) * LP + C_LQ + h * 64 + c80 * 8) = qw;
        *(LAS u32x4*)(KT + tt0 * S72 + c80 * 16) = (u32x4){pk2(kt[0], kt[1]), pk2(kt[2], kt[3]), pk2(kt[4], kt[5]), pk2(kt[6], kt[7])};
        if (tid < 64) ((float*)(A->ws + WS_CDB))[(size_t)((b * 4 + h) * 32 + n) * 64 + tid] = __expf(LA[63 * 64 + tid]);
    }
    __syncthreads();
    {
        bf16x8 af[2], kf2[2];
#pragma unroll
        for (int ks = 0; ks < 2; ++ks) { af[ks] = frag_rm(QT, S72, mb, ks, l15, g); kf2[ks] = frag_rm(KDT, S72, mb, ks, l15, g); }
#pragma unroll
        for (int j = 0; j < 2; ++j) { const int nb = 2 * (wid & 1) + j; f32x4 a = (f32x4){0.f, 0.f, 0.f, 0.f};
#pragma unroll
            for (int ks = 0; ks < 2; ++ks) a = MFMA16(af[ks], frag_rm(KT, S72, nb, ks, l15, g), a);
#pragma unroll
            for (int r = 0; r < 4; ++r) { const int i = mb * 16 + 4 * g + r, jj = nb * 16 + l15; *(LAS bf16*)(ATT + i * S72 + jj * 2) = (bf16)f2bf(jj <= i ? a[r] : 0.f); } }
        unsigned char* slot = gla_slot(A, b, h, n);
#pragma unroll
        for (int j = 0; j < 4; ++j) { f32x4 kvb = (f32x4){0.f, 0.f, 0.f, 0.f};
#pragma unroll
            for (int ks = 0; ks < 2; ++ks) kvb = MFMA16(kf2[ks], frag_tr(VV, S136, ks, nb0 + j, g, q4, p4), kvb);
            *(u32x2*)(slot + ((nb0 + j) * 16 + l15) * 128 + (mb * 16 + 4 * g) * 2) = (u32x2){pk2(kvb[0], kvb[1]), pk2(kvb[2], kvb[3])}; }
    }
    __syncthreads();
    { const int row = tid >> 3, c8 = tid & 7; *(u32x4*)(PJ + (row0 + row) * LP + C_LK + h * 64 + c8 * 8) = *(const LAS u32x4*)(ATT + row * S72 + c8 * 16); }
}
__device__ __forceinline__ void gla_state_scan(KArgP A) {
    for (int gt = obid() * 512 + otid(); gt < 64 * 2048; gt += ogrid() * 512) {
    const int ch = gt >> 11, e4 = gt & 2047, b = ch >> 2, h = ch & 3;
    const float* cdb = (const float*)(A->ws + WS_CDB) + (size_t)ch * 32 * 64 + (e4 & 15) * 4;
    float s0 = 0.f, s1 = 0.f, s2 = 0.f, s3 = 0.f;
#pragma unroll 8
    for (int n = 0; n < 32; ++n) {
        u32x2* p = (u32x2*)(gla_slot(A, b, h, n) + e4 * 8); const u32x2 kv = *p; const f32x4 cd = *(const f32x4*)(cdb + n * 64);
        *p = (u32x2){pk2(s0, s1), pk2(s2, s3)};
        s0 = cd[0] * s0 + bflo(kv.x); s1 = cd[1] * s1 + bfhi(kv.x); s2 = cd[2] * s2 + bflo(kv.y); s3 = cd[3] * s3 + bfhi(kv.y);
    }
    }
}
__device__ __forceinline__ void gla_out_task(KArgP A, int l, LAS unsigned char* lds, int b, int h, int n) {
    bf16* PJ = (bf16*)(A->ws + WS_PROJ);
    const int tid = otid(), lane = tid & 63, wid = tid >> 6, l15 = lane & 15, g = lane >> 4, q4 = l15 >> 2, p4 = lane & 3;
    constexpr int S72 = 144, S136 = 272;
    LAS unsigned char* QT = lds; LAS unsigned char* ATT = QT + 64 * S72; LAS unsigned char* VV = ATT + 64 * S72; LAS unsigned char* ST = VV + 64 * S136; LAS unsigned char* OST = ST + 128 * S72;
    LAS float* SSQ = (LAS float*)(OST + 64 * S136);
    const float* nw = A->gla_norm_w + l * 128;
    const size_t row0 = (size_t)b * SEQ + n * 64;
    const int mb = wid >> 1, nb0 = 4 * (wid & 1);
    const unsigned char* slot = gla_slot(A, b, h, n);
    u32x4 rpre[2];
#pragma unroll
    for (int q = 0; q < 2; ++q) { const int it = tid + 512 * q; rpre[q] = *(const u32x4*)(PJ + (row0 + (it >> 4)) * LP + C_OC + h * 128 + (it & 15) * 8); }
    __syncthreads();
    { const int row = tid >> 3, c8 = tid & 7;
      *(LAS u32x4*)(QT + row * S72 + c8 * 16) = *(const u32x4*)(PJ + (row0 + row) * LP + C_LQ + h * 64 + c8 * 8);
      *(LAS u32x4*)(ATT + row * S72 + c8 * 16) = *(const u32x4*)(PJ + (row0 + row) * LP + C_LK + h * 64 + c8 * 8); }
#pragma unroll
    for (int q = 0; q < 2; ++q) { const int c = tid + 512 * q;
        *(LAS u32x4*)(VV + (c >> 4) * S136 + (c & 15) * 16) = *(const u32x4*)(PJ + (row0 + (c >> 4)) * LP + C_LV + h * 128 + (c & 15) * 8);
        *(LAS u32x4*)(ST + (c >> 3) * S72 + (c & 7) * 16) = *(const u32x4*)(slot + (c >> 3) * 128 + (c & 7) * 16); }
    __syncthreads();
    f32x4 acc[4];
    {
        bf16x8 af[2], aa[2];
#pragma unroll
        for (int ks = 0; ks < 2; ++ks) { af[ks] = frag_rm(QT, S72, mb, ks, l15, g); aa[ks] = frag_rm(ATT, S72, mb, ks, l15, g); }
#pragma unroll
        for (int j = 0; j < 4; ++j) { acc[j] = (f32x4){0.f, 0.f, 0.f, 0.f};
#pragma unroll
            for (int ks = 0; ks < 2; ++ks) { acc[j] = MFMA16(af[ks], frag_rm(ST, S72, nb0 + j, ks, l15, g), acc[j]); acc[j] = MFMA16(aa[ks], frag_tr(VV, S136, ks, nb0 + j, g, q4, p4), acc[j]); } }
    }
    float ss[4];
#pragma unroll
    for (int r = 0; r < 4; ++r) { float s = 0.f;
#pragma unroll
        for (int j = 0; j < 4; ++j) s += acc[j][r] * acc[j][r];
        s += swz_xor<1>(s); s += swz_xor<2>(s); s += swz_xor<4>(s); s += swz_xor<8>(s); ss[r] = s; }
    if (l15 == 0) {
#pragma unroll
        for (int r = 0; r < 4; ++r) SSQ[(mb * 16 + 4 * g + r) * 2 + (wid & 1)] = ss[r]; }
    __syncthreads();
#pragma unroll
    for (int r = 0; r < 4; ++r) { const int i = mb * 16 + 4 * g + r; const float sc = rsqrtf((SSQ[i * 2] + SSQ[i * 2 + 1]) * (1.f / 128.f) + 1e-6f);
#pragma unroll
        for (int j = 0; j < 4; ++j) { const int dv = (nb0 + j) * 16 + l15; *(LAS bf16*)(OST + i * S136 + dv * 2) = (bf16)f2bf(acc[j][r] * sc * nw[dv]); } }
    __syncthreads();
#pragma unroll
    for (int q = 0; q < 2; ++q) { const int it = tid + 512 * q, tt = it >> 4, c8 = it & 15;
        bf16* gp = PJ + (row0 + tt) * LP + C_OC + h * 128 + c8 * 8; const u32x4 rv = rpre[q]; const u32x4 ov = *(const LAS u32x4*)(OST + tt * S136 + c8 * 16);
        u32x4 w; w.x = pk2(bflo(ov.x) * siluf_(bflo(rv.x)), bfhi(ov.x) * siluf_(bfhi(rv.x))); w.y = pk2(bflo(ov.y) * siluf_(bflo(rv.y)), bfhi(ov.y) * siluf_(bfhi(rv.y)));
        w.z = pk2(bflo(ov.z) * siluf_(bflo(rv.z)), bfhi(ov.z) * siluf_(bfhi(rv.z))); w.w = pk2(bflo(ov.w) * siluf_(bflo(rv.w)), bfhi(ov.w) * siluf_(bfhi(rv.w)));
        *(u32x4*)gp = w; }
}

struct LnRow { float v[16]; };
__device__ __forceinline__ void ln_normalize(LnRow& r, const float* g, const float* bta, int lane) {
    float s = 0.f;
#pragma unroll
    for (int i = 0; i < 16; ++i) s += r.v[i];
    const float mean = wave_sum(s) * (1.f / 1024.f); float q = 0.f;
#pragma unroll
    for (int i = 0; i < 16; ++i) { r.v[i] -= mean; q += r.v[i] * r.v[i]; }
    const float rstd = rsqrtf(wave_sum(q) * (1.f / 1024.f) + 1e-5f);
#pragma unroll
    for (int jj = 0; jj < 2; ++jj) { const int k = 8 * (lane + 64 * jj);
        const f32x4 g0 = *(const f32x4*)(g + k), g1 = *(const f32x4*)(g + k + 4), b0 = *(const f32x4*)(bta + k), b1 = *(const f32x4*)(bta + k + 4);
#pragma unroll
        for (int e = 0; e < 4; ++e) { r.v[jj * 8 + e] = r.v[jj * 8 + e] * rstd * g0[e] + b0[e]; r.v[jj * 8 + 4 + e] = r.v[jj * 8 + 4 + e] * rstd * g1[e] + b1[e]; } }
}
struct LnW { float g[16], b[16]; };
__device__ __forceinline__ void ln_weights(LnW& W, const float* g, const float* bta, int lane) {
#pragma unroll
    for (int jj = 0; jj < 2; ++jj) { const int k = 8 * (lane + 64 * jj);
        const f32x4 g0 = *(const f32x4*)(g + k), g1 = *(const f32x4*)(g + k + 4), b0 = *(const f32x4*)(bta + k), b1 = *(const f32x4*)(bta + k + 4);
#pragma unroll
        for (int e = 0; e < 4; ++e) { W.g[jj * 8 + e] = g0[e]; W.g[jj * 8 + 4 + e] = g1[e]; W.b[jj * 8 + e] = b0[e]; W.b[jj * 8 + 4 + e] = b1[e]; } }
}
__device__ __forceinline__ void ln_normalize_w(LnRow& r, const LnW& W) {
    float s = 0.f;
#pragma unroll
    for (int i = 0; i < 16; ++i) s += r.v[i];
    const float mean = wave_sum(s) * (1.f / 1024.f); float q = 0.f;
#pragma unroll
    for (int i = 0; i < 16; ++i) { r.v[i] -= mean; q += r.v[i] * r.v[i]; }
    const float rstd = rsqrtf(wave_sum(q) * (1.f / 1024.f) + 1e-5f);
#pragma unroll
    for (int i = 0; i < 16; ++i) r.v[i] = r.v[i] * rstd * W.g[i] + W.b[i];
}
__device__ __forceinline__ void ln_unpack(LnRow& r, const u32x4 (&t)[2], float scale) {
#pragma unroll
    for (int jj = 0; jj < 2; ++jj) {
        r.v[jj * 8 + 0] = scale * bflo(t[jj].x); r.v[jj * 8 + 1] = scale * bfhi(t[jj].x); r.v[jj * 8 + 2] = scale * bflo(t[jj].y); r.v[jj * 8 + 3] = scale * bfhi(t[jj].y);
        r.v[jj * 8 + 4] = scale * bflo(t[jj].z); r.v[jj * 8 + 5] = scale * bfhi(t[jj].z); r.v[jj * 8 + 6] = scale * bflo(t[jj].w); r.v[jj * 8 + 7] = scale * bfhi(t[jj].w); }
}
__device__ __forceinline__ void ln_unpack_add(LnRow& r, const u32x4 (&t)[2], float scale) {
#pragma unroll
    for (int jj = 0; jj < 2; ++jj) {
        r.v[jj * 8 + 0] += scale * bflo(t[jj].x); r.v[jj * 8 + 1] += scale * bfhi(t[jj].x); r.v[jj * 8 + 2] += scale * bflo(t[jj].y); r.v[jj * 8 + 3] += scale * bfhi(t[jj].y);
        r.v[jj * 8 + 4] += scale * bflo(t[jj].z); r.v[jj * 8 + 5] += scale * bfhi(t[jj].z); r.v[jj * 8 + 6] += scale * bflo(t[jj].w); r.v[jj * 8 + 7] += scale * bfhi(t[jj].w); }
}
__device__ __forceinline__ void ln_fetch(u32x4 (&t)[2], const bf16* row, int lane) { t[0] = *(const u32x4*)(row + 8 * lane); t[1] = *(const u32x4*)(row + 8 * (lane + 64)); }
__device__ __forceinline__ void ln_load_bf16(LnRow& r, const bf16* row, int lane, float scale) {
#pragma unroll
    for (int jj = 0; jj < 2; ++jj) { const u32x4 t = *(const u32x4*)(row + 8 * (lane + 64 * jj));
        r.v[jj * 8 + 0] = scale * bflo(t.x); r.v[jj * 8 + 1] = scale * bfhi(t.x); r.v[jj * 8 + 2] = scale * bflo(t.y); r.v[jj * 8 + 3] = scale * bfhi(t.y);
        r.v[jj * 8 + 4] = scale * bflo(t.z); r.v[jj * 8 + 5] = scale * bfhi(t.z); r.v[jj * 8 + 6] = scale * bflo(t.w); r.v[jj * 8 + 7] = scale * bfhi(t.w); }
}
__device__ __forceinline__ void ln_add_bf16(LnRow& r, const bf16* row, int lane, float scale) {
#pragma unroll
    for (int jj = 0; jj < 2; ++jj) { const u32x4 t = *(const u32x4*)(row + 8 * (lane + 64 * jj));
        r.v[jj * 8 + 0] += scale * bflo(t.x); r.v[jj * 8 + 1] += scale * bfhi(t.x); r.v[jj * 8 + 2] += scale * bflo(t.y); r.v[jj * 8 + 3] += scale * bfhi(t.y);
        r.v[jj * 8 + 4] += scale * bflo(t.z); r.v[jj * 8 + 5] += scale * bfhi(t.z); r.v[jj * 8 + 6] += scale * bflo(t.w); r.v[jj * 8 + 7] += scale * bfhi(t.w); }
}
__device__ __forceinline__ void ln_store_bf16(const LnRow& r, bf16* row, int lane) {
#pragma unroll
    for (int jj = 0; jj < 2; ++jj) { u32x4 w; w.x = pk2(r.v[jj * 8], r.v[jj * 8 + 1]); w.y = pk2(r.v[jj * 8 + 2], r.v[jj * 8 + 3]); w.z = pk2(r.v[jj * 8 + 4], r.v[jj * 8 + 5]); w.w = pk2(r.v[jj * 8 + 6], r.v[jj * 8 + 7]);
        *(u32x4*)(row + 8 * (lane + 64 * jj)) = w; }
}
__device__ __forceinline__ void ln_store_f32(const LnRow& r, float* row, int lane) {
#pragma unroll
    for (int jj = 0; jj < 2; ++jj) { float* p = row + 8 * (lane + 64 * jj);
        *(f32x4*)p = (f32x4){r.v[jj * 8], r.v[jj * 8 + 1], r.v[jj * 8 + 2], r.v[jj * 8 + 3]}; *(f32x4*)(p + 4) = (f32x4){r.v[jj * 8 + 4], r.v[jj * 8 + 5], r.v[jj * 8 + 6], r.v[jj * 8 + 7]}; }
}

__device__ __forceinline__ KArgP argp() { KArgP p = (KArgP)__builtin_amdgcn_kernarg_segment_ptr(); asm volatile("" : "+s"(p)); return p; }
namespace pg8 {
struct EpiResidStat {
    static constexpr bool PERM = true;
    const bf16* X; bf16* Y;
    __device__ __forceinline__ void operator()(const f32x4 (&acc)[2][2][4][2], const Unit& u, int wr, int wc, int fr, int fq) const {
        constexpr int ldc = 1024; float* ST = (float*)((unsigned char*)argp()->out + DO_STAT);
        const int pidx = (u.col0 >> 8) * 4 + wc;
#pragma unroll
        for (int ai = 0; ai < 2; ++ai) {
            u32x4 xv[4][2];
#pragma unroll
            for (int m = 0; m < 4; ++m)
#pragma unroll
                for (int bj = 0; bj < 2; ++bj) xv[m][bj] = *(const u32x4*)(X + (size_t)(u.row0 + ai * HALF + wr * 64 + m * 16 + fr) * ldc + u.col0 + bj * HALF + wc * 32 + 8 * fq);
#pragma unroll
            for (int m = 0; m < 4; ++m) { const int row = u.row0 + ai * HALF + wr * 64 + m * 16 + fr; float s1 = 0.f, s2 = 0.f;
#pragma unroll
                for (int bj = 0; bj < 2; ++bj) { const f32x4 v0 = acc[ai][bj][m][0], v1 = acc[ai][bj][m][1]; const u32x4 t = xv[m][bj];
                    const float y0 = ALPHA * bflo(t.x) + v0[0], y1 = ALPHA * bfhi(t.x) + v0[1], y2 = ALPHA * bflo(t.y) + v0[2], y3 = ALPHA * bfhi(t.y) + v0[3];
                    const float y4 = ALPHA * bflo(t.z) + v1[0], y5 = ALPHA * bfhi(t.z) + v1[1], y6 = ALPHA * bflo(t.w) + v1[2], y7 = ALPHA * bfhi(t.w) + v1[3];
                    s1 += ((y0 + y1) + (y2 + y3)) + ((y4 + y5) + (y6 + y7));
                    s2 += ((y0 * y0 + y1 * y1) + (y2 * y2 + y3 * y3)) + ((y4 * y4 + y5 * y5) + (y6 * y6 + y7 * y7));
                    u32x4 w; w.x = pk2(y0, y1); w.y = pk2(y2, y3); w.z = pk2(y4, y5); w.w = pk2(y6, y7);
                    *(u32x4*)(Y + (size_t)row * ldc + u.col0 + bj * HALF + wc * 32 + 8 * fq) = w; }
                s1 += swz_xor<16>(s1); s2 += swz_xor<16>(s2); s1 = half_sum(s1); s2 = half_sum(s2);
                if (fq == 0) *(f32x2*)(ST + (size_t)row * 32 + pidx * 2) = (f32x2){s1, s2}; }
        }
    }
};
__device__ __forceinline__ void ln_unit_stats(const float* ST, int row0, LAS f32x2* MR) {
    const int t = otid(), rl = t >> 1, hp = t & 1; const float* sp = ST + (size_t)(row0 + rl) * 32 + hp * 16;
    const f32x4 a = *(const f32x4*)sp, b = *(const f32x4*)(sp + 4), c = *(const f32x4*)(sp + 8), d = *(const f32x4*)(sp + 12);
    float s1 = ((a[0] + a[2]) + (b[0] + b[2])) + ((c[0] + c[2]) + (d[0] + d[2])), s2 = ((a[1] + a[3]) + (b[1] + b[3])) + ((c[1] + c[3]) + (d[1] + d[3]));
    s1 += swz_xor<1>(s1); s2 += swz_xor<1>(s2);
    const float mean = s1 * (1.f / 1024.f), rstd = rsqrtf(fmaxf(s2 * (1.f / 1024.f) - mean * mean, 0.f) + 1e-5f);
    if (hp == 0) MR[rl] = (f32x2){mean, rstd};
    __syncthreads();
}
struct EpiQFold {
    static constexpr bool PERM = true;
    bf16* O; int l; LAS f32x2* MR;
    __device__ __forceinline__ void operator()(const f32x4 (&acc)[2][2][4][2], const Unit& u, int wr, int wc, int fr, int fq) const {
        constexpr int ldc = 1024; constexpr float scale = 0.0625f * LOG2E;
        const unsigned char* dsc_ = (const unsigned char*)argp()->out; const float* ST = (const float*)(dsc_ + DO_STAT); const float* CD = (const float*)(dsc_ + DO_CD) + l * 2048;
        f32x4 cv[2][2], dv[2][2];
#pragma unroll
        for (int bj = 0; bj < 2; ++bj) { const int gc = u.col0 + bj * HALF + wc * 32 + 8 * fq;
            cv[bj][0] = *(const f32x4*)(CD + gc); cv[bj][1] = *(const f32x4*)(CD + gc + 4); dv[bj][0] = *(const f32x4*)(CD + 1024 + gc) * scale; dv[bj][1] = *(const f32x4*)(CD + 1024 + gc + 4) * scale; }
        ln_unit_stats(ST, u.row0, MR);
#pragma unroll
        for (int ai = 0; ai < 2; ++ai)
#pragma unroll
            for (int m = 0; m < 4; ++m) { const int rl = ai * HALF + wr * 64 + m * 16 + fr, row = u.row0 + rl; const f32x2 mr = MR[rl]; const float mean = mr[0], rs = mr[1] * scale;
#pragma unroll
                for (int bj = 0; bj < 2; ++bj) { const f32x4 v0 = acc[ai][bj][m][0], v1 = acc[ai][bj][m][1]; const f32x4 c0 = cv[bj][0], c1 = cv[bj][1], d0 = dv[bj][0], d1 = dv[bj][1];
                    u32x4 w;
                    w.x = pk2((v0[0] - mean * c0[0]) * rs + d0[0], (v0[1] - mean * c0[1]) * rs + d0[1]); w.y = pk2((v0[2] - mean * c0[2]) * rs + d0[2], (v0[3] - mean * c0[3]) * rs + d0[3]);
                    w.z = pk2((v1[0] - mean * c1[0]) * rs + d1[0], (v1[1] - mean * c1[1]) * rs + d1[1]); w.w = pk2((v1[2] - mean * c1[2]) * rs + d1[2], (v1[3] - mean * c1[3]) * rs + d1[3]);
                    *(u32x4*)(O + (size_t)row * ldc + u.col0 + bj * HALF + wc * 32 + 8 * fq) = w; } }
    }
};
struct EpiResidLN {
    static constexpr bool PERM = true;
    bf16* Y; int l; LAS f32x2* MR;
    __device__ __forceinline__ void operator()(const f32x4 (&acc)[2][2][4][2], const Unit& u, int wr, int wc, int fr, int fq) const {
        constexpr int ldc = 1024; KArgP ap_ = argp();
        const float* ST = (const float*)((const unsigned char*)ap_->out + DO_STAT); const float* g = ap_->ln1_g + l * 1024; const float* bta = ap_->ln1_b + l * 1024;
        f32x4 gv[2][2], bv[2][2];
#pragma unroll
        for (int bj = 0; bj < 2; ++bj) { const int gc = u.col0 + bj * HALF + wc * 32 + 8 * fq;
            gv[bj][0] = *(const f32x4*)(g + gc); gv[bj][1] = *(const f32x4*)(g + gc + 4); bv[bj][0] = *(const f32x4*)(bta + gc) * ALPHA; bv[bj][1] = *(const f32x4*)(bta + gc + 4) * ALPHA; }
        ln_unit_stats(ST, u.row0, MR);
#pragma unroll
        for (int ai = 0; ai < 2; ++ai) {
            u32x4 xv[4][2];
#pragma unroll
            for (int m = 0; m < 4; ++m)
#pragma unroll
                for (int bj = 0; bj < 2; ++bj) xv[m][bj] = *(const u32x4*)(Y + (size_t)(u.row0 + ai * HALF + wr * 64 + m * 16 + fr) * ldc + u.col0 + bj * HALF + wc * 32 + 8 * fq);
#pragma unroll
            for (int m = 0; m < 4; ++m) { const int rl = ai * HALF + wr * 64 + m * 16 + fr, row = u.row0 + rl; const f32x2 mr = MR[rl]; const float mean = mr[0], a = ALPHA * mr[1];
#pragma unroll
                for (int bj = 0; bj < 2; ++bj) { const f32x4 v0 = acc[ai][bj][m][0], v1 = acc[ai][bj][m][1]; const u32x4 t = xv[m][bj]; const f32x4 g0 = gv[bj][0], g1 = gv[bj][1], b0 = bv[bj][0], b1 = bv[bj][1];
                    u32x4 w;
                    w.x = pk2((bflo(t.x) - mean) * a * g0[0] + b0[0] + v0[0], (bfhi(t.x) - mean) * a * g0[1] + b0[1] + v0[1]);
                    w.y = pk2((bflo(t.y) - mean) * a * g0[2] + b0[2] + v0[2], (bfhi(t.y) - mean) * a * g0[3] + b0[3] + v0[3]);
                    w.z = pk2((bflo(t.z) - mean) * a * g1[0] + b1[0] + v1[0], (bfhi(t.z) - mean) * a * g1[1] + b1[1] + v1[1]);
                    w.w = pk2((bflo(t.w) - mean) * a * g1[2] + b1[2] + v1[2], (bfhi(t.w) - mean) * a * g1[3] + b1[3] + v1[3]);
                    *(u32x4*)(Y + (size_t)row * ldc + u.col0 + bj * HALF + wc * 32 + 8 * fq) = w; } }
        }
    }
};
}
#define XB_TMO      128
#define XB_XCNT(j)  (256  + 64 * (j))
#define XB_XSUB(j)  (1280 + 64 * (j))
#define XB_XGEN(j)  (2304 + 64 * (j))
#define XB_TOP      3328
#define XB_TOPGEN   3392
#define XB_SPIN_CAP (1u << 20)
constexpr int CW_BAR = 4096;
__device__ __forceinline__ unsigned xb_ld(unsigned* p)              { return __hip_atomic_load(p, __ATOMIC_RELAXED, __HIP_MEMORY_SCOPE_AGENT); }
__device__ __forceinline__ unsigned xb_add(unsigned* p, unsigned v) { return __hip_atomic_fetch_add(p, v, __ATOMIC_RELAXED, __HIP_MEMORY_SCOPE_AGENT); }
__device__ __forceinline__ unsigned xb_xcc_id() { return (unsigned)__builtin_amdgcn_s_getreg((3 << 11) | 20) & 0xFu; }
#define XB_SPIN(cond, bar) do { unsigned _sp = 0; while (cond) { __builtin_amdgcn_s_sleep(1); \
    if ((++_sp & 255u) == 0u) { if (xb_ld(&(bar)[XB_TMO])) break; if (_sp > XB_SPIN_CAP) { atomicAdd(&(bar)[XB_TMO], 1u); break; } } } } while (0)
__device__ __forceinline__ void xcd_barrier_complete(unsigned* bar, unsigned x, unsigned& nloc, unsigned& nx) {
    const unsigned G = gridDim.x;
    unsigned sum, cnt, mine, sp = 0u;
    for (;;) {
        sum = 0u; cnt = 0u; mine = 0u;
#pragma unroll
        for (unsigned j = 0; j < 16; ++j) { const unsigned c = xb_ld(&bar[XB_XCNT(j)]); sum += c; cnt += (c > 0u) ? 1u : 0u; mine = (j == x) ? c : mine; }
        if (sum == G) break;
        __builtin_amdgcn_s_sleep(1);
        if ((++sp & 255u) == 0u) { if (xb_ld(&bar[XB_TMO])) break; if (sp > XB_SPIN_CAP) { atomicAdd(&bar[XB_TMO], 1u); break; } }
    }
    nloc = mine > 0u ? mine : 1u; nx = cnt > 0u ? cnt : 1u;
}
__device__ __forceinline__ void grid_barrier(LAS unsigned char* lds) {
    volatile LAS unsigned* st = (volatile LAS unsigned*)(lds + LDS_CTL + 2048);
    asm volatile("s_waitcnt vmcnt(0)" ::: "memory");
    __syncthreads();
    if (otid() == 0) {
        unsigned* bar = (unsigned*)(argp()->ws + WS_CTL) + CW_BAR;
        const unsigned x = xb_xcc_id();
        __builtin_amdgcn_s_waitcnt(0);
        unsigned nloc = st[0], nx = st[1];
        if (nloc == 0u) { xcd_barrier_complete(bar, x, nloc, nx); st[0] = nloc; st[1] = nx; }
        const unsigned old = xb_add(&bar[XB_XSUB(x)], 1u);
        const unsigned gen = old / nloc;
        if (old + 1u == (gen + 1u) * nloc) {
            __builtin_amdgcn_fence(__ATOMIC_RELEASE, "agent");
            asm volatile("s_waitcnt vmcnt(0)" ::: "memory");
            const unsigned og = xb_add(&bar[XB_TOP], 1u);
            const unsigned tg = og / nx;
            if (og + 1u == (tg + 1u) * nx) xb_add(&bar[XB_TOPGEN], 1u);
            else XB_SPIN(xb_ld(&bar[XB_TOPGEN]) == tg, bar);
            __builtin_amdgcn_fence(__ATOMIC_ACQUIRE, "agent");
            xb_add(&bar[XB_XGEN(x)], 1u);
            asm volatile("s_waitcnt vmcnt(0)" ::: "memory");
        } else {
            XB_SPIN(xb_ld(&bar[XB_XGEN(x)]) == gen, bar);
            __builtin_amdgcn_fence(__ATOMIC_ACQUIRE, "agent");
            asm volatile("s_waitcnt vmcnt(0)" ::: "memory");
        }
    }
    __syncthreads();
}

#define PH_COMMON \
    KArgP ap = argp(); unsigned char* ws = ap->ws; (void)ws; \
    const int tid = otid(), lane = tid & 63, wid = tid >> 6; (void)lane; (void)wid; \
    const int G = ogrid(), bx = obid(), gw = bx * 8 + wid, NGW = G * 8; (void)gw; (void)NGW; \
    unsigned char* wt = ws + WS_WT; (void)wt; bf16* XB = (bf16*)(ws + WS_XB); (void)XB; bf16* PJ = (bf16*)(ws + WS_PROJ); (void)PJ; \
    unsigned char* dsc = (unsigned char*)ap->out; bf16* Y = (bf16*)(dsc + DO_Y); (void)Y; bf16* KV = (bf16*)(dsc + DO_KV); (void)KV; bf16* MEMB = (bf16*)(dsc + DO_MEMB); (void)MEMB;

__device__ __forceinline__ void ph_input(LAS unsigned char* lds) { PH_COMMON
    convert_rows(ap->x, XB, (size_t)NTOK * DM);
    convert_rows(ap->mem, MEMB, (size_t)NMEM * DM);
}
__device__ __forceinline__ void ph_weights(LAS unsigned char* lds, int l) { KArgP A = argp(); phase_convert_weights(A, l, lds); }
__device__ __forceinline__ void ph_proj(LAS unsigned char* lds, int l) { PH_COMMON
    pg8::Gemm g{1024, 1024, 1024};
    RegSched S{NTOK / 256, LP / 256, (NTOK / 256) * (LP / 256), G, bx, (const char*)XB, (const char*)(wt + WT_WIN), (size_t)256 * 1024 * 2, (size_t)256 * 1024 * 2, 0};
    pg8::EpiProj E{PJ, LP, (bf16*)(dsc + DO_HALO)};
    pg8::gemm_phase(lds, g, S, E);
}
__device__ __forceinline__ void ph_kv(LAS unsigned char* lds, int l) { PH_COMMON
    pg8::Gemm g{1024, 1024, 1024};
    if (bx < G - 128) return;
    RegSched S2{NMEM / 256, 2048 / 256, (NMEM / 256) * (2048 / 256), G, bx - (G - 128), (const char*)MEMB, (const char*)(wt + WT_WKV), (size_t)256 * 1024 * 2, (size_t)256 * 1024 * 2, 0};
    pg8::EpiStore E2{KV, 2048, 1.f};
    pg8::gemm_phase(lds, g, S2, E2);
}
__device__ __forceinline__ void ph_gdn_prep(LAS unsigned char* lds, int l) {
    KArgP A = argp();
    const int G = ogrid(), bx = obid();
    TMARK(20);
    if (bx < NB * 8) fox_ck_task(A, l, lds, bx >> 3, bx & 7);
    { GdnPre P, N; if (bx < NB * 4 * 32) gdn_prep_issue(P, A, l, bx >> 7, (bx >> 5) & 3, bx & 31);
      for (int t = bx; t < NB * 4 * 32; t += G) { const int t2 = t + G; const bool hn = t2 < NB * 4 * 32;
          gdn_prep_task(A, l, lds, t >> 7, (t >> 5) & 3, t & 31, P, hn, t2 >> 7, (t2 >> 5) & 3, t2 & 31, N);
          P = N; } }
    TMARK(21);
    { GlaPre P, N; if (bx < NB * 4 * 32) gla_prep_issue(P, A, bx >> 7, (bx >> 5) & 3, bx & 31);
      for (int t = bx; t < NB * 4 * 32; t += G) { const int t2 = t + G; const bool hn = t2 < NB * 4 * 32;
          gla_prep_task(A, l, lds, t >> 7, (t >> 5) & 3, t & 31, P, hn, t2 >> 7, (t2 >> 5) & 3, t2 & 31, N);
          P = N; } }
    TMARK(22);
}
__device__ __forceinline__ void ph_gla_scan(LAS unsigned char* lds, int l) { KArgP A = argp(); gla_state_scan(A); }
__device__ __forceinline__ void ph_mix(LAS unsigned char* lds, int l) {
    KArgP A = argp();
    const int bx = obid();
    TMARK(23);
    if (bx < 64) gdn_scan_chain(A, l, lds, bx >> 2, bx & 3);
    TMARK(24);
    unsigned* ctr = (unsigned*)(A->ws + WS_CTL) + 128 + l;
    volatile LAS int* qw = (volatile LAS int*)(lds + LDS_CTL + 2400);
    for (;;) {
        __syncthreads();
        if (otid() == 0) qw[0] = (int)atomicAdd(ctr, 1u);
        __syncthreads();
        const int u = qw[0];
        if (u >= NB * 8 * 8 + NB * 4 * 32) break;
        if (u < NB * 8 * 8) { TMARK(26); const int qb = 7 - (u >> 7), bh = u & 127; fox_unit(A, l, lds, bh >> 3, bh & 7, qb); TMARK(27); }
        else { TMARK(28); const int t = u - NB * 8 * 8; gla_out_task(A, l, lds, t >> 7, (t >> 5) & 3, t & 31); TMARK(29); }
    }
    TMARK(25);
}
#ifndef PROBE_MIX
#define PROBE_MIX 0
#endif
__device__ __forceinline__ void ph_mix_probe(LAS unsigned char* lds, int l) {
    KArgP A = argp();
    const int bx = obid();
    if (PROBE_MIX == 1) {
        unsigned* ctr = (unsigned*)(A->ws + WS_CTL) + 132 + l;
        volatile LAS int* qw = (volatile LAS int*)(lds + LDS_CTL + 2400);
        for (;;) { __syncthreads(); if (otid() == 0) qw[0] = (int)atomicAdd(ctr, 1u); __syncthreads(); const int u = qw[0]; if (u >= NB * 8 * 8) break;
            const int qb = 7 - (u >> 7), bh = u & 127; fox_unit(A, l, lds, bh >> 3, bh & 7, qb, 5152); }
    }
    else if (PROBE_MIX == 3) { if (bx < 64) gdn_scan_chain(A, l, lds, bx >> 2, bx & 3, 5152); }
    else if (PROBE_MIX == 4) { const int G = ogrid(); GdnPre P, N; for (int t = bx; t < NB * 4 * 32; t += G) { gdn_prep_issue(P, A, l, t >> 7, (t >> 5) & 3, t & 31); gdn_prep_task(A, l, lds, t >> 7, (t >> 5) & 3, t & 31, P, false, 0, 0, 0, N, true); } }
}
__device__ __forceinline__ void ph_branch(LAS unsigned char* lds, int l) { PH_COMMON
    pg8::Gemm g{LP, 512, 512};
    BranchSched S{NTOK / 256, (NTOK / 256) * 12, G, bx, (const char*)PJ, (const char*)(wt + WT_P)};
    pg8::EpiStore E{PJ, LP, 1.f};
    pg8::gemm_phase(lds, g, S, E);
}
__device__ __forceinline__ void ph_gate(LAS unsigned char* lds, int l) { PH_COMMON
    pg8::Gemm g{1024, 1024, 1024};
    GateSched S{NTOK / 256, (NTOK / 256) * 4, G, bx, (const char*)XB, (const char*)(wt + WT_WIN + (size_t)LP * 1024 * 2)};
    pg8::EpiGate E{PJ, LP, ap->b_merge + (size_t)l * 3072};
    pg8::gemm_phase(lds, g, S, E);
}
__device__ __forceinline__ void ph_branch_gate(LAS unsigned char* lds, int l) { PH_COMMON
    pg8::Gemm g0{LP, 512, 512}, g1{1024, 1024, 1024};
    MixSched S{NTOK / 256, (NTOK / 256) * 4, G, bx, (const char*)PJ, (const char*)(wt + WT_P), (const char*)XB, (const char*)(wt + WT_WIN + (size_t)LP * 1024 * 2)};
    pg8::EpiStore E0{PJ, LP, 1.f};
    pg8::EpiGate E1{PJ, LP, ap->b_merge + (size_t)l * 3072};
    pg8::gemm_phase_mix(lds, g0, g1, S, E0, E1);
}
__device__ __forceinline__ void ph_out(LAS unsigned char* lds, int l) { PH_COMMON
    pg8::Gemm g{LP, 1024, 1024};
    RegSched S{NTOK / 256, 4, (NTOK / 256) * 4, G, bx, (const char*)(PJ + C_T), (const char*)(wt + WT_WOUT3), (size_t)256 * LP * 2, (size_t)256 * 1024 * 2, 0};
    pg8::EpiResidStat E{XB, Y};
    pg8::gemm_phase(lds, g, S, E);
}
__device__ __forceinline__ void ph_ln1(LAS unsigned char* lds, int l) { PH_COMMON
    const float* gg = ap->ln1_g + l * 1024; const float* bb = ap->ln1_b + l * 1024;
    LnW W; ln_weights(W, gg, bb, lane);
    for (int row = gw; row < NTOK; row += NGW) { LnRow r; ln_load_bf16(r, Y + (size_t)row * 1024, lane, 1.f); ln_normalize_w(r, W); ln_store_bf16(r, XB + (size_t)row * 1024, lane); }
}
__device__ __forceinline__ void ph_q(LAS unsigned char* lds, int l) { PH_COMMON
    bf16* Qb = (bf16*)(ws + WS_PROJ + PJ_Q);
    pg8::Gemm g{1024, 1024, 1024};
    RegSched S{NTOK / 256, 4, (NTOK / 256) * 4, G, bx, (const char*)Y, (const char*)(wt + WT_WQ), (size_t)256 * 1024 * 2, (size_t)256 * 1024 * 2, 0};
    pg8::EpiQFold E{Qb, l, (LAS f32x2*)(lds + LDS_X)};
    pg8::gemm_phase(lds, g, S, E);
}
__device__ __forceinline__ void ph_xattn(LAS unsigned char* lds, int l) { PH_COMMON
    bf16* Qb = (bf16*)(ws + WS_PROJ + PJ_Q); bf16* Ob = (bf16*)(ws + WS_PROJ + PJ_O);
    xattn_phase(lds, Qb, KV, Ob, G, bx);
}
__device__ __forceinline__ void ph_wo(LAS unsigned char* lds, int l) { PH_COMMON
    bf16* Ob = (bf16*)(ws + WS_PROJ + PJ_O);
    pg8::Gemm g{1024, 1024, 1024};
    RegSched S{NTOK / 256, 4, (NTOK / 256) * 4, G, bx, (const char*)Ob, (const char*)(wt + WT_WO), (size_t)256 * 1024 * 2, (size_t)256 * 1024 * 2, 0};
    pg8::EpiResidLN E{Y, l, (LAS f32x2*)(lds + LDS_X)};
    pg8::gemm_phase(lds, g, S, E);
}
__device__ __forceinline__ void ph_ln2_router(LAS unsigned char* lds, int l, int cnt_off = 0) { PH_COMMON
    unsigned* ctl = (unsigned*)(ws + WS_CTL);
    int* tokE = (int*)(ws + WS_SMALL + SM_TOKE); float* tokW = (float*)(ws + WS_SMALL + SM_TOKW); int* tokR = (int*)(ws + WS_SMALL + SM_TOKR);
    const int l15 = lane & 15, g = lane >> 4;
    constexpr int SX = 2064;
    LAS unsigned char* XH = lds; LAS unsigned char* XL = lds + 16 * SX;
    LAS float* PART = (LAS float*)(lds + 2 * 16 * SX);
    LAS float* LOG = PART + 8 * 16 * 48;
    unsigned* wcnt = ctl + 16384 + l * 8192 + cnt_off * 64;
    LAS unsigned* lcnt = (LAS unsigned*)(lds + LDS_CTL + 2560);
    const float* gg = ap->ln2_g + l * 1024; const float* bb = ap->ln2_b + l * 1024;
    const float* bgp = ap->moe_b_group + l * 4; const float* bep = ap->moe_b_expert + l * 32;
    bf16x8 bh[3][4], bl[3][4];
    { const bf16* RH = (const bf16*)(wt + WT_RWH); const bf16* RL = (const bf16*)(wt + WT_RWL);
#pragma unroll
      for (int nb = 0; nb < 3; ++nb)
#pragma unroll
          for (int kk = 0; kk < 4; ++kk) { const size_t off = (size_t)(nb * 16 + l15) * 1024 + (4 * wid + kk) * 32 + 8 * g; bh[nb][kk] = *(const bf16x8*)(RH + off); bl[nb][kk] = *(const bf16x8*)(RL + off); } }
    __syncthreads();
    if (tid < 32) lcnt[tid] = 0u;
    LnW LW; ln_weights(LW, gg, bb, lane);
    u32x4 yp[2][2];
    if (bx < NTOK / 16) {
#pragma unroll
        for (int q = 0; q < 2; ++q)
#pragma unroll
            for (int jj = 0; jj < 2; ++jj) yp[q][jj] = *(const u32x4*)(Y + ((size_t)bx * 16 + wid * 2 + q) * 1024 + 8 * (lane + 64 * jj)); }
    for (int bt = bx; bt < NTOK / 16; bt += G) {
#pragma unroll
        for (int q = 0; q < 2; ++q) { const int rl = wid * 2 + q; const size_t row = (size_t)bt * 16 + rl;
            LnRow r;
#pragma unroll
            for (int jj = 0; jj < 2; ++jj) { const u32x4 t = yp[q][jj];
                r.v[jj * 8 + 0] = bflo(t.x); r.v[jj * 8 + 1] = bfhi(t.x); r.v[jj * 8 + 2] = bflo(t.y); r.v[jj * 8 + 3] = bfhi(t.y);
                r.v[jj * 8 + 4] = bflo(t.z); r.v[jj * 8 + 5] = bfhi(t.z); r.v[jj * 8 + 6] = bflo(t.w); r.v[jj * 8 + 7] = bfhi(t.w); }
            if (bt + G < NTOK / 16) {
#pragma unroll
                for (int jj = 0; jj < 2; ++jj) yp[q][jj] = *(const u32x4*)(Y + ((size_t)(bt + G) * 16 + rl) * 1024 + 8 * (lane + 64 * jj)); }
            ln_normalize_w(r, LW); ln_store_bf16(r, XB + row * 1024, lane);
#pragma unroll
            for (int jj = 0; jj < 2; ++jj) { unsigned hw[4], lw[4];
#pragma unroll
                for (int e2 = 0; e2 < 4; ++e2) { const float a = r.v[jj * 8 + 2 * e2], c = r.v[jj * 8 + 2 * e2 + 1]; const unsigned ha = f2bf(a), hc = f2bf(c);
                    hw[e2] = ha | (hc << 16); lw[e2] = pk2(a - bf2f((unsigned short)ha), c - bf2f((unsigned short)hc)); }
                *(LAS u32x4*)(XH + rl * SX + (lane + 64 * jj) * 16) = (u32x4){hw[0], hw[1], hw[2], hw[3]};
                *(LAS u32x4*)(XL + rl * SX + (lane + 64 * jj) * 16) = (u32x4){lw[0], lw[1], lw[2], lw[3]}; } }
        __syncthreads();
        {
            f32x4 acc[3];
#pragma unroll
            for (int nb = 0; nb < 3; ++nb) acc[nb] = (f32x4){0.f, 0.f, 0.f, 0.f};
#pragma unroll
            for (int kk = 0; kk < 4; ++kk) { const bf16x8 ah = frag_rm(XH, SX, 0, 4 * wid + kk, l15, g), al = frag_rm(XL, SX, 0, 4 * wid + kk, l15, g);
#pragma unroll
                for (int nb = 0; nb < 3; ++nb) { acc[nb] = MFMA16(ah, bh[nb][kk], acc[nb]); acc[nb] = MFMA16(ah, bl[nb][kk], acc[nb]); acc[nb] = MFMA16(al, bh[nb][kk], acc[nb]); } }
#pragma unroll
            for (int nb = 0; nb < 3; ++nb)
#pragma unroll
                for (int r = 0; r < 4; ++r) PART[(wid * 16 + 4 * g + r) * 48 + nb * 16 + l15] = acc[nb][r];
        }
        __syncthreads();
        for (int p = tid; p < 16 * 48; p += 512) { float s = 0.f;
#pragma unroll
            for (int w = 0; w < 8; ++w) s += PART[w * 16 * 48 + p];
            LOG[p] = s; }
        __syncthreads();
        if (tid < 16) { const size_t row = (size_t)bt * 16 + tid; const LAS float* lg = LOG + tid * 48;
            float gl[4];
#pragma unroll
            for (int c = 0; c < 4; ++c) gl[c] = lg[c] + bgp[c];
            int gsel = 0; float gm = gl[0];
#pragma unroll
            for (int c = 1; c < 4; ++c) if (gl[c] > gm) { gm = gl[c]; gsel = c; }
            float gsum = 0.f;
#pragma unroll
            for (int c = 0; c < 4; ++c) gsum += __expf(gl[c] - gm);
            const float ptop = 1.f / gsum;
            float el[8];
#pragma unroll
            for (int jx = 0; jx < 8; ++jx) el[jx] = lg[4 + gsel * 8 + jx] + bep[gsel * 8 + jx];
            int e0 = 0; float m0 = el[0];
#pragma unroll
            for (int jx = 1; jx < 8; ++jx) if (el[jx] > m0) { m0 = el[jx]; e0 = jx; }
            int e1 = -1; float m1 = -3.0e38f;
#pragma unroll
            for (int jx = 0; jx < 8; ++jx) if (jx != e0 && el[jx] > m1) { m1 = el[jx]; e1 = jx; }
            const float ex = __expf(m1 - m0); const float w0 = ptop / (1.f + ex), w1 = ptop * ex / (1.f + ex);
            const int ge0 = gsel * 8 + e0, ge1 = gsel * 8 + e1;
            const int r0 = (int)__hip_atomic_fetch_add(lcnt + ge0, 1u, __ATOMIC_RELAXED, __HIP_MEMORY_SCOPE_WORKGROUP), r1 = (int)__hip_atomic_fetch_add(lcnt + ge1, 1u, __ATOMIC_RELAXED, __HIP_MEMORY_SCOPE_WORKGROUP);
            tokE[row * 2] = ge0; tokE[row * 2 + 1] = ge1; tokW[row * 2] = w0; tokW[row * 2 + 1] = w1; tokR[row * 2] = r0; tokR[row * 2 + 1] = r1;
            unsigned char* lst = dsc + DO_LIST; const unsigned char il = (unsigned char)(((bt - bx) / G) * 16 + tid);
            lst[((size_t)bx * 32 + ge0) * 256 + r0] = il; lst[((size_t)bx * 32 + ge1) * 256 + r1] = il; }
    }
    __syncthreads();
    if (tid < 32) wcnt[bx * 32 + tid] = lcnt[tid];
}
__device__ __forceinline__ void ph_dispatch(LAS unsigned char* lds, int l) { PH_COMMON
    unsigned* ctl = (unsigned*)(ws + WS_CTL);
    int* tokE = (int*)(ws + WS_SMALL + SM_TOKE); int* tokR = (int*)(ws + WS_SMALL + SM_TOKR); int* tokS = (int*)(ws + WS_SMALL + SM_TOKS);
    int* slotTok = (int*)(ws + WS_SMALL + SM_SLOTTOK);
    LAS int* tab = (LAS int*)(lds + LDS_CTL);
    __syncthreads();
    {
        const unsigned* wcnt = ctl + 16384 + l * 8192;
        LAS int* red = (LAS int*)lds;
        const int e = tid & 31, part = tid >> 5; int tot = 0, pre = 0;
        for (int w = part; w < G; w += 16) { const int c = (int)wcnt[w * 32 + e]; tot += c; if (w < bx) pre += c; }
        red[(part * 32 + e) * 2] = tot; red[(part * 32 + e) * 2 + 1] = pre;
        __syncthreads();
        if (tid < 32) { int t2 = 0, p2 = 0; for (int p = 0; p < 16; ++p) { t2 += red[(p * 32 + tid) * 2]; p2 += red[(p * 32 + tid) * 2 + 1]; } tab[360 + tid] = t2; tab[400 + tid] = p2; }
        __syncthreads();
    }
    if (tid == 0) { int ps = 0, nb = 0;
        for (int e = 0; e < 32; ++e) { const int c = tab[360 + e]; const int nbe = (c + 255) >> 8; tab[320 + e] = ps;
            for (int q = 0; q < nbe; ++q) tab[1 + nb + q] = e; nb += nbe; ps += nbe * 256; }
        tab[352] = ps; tab[0] = nb; }
    __syncthreads();
    for (int i = tid; ; i += 512) { const int bt = bx + (i >> 4) * G; if (bt >= NTOK / 16) break; const int row = bt * 16 + (i & 15);
        const int e0 = tokE[row * 2], e1 = tokE[row * 2 + 1]; const int s0 = tab[320 + e0] + tab[400 + e0] + tokR[row * 2], s1 = tab[320 + e1] + tab[400 + e1] + tokR[row * 2 + 1];
        tokS[row * 2] = s0; tokS[row * 2 + 1] = s1; slotTok[s0] = row; slotTok[s1] = row;
    }
    for (int e = 0; e < 32; ++e) { const int c = tab[360 + e], st = tab[320 + e] + c, en = tab[320 + e] + (((c + 255) >> 8) << 8);
        for (int rr = st + bx * 512 + tid; rr < en; rr += G * 512) slotTok[rr] = 0; }
}
__device__ __forceinline__ void ph_moe_gu(LAS unsigned char* lds, int l) { PH_COMMON
    bf16* Hb = (bf16*)(ws + WS_PROJ + PJ_H);
    unsigned* ctl = (unsigned*)(ws + WS_CTL);
    int* tokE = (int*)(ws + WS_SMALL + SM_TOKE); int* tokR = (int*)(ws + WS_SMALL + SM_TOKR); int* tokS = (int*)(ws + WS_SMALL + SM_TOKS);
    const unsigned char* lst = dsc + DO_LIST;
    LAS int* tab = (LAS int*)(lds + LDS_CTL);
    LAS int* PFX = (LAS int*)lds;
    LAS int* CH = (LAS int*)(lds + 40960);
    LAS int* gtab = (LAS int*)(lds + LDS_X);
    __syncthreads();
    {   const unsigned* wcnt = ctl + 16384 + l * 8192;
        const int e = tid & 31, ch = tid >> 5; int c[16], sum = 0;
#pragma unroll
        for (int i = 0; i < 16; ++i) { const int w = ch * 16 + i; c[i] = w < G ? (int)wcnt[w * 32 + e] : 0; sum += c[i]; }
        CH[ch * 32 + e] = sum;
        __syncthreads();
        int base = 0;
        for (int p = 0; p < ch; ++p) base += CH[p * 32 + e];
#pragma unroll
        for (int i = 0; i < 16; ++i) { PFX[e * 260 + ch * 16 + i] = base; base += c[i]; }
        if (ch == 15) { PFX[e * 260 + 256] = base; tab[360 + e] = base; }
        __syncthreads();
        if (tid < 32) tab[400 + tid] = PFX[tid * 260 + bx];
    }
    if (tid == 0) { int ps = 0, nb = 0;
        for (int e = 0; e < 32; ++e) { const int c = tab[360 + e]; const int nbe = (c + 255) >> 8; tab[320 + e] = ps;
            for (int q = 0; q < nbe; ++q) tab[1 + nb + q] = e; nb += nbe; ps += nbe * 256; }
        tab[352] = ps; tab[0] = nb; }
    __syncthreads();
    for (int i = tid; ; i += 512) { const int bt = bx + (i >> 4) * G; if (bt >= NTOK / 16) break; const int row = bt * 16 + (i & 15);
        const int e0 = tokE[row * 2], e1 = tokE[row * 2 + 1];
        tokS[row * 2] = tab[320 + e0] + tab[400 + e0] + tokR[row * 2]; tokS[row * 2 + 1] = tab[320 + e1] + tab[400 + e1] + tokR[row * 2 + 1]; }
    { const int nu = tab[0] * 2;
      int jl[2], ee[2], lo[2]; bool act[2], real[2];
#pragma unroll
      for (int q = 0; q < 2; ++q) { const int j = 2 * q + (tid >> 8), L = j * G + bx; act[q] = L < nu; const int rb = act[q] ? (L >> 1) : 0; ee[q] = tab[1 + rb];
          jl[q] = rb * 256 + (tid & 255) - tab[320 + ee[q]]; real[q] = act[q] && jl[q] < tab[360 + ee[q]]; lo[q] = 0; }
#pragma unroll
      for (int st = 128; st >= 1; st >>= 1)
#pragma unroll
          for (int q = 0; q < 2; ++q) { const int v = PFX[ee[q] * 260 + lo[q] + st]; if (v <= jl[q]) lo[q] += st; }
#pragma unroll
      for (int q = 0; q < 2; ++q) { int tok = 0;
          if (real[q]) { const int il = (int)lst[((size_t)lo[q] * 32 + ee[q]) * 256 + (jl[q] - PFX[ee[q] * 260 + lo[q]])]; tok = (lo[q] + (il >> 4) * G) * 16 + (il & 15); }
          if (act[q]) gtab[(2 * q + (tid >> 8)) * 256 + (tid & 255)] = tok; } }
    __syncthreads();
    pg8::Gemm g{1024, 1024, 1024};
    MoeSched S{2, G, bx, tab, (const char*)XB, 0, (const char*)(wt + WT_GU), (size_t)512 * 1024 * 2, (size_t)256 * 1024 * 2};
    pg8::EpiSwiglu E{Hb, 256};
    pg8::gemm_phase_gather(lds, g, S, E, (const char*)XB, gtab);
}
__device__ __forceinline__ void ph_moe_dn(LAS unsigned char* lds, int l) { PH_COMMON
    bf16* Hb = (bf16*)(ws + WS_PROJ + PJ_H); bf16* YS = (bf16*)(ws + WS_PROJ + PJ_YS);
    const LAS int* tab = (const LAS int*)(lds + LDS_CTL);
    pg8::Gemm g{256, 256, 256};
    MoeSched S{4, G, bx, tab, (const char*)Hb, (size_t)256 * 256 * 2, (const char*)(wt + WT_DN), (size_t)1024 * 256 * 2, (size_t)256 * 256 * 2};
    pg8::EpiStore E{YS, 1024, 1.f};
    pg8::gemm_phase(lds, g, S, E);
}
__device__ __forceinline__ void ph_ln3(LAS unsigned char* lds, int l) { PH_COMMON
    float* tokW = (float*)(ws + WS_SMALL + SM_TOKW); int* tokS = (int*)(ws + WS_SMALL + SM_TOKS);
    bf16* YS = (bf16*)(ws + WS_PROJ + PJ_YS);
    const float* gg = ap->ln3_g + l * 1024; const float* bb = ap->ln3_b + l * 1024;
    float* out = ap->out;
    LnW W; ln_weights(W, gg, bb, lane);
    for (int row = gw; row < NTOK; row += NGW) {
        LnRow r; ln_load_bf16(r, XB + (size_t)row * 1024, lane, ALPHA);
        ln_add_bf16(r, YS + (size_t)tokS[row * 2] * 1024, lane, tokW[row * 2]); ln_add_bf16(r, YS + (size_t)tokS[row * 2 + 1] * 1024, lane, tokW[row * 2 + 1]);
        ln_normalize_w(r, W);
        if (l == DEPTH - 1) ln_store_f32(r, out + (size_t)row * 1024, lane); else ln_store_bf16(r, XB + (size_t)row * 1024, lane);
    }
}

#define GSYNC() grid_barrier(lds)
template <int l> __device__ __forceinline__ void layer_body(LAS unsigned char* lds) {

        TMARK(0);
        if (PH_MASK & 2) { ph_proj(lds, l); ph_kv(lds, l); }
        if (REP_MASK & 2) { GSYNC(); ph_proj(lds, l); ph_kv(lds, l); }
        GSYNC();
        TMARK(1);
        if (PH_MASK & 4) { if (PROBE_MIX == 4) { ph_mix_probe(lds, l); GSYNC(); } ph_gdn_prep(lds, l); GSYNC(); TMARK(2); ph_gla_scan(lds, l); GSYNC(); TMARK(3); if (PROBE_MIX && PROBE_MIX != 4) { ph_mix_probe(lds, l); GSYNC(); } ph_mix(lds, l); }
        GSYNC();
        TMARK(4);
        if (PH_MASK & 8) ph_branch_gate(lds, l);
        TMARK(5);
        GSYNC();
        TMARK(6);
        if (PH_MASK & 32) ph_out(lds, l);
        if (REP_MASK & 32) { GSYNC(); ph_out(lds, l); }
        GSYNC();
        TMARK(7);
        TMARK(8);
        if (PH_MASK & 128) ph_q(lds, l);
        asm volatile("s_waitcnt vmcnt(0)" ::: "memory");
        __syncthreads();
        if (otid() == 0) { __builtin_amdgcn_fence(__ATOMIC_ACQUIRE, "agent"); asm volatile("s_waitcnt vmcnt(0)" ::: "memory"); }
        __syncthreads();
        TMARK(9);
        if (PH_MASK & 256) ph_xattn(lds, l);
        if (REP_MASK & 256) { GSYNC(); ph_xattn(lds, l); }
        GSYNC();
        TMARK(10);
        if (PH_MASK & 512) ph_wo(lds, l);
        if (REP_MASK & 512) { GSYNC(); ph_wo(lds, l); }
        GSYNC();
        TMARK(11);
        if (REP_MASK & 1024) { ph_ln2_router(lds, l, 512); GSYNC(); }
        if (PH_MASK & 1024) ph_ln2_router(lds, l);
        GSYNC();
        TMARK(12);
        TMARK(13);
        if (PH_MASK & 4096) ph_moe_gu(lds, l);
        if (REP_MASK & 4096) { GSYNC(); ph_moe_gu(lds, l); }
        GSYNC();
        TMARK(14);
        if (PH_MASK & 8192) ph_moe_dn(lds, l);
        if (REP_MASK & 8192) { GSYNC(); ph_moe_dn(lds, l); }
        GSYNC();
        TMARK(15);
        if (PH_MASK & 16384) ph_ln3(lds, l);
        if ((REP_MASK & 16384) && l == DEPTH - 1) { GSYNC(); ph_ln3(lds, l); }
        if (l + 1 < DEPTH) { if (PH_MASK & 1) ph_weights(lds, l + 1); GSYNC(); }
        TMARK(16);
}

__global__ void __launch_bounds__(512, 2) mega_fwd(Args A_unused) {
    extern __shared__ __attribute__((aligned(16))) unsigned char lds_raw[];
    LAS unsigned char* lds = (LAS unsigned char*)lds_raw;
    cg::grid_group grid = cg::this_grid();
    {
        volatile LAS unsigned* st = (volatile LAS unsigned*)(lds + LDS_CTL + 2048);
        if (threadIdx.x < 2) st[threadIdx.x] = 0u;
        if (threadIdx.x == 0) { unsigned* bar = (unsigned*)(argp()->ws + WS_CTL) + CW_BAR; (void)xb_add(&bar[XB_XCNT(xb_xcc_id())], 1u); }
        __syncthreads();
    }
    ph_input(lds);
    if (PH_MASK & 1) ph_weights(lds, 0);
    if (argp()->ws == nullptr) grid.sync();
    GSYNC();
    if (TIMER_A >= 0 || TIMER_B >= 0) { if (otid() < 2) ((volatile LAS unsigned*)(lds + LDS_CTL + 2800))[otid()] = 0u; }
    layer_body<0>(lds);
    layer_body<1>(lds);
    if (TIMER_A >= 0 || TIMER_B >= 0) {
        GSYNC();
        if (obid() == TIMER_WG) { volatile LAS unsigned* tw = (volatile LAS unsigned*)(lds + LDS_CTL + 2800); float* out = argp()->out;
            if (TIMER_A >= 0) { const int nz = (tw[0] / 100u > (unsigned)TIMER_T) ? 16000 : 0; for (int i = otid(); i < nz * 1024; i += 512) out[i] = 0.f; }
            if (TIMER_B >= 0 && otid() == 0) out[(size_t)NTOK * 1024 - 1] = (float)(tw[1] / 100u) * 0.25f; }
    }
}

extern "C" void kernel_launch(void* const* d_in, const int* in_sizes, int n_in, void* d_out, int out_size, void* d_ws, size_t ws_size, hipStream_t stream) {
    static int grid = 0;
    if (grid == 0) {
        if (n_in != 32 || out_size != NTOK * DM || ws_size < WS_END) { fprintf(stderr, "kernel_launch: unexpected shapes (n_in %d out %d ws %zu)\n", n_in, out_size, ws_size); grid = -1; return; }
        int dev = 0, cus = 0, per_cu = 0;
        hipGetDevice(&dev); hipDeviceGetAttribute(&cus, hipDeviceAttributeMultiprocessorCount, dev);
        hipFuncSetAttribute((const void*)mega_fwd, hipFuncAttributeMaxDynamicSharedMemorySize, LDS_BYTES);
        hipOccupancyMaxActiveBlocksPerMultiprocessor(&per_cu, (const void*)mega_fwd, 512, LDS_BYTES);
        (void)hipGetLastError();
        if (per_cu < 1) { fprintf(stderr, "kernel_launch: occupancy query says %d blocks per CU\n", per_cu); grid = -1; return; }
        grid = cus;
        if (grid < 192) { fprintf(stderr, "kernel_launch: too few CUs (%d)\n", grid); grid = -1; return; }
    }
    if (grid < 0) return;
    hipMemsetAsync((char*)d_ws + WS_CTL, 0, 1 * MiB, stream);
    Args a{};
    const float** p = (const float**)&a;
    for (int i = 0; i < 32; ++i) p[i] = (const float*)d_in[i];
    a.out = (float*)d_out; a.ws = (unsigned char*)d_ws;
    void* args[] = {&a};
    hipError_t e = hipLaunchCooperativeKernel((const void*)mega_fwd, dim3(grid), dim3(512), args, LDS_BYTES, stream);
    if (e != hipSuccess) fprintf(stderr, "cooperative launch failed: %s (grid %d)\n", hipGetErrorString(e), grid);
}
```
